# Optimizing an MI355X kernel written in HIP

```python
import math
import jax
import jax.numpy as jnp
from jax import lax
import numpy as np

D_MODEL = 1024
BATCH = 1
SEQ = 16384
DEPTH = 4

N_A_LAYERS = DEPTH // 2
N_B_LAYERS = DEPTH - N_A_LAYERS

HEAD_DIM = 64
Q_BLOCK = 128
LN_EPS = 1e-5
NEG_INF = -1e30
TINY = 1e-30
F32 = jnp.float32

A_WINDOWS = (128, 512, 2048)
A_DILATIONS = (1, 4, 16)
A_N_GROUPS = len(A_WINDOWS)
A_HEADS = D_MODEL // HEAD_DIM
A_WIDTH = A_HEADS * HEAD_DIM
A_IN_COLS = A_N_GROUPS * 3 * A_WIDTH

B_HEADS = D_MODEL // HEAD_DIM
B_KV_GROUPS = 4
B_HPG = B_HEADS // B_KV_GROUPS
B_WIDTH = B_HEADS * HEAD_DIM
B_N_BRANCH = 3
B_Q_COLS = B_WIDTH + B_N_BRANCH * B_HEADS
B_KV_COLS = 2 * B_N_BRANCH * B_KV_GROUPS * HEAD_DIM
CMP_LEN = 32
CMP_STRIDE = 16
CMP_HIDDEN = 256
SLC_BLOCK = 64
N_SELECT = 16
WIN = 512
FORCE_SCORE = 1e4

N_EXPERT_GROUPS = 4
EXPERTS_PER_GROUP = 4
N_EXPERTS = N_EXPERT_GROUPS * EXPERTS_PER_GROUP
TOP_K_EXPERTS = 2
D_EXPERT = 256
MOE_CHUNK = 2048

DEEPNORM_ALPHA = (2.0 * DEPTH) ** 0.25
DEEPNORM_BETA = (8.0 * DEPTH) ** -0.25

kernel_name = 'yoco_dilated_nsa_hmoe_deepnorm'


def _alibi_slopes(n):
    return jnp.asarray(2.0 ** (-8.0 * np.arange(1, n + 1) / n), dtype=F32)


def layer_norm(x, g, b):
    xf = x.astype(F32)
    mu = jnp.mean(xf, axis=-1, keepdims=True)
    var = jnp.mean(jnp.square(xf - mu), axis=-1, keepdims=True)
    return ((xf - mu) * lax.rsqrt(var + LN_EPS) * g + b).astype(x.dtype)


def _masked_softmax(s, mask):
    s = jnp.where(mask, s, NEG_INF)
    m = jnp.max(s, axis=-1, keepdims=True)
    p = jnp.where(mask, jnp.exp(s - m), 0.0)
    return p / jnp.maximum(jnp.sum(p, axis=-1, keepdims=True), TINY)


def dilated_attention(h, w_in, w_out):
    bsz, seq, _ = h.shape
    qkv = jnp.einsum('bsd,dc->bsc', h, w_in).reshape(bsz, seq, A_N_GROUPS, 3, A_HEADS, HEAD_DIM)
    q_groups = [qkv[:, :, g, 0] for g in range(A_N_GROUPS)]
    k_groups = [qkv[:, :, g, 1] for g in range(A_N_GROUPS)]
    v_groups = [qkv[:, :, g, 2] for g in range(A_N_GROUPS)]
    slopes = _alibi_slopes(A_HEADS)[:, None, None]
    scale = HEAD_DIM ** -0.5

    def block(i):
        t0 = i * Q_BLOCK
        t = t0 + jnp.arange(Q_BLOCK)
        outs, lses = [], []
        for g in range(A_N_GROUPS):
            dil = A_DILATIONS[g]
            dist = jnp.arange(A_WINDOWS[g] // dil + 1) * dil
            idx = t[:, None] - dist[None, :]
            valid = idx >= 0
            idx = jnp.maximum(idx, 0)
            qb = lax.dynamic_slice_in_dim(q_groups[g], t0, Q_BLOCK, axis=1)
            kb = jnp.take(k_groups[g], idx, axis=1)
            vb = jnp.take(v_groups[g], idx, axis=1)
            s = jnp.einsum('bqhd,bqkhd->bhqk', qb, kb).astype(F32) * scale - slopes * dist.astype(F32)
            s = jnp.where(valid, s, NEG_INF)
            m = jnp.max(s, axis=-1, keepdims=True)
            p = jnp.exp(s - m)
            l = jnp.sum(p, axis=-1, keepdims=True)
            outs.append(jnp.einsum('bhqk,bqkhd->bqhd', p / l, vb))
            lses.append(jnp.transpose((m + jnp.log(l))[..., 0], (0, 2, 1)))
        w = jax.nn.softmax(jnp.stack(lses, axis=0), axis=0)
        o = w[0][..., None] * outs[0]
        for g in range(1, A_N_GROUPS):
            o = o + w[g][..., None] * outs[g]
        return o

    o = lax.map(block, jnp.arange(seq // Q_BLOCK))
    o = jnp.transpose(o, (1, 0, 2, 3, 4)).reshape(bsz, seq, A_WIDTH)
    return jnp.einsum('bsc,cd->bsd', o, w_out).astype(h.dtype)


def nsa_shared_kv(h, w_kv, cmp_pos, cmp_w1, cmp_b1, cmp_w2, cmp_b2):
    bsz, seq, _ = h.shape
    kv = jnp.einsum('bsd,dc->bsc', h, w_kv).reshape(bsz, seq, 2 * B_N_BRANCH, B_KV_GROUPS, HEAD_DIM)
    r = CMP_LEN // CMP_STRIDE
    n_chunks = seq // CMP_STRIDE
    n_cmp = n_chunks - r + 1

    def compress(u, j):
        c = u.reshape(bsz, n_chunks, CMP_STRIDE, B_KV_GROUPS, HEAD_DIM)
        blocks = jnp.concatenate([c[:, o:o + n_cmp] for o in range(r)], axis=2)
        blocks = blocks + cmp_pos[j][:, None, :]
        flat = jnp.transpose(blocks, (0, 1, 3, 2, 4)).reshape(bsz, n_cmp, B_KV_GROUPS, CMP_LEN * HEAD_DIM)
        hid = jax.nn.gelu(flat @ cmp_w1[j] + cmp_b1[j])
        return hid @ cmp_w2[j] + cmp_b2[j]

    k_cmp = compress(kv[:, :, 0], 0)
    v_cmp = compress(kv[:, :, 1], 1)
    return (k_cmp, v_cmp, kv[:, :, 2], kv[:, :, 3], kv[:, :, 4], kv[:, :, 5])


def nsa_attention(h, w_q, b_q, w_out, k_cmp, v_cmp, k_slc, v_slc, k_win, v_win):
    bsz, seq, _ = h.shape
    proj = jnp.einsum('bsd,dc->bsc', h, w_q) + b_q
    q = proj[..., :B_WIDTH].reshape(bsz, seq, B_KV_GROUPS, B_HPG, HEAD_DIM)
    gates = jax.nn.sigmoid(proj[..., B_WIDTH:].astype(F32)).reshape(bsz, seq, B_N_BRANCH, B_KV_GROUPS, B_HPG)
    slopes = _alibi_slopes(B_HEADS).reshape(B_KV_GROUPS, B_HPG, 1, 1)
    scale = HEAD_DIM ** -0.5
    n_cmp = k_cmp.shape[1]
    cmp_end = jnp.arange(n_cmp) * CMP_STRIDE + (CMP_LEN - 1)
    n_slc = seq // SLC_BLOCK
    n_sel = min(N_SELECT, n_slc)
    n_keys_sel = n_sel * SLC_BLOCK
    r_s = SLC_BLOCK // CMP_STRIDE
    r_c = CMP_LEN // CMP_STRIDE
    slc_ids = jnp.arange(n_slc)
    map_idx = (r_s * slc_ids[:, None, None] + jnp.arange(r_s)[None, :, None]
               - jnp.arange(r_c)[None, None, :]).reshape(n_slc, r_s * r_c)
    map_valid = ((map_idx >= 0) & (map_idx < n_cmp)).astype(F32)
    map_idx = jnp.clip(map_idx, 0, n_cmp - 1)
    b_ids = jnp.arange(bsz)[:, None, None]
    g_ids = jnp.arange(B_KV_GROUPS)[None, :, None]
    k_win_p = jnp.pad(k_win, ((0, 0), (WIN, 0), (0, 0), (0, 0)))
    v_win_p = jnp.pad(v_win, ((0, 0), (WIN, 0), (0, 0), (0, 0)))

    def block(i):
        t0 = i * Q_BLOCK
        t = t0 + jnp.arange(Q_BLOCK)
        qb = lax.dynamic_slice_in_dim(q, t0, Q_BLOCK, axis=1)
        d_c = t[:, None] - cmp_end[None, :]
        s_c = jnp.einsum('bqgrd,bcgd->bgrqc', qb, k_cmp).astype(F32) * scale - slopes * d_c.astype(F32)
        p_c = _masked_softmax(s_c, d_c >= 0)
        o_c = jnp.einsum('bgrqc,bcgd->bqgrd', p_c, v_cmp)
        imp = jnp.sum(p_c, axis=2)
        p_slc = jnp.sum(jnp.take(imp, map_idx, axis=-1) * map_valid, axis=-1)
        cur = (t // SLC_BLOCK)[:, None]
        forced = (slc_ids[None, :] == 0) | (slc_ids[None, :] == cur) | (slc_ids[None, :] == cur - 1)
        score = jnp.where(forced, FORCE_SCORE, p_slc)
        score = jnp.where(slc_ids[None, :] <= cur, score, -FORCE_SCORE)
        _, sel = lax.top_k(score, n_sel)
        tok = (sel[..., None] * SLC_BLOCK + jnp.arange(SLC_BLOCK)).reshape(bsz, B_KV_GROUPS, Q_BLOCK * n_keys_sel)
        k_s = k_slc[b_ids, tok, g_ids].reshape(bsz, B_KV_GROUPS, Q_BLOCK, n_keys_sel, HEAD_DIM)
        v_s = v_slc[b_ids, tok, g_ids].reshape(bsz, B_KV_GROUPS, Q_BLOCK, n_keys_sel, HEAD_DIM)
        d_s = t[None, None, :, None] - tok.reshape(bsz, B_KV_GROUPS, Q_BLOCK, n_keys_sel)
        s_s = jnp.einsum('bqgrd,bgqkd->bgrqk', qb, k_s).astype(F32) * scale - slopes * d_s[:, :, None].astype(F32)
        p_s = _masked_softmax(s_s, (d_s >= 0)[:, :, None])
        o_s = jnp.einsum('bgrqk,bgqkd->bqgrd', p_s, v_s)
        k_w = lax.dynamic_slice_in_dim(k_win_p, t0, WIN + Q_BLOCK, axis=1)
        v_w = lax.dynamic_slice_in_dim(v_win_p, t0, WIN + Q_BLOCK, axis=1)
        pos_w = t0 - WIN + jnp.arange(WIN + Q_BLOCK)
        d_w = t[:, None] - pos_w[None, :]
        mask_w = (d_w >= 0) & (d_w < WIN) & (pos_w[None, :] >= 0)
        s_w = jnp.einsum('bqgrd,bkgd->bgrqk', qb, k_w).astype(F32) * scale - slopes * d_w.astype(F32)
        p_w = _masked_softmax(s_w, mask_w)
        o_w = jnp.einsum('bgrqk,bkgd->bqgrd', p_w, v_w)
        gb = lax.dynamic_slice_in_dim(gates, t0, Q_BLOCK, axis=1)[..., None]
        return gb[:, :, 0] * o_c + gb[:, :, 1] * o_s + gb[:, :, 2] * o_w

    o = lax.map(block, jnp.arange(seq // Q_BLOCK))
    o = jnp.transpose(o, (1, 0, 2, 3, 4, 5)).reshape(bsz, seq, B_WIDTH)
    return jnp.einsum('bsc,cd->bsd', o, w_out).astype(h.dtype)


def hier_moe(h, w_router, b_router, w_gate_up, w_down):
    bsz, seq, d = h.shape
    n_tok = bsz * seq
    xt = h.reshape(n_tok, d)
    logits = (xt @ w_router + b_router).astype(F32)
    g_logits = logits[:, :N_EXPERT_GROUPS]
    e_logits = logits[:, N_EXPERT_GROUPS:].reshape(n_tok, N_EXPERT_GROUPS, EXPERTS_PER_GROUP)
    p_group = jax.nn.softmax(g_logits, axis=-1)
    g_idx = jnp.argmax(g_logits, axis=-1)
    g_w = jnp.take_along_axis(p_group, g_idx[:, None], axis=1)
    e_in = jnp.take_along_axis(e_logits, g_idx[:, None, None], axis=1)[:, 0]
    e_val, e_idx = lax.top_k(e_in, TOP_K_EXPERTS)
    e_w = jax.nn.softmax(e_val, axis=-1) * g_w
    expert_id = g_idx[:, None] * EXPERTS_PER_GROUP + e_idx
    combine = jnp.sum(jax.nn.one_hot(expert_id, N_EXPERTS, dtype=F32) * e_w[..., None], axis=1)
    chunk = math.gcd(n_tok, MOE_CHUNK)

    def run(args):
        xc, cc = args
        gu = jnp.einsum('td,edf->tef', xc, w_gate_up)
        hid = jax.nn.silu(gu[..., :D_EXPERT]) * gu[..., D_EXPERT:] * cc[..., None].astype(gu.dtype)
        return jnp.einsum('tef,efd->td', hid, w_down)

    y = lax.map(run, (xt.reshape(-1, chunk, d), combine.reshape(-1, chunk, N_EXPERTS)))
    return y.reshape(bsz, seq, d).astype(h.dtype)


def setup_inputs(seed: int = 0) -> dict:
    key = jax.random.key(seed)
    ks = jax.random.split(key, 20)

    def dense(k, shape, fan_in, gain=1.0):
        return jax.random.normal(k, shape, F32) * (gain * fan_in ** -0.5)

    def small(k, shape, s):
        return s * jax.random.normal(k, shape, F32)

    x = jax.random.normal(ks[0], (BATCH, SEQ, D_MODEL), F32)
    v_scale_a = jnp.asarray([1.0, 1.0, DEEPNORM_BETA], F32)[:, None]
    a_w_in = (dense(ks[1], (N_A_LAYERS, D_MODEL, A_N_GROUPS, 3, A_WIDTH), D_MODEL) * v_scale_a).reshape(N_A_LAYERS, D_MODEL, A_IN_COLS)
    a_w_out = dense(ks[2], (N_A_LAYERS, A_WIDTH, D_MODEL), A_WIDTH, DEEPNORM_BETA)
    v_scale_b = jnp.asarray([1.0, DEEPNORM_BETA] * B_N_BRANCH, F32)[:, None]
    b_w_kv = (dense(ks[3], (D_MODEL, 2 * B_N_BRANCH, B_KV_GROUPS * HEAD_DIM), D_MODEL) * v_scale_b).reshape(D_MODEL, B_KV_COLS)
    b_cmp_pos = small(ks[4], (2, CMP_LEN, HEAD_DIM), 0.1)
    b_cmp_w1 = dense(ks[5], (2, CMP_LEN * HEAD_DIM, CMP_HIDDEN), CMP_LEN * HEAD_DIM)
    b_cmp_b1 = small(ks[6], (2, CMP_HIDDEN), 0.01)
    b_cmp_w2 = dense(ks[7], (2, CMP_HIDDEN, HEAD_DIM), CMP_HIDDEN)
    b_cmp_b2 = small(ks[8], (2, HEAD_DIM), 0.01)
    b_w_q = dense(ks[9], (N_B_LAYERS, D_MODEL, B_Q_COLS), D_MODEL)
    b_b_q = small(ks[10], (N_B_LAYERS, B_Q_COLS), 0.01)
    b_w_out = dense(ks[11], (N_B_LAYERS, B_WIDTH, D_MODEL), B_WIDTH, DEEPNORM_BETA)
    moe_w_router = dense(ks[12], (DEPTH, D_MODEL, N_EXPERT_GROUPS + N_EXPERTS), D_MODEL)
    moe_b_router = small(ks[13], (DEPTH, N_EXPERT_GROUPS + N_EXPERTS), 0.01)
    moe_w_gate_up = dense(ks[14], (DEPTH, N_EXPERTS, D_MODEL, 2 * D_EXPERT), D_MODEL)
    moe_w_down = dense(ks[15], (DEPTH, N_EXPERTS, D_EXPERT, D_MODEL), D_EXPERT, DEEPNORM_BETA)
    ln_mix_g = 1.0 + small(ks[16], (DEPTH, D_MODEL), 0.05)
    ln_mix_b = small(ks[17], (DEPTH, D_MODEL), 0.02)
    ln_ffn_g = 1.0 + small(ks[18], (DEPTH, D_MODEL), 0.05)
    ln_ffn_b = small(ks[19], (DEPTH, D_MODEL), 0.02)
    return {'x': x, 'a_w_in': a_w_in, 'a_w_out': a_w_out, 'b_w_kv': b_w_kv,
            'b_cmp_pos': b_cmp_pos, 'b_cmp_w1': b_cmp_w1, 'b_cmp_b1': b_cmp_b1,
            'b_cmp_w2': b_cmp_w2, 'b_cmp_b2': b_cmp_b2, 'b_w_q': b_w_q, 'b_b_q': b_b_q,
            'b_w_out': b_w_out, 'moe_w_router': moe_w_router, 'moe_b_router': moe_b_router,
            'moe_w_gate_up': moe_w_gate_up, 'moe_w_down': moe_w_down,
            'ln_mix_g': ln_mix_g, 'ln_mix_b': ln_mix_b, 'ln_ffn_g': ln_ffn_g, 'ln_ffn_b': ln_ffn_b}


def reference(x, a_w_in, a_w_out, b_w_kv, b_cmp_pos, b_cmp_w1, b_cmp_b1, b_cmp_w2, b_cmp_b2,
              b_w_q, b_b_q, b_w_out, moe_w_router, moe_b_router, moe_w_gate_up, moe_w_down,
              ln_mix_g, ln_mix_b, ln_ffn_g, ln_ffn_b):
    h = x
    shared_kv = None
    for layer in range(DEPTH):
        if layer < N_A_LAYERS:
            mix = dilated_attention(h, a_w_in[layer], a_w_out[layer])
        else:
            if layer == N_A_LAYERS:
                shared_kv = nsa_shared_kv(h, b_w_kv, b_cmp_pos, b_cmp_w1, b_cmp_b1, b_cmp_w2, b_cmp_b2)
            i = layer - N_A_LAYERS
            mix = nsa_attention(h, b_w_q[i], b_b_q[i], b_w_out[i], *shared_kv)
        h = layer_norm(DEEPNORM_ALPHA * h + mix, ln_mix_g[layer], ln_mix_b[layer])
        ffn = hier_moe(h, moe_w_router[layer], moe_b_router[layer], moe_w_gate_up[layer], moe_w_down[layer])
        h = layer_norm(DEEPNORM_ALPHA * h + ffn, ln_ffn_g[layer], ln_ffn_b[layer])
    return h
```

```cpp
#include <hip/hip_runtime.h>
#include <cstdio>
#include <cstdint>
#include <cmath>
namespace pg8 {
#define PG8_LAS __attribute__((address_space(3)))
typedef unsigned short bf16_t;
typedef short bf16x8 __attribute__((ext_vector_type(8)));
typedef float f32x4 __attribute__((ext_vector_type(4)));
typedef unsigned u32x4 __attribute__((ext_vector_type(4)));
constexpr int BM = 256, BK = 64, HALF = 128, HTB = HALF * BK * 2  , STAGE_BYTES = 8 * HTB, NXCD = 8, WGM = 8;

__host__ __device__ __forceinline__ int lds_byte(int r, int c) { const int st = (r >> 4) * 2 + (c >> 5), rr = r & 15, cc = c & 31, ob = rr * 64 + cc * 2; return st * 1024 + (ob ^ (((ob >> 9) & 1) << 5)); }
__host__ __device__ __forceinline__ void stage_rc(int b, int& R, int& C) { const int st = b / 1024, sb = b % 1024, swz = sb ^ (((sb >> 9) & 1) << 5); R = (st >> 1) * 16 + swz / 64; C = (st & 1) * 32 + (swz % 64) / 2; }
__host__ __device__ __forceinline__ int perm32(int rho) { const int n = rho >> 4, i = rho & 15; return 8 * (i >> 2) + 4 * n + (i & 3); }

struct Unit { int pm, pn; };
struct Gemm { const bf16_t* A; const bf16_t* Bt; int M, N, K; };

struct StaticOrder {
    int nM, nN, nwg, G, c;
    __host__ __device__ void init(int M, int N, int G_, int c_) { nM = M / BM; nN = N / BM; nwg = nM * nN; G = G_; c = c_; }
    __host__ __device__ bool next(int i, Unit& u) const {
        const long L = (long)i * G + c; if (L >= nwg) return false;
        int wgid = (int)L; { const int q = nwg / NXCD, r = nwg % NXCD, xcd = wgid % NXCD, off = wgid / NXCD; wgid = (xcd < r ? xcd * (q + 1) : r * (q + 1) + (xcd - r) * q) + off; }
        const int nig = WGM * nN, gid = wgid / nig, fm = gid * WGM, gsz = (nM - fm) < WGM ? (nM - fm) : WGM;
        u.pm = fm + ((wgid % nig) % gsz); u.pn = (wgid % nig) / gsz; return true;
    }
    __device__ __forceinline__ void a_ready(const Unit&) const {}
    __device__ __forceinline__ void done(const Unit&) const {}
};
struct CountedOrder : StaticOrder {
    const unsigned* ready; unsigned need; unsigned* tmo;
    __device__ __forceinline__ void a_ready(const Unit& u) const {
        if (threadIdx.x < 64) {
            const unsigned long long t0 = __builtin_amdgcn_s_memrealtime(); unsigned polls = 0;
            while ((unsigned)__builtin_amdgcn_readfirstlane(__hip_atomic_load(ready + 64 * u.pm, __ATOMIC_RELAXED, __HIP_MEMORY_SCOPE_AGENT)) < need) {
                if ((++polls & 255u) == 0u && __builtin_amdgcn_readfirstlane(__hip_atomic_load(tmo, __ATOMIC_RELAXED, __HIP_MEMORY_SCOPE_AGENT)) != 0u) break;
                if (__builtin_amdgcn_s_memrealtime() - t0 > 2000000ull) {
                    if (threadIdx.x == 0) { unsigned expect = 0u; __hip_atomic_compare_exchange_strong(tmo + 1, &expect, 0x600u | (unsigned)(u.pm & 0xff), __ATOMIC_RELAXED, __ATOMIC_RELAXED, __HIP_MEMORY_SCOPE_AGENT); __hip_atomic_store(tmo, 1u, __ATOMIC_RELAXED, __HIP_MEMORY_SCOPE_AGENT); }
                    break; }
                __builtin_amdgcn_s_sleep(2); }
            __builtin_amdgcn_fence(__ATOMIC_ACQUIRE, "agent");
            asm volatile("s_waitcnt vmcnt(0)" ::: "memory");
        }
#if !defined(BROKEN_HOOK_NO_BARRIER)
        asm volatile("" ::: "memory"); __builtin_amdgcn_s_barrier(); asm volatile("" ::: "memory");
#endif
    }
};

__device__ __forceinline__ unsigned cvt_pk_bf16(float lo, float hi) { unsigned r; asm volatile("v_cvt_pk_bf16_f32 %0, %1, %2" : "=v"(r) : "v"(lo), "v"(hi)); return r; }
typedef float f32x2 __attribute__((ext_vector_type(2)));
__device__ __forceinline__ f32x2 gelu_pk(f32x2 v) {
    const f32x2 av = __builtin_elementwise_abs(v), d = av * 0.2316418882f + 1.0f;
    f32x2 t; t.x = __builtin_amdgcn_rcpf(d.x); t.y = __builtin_amdgcn_rcpf(d.y);
    f32x2 q = t * 0.5307027145f + (-0.7265760135f); q = q * t + 0.7107068705f; q = q * t + (-0.142248368f); q = q * t + 0.127414796f; q = q * t;
    const f32x2 s = (v * v) * (-0.72134752044f);
    f32x2 e; e.x = __builtin_amdgcn_exp2f(s.x); e.y = __builtin_amdgcn_exp2f(s.y);
    const f32x2 m = v * (q * e), r = v - m;
    f32x2 o; o.x = v.x < 0.f ? m.x : r.x; o.y = v.y < 0.f ? m.y : r.y; return o;
}

struct EpiF32 {
    static constexpr bool PERM = false, AFTER_DRAIN = false;
    float* C; int ldc; const float* bias;
    __device__ __forceinline__ void operator()(const f32x4 (&acc)[2][2][4][2], const Unit& u, int wr, int wc, int fr, int fq) const {
        const int row0 = u.pm * BM + wr * 64 + fr, col0 = u.pn * BM + wc * 32 + 4 * fq;
        f32x4 bv[2][2];
#pragma unroll
        for (int bj = 0; bj < 2; ++bj)
#pragma unroll
            for (int n = 0; n < 2; ++n) bv[bj][n] = bias ? *(const f32x4*)(bias + col0 + bj * HALF + n * 16) : (f32x4){0.f, 0.f, 0.f, 0.f};
#pragma unroll
        for (int ai = 0; ai < 2; ++ai)
#pragma unroll
            for (int m = 0; m < 4; ++m) { float* rowp = C + (size_t)(row0 + ai * HALF + m * 16) * ldc + col0;
#pragma unroll
                for (int bj = 0; bj < 2; ++bj)
#pragma unroll
                    for (int n = 0; n < 2; ++n) *(f32x4*)(rowp + bj * HALF + n * 16) = acc[ai][bj][m][n] + bv[bj][n]; }
    }
};
template <int ACT  > struct EpiBf16 {
    static constexpr bool PERM = true, AFTER_DRAIN = false;
    bf16_t* O; int ldc; const float* bias; int split_cols; size_t split_stride;
    __device__ __forceinline__ void operator()(const f32x4 (&acc)[2][2][4][2], const Unit& u, int wr, int wc, int fr, int fq) const {
        const int row0 = u.pm * BM + wr * 64 + fr; int colt = u.pn * BM; bf16_t* base = O;
        if (split_cols) { const int t = colt / split_cols; base += (size_t)t * split_stride; colt -= t * split_cols; }
        const int col0 = colt + wc * 32 + 8 * fq, bcol0 = u.pn * BM + wc * 32 + 8 * fq;
        f32x4 bv[2][2];
#pragma unroll
        for (int bj = 0; bj < 2; ++bj)
#pragma unroll
            for (int n = 0; n < 2; ++n) bv[bj][n] = bias ? *(const f32x4*)(bias + bcol0 + bj * HALF + 4 * n) : (f32x4){0.f, 0.f, 0.f, 0.f};
#pragma unroll
        for (int ai = 0; ai < 2; ++ai)
#pragma unroll
            for (int m = 0; m < 4; ++m) { bf16_t* rowp = base + (size_t)(row0 + ai * HALF + m * 16) * ldc + col0;
#pragma unroll
                for (int bj = 0; bj < 2; ++bj) { f32x4 v0 = acc[ai][bj][m][0] + bv[bj][0], v1 = acc[ai][bj][m][1] + bv[bj][1];
                    if (ACT == 1) { f32x2 a = gelu_pk((f32x2){v0[0], v0[1]}), b = gelu_pk((f32x2){v0[2], v0[3]}), c = gelu_pk((f32x2){v1[0], v1[1]}), d = gelu_pk((f32x2){v1[2], v1[3]});
                        v0 = (f32x4){a.x, a.y, b.x, b.y}; v1 = (f32x4){c.x, c.y, d.x, d.y}; }
                    if (ACT == 2) {
#pragma unroll
                        for (int j = 0; j < 4; ++j) { v0[j] = 0.5f * v0[j] * (1.0f + erff(v0[j] * 0.70710678f)); v1[j] = 0.5f * v1[j] * (1.0f + erff(v1[j] * 0.70710678f)); } }
                    u32x4 w; w.x = cvt_pk_bf16(v0[0], v0[1]); w.y = cvt_pk_bf16(v0[2], v0[3]); w.z = cvt_pk_bf16(v1[0], v1[1]); w.w = cvt_pk_bf16(v1[2], v1[3]);
                    *(u32x4*)(rowp + bj * HALF) = w; } }
    }
};

struct PanelStats {
    unsigned* xbuf;
    unsigned* cnt;
    unsigned* tmo;
    int ntn; float eps;
    unsigned code;
    __device__ __forceinline__ bool run(const f32x4 (&v)[2][2][4][2], const Unit& u, int wr, int wc, int fr, int fq, PG8_LAS unsigned char* lds, int wid, int lane) const {
        typedef float f32x2v __attribute__((ext_vector_type(2)));
        PG8_LAS f32x2v* P = (PG8_LAS f32x2v*)lds;
        PG8_LAS f32x2v* S = (PG8_LAS f32x2v*)(lds + 8192);
        PG8_LAS unsigned* flag = (PG8_LAS unsigned*)(lds + 8192 + 2048);
#pragma unroll
        for (int ai = 0; ai < 2; ++ai)
#pragma unroll
            for (int m = 0; m < 4; ++m) {
                float s = 0.f;
#pragma unroll
                for (int bj = 0; bj < 2; ++bj)
#pragma unroll
                    for (int n = 0; n < 2; ++n) { const f32x4 x = v[ai][bj][m][n]; s += (x[0] + x[1]) + (x[2] + x[3]); }
                s += __shfl_xor(s, 16); s += __shfl_xor(s, 32);
                const float mw = s * (1.0f / 64.0f); float q = 0.f;
#pragma unroll
                for (int bj = 0; bj < 2; ++bj)
#pragma unroll
                    for (int n = 0; n < 2; ++n) { const f32x4 d = v[ai][bj][m][n] - mw; q += (d[0] * d[0] + d[1] * d[1]) + (d[2] * d[2] + d[3] * d[3]); }
                q += __shfl_xor(q, 16); q += __shfl_xor(q, 32);
                if (fq == 0) P[(ai * HALF + wr * 64 + m * 16 + fr) * 4 + wc] = (f32x2v){mw, q};
            }
        asm volatile("s_waitcnt lgkmcnt(0)" ::: "memory"); __builtin_amdgcn_s_barrier(); asm volatile("" ::: "memory");
#if defined(BROKEN_NO_WAIT)
        if (blockIdx.x >= 64) { const long long t0 = clock64(); while (clock64() - t0 < 60000) __builtin_amdgcn_s_sleep(8); }
#endif
        const int row = wid * 32 + (lane & 31);
        if (lane < 32) {
            const f32x2v a = P[row * 4 + 0], b = P[row * 4 + 1], c = P[row * 4 + 2], d = P[row * 4 + 3];
            const float mt = (a.x + b.x + c.x + d.x) * 0.25f;
            const float da = a.x - mt, db = b.x - mt, dc = c.x - mt, dd = d.x - mt;
            const float m2 = (a.y + b.y) + (c.y + d.y) + 64.0f * ((da * da + db * db) + (dc * dc + dd * dd));
            unsigned long long* slot = (unsigned long long*)xbuf + ((size_t)(u.pm * BM + row) * 4 + u.pn);
            __hip_atomic_store(slot, ((unsigned long long)__float_as_uint(m2) << 32) | __float_as_uint(mt), __ATOMIC_RELAXED, __HIP_MEMORY_SCOPE_AGENT);
        }
        asm volatile("s_waitcnt vmcnt(0)" ::: "memory");
        if (lane == 0) __hip_atomic_fetch_add(cnt + 64 * u.pm, 1u, __ATOMIC_RELAXED, __HIP_MEMORY_SCOPE_AGENT);
        if (wid == 0) {
            bool dead = false; const unsigned long long t0 = __builtin_amdgcn_s_memrealtime(); const unsigned want = 8u * (unsigned)ntn;
            for (;;) {
#if defined(BROKEN_NO_WAIT)
                break;
#endif
                if ((unsigned)__builtin_amdgcn_readfirstlane(__hip_atomic_load(cnt + 64 * u.pm, __ATOMIC_RELAXED, __HIP_MEMORY_SCOPE_AGENT)) >= want) break;
                if (__builtin_amdgcn_s_memrealtime() - t0 > 2000000ull) {
                    if (lane == 0) { unsigned expect = 0u; __hip_atomic_compare_exchange_strong(tmo + 1, &expect, code | (unsigned)(u.pm & 0xff), __ATOMIC_RELAXED, __ATOMIC_RELAXED, __HIP_MEMORY_SCOPE_AGENT);
                                     __hip_atomic_store(tmo, 1u, __ATOMIC_RELAXED, __HIP_MEMORY_SCOPE_AGENT); }
                    dead = true; break; }
                __builtin_amdgcn_s_sleep(2);
            }
            __builtin_amdgcn_fence(__ATOMIC_ACQUIRE, "agent");
            if (lane == 0) flag[0] = dead ? 1u : 0u;
        }
        asm volatile("s_waitcnt vmcnt(0) lgkmcnt(0)" ::: "memory"); __builtin_amdgcn_s_barrier(); asm volatile("" ::: "memory");
        const bool bad = flag[0] != 0u;
        if (lane < 32) {
            const unsigned long long* slot = (const unsigned long long*)xbuf + (size_t)(u.pm * BM + row) * 4; float mt[4], m2[4]; float ms = 0.f;
#pragma unroll
            for (int t = 0; t < 4; ++t) { if (t < ntn) { const unsigned long long w = __hip_atomic_load(slot + t, __ATOMIC_RELAXED, __HIP_MEMORY_SCOPE_AGENT); mt[t] = __uint_as_float((unsigned)w); m2[t] = __uint_as_float((unsigned)(w >> 32)); } else { mt[t] = 0.f; m2[t] = 0.f; } ms += mt[t]; }
            const float mean = ms / (float)ntn; float q = 0.f;
#pragma unroll
            for (int t = 0; t < 4; ++t) if (t < ntn) { const float dm = mt[t] - mean; q += m2[t] + 256.0f * dm * dm; }
            S[row] = (f32x2v){mean, 1.0f / sqrtf(q / (256.0f * (float)ntn) + eps)};
        }
        asm volatile("s_waitcnt lgkmcnt(0)" ::: "memory"); __builtin_amdgcn_s_barrier(); asm volatile("" ::: "memory");
        return bad;
    }
};
struct EpiLnRes {
    static constexpr bool PERM = false, AFTER_DRAIN = true;
    const float* base; float* out; int ldc; const float* bias; PanelStats st; unsigned poison;
    __device__ __forceinline__ void refuse(size_t i0, size_t stride, int M, int N) const { const float q = __builtin_nanf(""); for (size_t i = i0; i < (size_t)M * N; i += stride) out[(i / N) * ldc + i % N] = q;
        if (i0 == 0) { unsigned expect = 0u; __hip_atomic_compare_exchange_strong(st.tmo + 1, &expect, 0x7f0u, __ATOMIC_RELAXED, __ATOMIC_RELAXED, __HIP_MEMORY_SCOPE_AGENT); __hip_atomic_store(st.tmo, 1u, __ATOMIC_RELAXED, __HIP_MEMORY_SCOPE_AGENT); } }
    __device__ __forceinline__ void fused(f32x4 (&acc)[2][2][4][2], const Unit& u, int wr, int wc, int fr, int fq, PG8_LAS unsigned char* lds, int wid, int lane) const {
        typedef float f32x2v __attribute__((ext_vector_type(2)));
        const PG8_LAS f32x2v* S = (const PG8_LAS f32x2v*)(lds + 8192);
        const int col0 = u.pn * BM + wc * 32 + 4 * fq;
#pragma unroll
        for (int bj = 0; bj < 2; ++bj)
#pragma unroll
            for (int n = 0; n < 2; ++n) { const f32x4 bv = bias ? *(const f32x4*)(bias + col0 + bj * HALF + n * 16) : (f32x4){0.f, 0.f, 0.f, 0.f};
#pragma unroll
                for (int ai = 0; ai < 2; ++ai)
#pragma unroll
                    for (int m = 0; m < 4; ++m) acc[ai][bj][m][n] += bv; }
        const bool bad = st.run(acc, u, wr, wc, fr, fq, lds, wid, lane) || poison != 0u;
        const float qnan = __builtin_nanf("");
#pragma unroll
        for (int ai = 0; ai < 2; ++ai)
#pragma unroll
            for (int m = 0; m < 4; ++m) { const int r = ai * HALF + wr * 64 + m * 16 + fr; const f32x2v sr = S[r]; const size_t off = (size_t)(u.pm * BM + r) * ldc + col0;
#pragma unroll
                for (int bj = 0; bj < 2; ++bj)
#pragma unroll
                    for (int n = 0; n < 2; ++n) { const f32x4 bs = *(const f32x4*)(base + off + bj * HALF + n * 16); f32x4 o = bs + (acc[ai][bj][m][n] - sr.x) * sr.y;
                        if (bad) o = (f32x4){qnan, qnan, qnan, qnan}; *(f32x4*)(out + off + bj * HALF + n * 16) = o; }
                asm volatile("" ::: "memory"); }
    }
};
struct EpiLnResLn {
    static constexpr bool PERM = false, AFTER_DRAIN = true;
    const float* base; float* out; bf16_t* xn; int ldc; const float* bias; PanelStats st1, st2; unsigned poison;
    __device__ __forceinline__ void refuse(size_t i0, size_t stride, int M, int N) const { const float q = __builtin_nanf(""); for (size_t i = i0; i < (size_t)M * N; i += stride) { const size_t o = (i / N) * ldc + i % N; out[o] = q; xn[o] = (bf16_t)0x7fc0u; }
        if (i0 == 0) { unsigned expect = 0u; __hip_atomic_compare_exchange_strong(st1.tmo + 1, &expect, 0x7f0u, __ATOMIC_RELAXED, __ATOMIC_RELAXED, __HIP_MEMORY_SCOPE_AGENT); __hip_atomic_store(st1.tmo, 1u, __ATOMIC_RELAXED, __HIP_MEMORY_SCOPE_AGENT); } }
    __device__ __forceinline__ void fused(f32x4 (&acc)[2][2][4][2], const Unit& u, int wr, int wc, int fr, int fq, PG8_LAS unsigned char* lds, int wid, int lane) const {
        typedef float f32x2v __attribute__((ext_vector_type(2))); typedef unsigned u32x2v __attribute__((ext_vector_type(2)));
        const PG8_LAS f32x2v* S = (const PG8_LAS f32x2v*)(lds + 8192);
        const int col0 = u.pn * BM + wc * 32 + 4 * fq;
#pragma unroll
        for (int bj = 0; bj < 2; ++bj)
#pragma unroll
            for (int n = 0; n < 2; ++n) { const f32x4 bv = bias ? *(const f32x4*)(bias + col0 + bj * HALF + n * 16) : (f32x4){0.f, 0.f, 0.f, 0.f};
#pragma unroll
                for (int ai = 0; ai < 2; ++ai)
#pragma unroll
                    for (int m = 0; m < 4; ++m) acc[ai][bj][m][n] += bv; }
        bool bad = st1.run(acc, u, wr, wc, fr, fq, lds, wid, lane) || poison != 0u;
        const float qnan = __builtin_nanf("");
#pragma unroll
        for (int ai = 0; ai < 2; ++ai)
#pragma unroll
            for (int m = 0; m < 4; ++m) { const int r = ai * HALF + wr * 64 + m * 16 + fr; const f32x2v sr = S[r]; const size_t off = (size_t)(u.pm * BM + r) * ldc + col0;
#pragma unroll
                for (int bj = 0; bj < 2; ++bj)
#pragma unroll
                    for (int n = 0; n < 2; ++n) { const f32x4 bs = *(const f32x4*)(base + off + bj * HALF + n * 16); acc[ai][bj][m][n] = bs + (acc[ai][bj][m][n] - sr.x) * sr.y; }
                asm volatile("" : "+v"(acc[ai][0][m][0]), "+v"(acc[ai][0][m][1]), "+v"(acc[ai][1][m][0]), "+v"(acc[ai][1][m][1]));
                if (m & 1) asm volatile("" ::: "memory"); }
        const bool bad1 = bad;
        bad = st2.run(acc, u, wr, wc, fr, fq, lds, wid, lane) || bad;
#pragma unroll
        for (int ai = 0; ai < 2; ++ai)
#pragma unroll
            for (int m = 0; m < 4; ++m) { const int r = ai * HALF + wr * 64 + m * 16 + fr; const f32x2v sr = S[r]; const size_t off = (size_t)(u.pm * BM + r) * ldc + col0;
#pragma unroll
                for (int bj = 0; bj < 2; ++bj)
#pragma unroll
                    for (int n = 0; n < 2; ++n) { const f32x4 x1 = acc[ai][bj][m][n]; *(f32x4*)(out + off + bj * HALF + n * 16) = bad1 ? (f32x4){qnan, qnan, qnan, qnan} : x1;
                        const f32x4 o = (x1 - sr.x) * sr.y; u32x2v w; w.x = cvt_pk_bf16(o[0], o[1]); w.y = cvt_pk_bf16(o[2], o[3]);
                        if (bad) { w.x = 0x7fc07fc0u; w.y = 0x7fc07fc0u; } *(u32x2v*)(xn + off + bj * HALF + n * 16) = w; }
                asm volatile("" ::: "memory"); }
    }
};

template <class Epi, class Sched, bool STAMP = false>
__device__ __forceinline__ void gemm_phase(PG8_LAS unsigned char* lds, const Gemm g, const Sched& S, const Epi& E, unsigned long long* stamps) {
    const int tid = threadIdx.x, wid = __builtin_amdgcn_readfirstlane(tid >> 6), lane = tid & 63, wr = wid >> 2, wc = wid & 3, fr = lane & 15, fq = lane >> 4;
    const int K = g.K, nt = K / BK;
    int ts_lo = 0, ts_hi = 0, nts = 0; const unsigned long long rt_entry = STAMP ? (unsigned long long)wall_clock64() : 0ull;
#define PG8_STAMP() do { if (STAMP && wid == 0 && nts < 64) { const unsigned long long _c = (unsigned long long)clock64(); \
        ts_lo = (lane == nts) ? (int)(unsigned)_c : ts_lo; ts_hi = (lane == nts) ? (int)(unsigned)(_c >> 32) : ts_hi; ++nts; } } while (0)
    PG8_STAMP();
    unsigned voffA[2], voffB[2];
#pragma unroll
    for (int i = 0; i < 2; ++i) { int R, C; stage_rc(tid * 16 + i * 8192, R, C); const int Rb = Epi::PERM ? ((R & ~31) + perm32(R & 31)) : R;
        voffA[i] = (unsigned)(R * K + C) * 2u; voffB[i] = (unsigned)(Rb * K + C) * 2u; }
    const size_t kstep = (size_t)(BK * 2);
    const size_t hstep = (size_t)HALF * K * 2;
    const size_t tstep = 2 * hstep;
    const unsigned ldsw = (unsigned)wid * 1024u;
    const int aoff = lds_byte(wr * 64 + fr, fq * 8), boff = lds_byte(wc * 32 + fr, fq * 8);
#define PG8_SA(b, h) (((b) * 2 + (h)) * HTB)
#define PG8_SB(b, h) ((4 + (b) * 2 + (h)) * HTB)
#define PG8_STAGE(bufoff, gbase, voff) do { _Pragma("unroll") for (int _i = 0; _i < 2; ++_i) \
        __builtin_amdgcn_global_load_lds((const unsigned*)((const char*)(gbase) + (voff)[_i]), (PG8_LAS unsigned*)(lds + (bufoff) + ldsw + _i * 8192), 16, 0, 0); } while (0)
#define PG8_LDA(dst, b, h) do { _Pragma("unroll") for (int m = 0; m < 4; ++m) _Pragma("unroll") for (int k = 0; k < 2; ++k) dst[m][k] = *(const PG8_LAS bf16x8*)(lds + PG8_SA(b, h) + aoff + m * 2048 + k * 1024); } while (0)
#define PG8_LDB(dst, b, h) do { _Pragma("unroll") for (int n = 0; n < 2; ++n) _Pragma("unroll") for (int k = 0; k < 2; ++k) dst[n][k] = *(const PG8_LAS bf16x8*)(lds + PG8_SB(b, h) + boff + n * 2048 + k * 1024); } while (0)
#define PG8_MMA(ai, bj, At, Bt) do { __builtin_amdgcn_s_setprio(1); _Pragma("unroll") for (int m = 0; m < 4; ++m) _Pragma("unroll") for (int n = 0; n < 2; ++n) _Pragma("unroll") for (int k = 0; k < 2; ++k) \
        acc[ai][bj][m][n] = __builtin_amdgcn_mfma_f32_16x16x32_bf16(Bt[n][k], At[m][k], acc[ai][bj][m][n], 0, 0, 0); __builtin_amdgcn_s_setprio(0); } while (0)
#define PG8_WAIT_V(n) asm volatile("s_waitcnt vmcnt(" #n ")" ::: "memory")
#define PG8_WAIT_L(n) asm volatile("s_waitcnt lgkmcnt(" #n ")" ::: "memory")
#define PG8_BAR __builtin_amdgcn_s_barrier()
#define PG8_SCHED __builtin_amdgcn_sched_barrier(0)
    Unit cur, nxt; int ui = 0;
    if (!S.next(0, cur)) return;
    f32x4 acc[2][2][4][2];
#pragma unroll
    for (int a = 0; a < 2; ++a)
#pragma unroll
        for (int b = 0; b < 2; ++b)
#pragma unroll
            for (int m = 0; m < 4; ++m)
#pragma unroll
                for (int n = 0; n < 2; ++n) acc[a][b][m][n] = (f32x4){0.f, 0.f, 0.f, 0.f};
    bf16x8 At[4][2], B0[2][2], B1[2][2];
    const char* cA = (const char*)g.A + (size_t)cur.pm * tstep; const char* cB = (const char*)g.Bt + (size_t)cur.pn * tstep;
    S.a_ready(cur);
    PG8_STAGE(PG8_SB(0, 0), cB, voffB); PG8_STAGE(PG8_SA(0, 0), cA, voffA); PG8_STAGE(PG8_SB(0, 1), cB + hstep, voffB); PG8_STAGE(PG8_SA(0, 1), cA + hstep, voffA);
    if (wr == 1) PG8_BAR;
    PG8_WAIT_V(4); PG8_BAR;
    PG8_STAGE(PG8_SB(1, 0), cB + kstep, voffB); PG8_STAGE(PG8_SA(1, 0), cA + kstep, voffA); PG8_STAGE(PG8_SB(1, 1), cB + hstep + kstep, voffB);
    PG8_WAIT_V(6); PG8_BAR;
    PG8_STAMP();
    for (;;) {
        const bool has_next = S.next(ui + 1, nxt);
        const char* nA = has_next ? (const char*)g.A + (size_t)nxt.pm * tstep : cA; const char* nB = has_next ? (const char*)g.Bt + (size_t)nxt.pn * tstep : cB;
        for (int t = 0; t < nt; t += 2) {
            const bool last = (t == nt - 2);
            const char* a1 = cA + (size_t)(t + 1) * kstep;
            const char* a2 = last ? nA : cA + (size_t)(t + 2) * kstep; const char* b2 = last ? nB : cB + (size_t)(t + 2) * kstep;
            const char* a3 = a2 + kstep; const char* b3 = b2 + kstep;
            if (last && has_next) S.a_ready(nxt);
            PG8_LDB(B0, 0, 0); PG8_SCHED; PG8_LDA(At, 0, 0); PG8_STAGE(PG8_SA(1, 1), a1 + hstep, voffA);
            PG8_WAIT_L(8); PG8_BAR; PG8_WAIT_L(0); PG8_MMA(0, 0, At, B0); PG8_BAR; PG8_SCHED;
            PG8_LDB(B1, 0, 1); PG8_STAGE(PG8_SB(0, 0), b2, voffB);
            PG8_BAR; PG8_WAIT_L(0); PG8_MMA(0, 1, At, B1); PG8_BAR;
            PG8_LDA(At, 0, 1); PG8_STAGE(PG8_SA(0, 0), a2, voffA);
            PG8_BAR; PG8_WAIT_L(0); PG8_MMA(1, 0, At, B0); PG8_BAR; PG8_SCHED;
            PG8_STAGE(PG8_SB(0, 1), b2 + hstep, voffB);
            PG8_WAIT_V(6); PG8_BAR; PG8_MMA(1, 1, At, B1); PG8_BAR;
            PG8_LDB(B0, 1, 0); PG8_SCHED; PG8_LDA(At, 1, 0); PG8_STAGE(PG8_SA(0, 1), a2 + hstep, voffA);
            PG8_WAIT_L(8); PG8_BAR; PG8_WAIT_L(0); PG8_MMA(0, 0, At, B0); PG8_BAR; PG8_SCHED;
            PG8_LDB(B1, 1, 1); PG8_STAGE(PG8_SB(1, 0), b3, voffB);
            PG8_BAR; PG8_WAIT_L(0); PG8_MMA(0, 1, At, B1); PG8_BAR;
            PG8_LDA(At, 1, 1); PG8_STAGE(PG8_SA(1, 0), a3, voffA);
            PG8_BAR; PG8_WAIT_L(0); PG8_MMA(1, 0, At, B0); PG8_BAR; PG8_SCHED;
            PG8_STAGE(PG8_SB(1, 1), b3 + hstep, voffB);
            PG8_WAIT_V(6); PG8_BAR; PG8_MMA(1, 1, At, B1); PG8_BAR;
        }
        PG8_STAMP();
        if constexpr (!Epi::AFTER_DRAIN) { E(acc, cur, wr, wc, fr, fq); S.done(cur); }
        PG8_STAMP();
        if (!has_next) break;
#pragma unroll
        for (int a = 0; a < 2; ++a)
#pragma unroll
            for (int b = 0; b < 2; ++b)
#pragma unroll
                for (int m = 0; m < 4; ++m)
#pragma unroll
                    for (int n = 0; n < 2; ++n) acc[a][b][m][n] = (f32x4){0.f, 0.f, 0.f, 0.f};
        cur = nxt; cA = nA; cB = nB; ++ui;
    }
    PG8_WAIT_V(0);
    if (wr == 0) PG8_BAR;
    PG8_BAR;
    if constexpr (Epi::AFTER_DRAIN) { E.fused(acc, cur, wr, wc, fr, fq, lds, wid, lane); S.done(cur); }
    PG8_STAMP();
    if (STAMP && wid == 0) { stamps[lane] = lane < nts ? (((unsigned long long)(unsigned)ts_hi << 32) | (unsigned)ts_lo) : 0ull;
        if (lane == 62) stamps[62] = rt_entry; if (lane == 63) stamps[63] = (unsigned long long)wall_clock64(); }
#undef PG8_STAMP
#undef PG8_SA
#undef PG8_SB
#undef PG8_STAGE
#undef PG8_LDA
#undef PG8_LDB
#undef PG8_MMA
#undef PG8_WAIT_V
#undef PG8_WAIT_L
#undef PG8_BAR
#undef PG8_SCHED
}
}
#ifndef MK_ONE_LAUNCH
#define MK_ONE_LAUNCH 0
#endif
#ifndef DBG_CHECK
#define DBG_CHECK 0
#endif
#define LAS __attribute__((address_space(3)))
typedef unsigned short bf16;
typedef short bf16x8 __attribute__((ext_vector_type(8)));
typedef short s16x4 __attribute__((ext_vector_type(4)));
typedef short v4i16_t __attribute__((ext_vector_type(4)));
typedef float f32x16 __attribute__((ext_vector_type(16)));
typedef float f32x4 __attribute__((ext_vector_type(4)));
typedef unsigned u32x4 __attribute__((ext_vector_type(4)));
typedef unsigned u32x2 __attribute__((ext_vector_type(2)));

constexpr int SEQ = 16384, DM = 1024, NQKV = 9216, NKV = 1536;
constexpr int NWAVES = 8, NTHREADS = 512;
constexpr float ALPHA = 1.6817928305074290f;
constexpr float LOG2E = 1.4426950408889634f;
constexpr float C1 = 0.125f * LOG2E;
constexpr float LN_EPS = 1e-5f;
constexpr int MAXTILES = 144;
constexpr int MAXROWS = MAXTILES * 256;

constexpr size_t MiB = 1u << 20;
constexpr size_t WS_CTL = 0, CTL_BYTES = 1 * MiB;
constexpr size_t WS_HIST = 1 * MiB;
constexpr size_t WS_TILEB = 1 * MiB + 64 * 1024;
constexpr size_t WS_ROUTE = 2 * MiB;
constexpr size_t WS_ROWINFO = 3 * MiB;
constexpr size_t WS_ROWW = 4 * MiB;
constexpr size_t WS_GATES = 5 * MiB;
constexpr size_t WS_B1P = 8 * MiB;
constexpr size_t WS_WR = 9 * MiB;
constexpr size_t WS_WG = 9 * MiB + 256 * 1024;
constexpr size_t WS_W2T = 9 * MiB + 512 * 1024;
constexpr size_t WS_W1T = 10 * MiB;
constexpr size_t WS_WIN = 12 * MiB;
constexpr size_t WS_WOUTA = 48 * MiB;
constexpr size_t WS_WKV = 52 * MiB;
constexpr size_t WS_WQ = 55 * MiB;
constexpr size_t WS_WOUTB = 59 * MiB;
constexpr size_t WS_WGU = 64 * MiB;
constexpr size_t WS_WDN = 80 * MiB;
constexpr size_t WS_HF = 88 * MiB;
constexpr size_t WS_HB = 152 * MiB;
constexpr size_t WS_O = 184 * MiB;
constexpr size_t WS_BIG = 216 * MiB;
constexpr size_t BIG_HS = WS_BIG;
constexpr size_t BIG_HID = WS_BIG + 72 * MiB;
constexpr size_t BIG_Y = WS_BIG + 90 * MiB;
constexpr size_t BIG_KV = WS_BIG + 160 * MiB;
constexpr size_t BIG_KCMP = WS_BIG + 208 * MiB;
constexpr size_t BIG_Q = WS_BIG + 210 * MiB;
constexpr size_t WS_END = 504 * MiB;
constexpr int CW_BAR = 4096;
constexpr int CW_DBG = 16384;

constexpr int LDS_MISC = 131072;
constexpr int LDS_BAR = 131072 + 20480;
constexpr int LDS_BYTES = 155648;

#define MFMA32(a, b, c) __builtin_amdgcn_mfma_f32_32x32x16_bf16(a, b, c, 0, 0, 0)
__device__ __forceinline__ int crow(int r, int hi) { return (r & 3) + 8 * (r >> 2) + 4 * hi; }
__device__ __forceinline__ unsigned pk2(float lo, float hi) { unsigned r; asm("v_cvt_pk_bf16_f32 %0, %1, %2" : "=v"(r) : "v"(lo), "v"(hi)); return r; }
__device__ __forceinline__ float bf2f(unsigned short b) { return __uint_as_float(((unsigned)b) << 16); }
__device__ __forceinline__ float bflo(unsigned w) { return __uint_as_float(w << 16); }
__device__ __forceinline__ float bfhi(unsigned w) { return __uint_as_float(w & 0xffff0000u); }
__device__ __forceinline__ float ex2(float x) { return __builtin_amdgcn_exp2f(x); }
__device__ __forceinline__ float wave_sum(float v) {
#pragma unroll
    for (int o = 1; o < 64; o <<= 1) v += __shfl_xor(v, o);
    return v;
}
__device__ __forceinline__ s16x4 tr_read(LAS unsigned char* p) { return __builtin_bit_cast(s16x4, __builtin_amdgcn_ds_read_tr16_b64_v4i16((LAS v4i16_t*)p)); }
#define LDS_WAIT() asm volatile("s_waitcnt lgkmcnt(0)" ::: "memory")

#define XB_TMO      128
#define XB_XCNT(j)  (256  + 64 * (j))
#define XB_XSUB(j)  (1280 + 64 * (j))
#define XB_XGEN(j)  (2304 + 64 * (j))
#define XB_TOP      3328
#define XB_TOPGEN   3392
#define XCD_BAR_WORDS 3456
#define XB_SPIN_CAP (1u << 18)
__device__ __forceinline__ unsigned xb_ld(unsigned* p)              { return __hip_atomic_load(p, __ATOMIC_RELAXED, __HIP_MEMORY_SCOPE_AGENT); }
__device__ __forceinline__ unsigned xb_add(unsigned* p, unsigned v) { return __hip_atomic_fetch_add(p, v, __ATOMIC_RELAXED, __HIP_MEMORY_SCOPE_AGENT); }
__device__ __forceinline__ unsigned xb_xcc_id() { return (unsigned)__builtin_amdgcn_s_getreg((3 << 11) | 20) & 0xFu; }
#define XB_SPIN(cond, bar) do { unsigned _sp = 0; while (cond) { __builtin_amdgcn_s_sleep(1); \
    if ((++_sp & 255u) == 0u) { if (xb_ld(&(bar)[XB_TMO])) break; if (_sp > XB_SPIN_CAP) { atomicAdd(&(bar)[XB_TMO], 1u); break; } } } } while (0)
struct XcdBarrier { unsigned* bar; unsigned x; volatile LAS unsigned* st; };
__device__ __forceinline__ XcdBarrier xcd_barrier_post(unsigned* bar, volatile LAS unsigned* st) {
    XcdBarrier b; b.bar = bar; b.x = xb_xcc_id(); b.st = st;
    if (threadIdx.x == 0) (void)xb_add(&bar[XB_XCNT(b.x)], 1u);
    return b;
}
__device__ __forceinline__ void xcd_barrier_complete(unsigned* bar, unsigned x, unsigned& nloc, unsigned& nx) {
    const unsigned G = gridDim.x * gridDim.y * gridDim.z;
    unsigned sum, cnt, mine, sp = 0u;
    for (;;) {
        sum = 0u; cnt = 0u; mine = 0u;
#pragma unroll
        for (unsigned j = 0; j < 16; ++j) { const unsigned c = xb_ld(&bar[XB_XCNT(j)]); sum += c; cnt += (c > 0u) ? 1u : 0u; mine = (j == x) ? c : mine; }
        if (sum == G) break;
        __builtin_amdgcn_s_sleep(1);
        if ((++sp & 255u) == 0u) { if (xb_ld(&bar[XB_TMO])) break; if (sp > XB_SPIN_CAP) { atomicAdd(&bar[XB_TMO], 1u); break; } }
    }
    nloc = mine > 0u ? mine : 1u; nx = cnt > 0u ? cnt : 1u;
}
__device__ __forceinline__ void xcd_barrier(const XcdBarrier& b) {
    asm volatile("s_waitcnt vmcnt(0)" ::: "memory");
    __syncthreads();
    if (threadIdx.x == 0) {
        unsigned* bar = b.bar;
        __builtin_amdgcn_s_waitcnt(0);
        unsigned nloc = b.st[0], nx = b.st[1];
        if (nloc == 0u) { xcd_barrier_complete(bar, b.x, nloc, nx); b.st[0] = nloc; b.st[1] = nx; }
        const unsigned old = xb_add(&bar[XB_XSUB(b.x)], 1u);
        const unsigned gen = old / nloc;
        if (old + 1u == (gen + 1u) * nloc) {
            __builtin_amdgcn_fence(__ATOMIC_RELEASE, "agent");
            asm volatile("s_waitcnt vmcnt(0)" ::: "memory");
            const unsigned og = xb_add(&bar[XB_TOP], 1u);
            const unsigned tg = og / nx;
            if (og + 1u == (tg + 1u) * nx) xb_add(&bar[XB_TOPGEN], 1u);
            else XB_SPIN(xb_ld(&bar[XB_TOPGEN]) == tg, bar);
            __builtin_amdgcn_fence(__ATOMIC_ACQUIRE, "agent");
            xb_add(&bar[XB_XGEN(b.x)], 1u);
            asm volatile("s_waitcnt vmcnt(0)" ::: "memory");
        } else {
            XB_SPIN(xb_ld(&bar[XB_XGEN(b.x)]) == gen, bar);
            __builtin_amdgcn_fence(__ATOMIC_ACQUIRE, "agent");
            asm volatile("s_waitcnt vmcnt(0)" ::: "memory");
        }
    }
    __syncthreads();
}

__device__ __forceinline__ void tc_item(const float* src, int ld, int K, int srccol0, int nvalid, bf16* dst, int dstrow0, int kb, LAS float* scr, int lane) {
    const int k0 = 64 * kb;
#pragma unroll 8
    for (int i = 0; i < 32; ++i) { const int kk = 2 * i + (lane >> 5), n = lane & 31; scr[kk * 33 + n] = (n < nvalid) ? src[(size_t)(k0 + kk) * ld + srccol0 + n] : 0.f; }
    LDS_WAIT();
    const int c = lane & 7;
#pragma unroll
    for (int j = 0; j < 4; ++j) { const int n = (lane >> 3) + 8 * j; const LAS float* s = scr + (8 * c) * 33 + n;
        u32x4 o; o.x = pk2(s[0 * 33], s[1 * 33]); o.y = pk2(s[2 * 33], s[3 * 33]); o.z = pk2(s[4 * 33], s[5 * 33]); o.w = pk2(s[6 * 33], s[7 * 33]);
        *(u32x4*)(dst + (size_t)(dstrow0 + n) * K + k0 + 8 * c) = o; }
    LDS_WAIT();
}
__device__ __forceinline__ void tc_matrix(const float* src, int ld, int K, int col0, int ncolvalid, bf16* dst, int nrows, LAS float* scr, int lane, int gw, int NGW) {
    const int nkb = K / 64, nnb = nrows / 32;
    for (int it = gw; it < nkb * nnb; it += NGW) { const int kb = it / nnb, nb = it % nnb; int nv = ncolvalid - 32 * nb; nv = nv < 0 ? 0 : (nv > 32 ? 32 : nv);
        tc_item(src, ld, K, col0 + 32 * nb, nv, dst, 32 * nb, kb, scr, lane); }
}
__device__ __forceinline__ void convert_moe_weights(const float* gu, const float* dn, bf16* WGU, bf16* WDN, LAS float* scr, int lane, int gw, int NGW) {
    for (int it = gw; it < 16 * 256; it += NGW) { const int e = it >> 8, r = it & 255, kb = r >> 4, nb = r & 15;
        const int rho0 = 32 * nb, ct = rho0 >> 8, half = (rho0 >> 7) & 1, x0 = rho0 & 127;
        tc_item(gu + (size_t)e * 1024 * 512, 512, 1024, half * 256 + 128 * ct + x0, 32, WGU + (size_t)e * 512 * 1024, rho0, kb, scr, lane); }
    for (int it = gw; it < 16 * 128; it += NGW) { const int e = it >> 7, r = it & 127, kb = r >> 5, nb = r & 31;
        tc_item(dn + (size_t)e * 256 * 1024, 1024, 256, 32 * nb, 32, WDN + (size_t)e * 1024 * 256, 32 * nb, kb, scr, lane); }
}

struct KVT { bf16x8 k[4]; u32x4 v[4]; };
template <class RowF>
__device__ __forceinline__ void kv_load(KVT& T, const bf16* kbase, const bf16* vbase, RowF rowf, int lane) {
    const int hi = lane >> 5;
    const size_t ko = rowf(lane & 31);
#pragma unroll
    for (int s = 0; s < 4; ++s) T.k[s] = *(const bf16x8*)(kbase + ko + 16 * s + 8 * hi);
#pragma unroll
    for (int i = 0; i < 4; ++i) { const size_t vo = rowf(8 * i + (lane >> 3)); T.v[i] = *(const u32x4*)(vbase + vo + 8 * (lane & 7)); }
}
template <class RowF>
__device__ __forceinline__ void k_load(bf16x8 (&k)[4], const bf16* kbase, RowF rowf, int lane) {
    const int hi = lane >> 5;
    const size_t ko = rowf(lane & 31);
#pragma unroll
    for (int s = 0; s < 4; ++s) k[s] = *(const bf16x8*)(kbase + ko + 16 * s + 8 * hi);
}
__device__ __forceinline__ void q_load(bf16x8 (&q)[4], const bf16* qrow, int lane) {
    const int hi = lane >> 5;
#pragma unroll
    for (int s = 0; s < 4; ++s) q[s] = *(const bf16x8*)(qrow + 16 * s + 8 * hi);
}
__device__ __forceinline__ void v_stage(const KVT& T, LAS unsigned char* vs, int lane) {
#pragma unroll
    for (int i = 0; i < 4; ++i) { const int key = 8 * i + (lane >> 3), c = lane & 7; *(LAS u32x4*)(vs + (c >> 2) * 2048 + key * 64 + (c & 3) * 16) = T.v[i]; }
}
__device__ __forceinline__ void pv_acc(const f32x16& p, LAS unsigned char* vs, int lane, f32x16 (&o)[2]) {
    const int hi = lane >> 5;
    u32x4 w0, w1;
    w0.x = pk2(p[0], p[1]); w0.y = pk2(p[2], p[3]); w0.z = pk2(p[4], p[5]); w0.w = pk2(p[6], p[7]);
    w1.x = pk2(p[8], p[9]); w1.y = pk2(p[10], p[11]); w1.z = pk2(p[12], p[13]); w1.w = pk2(p[14], p[15]);
    const bf16x8 pf0 = __builtin_bit_cast(bf16x8, w0), pf1 = __builtin_bit_cast(bf16x8, w1);
    LAS unsigned char* vp = vs + ((lane >> 4) & 1) * 32 + (lane & 3) * 8 + (4 * hi + ((lane & 15) >> 2)) * 64;
    asm volatile("" ::: "memory");
#pragma unroll
    for (int db = 0; db < 2; ++db) {
        { const s16x4 lo = tr_read(vp + db * 2048), h4 = tr_read(vp + db * 2048 + 512);
          const bf16x8 vf = {lo[0], lo[1], lo[2], lo[3], h4[0], h4[1], h4[2], h4[3]}; o[db] = MFMA32(vf, pf0, o[db]); }
        { const s16x4 lo = tr_read(vp + db * 2048 + 1024), h4 = tr_read(vp + db * 2048 + 1024 + 512);
          const bf16x8 vf = {lo[0], lo[1], lo[2], lo[3], h4[0], h4[1], h4[2], h4[3]}; o[db] = MFMA32(vf, pf1, o[db]); }
    }
    asm volatile("" ::: "memory");
}
__device__ __forceinline__ f32x16 qk_tile(const bf16x8 (&qf)[4], const bf16x8 (&kf)[4]) {
    f32x16 s;
#pragma unroll
    for (int r = 0; r < 16; ++r) s[r] = 0.f;
#pragma unroll
    for (int d0 = 0; d0 < 4; ++d0) s = MFMA32(kf[d0], qf[d0], s);
    return s;
}
template <class ScoreF>
__device__ __forceinline__ void attn_tile(const bf16x8 (&qf)[4], const KVT& T, LAS unsigned char* vs, int lane, float& m, float& l, f32x16 (&o)[2], ScoreF sf) {
    v_stage(T, vs, lane);
    f32x16 s = qk_tile(qf, T.k);
    float mx = -INFINITY;
#pragma unroll
    for (int r = 0; r < 16; ++r) { s[r] = sf(r, s[r]); mx = fmaxf(mx, s[r]); }
    mx = fmaxf(mx, __shfl_xor(mx, 32));
    const float mn = fmaxf(m, mx), alpha = ex2(m - mn); m = mn;
    float ps = 0.f;
#pragma unroll
    for (int r = 0; r < 16; ++r) { s[r] = ex2(s[r] - mn); ps += s[r]; }
    l = l * alpha + ps;
#pragma unroll
    for (int r = 0; r < 16; ++r) { o[0][r] *= alpha; o[1][r] *= alpha; }
    pv_acc(s, vs, lane, o);
}
template <class ScoreF>
__device__ __forceinline__ void stats_tile(const bf16x8 (&qf)[4], const bf16x8 (&kf)[4], float& m, float& l, ScoreF sf) {
    f32x16 s = qk_tile(qf, kf);
    float mx = -INFINITY;
#pragma unroll
    for (int r = 0; r < 16; ++r) { s[r] = sf(r, s[r]); mx = fmaxf(mx, s[r]); }
    mx = fmaxf(mx, __shfl_xor(mx, 32));
    const float mn = fmaxf(m, mx), alpha = ex2(m - mn); m = mn;
    float ps = 0.f;
#pragma unroll
    for (int r = 0; r < 16; ++r) ps += ex2(s[r] - mn);
    l = l * alpha + ps;
}
__device__ __forceinline__ void o_store(const f32x16 (&o)[2], bf16* orow, int hi) {
#pragma unroll
    for (int db = 0; db < 2; ++db)
#pragma unroll
        for (int k = 0; k < 4; ++k) { u32x2 w; w.x = pk2(o[db][4 * k], o[db][4 * k + 1]); w.y = pk2(o[db][4 * k + 2], o[db][4 * k + 3]); *(u32x2*)(orow + 32 * db + 8 * k + 4 * hi) = w; }
}

__device__ __forceinline__ void dil_item(const bf16* qkv, bf16* O, int B, int rr, int h, LAS unsigned char* vs, int lane) {
    const int hi = lane >> 5, qi = lane & 31;
    const int T0 = 512 * B + rr, tq = T0 + 16 * qi;
    const float slope2 = exp2f(-0.5f * (float)(h + 1)) * LOG2E;
    float m = -1e30f, l = 0.f; f32x16 o[2];
#pragma unroll
    for (int r = 0; r < 16; ++r) { o[0][r] = 0.f; o[1][r] = 0.f; }
    for (int g = 0; g < 3; ++g) {
        const int d = 1 << (2 * g), W = 128 << (2 * g), nt = (g == 0) ? 20 : ((g == 1) ? 8 : 5);
        bf16x8 qf[4]; q_load(qf, qkv + (size_t)tq * NQKV + g * 3072 + h * 64, lane);
        const bf16* kb = qkv + g * 3072 + 1024 + h * 64; const bf16* vb = kb + 1024;
        const int tk00 = T0 - W;
        for (int ti = 0; ti < nt; ++ti) {
            const int tlo = tk00 + d * 32 * ti, thi = tlo + 31 * d;
            if (thi < 0 || tlo > T0 + 496) continue;
            KVT T;
            kv_load(T, kb, vb, [&](int key) { int tk = tlo + d * key; tk = tk < 0 ? 0 : (tk > SEQ - 1 ? SEQ - 1 : tk); return (size_t)tk * NQKV; }, lane);
            attn_tile(qf, T, vs, lane, m, l, o, [&](int r, float raw) {
                const int tk = tlo + d * crow(r, hi), dist = tq - tk; const bool ok = (tk >= 0) & (dist >= 0) & (dist <= W);
                return ok ? fmaf(raw, C1, -slope2 * (float)dist) : -INFINITY; });
        }
    }
    l += __shfl_xor(l, 32);
    const float inv = 1.0f / l;
#pragma unroll
    for (int r = 0; r < 16; ++r) { o[0][r] *= inv; o[1][r] *= inv; }
    o_store(o, O + (size_t)tq * DM + h * 64, hi);
}

constexpr int SL_S = 4096, SL_SEL = 4096 + 8 * 257 * 4;
__device__ __forceinline__ void nsa_item(const bf16* Q, const bf16* KV, const bf16* KC, const bf16* VC, const float* GATES, bf16* O, int tt, int g, LAS unsigned char* slab, int lane) {
    const int hi = lane >> 5, col = lane & 31, ti = col >> 2, r4 = col & 3, hh = 4 * g + r4;
    const int tq = 8 * tt + ti;
    const float slope2 = exp2f(-0.5f * (float)(hh + 1)) * LOG2E;
    LAS unsigned char* vs = slab;
    LAS float* S = (LAS float*)(slab + SL_S);
    LAS unsigned* SEL = (LAS unsigned*)(slab + SL_SEL);
    bf16x8 qf[4]; q_load(qf, Q + (size_t)tq * DM + hh * 64, lane);
    const float* gt = GATES + (size_t)tq * 48 + g * 4 + r4;
    f32x16 oacc[2];
#pragma unroll
    for (int r = 0; r < 16; ++r) { oacc[0][r] = 0.f; oacc[1][r] = 0.f; }
    for (int i = lane; i < 8 * 257; i += 64) S[i] = 0.f;
    const int tqmax = 8 * tt + 7;
    const int ncmp = (tqmax >= 31) ? (((tqmax - 31) >> 4) + 1) : 0;
    const int ntc = (ncmp + 31) >> 5;
    {
        float m = -1e30f, l = 0.f;
        for (int t2 = 0; t2 < ntc; ++t2) {
            bf16x8 kf[4];
            k_load(kf, KC, [&](int key) { int c = 32 * t2 + key; c = c > 1022 ? 1022 : c; return (size_t)(c * 4 + g) * 64; }, lane);
            stats_tile(qf, kf, m, l, [&](int r, float raw) { const int c = 32 * t2 + crow(r, hi), dist = tq - (16 * c + 31);
                return (dist >= 0) ? fmaf(raw, C1, -slope2 * (float)dist) : -INFINITY; });
        }
        l += __shfl_xor(l, 32);
        const float linv = (l > 0.f) ? 1.0f / l : 0.f;
        const float gc = gt[0];
        f32x16 oc[2];
#pragma unroll
        for (int r = 0; r < 16; ++r) { oc[0][r] = 0.f; oc[1][r] = 0.f; }
        float carry = 0.f;
        for (int t2 = 0; t2 < ntc; ++t2) {
            KVT T;
            kv_load(T, KC, VC, [&](int key) { int c = 32 * t2 + key; c = c > 1022 ? 1022 : c; return (size_t)(c * 4 + g) * 64; }, lane);
            v_stage(T, vs, lane);
            f32x16 s = qk_tile(qf, T.k);
#pragma unroll
            for (int r = 0; r < 16; ++r) { const int c = 32 * t2 + crow(r, hi), dist = tq - (16 * c + 31);
                const float sc = (dist >= 0) ? fmaf(s[r], C1, -slope2 * (float)dist) : -INFINITY; s[r] = ex2(sc - m) * linv; }
            pv_acc(s, vs, lane, oc);
            float part[4], edge[4], recv[4];
#pragma unroll
            for (int i = 0; i < 4; ++i) { float e = s[4 * i + 3], p = 2.f * (s[4 * i] + s[4 * i + 1] + s[4 * i + 2]) + e;
                p += __shfl_xor(p, 1); p += __shfl_xor(p, 2); e += __shfl_xor(e, 1); e += __shfl_xor(e, 2); part[i] = p; edge[i] = e; }
#pragma unroll
            for (int i = 0; i < 4; ++i) recv[i] = __shfl_xor(edge[i], 32);
#pragma unroll
            for (int i = 0; i < 4; ++i) { const float prev = hi ? recv[i] : (i > 0 ? recv[i > 0 ? i - 1 : 0] : carry); const float sc = part[i] + prev;
                const int u = 8 * t2 + 2 * i + hi; if (r4 == 0) S[ti * 257 + u] = sc; }
            carry = recv[3];
        }
#pragma unroll
        for (int r = 0; r < 16; ++r) { oacc[0][r] = gc * oc[0][r]; oacc[1][r] = gc * oc[1][r]; }
    }
    LDS_WAIT();
    const int cur = (8 * tt) >> 6;
    if (lane < 8) {
        unsigned w[8];
#pragma unroll
        for (int k = 0; k < 8; ++k) w[k] = 0u;
        if (cur <= 15) { w[0] = (2u << cur) - 1u; }
        else {
            float lv[13]; int li[13];
#pragma unroll
            for (int k = 0; k < 13; ++k) { lv[k] = 0.f; li[k] = -1; }
            const LAS float* Sr = S + lane * 257;
            for (int u = 1; u <= cur - 2; ++u) {
                const float v = Sr[u];
                if (v > lv[12]) { lv[12] = v; li[12] = u;
#pragma unroll
                    for (int k = 12; k >= 1; --k) { if (lv[k] > lv[k - 1]) { const float tv = lv[k]; lv[k] = lv[k - 1]; lv[k - 1] = tv; const int tn = li[k]; li[k] = li[k - 1]; li[k - 1] = tn; } }
                }
            }
            int need = 13;
#pragma unroll
            for (int k = 0; k < 13; ++k) { if (li[k] >= 0) { --need;
#pragma unroll
                    for (int wd = 0; wd < 8; ++wd) w[wd] |= ((li[k] >> 5) == wd) ? (1u << (li[k] & 31)) : 0u; } }
#pragma unroll
            for (int wd = 0; wd < 8; ++wd) { w[wd] |= (wd == 0) ? 1u : 0u; w[wd] |= ((cur >> 5) == wd) ? (1u << (cur & 31)) : 0u; w[wd] |= (((cur - 1) >> 5) == wd) ? (1u << ((cur - 1) & 31)) : 0u; }
            if (need > 0) {
#pragma unroll
                for (int wd = 0; wd < 8; ++wd) {
                    if (need > 0) { for (int b = 0; b < 32; ++b) { const int u = wd * 32 + b; if (u >= 1 && u <= cur - 2 && need > 0 && !((w[wd] >> b) & 1u)) { w[wd] |= 1u << b; --need; } } }
                }
            }
        }
#pragma unroll
        for (int wd = 0; wd < 8; ++wd) SEL[lane * 8 + wd] = w[wd];
    }
    LDS_WAIT();
    {
        float m = -1e30f, l = 0.f; f32x16 os[2];
#pragma unroll
        for (int r = 0; r < 16; ++r) { os[0][r] = 0.f; os[1][r] = 0.f; }
        const bf16* kb = KV + 512 + g * 64; const bf16* vb = KV + 768 + g * 64;
        for (int wd = 0; wd < 8; ++wd) {
            const unsigned mw = SEL[ti * 8 + wd];
            unsigned uw = 0u;
#pragma unroll
            for (int i = 0; i < 8; ++i) uw |= (unsigned)__builtin_amdgcn_readlane((int)mw, 4 * i);
            while (uw) {
                const int b = __builtin_ctz(uw); uw &= uw - 1u;
                const int u = wd * 32 + b; const bool mysel = (mw >> b) & 1u;
                for (int hf = 0; hf < 2; ++hf) {
                    const int tk0 = 64 * u + 32 * hf;
                    if (tk0 > tqmax) continue;
                    KVT T;
                    kv_load(T, kb, vb, [&](int key) { return (size_t)(tk0 + key) * NKV; }, lane);
                    attn_tile(qf, T, vs, lane, m, l, os, [&](int r, float raw) { const int dist = tq - (tk0 + crow(r, hi));
                        return (mysel && dist >= 0) ? fmaf(raw, C1, -slope2 * (float)dist) : -INFINITY; });
                }
            }
        }
        l += __shfl_xor(l, 32);
        const float f = (l > 0.f) ? gt[16] / l : 0.f;
#pragma unroll
        for (int r = 0; r < 16; ++r) { oacc[0][r] += f * os[0][r]; oacc[1][r] += f * os[1][r]; }
    }
    {
        float m = -1e30f, l = 0.f; f32x16 ow[2];
#pragma unroll
        for (int r = 0; r < 16; ++r) { ow[0][r] = 0.f; ow[1][r] = 0.f; }
        const bf16* kb = KV + 1024 + g * 64; const bf16* vb = KV + 1280 + g * 64;
        const int tkb = 8 * tt + 8 - 32 * 17;
        for (int t2 = 0; t2 < 17; ++t2) {
            const int tk0 = tkb + 32 * t2;
            if (tk0 + 31 < 0) continue;
            KVT T;
            kv_load(T, kb, vb, [&](int key) { int tk = tk0 + key; tk = tk < 0 ? 0 : (tk > SEQ - 1 ? SEQ - 1 : tk); return (size_t)tk * NKV; }, lane);
            attn_tile(qf, T, vs, lane, m, l, ow, [&](int r, float raw) { const int tk = tk0 + crow(r, hi), dist = tq - tk;
                return (tk >= 0 && dist >= 0 && dist < 512) ? fmaf(raw, C1, -slope2 * (float)dist) : -INFINITY; });
        }
        l += __shfl_xor(l, 32);
        const float f = (l > 0.f) ? gt[32] / l : 0.f;
#pragma unroll
        for (int r = 0; r < 16; ++r) { oacc[0][r] += f * ow[0][r]; oacc[1][r] += f * ow[1][r]; }
    }
    o_store(oacc, O + (size_t)tq * DM + hh * 64, hi);
}

struct EpiAccF32 {
    static constexpr bool PERM = false, AFTER_DRAIN = false;
    float* C; int ldc;
    __device__ __forceinline__ void operator()(const f32x4 (&acc)[2][2][4][2], const pg8::Unit& u, int wr, int wc, int fr, int fq) const {
        const int row0 = u.pm * 256 + wr * 64 + fr, col0 = u.pn * 256 + wc * 32 + 4 * fq;
#pragma unroll
        for (int ai = 0; ai < 2; ++ai)
#pragma unroll
            for (int m = 0; m < 4; ++m) { float* rowp = C + (size_t)(row0 + ai * 128 + m * 16) * ldc + col0;
#pragma unroll
                for (int bj = 0; bj < 2; ++bj)
#pragma unroll
                    for (int n = 0; n < 2; ++n) { f32x4* p = (f32x4*)(rowp + bj * 128 + n * 16); *p = *p + acc[ai][bj][m][n]; } }
    }
};
struct EpiSwiglu {
    static constexpr bool PERM = true, AFTER_DRAIN = false;
    bf16* HID; const float* roww;
    __device__ __forceinline__ void operator()(const f32x4 (&acc)[2][2][4][2], const pg8::Unit& u, int wr, int wc, int fr, int fq) const {
        const int row0 = u.pm * 256 + wr * 64 + fr, ct = u.pn & 1, col0 = ct * 128 + wc * 32 + 8 * fq;
#pragma unroll
        for (int ai = 0; ai < 2; ++ai)
#pragma unroll
            for (int m = 0; m < 4; ++m) { const int row = row0 + ai * 128 + m * 16; const float w = roww[row];
                float hv[8];
#pragma unroll
                for (int n = 0; n < 2; ++n)
#pragma unroll
                    for (int j = 0; j < 4; ++j) { const float gte = acc[ai][0][m][n][j], up = acc[ai][1][m][n][j];
                        hv[4 * n + j] = gte * __builtin_amdgcn_rcpf(1.0f + ex2(-gte * LOG2E)) * up * w; }
                u32x4 o; o.x = pk2(hv[0], hv[1]); o.y = pk2(hv[2], hv[3]); o.z = pk2(hv[4], hv[5]); o.w = pk2(hv[6], hv[7]);
                *(u32x4*)(HID + (size_t)row * 256 + col0) = o; }
    }
};
struct EpiScatter {
    static constexpr bool PERM = true, AFTER_DRAIN = false;
    bf16* Y; const int* rowinfo;
    __device__ __forceinline__ void operator()(const f32x4 (&acc)[2][2][4][2], const pg8::Unit& u, int wr, int wc, int fr, int fq) const {
        const int row0 = u.pm * 256 + wr * 64 + fr, ct = u.pn & 3, col0 = ct * 256 + wc * 32 + 8 * fq;
#pragma unroll
        for (int ai = 0; ai < 2; ++ai)
#pragma unroll
            for (int m = 0; m < 4; ++m) { const int info = rowinfo[row0 + ai * 128 + m * 16];
                if (info >= 0) { bf16* rowp = Y + ((size_t)(info & 1) * SEQ + (size_t)(info >> 1)) * DM + col0;
#pragma unroll
                    for (int bj = 0; bj < 2; ++bj) { const f32x4 v0 = acc[ai][bj][m][0], v1 = acc[ai][bj][m][1];
                        u32x4 o; o.x = pk2(v0[0], v0[1]); o.y = pk2(v0[2], v0[3]); o.z = pk2(v1[0], v1[1]); o.w = pk2(v1[2], v1[3]);
                        *(u32x4*)(rowp + bj * 128) = o; } } }
    }
};
struct MoeOrder {
    const LAS int* tb; int NCT, G, c;
    __device__ __forceinline__ void init(const LAS int* tb_, int nct, int G_, int c_) { tb = tb_; NCT = nct; G = G_; c = c_; }
    __device__ __forceinline__ bool next(int i, pg8::Unit& u) const {
        const int L = i * G + c, rt = L / NCT; if (rt >= __builtin_amdgcn_readfirstlane(tb[16])) return false;
        int e = 0;
#pragma unroll
        for (int k = 1; k < 16; ++k) e += (rt >= tb[k]) ? 1 : 0;
        u.pm = rt; u.pn = __builtin_amdgcn_readfirstlane(e) * NCT + (L % NCT); return true;
    }
    __device__ __forceinline__ void a_ready(const pg8::Unit&) const {}
    __device__ __forceinline__ void done(const pg8::Unit&) const {}
};

__device__ __forceinline__ void ln_phase(LAS unsigned char* lds, int mode, const float* HFin, const bf16* Y, const float* gam, const float* bet, float* outF, float oscale, bf16* HB,
                                         const bf16* WT, const float* sb, int4* ROUTE, int* HIST, float* GATES) {
    const int tid = threadIdx.x, lane = tid & 63, wave = __builtin_amdgcn_readfirstlane(tid >> 6), hi = lane >> 5;
    LAS float* LOG = (LAS float*)(lds + LDS_MISC);
    LAS int* HCNT = (LAS int*)(lds + LDS_MISC + 64 * 65 * 4);
    f32x4 gv[4], bv[4];
#pragma unroll
    for (int j = 0; j < 4; ++j) { gv[j] = *(const f32x4*)(gam + 4 * lane + 256 * j); bv[j] = *(const f32x4*)(bet + 4 * lane + 256 * j); }
    for (int ch = blockIdx.x; ch < SEQ / 64; ch += gridDim.x) {
        if (tid < 16) HCNT[tid] = 0;
        for (int i = 0; i < 8; ++i) {
            const int rl = wave * 8 + i; const size_t row = (size_t)ch * 64 + rl;
            f32x4 v[4];
#pragma unroll
            for (int j = 0; j < 4; ++j) v[j] = *(const f32x4*)(HFin + row * DM + 4 * lane + 256 * j);
            if (Y) {
#pragma unroll
                for (int sl = 0; sl < 2; ++sl)
#pragma unroll
                    for (int j = 0; j < 4; ++j) { const u32x2 a = *(const u32x2*)(Y + ((size_t)sl * SEQ + row) * DM + 4 * lane + 256 * j);
                        v[j][0] += bflo(a.x); v[j][1] += bfhi(a.x); v[j][2] += bflo(a.y); v[j][3] += bfhi(a.y); }
            }
            float s = 0.f;
#pragma unroll
            for (int j = 0; j < 4; ++j) s += (v[j][0] + v[j][1]) + (v[j][2] + v[j][3]);
            const float mean = wave_sum(s) * (1.0f / DM);
            float q = 0.f;
#pragma unroll
            for (int j = 0; j < 4; ++j) { v[j] = v[j] - mean; q += (v[j][0] * v[j][0] + v[j][1] * v[j][1]) + (v[j][2] * v[j][2] + v[j][3] * v[j][3]); }
            const float rstd = 1.0f / sqrtf(wave_sum(q) * (1.0f / DM) + LN_EPS);
#pragma unroll
            for (int j = 0; j < 4; ++j) { const f32x4 y = v[j] * rstd * gv[j] + bv[j];
                *(f32x4*)(outF + row * DM + 4 * lane + 256 * j) = y * oscale;
                u32x2 w; w.x = pk2(y[0], y[1]); w.y = pk2(y[2], y[3]);
                *(u32x2*)(HB + row * DM + 4 * lane + 256 * j) = w;
                const int ck = (lane >> 1) + 32 * j;
                *(LAS u32x2*)(lds + rl * 2048 + ((ck ^ (rl & 15)) << 4) + (lane & 1) * 8) = w; }
        }
        __syncthreads();
        const int nct = (mode == 0) ? 1 : ((mode == 1) ? 2 : 0);
        if (wave < 2 * nct) {
            const int tt = wave & 1, ct = wave >> 1, rl = tt * 32 + (lane & 31);
            const bf16* wrow = WT + (size_t)(ct * 32 + (lane & 31)) * DM + 8 * hi;
            f32x16 acc;
#pragma unroll
            for (int r = 0; r < 16; ++r) acc[r] = 0.f;
#pragma unroll 4
            for (int s = 0; s < 64; ++s) { const bf16x8 a = *(const bf16x8*)(wrow + 16 * s); const int ck = 2 * s + hi;
                const bf16x8 b = *(const LAS bf16x8*)(lds + rl * 2048 + ((ck ^ (rl & 15)) << 4)); acc = MFMA32(a, b, acc); }
#pragma unroll
            for (int r = 0; r < 16; ++r) LOG[rl * 65 + 32 * ct + crow(r, hi)] = acc[r];
        }
        __syncthreads();
        if (mode == 0 && tid < 64) {
            const LAS float* lg = LOG + tid * 65;
            int gi = 0; float gm = lg[0] + sb[0];
#pragma unroll
            for (int k = 1; k < 4; ++k) { const float x = lg[k] + sb[k]; if (x > gm) { gm = x; gi = k; } }
            float den = 0.f;
#pragma unroll
            for (int k = 0; k < 4; ++k) den += __expf(lg[k] + sb[k] - gm);
            const float gw = 1.0f / den;
            float ev[4];
#pragma unroll
            for (int k = 0; k < 4; ++k) ev[k] = lg[4 + 4 * gi + k] + sb[4 + 4 * gi + k];
            int i0 = 0; float v0 = ev[0];
#pragma unroll
            for (int k = 1; k < 4; ++k) if (ev[k] > v0) { v0 = ev[k]; i0 = k; }
            int i1 = -1; float v1 = -INFINITY;
#pragma unroll
            for (int k = 0; k < 4; ++k) if (k != i0 && ev[k] > v1) { v1 = ev[k]; i1 = k; }
            const float t = __expf(v1 - v0), w0 = gw / (1.0f + t), w1 = gw * t / (1.0f + t);
            const int e0 = 4 * gi + i0, e1 = 4 * gi + i1;
            ROUTE[(size_t)ch * 64 + tid] = make_int4(e0, e1, __float_as_int(w0), __float_as_int(w1));
            atomicAdd((int*)&HCNT[e0], 1); atomicAdd((int*)&HCNT[e1], 1);
        }
        if (mode == 1 && tid < 64) {
            const LAS float* lg = LOG + tid * 65; float* go = GATES + ((size_t)ch * 64 + tid) * 48;
#pragma unroll 4
            for (int c = 0; c < 48; ++c) go[c] = 1.0f / (1.0f + __expf(-(lg[c] + sb[c])));
        }
        __syncthreads();
        if (mode == 0 && tid < 16) HIST[ch * 16 + tid] = HCNT[tid];
    }
}

__device__ __forceinline__ void moe_scatter(LAS unsigned char* lds, const int4* ROUTE, const int* HIST, int* TILEB, const bf16* HB, bf16* HS, int* ROWINFO, float* ROWW) {
    const int tid = threadIdx.x, lane = tid & 63, wave = __builtin_amdgcn_readfirstlane(tid >> 6);
    LAS int* tot = (LAS int*)(lds + LDS_MISC);
    LAS int* pre = tot + 16;
    LAS int* tbl = pre + 16;
    LAS int* ent = tbl + 32;
    LAS int* pos = ent + 128;
    LAS float* ewt = (LAS float*)(pos + 128);
    for (int ch = blockIdx.x; ch < SEQ / 64; ch += gridDim.x) {
        if (tid < 16) { int t = 0, p = 0; for (int c = 0; c < SEQ / 64; ++c) { const int v = HIST[c * 16 + tid]; t += v; p += (c < ch) ? v : 0; } tot[tid] = t; pre[tid] = p; }
        if (tid >= 64 && tid < 128) { const int k = tid - 64; const int4 r = ROUTE[(size_t)ch * 64 + k]; ent[2 * k] = r.x; ent[2 * k + 1] = r.y; ewt[2 * k] = __int_as_float(r.z); ewt[2 * k + 1] = __int_as_float(r.w); }
        __syncthreads();
        if (tid == 0) { int a = 0; for (int e = 0; e < 16; ++e) { tbl[e] = a; a += (tot[e] + 255) >> 8; } tbl[16] = a;
            if (ch == 0) { for (int e = 0; e < 17; ++e) TILEB[e] = tbl[e]; } }
        __syncthreads();
        if (tid < 16) { int run = tbl[tid] * 256 + pre[tid]; for (int k = 0; k < 128; ++k) if (ent[k] == tid) pos[k] = run++; }
        __syncthreads();
        for (int k = wave * 16; k < wave * 16 + 16; ++k) {
            const int p = pos[k]; const size_t token = (size_t)ch * 64 + (k >> 1);
            const u32x4* src = (const u32x4*)(HB + token * DM); u32x4* dst = (u32x4*)(HS + (size_t)p * DM);
            dst[lane] = src[lane]; dst[lane + 64] = src[lane + 64];
            if (lane == 0) { ROWINFO[p] = (int)token * 2 + (k & 1); ROWW[p] = ewt[k]; }
        }
        if (ch < 16) { const int e = ch, r0 = tbl[e] * 256 + tot[e], r1 = tbl[e + 1] * 256; for (int r = r0 + tid; r < r1; r += NTHREADS) { ROWINFO[r] = -1; ROWW[r] = 0.f; } }
        __syncthreads();
    }
}

__device__ __forceinline__ float gelu_tanh(float x) { const float u = 0.7978845608028654f * (x + 0.044715f * x * x * x); const float t = 1.0f - 2.0f / (__expf(2.0f * u) + 1.0f); return 0.5f * x * (1.0f + t); }
__device__ __forceinline__ void compress_phase(LAS unsigned char* lds, const bf16* KV, const bf16* W1T, const bf16* W2T, const float* B1P, const float* b1, const float* b2, bf16* KCMP) {
    const int tid = threadIdx.x, lane = tid & 63, wave = __builtin_amdgcn_readfirstlane(tid >> 6), hi = lane >> 5;
    LAS unsigned char* H1 = lds;
    for (int item = blockIdx.x; item < 256; item += gridDim.x) {
        const int j = item >> 7, rt = item & 127;
        int rho = 32 * rt + (lane & 31); const bool rvalid = rho < 4092; rho = rvalid ? rho : 4091;
        const int c = rho >> 2, g = rho & 3;
        const bf16* arow = KV + (size_t)(16 * c) * NKV + j * 256 + g * 64;
        const bf16* wrow = W1T + ((size_t)j * 256 + 32 * wave + (lane & 31)) * 2048;
        f32x16 acc;
#pragma unroll
        for (int r = 0; r < 16; ++r) acc[r] = 0.f;
#pragma unroll 4
        for (int s = 0; s < 128; ++s) { const int k = 16 * s + 8 * hi;
            const bf16x8 b = *(const bf16x8*)(arow + (size_t)(k >> 6) * NKV + (k & 63)); const bf16x8 a = *(const bf16x8*)(wrow + k); acc = MFMA32(a, b, acc); }
#pragma unroll
        for (int r = 0; r < 16; ++r) { const int n = 32 * wave + crow(r, hi); float bsum = b1[j * 256 + n];
            for (int ks = 0; ks < 16; ++ks) bsum += B1P[(j * 16 + ks) * 256 + n];
            const float hval = gelu_tanh(acc[r] + bsum);
            *(LAS unsigned short*)(H1 + (lane & 31) * 528 + n * 2) = (unsigned short)(pk2(hval, 0.f) & 0xffffu); }
        __syncthreads();
        if (wave < 2) {
            const int db = wave;
            const bf16* w2row = W2T + ((size_t)j * 64 + 32 * db + (lane & 31)) * 256 + 8 * hi;
            f32x16 o;
#pragma unroll
            for (int r = 0; r < 16; ++r) o[r] = 0.f;
#pragma unroll
            for (int s = 0; s < 16; ++s) { const bf16x8 a = *(const bf16x8*)(w2row + 16 * s); const bf16x8 b = *(const LAS bf16x8*)(H1 + (lane & 31) * 528 + (16 * s + 8 * hi) * 2); o = MFMA32(a, b, o); }
            if (rvalid) { bf16* orow = KCMP + ((size_t)j * 1024 * 4 + (size_t)c * 4 + g) * 64 + 32 * db;
#pragma unroll
                for (int k = 0; k < 4; ++k) { const int d0 = 32 * db + 8 * k + 4 * hi; u32x2 w;
                    w.x = pk2(o[4 * k] + b2[j * 64 + d0], o[4 * k + 1] + b2[j * 64 + d0 + 1]); w.y = pk2(o[4 * k + 2] + b2[j * 64 + d0 + 2], o[4 * k + 3] + b2[j * 64 + d0 + 3]);
                    *(u32x2*)(orow + 8 * k + 4 * hi) = w; } }
        }
        __syncthreads();
    }
}

struct Args { const float* in[20]; float* out; unsigned char* ws; int ph_lo, ph_hi; };
enum { I_X = 0, I_AWIN, I_AWOUT, I_BWKV, I_CPOS, I_CW1, I_CB1, I_CW2, I_CB2, I_BWQ, I_BBQ, I_BWOUT, I_MWR, I_MBR, I_MWGU, I_MWDN, I_LMG, I_LMB, I_LFG, I_LFB };
typedef const __attribute__((address_space(4))) Args* KArgs;
__device__ __forceinline__ KArgs kargs() { KArgs p = (KArgs)__builtin_amdgcn_kernarg_segment_ptr(); asm volatile("" : "+s"(p)); return p; }

struct Ids { int lane, wave, gw, NGW, G, bx; };
__device__ __forceinline__ Ids ids() {
    Ids d; const int tid = threadIdx.x; d.lane = tid & 63; d.wave = __builtin_amdgcn_readfirstlane(tid >> 6); d.G = gridDim.x; d.bx = blockIdx.x;
    const int vcu = (d.G % 8 == 0) ? (d.bx % 8) * (d.G / 8) + d.bx / 8 : d.bx;
    d.gw = vcu * NWAVES + d.wave; d.NGW = d.G * NWAVES; return d;
}
#define PHASE_IF(k) if ((k) >= lo && (k) < hi)
#define PHASE_BAR(k) do { if ((k) >= lo && (k) + 1 < hi) xcd_barrier(bar); } while (0)

__device__ __forceinline__ void phase_prologue(LAS unsigned char* lds) {
    KArgs ka = kargs(); unsigned char* ws = ka->ws; const Ids d = ids(); const int lane = d.lane, gw = d.gw, NGW = d.NGW;
    LAS float* scr = (LAS float*)(lds + d.wave * 16384);
    for (int l = 0; l < 2; ++l) tc_matrix(ka->in[I_AWIN] + (size_t)l * DM * NQKV, NQKV, DM, 0, NQKV, (bf16*)(ws + WS_WIN) + (size_t)l * NQKV * DM, NQKV, scr, lane, gw, NGW);
    for (int l = 0; l < 2; ++l) tc_matrix(ka->in[I_AWOUT] + (size_t)l * DM * DM, DM, DM, 0, DM, (bf16*)(ws + WS_WOUTA) + (size_t)l * DM * DM, DM, scr, lane, gw, NGW);
    tc_matrix(ka->in[I_BWKV], NKV, DM, 0, NKV, (bf16*)(ws + WS_WKV), NKV, scr, lane, gw, NGW);
    for (int i = 0; i < 2; ++i) {
        tc_matrix(ka->in[I_BWQ] + (size_t)i * DM * 1072, 1072, DM, 0, 1024, (bf16*)(ws + WS_WQ) + (size_t)i * DM * DM, DM, scr, lane, gw, NGW);
        tc_matrix(ka->in[I_BWQ] + (size_t)i * DM * 1072, 1072, DM, 1024, 48, (bf16*)(ws + WS_WG) + (size_t)i * 64 * DM, 64, scr, lane, gw, NGW);
        tc_matrix(ka->in[I_BWOUT] + (size_t)i * DM * DM, DM, DM, 0, DM, (bf16*)(ws + WS_WOUTB) + (size_t)i * DM * DM, DM, scr, lane, gw, NGW);
    }
    for (int l = 0; l < 4; ++l) tc_matrix(ka->in[I_MWR] + (size_t)l * DM * 20, 20, DM, 0, 20, (bf16*)(ws + WS_WR) + (size_t)l * 32 * DM, 32, scr, lane, gw, NGW);
    for (int j = 0; j < 2; ++j) {
        tc_matrix(ka->in[I_CW1] + (size_t)j * 2048 * 256, 256, 2048, 0, 256, (bf16*)(ws + WS_W1T) + (size_t)j * 256 * 2048, 256, scr, lane, gw, NGW);
        tc_matrix(ka->in[I_CW2] + (size_t)j * 256 * 64, 64, 256, 0, 64, (bf16*)(ws + WS_W2T) + (size_t)j * 64 * 256, 64, scr, lane, gw, NGW);
    }
    convert_moe_weights(ka->in[I_MWGU], ka->in[I_MWDN], (bf16*)(ws + WS_WGU), (bf16*)(ws + WS_WDN), scr, lane, gw, NGW);
    float* B1P = (float*)(ws + WS_B1P);
    for (int it = gw; it < 128; it += NGW) { const int j = it >> 6, nb = (it >> 4) & 3, ks = it & 15, n = nb * 64 + lane;
        const float* W1 = ka->in[I_CW1] + (size_t)j * 2048 * 256; const float* pos = ka->in[I_CPOS] + (size_t)j * 2048; float a = 0.f;
        for (int k = ks * 128; k < ks * 128 + 128; ++k) a += pos[k] * W1[(size_t)k * 256 + n];
        B1P[(j * 16 + ks) * 256 + n] = a; }
    const float* x = ka->in[I_X]; float* HF = (float*)(ws + WS_HF); bf16* HB = (bf16*)(ws + WS_HB);
    for (int row = gw; row < SEQ; row += NGW) {
#pragma unroll
        for (int j = 0; j < 4; ++j) { const f32x4 v = *(const f32x4*)(x + (size_t)row * DM + 4 * lane + 256 * j);
            *(f32x4*)(HF + (size_t)row * DM + 4 * lane + 256 * j) = v * ALPHA;
            u32x2 w; w.x = pk2(v[0], v[1]); w.y = pk2(v[2], v[3]); *(u32x2*)(HB + (size_t)row * DM + 4 * lane + 256 * j) = w; }
    }
}

template <int L, int KIND, bool CONVERT>
__device__ __forceinline__ void phase_proj(LAS unsigned char* lds) {
    KArgs ka = kargs(); unsigned char* ws = ka->ws; const Ids d = ids();
    if (CONVERT) {
        convert_moe_weights(ka->in[I_MWGU] + (size_t)L * 16 * 1024 * 512, ka->in[I_MWDN] + (size_t)L * 16 * 256 * 1024, (bf16*)(ws + WS_WGU), (bf16*)(ws + WS_WDN),
                            (LAS float*)(lds + d.wave * 16384), d.lane, d.gw, d.NGW);
        __syncthreads();
    }
    const bf16* HB = (const bf16*)(ws + WS_HB);
#ifndef NO_G1
    if (KIND == 0) { pg8::Gemm gm{HB, (const bf16*)(ws + WS_WIN) + (size_t)L * NQKV * DM, SEQ, NQKV, DM}; pg8::EpiBf16<0> E{(bf16*)(ws + WS_BIG), NQKV, nullptr, 0, 0};
        pg8::StaticOrder S; S.init(SEQ, NQKV, d.G, d.bx); pg8::gemm_phase<pg8::EpiBf16<0>, pg8::StaticOrder, false>(lds, gm, S, E, nullptr); }
    else if (KIND == 1) { pg8::Gemm gm{HB, (const bf16*)(ws + WS_WKV), SEQ, NKV, DM}; pg8::EpiBf16<0> E{(bf16*)(ws + BIG_KV), NKV, nullptr, 0, 0};
        pg8::StaticOrder S; S.init(SEQ, NKV, d.G, d.bx); pg8::gemm_phase<pg8::EpiBf16<0>, pg8::StaticOrder, false>(lds, gm, S, E, nullptr); }
    else { pg8::Gemm gm{HB, (const bf16*)(ws + WS_WQ) + (size_t)(L - 2) * DM * DM, SEQ, DM, DM}; pg8::EpiBf16<0> E{(bf16*)(ws + BIG_Q), DM, ka->in[I_BBQ] + (size_t)(L - 2) * 1072, 0, 0};
        pg8::StaticOrder S; S.init(SEQ, DM, d.G, d.bx); pg8::gemm_phase<pg8::EpiBf16<0>, pg8::StaticOrder, false>(lds, gm, S, E, nullptr); }
#endif
}
__device__ __forceinline__ void phase_compress(LAS unsigned char* lds) {
    KArgs ka = kargs(); unsigned char* ws = ka->ws;
    compress_phase(lds, (const bf16*)(ws + BIG_KV), (const bf16*)(ws + WS_W1T), (const bf16*)(ws + WS_W2T), (const float*)(ws + WS_B1P), ka->in[I_CB1], ka->in[I_CB2], (bf16*)(ws + BIG_KCMP));
}
__device__ __forceinline__ void phase_attn_dilated(LAS unsigned char* lds) {
    KArgs ka = kargs(); unsigned char* ws = ka->ws; const Ids d = ids();
    const bf16* QKV = (const bf16*)(ws + WS_BIG); bf16* OB = (bf16*)(ws + WS_O); LAS unsigned char* slab = lds + d.wave * 16384;
#ifndef NO_DIL
    for (int it = d.gw; it < 8192; it += d.NGW) { const int rr = it & 15, h = (it >> 4) & 15, B = it >> 8; dil_item(QKV, OB, B, rr, h, slab, d.lane); }
#endif
}
__device__ __forceinline__ void phase_attn_nsa(LAS unsigned char* lds) {
    KArgs ka = kargs(); unsigned char* ws = ka->ws; const Ids d = ids();
    const bf16* KCMP = (const bf16*)(ws + BIG_KCMP); LAS unsigned char* slab = lds + d.wave * 16384;
#ifndef NO_NSA
    for (int k = 0; k < 4; ++k) { const int idx = ((k & 1) ? (d.NGW - 1 - d.gw) : d.gw) + d.NGW * k;
        if (idx < 8192) nsa_item((const bf16*)(ws + BIG_Q), (const bf16*)(ws + BIG_KV), KCMP, KCMP + 1024 * 256, (const float*)(ws + WS_GATES), (bf16*)(ws + WS_O), idx >> 2, idx & 3, slab, d.lane); }
#endif
}
template <int L>
__device__ __forceinline__ void phase_outproj(LAS unsigned char* lds) {
    KArgs ka = kargs(); unsigned char* ws = ka->ws; const Ids d = ids();
    const bf16* Wt = (L < 2) ? (const bf16*)(ws + WS_WOUTA) + (size_t)L * DM * DM : (const bf16*)(ws + WS_WOUTB) + (size_t)(L - 2) * DM * DM;
    pg8::Gemm gm{(const bf16*)(ws + WS_O), Wt, SEQ, DM, DM}; EpiAccF32 E{(float*)(ws + WS_HF), DM};
    pg8::StaticOrder S; S.init(SEQ, DM, d.G, d.bx);
#ifndef NO_G2
    pg8::gemm_phase<EpiAccF32, pg8::StaticOrder, false>(lds, gm, S, E, nullptr);
#endif
}
template <int L>
__device__ __forceinline__ void phase_ln_mix(LAS unsigned char* lds) {
    KArgs ka = kargs(); unsigned char* ws = ka->ws;
    ln_phase(lds, 0, (const float*)(ws + WS_HF), nullptr, ka->in[I_LMG] + (size_t)L * DM, ka->in[I_LMB] + (size_t)L * DM, (float*)(ws + WS_HF), ALPHA, (bf16*)(ws + WS_HB),
             (const bf16*)(ws + WS_WR) + (size_t)L * 32 * DM, ka->in[I_MBR] + (size_t)L * 20, (int4*)(ws + WS_ROUTE), (int*)(ws + WS_HIST), nullptr);
}
__device__ __forceinline__ void phase_scatter(LAS unsigned char* lds) {
    KArgs ka = kargs(); unsigned char* ws = ka->ws;
    moe_scatter(lds, (const int4*)(ws + WS_ROUTE), (const int*)(ws + WS_HIST), (int*)(ws + WS_TILEB), (const bf16*)(ws + WS_HB), (bf16*)(ws + BIG_HS), (int*)(ws + WS_ROWINFO), (float*)(ws + WS_ROWW));
}
__device__ __forceinline__ void load_tileb(LAS unsigned char* lds, const int* TILEB) {
    LAS int* tb = (LAS int*)(lds + LDS_MISC);
    if (threadIdx.x < 17) tb[threadIdx.x] = TILEB[threadIdx.x];
    __syncthreads();
}
__device__ __forceinline__ void phase_moe_up(LAS unsigned char* lds) {
    KArgs ka = kargs(); unsigned char* ws = ka->ws; const Ids d = ids();
    load_tileb(lds, (const int*)(ws + WS_TILEB));
    pg8::Gemm gm{(const bf16*)(ws + BIG_HS), (const bf16*)(ws + WS_WGU), MAXROWS, 512, DM}; EpiSwiglu E{(bf16*)(ws + BIG_HID), (const float*)(ws + WS_ROWW)};
    MoeOrder S; S.init((const LAS int*)(lds + LDS_MISC), 2, d.G, d.bx);
#ifndef NO_M2
    pg8::gemm_phase<EpiSwiglu, MoeOrder, false>(lds, gm, S, E, nullptr);
#endif
}
__device__ __forceinline__ void phase_moe_down(LAS unsigned char* lds) {
    KArgs ka = kargs(); unsigned char* ws = ka->ws; const Ids d = ids();
    load_tileb(lds, (const int*)(ws + WS_TILEB));
    pg8::Gemm gm{(const bf16*)(ws + BIG_HID), (const bf16*)(ws + WS_WDN), MAXROWS, 1024, 256}; EpiScatter E{(bf16*)(ws + BIG_Y), (const int*)(ws + WS_ROWINFO)};
    MoeOrder S; S.init((const LAS int*)(lds + LDS_MISC), 4, d.G, d.bx);
#ifndef NO_M3
    pg8::gemm_phase<EpiScatter, MoeOrder, false>(lds, gm, S, E, nullptr);
#endif
}
template <int L>
__device__ __forceinline__ void phase_ln_ffn(LAS unsigned char* lds) {
    KArgs ka = kargs(); unsigned char* ws = ka->ws;
    constexpr bool last = (L == 3), gates = (L == 1 || L == 2);
    ln_phase(lds, gates ? 1 : 2, (const float*)(ws + WS_HF), (const bf16*)(ws + BIG_Y), ka->in[I_LFG] + (size_t)L * DM, ka->in[I_LFB] + (size_t)L * DM, last ? ka->out : (float*)(ws + WS_HF),
             last ? 1.0f : ALPHA, (bf16*)(ws + WS_HB), (const bf16*)(ws + WS_WG) + (size_t)(gates ? L - 1 : 0) * 64 * DM, ka->in[I_BBQ] + (size_t)(gates ? L - 1 : 0) * 1072 + 1024,
             nullptr, nullptr, (float*)(ws + WS_GATES));
}

template <int L>
__device__ __forceinline__ void layer_phases(LAS unsigned char* lds, const XcdBarrier& bar, const int lo, const int hi) {
    constexpr int PB = (L == 0) ? 1 : ((L == 1) ? 9 : ((L == 2) ? 17 : 27));
    constexpr int P1 = (L == 2) ? PB + 2 : PB;
    if (L == 2) {
        PHASE_IF(PB) phase_proj<L, 1, true>(lds);
        PHASE_BAR(PB);
        PHASE_IF(PB + 1) phase_compress(lds);
        PHASE_BAR(PB + 1);
        PHASE_IF(P1) phase_proj<L, 2, false>(lds);
        PHASE_BAR(P1);
    } else if (L == 3) {
        PHASE_IF(P1) phase_proj<L, 2, true>(lds);
        PHASE_BAR(P1);
    } else {
        PHASE_IF(P1) phase_proj<L, 0, (L > 0)>(lds);
        PHASE_BAR(P1);
    }
    PHASE_IF(P1 + 1) { if (L < 2) phase_attn_dilated(lds); else phase_attn_nsa(lds); }
    PHASE_BAR(P1 + 1);
    PHASE_IF(P1 + 2) phase_outproj<L>(lds);
    PHASE_BAR(P1 + 2);
    PHASE_IF(P1 + 3) phase_ln_mix<L>(lds);
    PHASE_BAR(P1 + 3);
    PHASE_IF(P1 + 4) phase_scatter(lds);
    PHASE_BAR(P1 + 4);
    PHASE_IF(P1 + 5) phase_moe_up(lds);
    PHASE_BAR(P1 + 5);
    PHASE_IF(P1 + 6) phase_moe_down(lds);
    PHASE_BAR(P1 + 6);
    PHASE_IF(P1 + 7) phase_ln_ffn<L>(lds);
    PHASE_BAR(P1 + 7);
}
constexpr int NPHASES = 35;

__global__ void __launch_bounds__(NTHREADS, 2) yoco_fwd(Args args) {
    extern __shared__ __attribute__((aligned(16))) unsigned char lds_raw[];
    LAS unsigned char* lds = (LAS unsigned char*)lds_raw;
    const int lo = args.ph_lo, hi = args.ph_hi;
    if (threadIdx.x < 4) ((LAS unsigned*)(lds + LDS_BAR))[threadIdx.x] = 0u;
    __syncthreads();
    unsigned* barw = (unsigned*)(args.ws + WS_CTL) + CW_BAR;
    XcdBarrier bar; bar.bar = barw; bar.x = 0; bar.st = (volatile LAS unsigned*)(lds + LDS_BAR);
    if (hi - lo > 1) bar = xcd_barrier_post(barw, (volatile LAS unsigned*)(lds + LDS_BAR));
    PHASE_IF(0) phase_prologue(lds);
    PHASE_BAR(0);
    layer_phases<0>(lds, bar, lo, hi);
    layer_phases<1>(lds, bar, lo, hi);
    layer_phases<2>(lds, bar, lo, hi);
    layer_phases<3>(lds, bar, lo, hi);
}

extern "C" void kernel_launch(void* const* d_in, const int* in_sizes, int n_in, void* d_out, int out_size, void* d_ws, size_t ws_size, hipStream_t stream) {
    static int grid = 0;
    if (grid == 0) {
        if (n_in != 20 || out_size != SEQ * DM || ws_size < WS_END) { fprintf(stderr, "kernel_launch: unexpected problem shape (n_in %d, out %d, ws %zu)\n", n_in, out_size, ws_size); grid = -1; return; }
        int dev = 0, cus = 0;
        if (hipGetDevice(&dev) != hipSuccess || hipDeviceGetAttribute(&cus, hipDeviceAttributeMultiprocessorCount, dev) != hipSuccess) { grid = -1; return; }
        if (hipFuncSetAttribute((const void*)yoco_fwd, hipFuncAttributeMaxDynamicSharedMemorySize, LDS_BYTES) != hipSuccess) { fprintf(stderr, "kernel_launch: hipFuncSetAttribute failed\n"); grid = -1; return; }
        int per_cu = 0;
        if (hipOccupancyMaxActiveBlocksPerMultiprocessor(&per_cu, (const void*)yoco_fwd, NTHREADS, LDS_BYTES) != hipSuccess || per_cu < 1) fprintf(stderr, "kernel_launch: occupancy query says %d\n", per_cu);
        (void)hipGetLastError();
        grid = cus;
    }
    if (grid < 0) return;
    (void)hipMemsetAsync((char*)d_ws + WS_CTL, 0, CTL_BYTES, stream);
    Args a{};
    for (int i = 0; i < 20; ++i) a.in[i] = (const float*)d_in[i];
    a.out = (float*)d_out; a.ws = (unsigned char*)d_ws;
#if MK_ONE_LAUNCH
    a.ph_lo = 0; a.ph_hi = NPHASES;
    hipLaunchKernelGGL(yoco_fwd, dim3(grid), dim3(NTHREADS), LDS_BYTES, stream, a);
#else
    for (int ph = 0; ph < NPHASES; ++ph) { a.ph_lo = ph; a.ph_hi = ph + 1; hipLaunchKernelGGL(yoco_fwd, dim3(grid), dim3(NTHREADS), LDS_BYTES, stream, a); }
#endif
}
```

```cpp
#include <hip/hip_runtime.h>
#include <cstdio>
#include <cstdint>
#include <cmath>
#define MK_ONE_LAUNCH 1
namespace pg8 {
#define PG8_LAS __attribute__((address_space(3)))
typedef unsigned short bf16_t;
typedef short bf16x8 __attribute__((ext_vector_type(8)));
typedef float f32x4 __attribute__((ext_vector_type(4)));
typedef unsigned u32x4 __attribute__((ext_vector_type(4)));
constexpr int BM = 256, BK = 64, HALF = 128, HTB = HALF * BK * 2  , STAGE_BYTES = 8 * HTB, NXCD = 8, WGM = 8;

__host__ __device__ __forceinline__ int lds_byte(int r, int c) { const int st = (r >> 4) * 2 + (c >> 5), rr = r & 15, cc = c & 31, ob = rr * 64 + cc * 2; return st * 1024 + (ob ^ (((ob >> 9) & 1) << 5)); }
__host__ __device__ __forceinline__ void stage_rc(int b, int& R, int& C) { const int st = b / 1024, sb = b % 1024, swz = sb ^ (((sb >> 9) & 1) << 5); R = (st >> 1) * 16 + swz / 64; C = (st & 1) * 32 + (swz % 64) / 2; }
__host__ __device__ __forceinline__ int perm32(int rho) { const int n = rho >> 4, i = rho & 15; return 8 * (i >> 2) + 4 * n + (i & 3); }

struct Unit { int pm, pn; };
struct Gemm { const bf16_t* A; const bf16_t* Bt; int M, N, K; };

struct StaticOrder {
    int nM, nN, nwg, G, c;
    __host__ __device__ void init(int M, int N, int G_, int c_) { nM = M / BM; nN = N / BM; nwg = nM * nN; G = G_; c = c_; }
    __host__ __device__ bool next(int i, Unit& u) const {
        const long L = (long)i * G + c; if (L >= nwg) return false;
        int wgid = (int)L; { const int q = nwg / NXCD, r = nwg % NXCD, xcd = wgid % NXCD, off = wgid / NXCD; wgid = (xcd < r ? xcd * (q + 1) : r * (q + 1) + (xcd - r) * q) + off; }
        const int nig = WGM * nN, gid = wgid / nig, fm = gid * WGM, gsz = (nM - fm) < WGM ? (nM - fm) : WGM;
        u.pm = fm + ((wgid % nig) % gsz); u.pn = (wgid % nig) / gsz; return true;
    }
    __device__ __forceinline__ void a_ready(const Unit&) const {}
    __device__ __forceinline__ void done(const Unit&) const {}
};
struct CountedOrder : StaticOrder {
    const unsigned* ready; unsigned need; unsigned* tmo;
    __device__ __forceinline__ void a_ready(const Unit& u) const {
        if (threadIdx.x < 64) {
            const unsigned long long t0 = __builtin_amdgcn_s_memrealtime(); unsigned polls = 0;
            while ((unsigned)__builtin_amdgcn_readfirstlane(__hip_atomic_load(ready + 64 * u.pm, __ATOMIC_RELAXED, __HIP_MEMORY_SCOPE_AGENT)) < need) {
                if ((++polls & 255u) == 0u && __builtin_amdgcn_readfirstlane(__hip_atomic_load(tmo, __ATOMIC_RELAXED, __HIP_MEMORY_SCOPE_AGENT)) != 0u) break;
                if (__builtin_amdgcn_s_memrealtime() - t0 > 2000000ull) {
                    if (threadIdx.x == 0) { unsigned expect = 0u; __hip_atomic_compare_exchange_strong(tmo + 1, &expect, 0x600u | (unsigned)(u.pm & 0xff), __ATOMIC_RELAXED, __ATOMIC_RELAXED, __HIP_MEMORY_SCOPE_AGENT); __hip_atomic_store(tmo, 1u, __ATOMIC_RELAXED, __HIP_MEMORY_SCOPE_AGENT); }
                    break; }
                __builtin_amdgcn_s_sleep(2); }
            __builtin_amdgcn_fence(__ATOMIC_ACQUIRE, "agent");
            asm volatile("s_waitcnt vmcnt(0)" ::: "memory");
        }
#if !defined(BROKEN_HOOK_NO_BARRIER)
        asm volatile("" ::: "memory"); __builtin_amdgcn_s_barrier(); asm volatile("" ::: "memory");
#endif
    }
};

__device__ __forceinline__ unsigned cvt_pk_bf16(float lo, float hi) { unsigned r; asm volatile("v_cvt_pk_bf16_f32 %0, %1, %2" : "=v"(r) : "v"(lo), "v"(hi)); return r; }
typedef float f32x2 __attribute__((ext_vector_type(2)));
__device__ __forceinline__ f32x2 gelu_pk(f32x2 v) {
    const f32x2 av = __builtin_elementwise_abs(v), d = av * 0.2316418882f + 1.0f;
    f32x2 t; t.x = __builtin_amdgcn_rcpf(d.x); t.y = __builtin_amdgcn_rcpf(d.y);
    f32x2 q = t * 0.5307027145f + (-0.7265760135f); q = q * t + 0.7107068705f; q = q * t + (-0.142248368f); q = q * t + 0.127414796f; q = q * t;
    const f32x2 s = (v * v) * (-0.72134752044f);
    f32x2 e; e.x = __builtin_amdgcn_exp2f(s.x); e.y = __builtin_amdgcn_exp2f(s.y);
    const f32x2 m = v * (q * e), r = v - m;
    f32x2 o; o.x = v.x < 0.f ? m.x : r.x; o.y = v.y < 0.f ? m.y : r.y; return o;
}

struct EpiF32 {
    static constexpr bool PERM = false, AFTER_DRAIN = false;
    float* C; int ldc; const float* bias;
    __device__ __forceinline__ void operator()(const f32x4 (&acc)[2][2][4][2], const Unit& u, int wr, int wc, int fr, int fq) const {
        const int row0 = u.pm * BM + wr * 64 + fr, col0 = u.pn * BM + wc * 32 + 4 * fq;
        f32x4 bv[2][2];
#pragma unroll
        for (int bj = 0; bj < 2; ++bj)
#pragma unroll
            for (int n = 0; n < 2; ++n) bv[bj][n] = bias ? *(const f32x4*)(bias + col0 + bj * HALF + n * 16) : (f32x4){0.f, 0.f, 0.f, 0.f};
#pragma unroll
        for (int ai = 0; ai < 2; ++ai)
#pragma unroll
            for (int m = 0; m < 4; ++m) { float* rowp = C + (size_t)(row0 + ai * HALF + m * 16) * ldc + col0;
#pragma unroll
                for (int bj = 0; bj < 2; ++bj)
#pragma unroll
                    for (int n = 0; n < 2; ++n) *(f32x4*)(rowp + bj * HALF + n * 16) = acc[ai][bj][m][n] + bv[bj][n]; }
    }
};
template <int ACT  > struct EpiBf16 {
    static constexpr bool PERM = true, AFTER_DRAIN = false;
    bf16_t* O; int ldc; const float* bias; int split_cols; size_t split_stride;
    __device__ __forceinline__ void operator()(const f32x4 (&acc)[2][2][4][2], const Unit& u, int wr, int wc, int fr, int fq) const {
        const int row0 = u.pm * BM + wr * 64 + fr; int colt = u.pn * BM; bf16_t* base = O;
        if (split_cols) { const int t = colt / split_cols; base += (size_t)t * split_stride; colt -= t * split_cols; }
        const int col0 = colt + wc * 32 + 8 * fq, bcol0 = u.pn * BM + wc * 32 + 8 * fq;
        f32x4 bv[2][2];
#pragma unroll
        for (int bj = 0; bj < 2; ++bj)
#pragma unroll
            for (int n = 0; n < 2; ++n) bv[bj][n] = bias ? *(const f32x4*)(bias + bcol0 + bj * HALF + 4 * n) : (f32x4){0.f, 0.f, 0.f, 0.f};
#pragma unroll
        for (int ai = 0; ai < 2; ++ai)
#pragma unroll
            for (int m = 0; m < 4; ++m) { bf16_t* rowp = base + (size_t)(row0 + ai * HALF + m * 16) * ldc + col0;
#pragma unroll
                for (int bj = 0; bj < 2; ++bj) { f32x4 v0 = acc[ai][bj][m][0] + bv[bj][0], v1 = acc[ai][bj][m][1] + bv[bj][1];
                    if (ACT == 1) { f32x2 a = gelu_pk((f32x2){v0[0], v0[1]}), b = gelu_pk((f32x2){v0[2], v0[3]}), c = gelu_pk((f32x2){v1[0], v1[1]}), d = gelu_pk((f32x2){v1[2], v1[3]});
                        v0 = (f32x4){a.x, a.y, b.x, b.y}; v1 = (f32x4){c.x, c.y, d.x, d.y}; }
                    if (ACT == 2) {
#pragma unroll
                        for (int j = 0; j < 4; ++j) { v0[j] = 0.5f * v0[j] * (1.0f + erff(v0[j] * 0.70710678f)); v1[j] = 0.5f * v1[j] * (1.0f + erff(v1[j] * 0.70710678f)); } }
                    u32x4 w; w.x = cvt_pk_bf16(v0[0], v0[1]); w.y = cvt_pk_bf16(v0[2], v0[3]); w.z = cvt_pk_bf16(v1[0], v1[1]); w.w = cvt_pk_bf16(v1[2], v1[3]);
                    *(u32x4*)(rowp + bj * HALF) = w; } }
    }
};

struct PanelStats {
    unsigned* xbuf;
    unsigned* cnt;
    unsigned* tmo;
    int ntn; float eps;
    unsigned code;
    __device__ __forceinline__ bool run(const f32x4 (&v)[2][2][4][2], const Unit& u, int wr, int wc, int fr, int fq, PG8_LAS unsigned char* lds, int wid, int lane) const {
        typedef float f32x2v __attribute__((ext_vector_type(2)));
        PG8_LAS f32x2v* P = (PG8_LAS f32x2v*)lds;
        PG8_LAS f32x2v* S = (PG8_LAS f32x2v*)(lds + 8192);
        PG8_LAS unsigned* flag = (PG8_LAS unsigned*)(lds + 8192 + 2048);
#pragma unroll
        for (int ai = 0; ai < 2; ++ai)
#pragma unroll
            for (int m = 0; m < 4; ++m) {
                float s = 0.f;
#pragma unroll
                for (int bj = 0; bj < 2; ++bj)
#pragma unroll
                    for (int n = 0; n < 2; ++n) { const f32x4 x = v[ai][bj][m][n]; s += (x[0] + x[1]) + (x[2] + x[3]); }
                s += __shfl_xor(s, 16); s += __shfl_xor(s, 32);
                const float mw = s * (1.0f / 64.0f); float q = 0.f;
#pragma unroll
                for (int bj = 0; bj < 2; ++bj)
#pragma unroll
                    for (int n = 0; n < 2; ++n) { const f32x4 d = v[ai][bj][m][n] - mw; q += (d[0] * d[0] + d[1] * d[1]) + (d[2] * d[2] + d[3] * d[3]); }
                q += __shfl_xor(q, 16); q += __shfl_xor(q, 32);
                if (fq == 0) P[(ai * HALF + wr * 64 + m * 16 + fr) * 4 + wc] = (f32x2v){mw, q};
            }
        asm volatile("s_waitcnt lgkmcnt(0)" ::: "memory"); __builtin_amdgcn_s_barrier(); asm volatile("" ::: "memory");
#if defined(BROKEN_NO_WAIT)
        if (blockIdx.x >= 64) { const long long t0 = clock64(); while (clock64() - t0 < 60000) __builtin_amdgcn_s_sleep(8); }
#endif
        const int row = wid * 32 + (lane & 31);
        if (lane < 32) {
            const f32x2v a = P[row * 4 + 0], b = P[row * 4 + 1], c = P[row * 4 + 2], d = P[row * 4 + 3];
            const float mt = (a.x + b.x + c.x + d.x) * 0.25f;
            const float da = a.x - mt, db = b.x - mt, dc = c.x - mt, dd = d.x - mt;
            const float m2 = (a.y + b.y) + (c.y + d.y) + 64.0f * ((da * da + db * db) + (dc * dc + dd * dd));
            unsigned long long* slot = (unsigned long long*)xbuf + ((size_t)(u.pm * BM + row) * 4 + u.pn);
            __hip_atomic_store(slot, ((unsigned long long)__float_as_uint(m2) << 32) | __float_as_uint(mt), __ATOMIC_RELAXED, __HIP_MEMORY_SCOPE_AGENT);
        }
        asm volatile("s_waitcnt vmcnt(0)" ::: "memory");
        if (lane == 0) __hip_atomic_fetch_add(cnt + 64 * u.pm, 1u, __ATOMIC_RELAXED, __HIP_MEMORY_SCOPE_AGENT);
        if (wid == 0) {
            bool dead = false; const unsigned long long t0 = __builtin_amdgcn_s_memrealtime(); const unsigned want = 8u * (unsigned)ntn;
            for (;;) {
#if defined(BROKEN_NO_WAIT)
                break;
#endif
                if ((unsigned)__builtin_amdgcn_readfirstlane(__hip_atomic_load(cnt + 64 * u.pm, __ATOMIC_RELAXED, __HIP_MEMORY_SCOPE_AGENT)) >= want) break;
                if (__builtin_amdgcn_s_memrealtime() - t0 > 2000000ull) {
                    if (lane == 0) { unsigned expect = 0u; __hip_atomic_compare_exchange_strong(tmo + 1, &expect, code | (unsigned)(u.pm & 0xff), __ATOMIC_RELAXED, __ATOMIC_RELAXED, __HIP_MEMORY_SCOPE_AGENT);
                                     __hip_atomic_store(tmo, 1u, __ATOMIC_RELAXED, __HIP_MEMORY_SCOPE_AGENT); }
                    dead = true; break; }
                __builtin_amdgcn_s_sleep(2);
            }
            __builtin_amdgcn_fence(__ATOMIC_ACQUIRE, "agent");
            if (lane == 0) flag[0] = dead ? 1u : 0u;
        }
        asm volatile("s_waitcnt vmcnt(0) lgkmcnt(0)" ::: "memory"); __builtin_amdgcn_s_barrier(); asm volatile("" ::: "memory");
        const bool bad = flag[0] != 0u;
        if (lane < 32) {
            const unsigned long long* slot = (const unsigned long long*)xbuf + (size_t)(u.pm * BM + row) * 4; float mt[4], m2[4]; float ms = 0.f;
#pragma unroll
            for (int t = 0; t < 4; ++t) { if (t < ntn) { const unsigned long long w = __hip_atomic_load(slot + t, __ATOMIC_RELAXED, __HIP_MEMORY_SCOPE_AGENT); mt[t] = __uint_as_float((unsigned)w); m2[t] = __uint_as_float((unsigned)(w >> 32)); } else { mt[t] = 0.f; m2[t] = 0.f; } ms += mt[t]; }
            const float mean = ms / (float)ntn; float q = 0.f;
#pragma unroll
            for (int t = 0; t < 4; ++t) if (t < ntn) { const float dm = mt[t] - mean; q += m2[t] + 256.0f * dm * dm; }
            S[row] = (f32x2v){mean, 1.0f / sqrtf(q / (256.0f * (float)ntn) + eps)};
        }
        asm volatile("s_waitcnt lgkmcnt(0)" ::: "memory"); __builtin_amdgcn_s_barrier(); asm volatile("" ::: "memory");
        return bad;
    }
};
struct EpiLnRes {
    static constexpr bool PERM = false, AFTER_DRAIN = true;
    const float* base; float* out; int ldc; const float* bias; PanelStats st; unsigned poison;
    __device__ __forceinline__ void refuse(size_t i0, size_t stride, int M, int N) const { const float q = __builtin_nanf(""); for (size_t i = i0; i < (size_t)M * N; i += stride) out[(i / N) * ldc + i % N] = q;
        if (i0 == 0) { unsigned expect = 0u; __hip_atomic_compare_exchange_strong(st.tmo + 1, &expect, 0x7f0u, __ATOMIC_RELAXED, __ATOMIC_RELAXED, __HIP_MEMORY_SCOPE_AGENT); __hip_atomic_store(st.tmo, 1u, __ATOMIC_RELAXED, __HIP_MEMORY_SCOPE_AGENT); } }
    __device__ __forceinline__ void fused(f32x4 (&acc)[2][2][4][2], const Unit& u, int wr, int wc, int fr, int fq, PG8_LAS unsigned char* lds, int wid, int lane) const {
        typedef float f32x2v __attribute__((ext_vector_type(2)));
        const PG8_LAS f32x2v* S = (const PG8_LAS f32x2v*)(lds + 8192);
        const int col0 = u.pn * BM + wc * 32 + 4 * fq;
#pragma unroll
        for (int bj = 0; bj < 2; ++bj)
#pragma unroll
            for (int n = 0; n < 2; ++n) { const f32x4 bv = bias ? *(const f32x4*)(bias + col0 + bj * HALF + n * 16) : (f32x4){0.f, 0.f, 0.f, 0.f};
#pragma unroll
                for (int ai = 0; ai < 2; ++ai)
#pragma unroll
                    for (int m = 0; m < 4; ++m) acc[ai][bj][m][n] += bv; }
        const bool bad = st.run(acc, u, wr, wc, fr, fq, lds, wid, lane) || poison != 0u;
        const float qnan = __builtin_nanf("");
#pragma unroll
        for (int ai = 0; ai < 2; ++ai)
#pragma unroll
            for (int m = 0; m < 4; ++m) { const int r = ai * HALF + wr * 64 + m * 16 + fr; const f32x2v sr = S[r]; const size_t off = (size_t)(u.pm * BM + r) * ldc + col0;
#pragma unroll
                for (int bj = 0; bj < 2; ++bj)
#pragma unroll
                    for (int n = 0; n < 2; ++n) { const f32x4 bs = *(const f32x4*)(base + off + bj * HALF + n * 16); f32x4 o = bs + (acc[ai][bj][m][n] - sr.x) * sr.y;
                        if (bad) o = (f32x4){qnan, qnan, qnan, qnan}; *(f32x4*)(out + off + bj * HALF + n * 16) = o; }
                asm volatile("" ::: "memory"); }
    }
};
struct EpiLnResLn {
    static constexpr bool PERM = false, AFTER_DRAIN = true;
    const float* base; float* out; bf16_t* xn; int ldc; const float* bias; PanelStats st1, st2; unsigned poison;
    __device__ __forceinline__ void refuse(size_t i0, size_t stride, int M, int N) const { const float q = __builtin_nanf(""); for (size_t i = i0; i < (size_t)M * N; i += stride) { const size_t o = (i / N) * ldc + i % N; out[o] = q; xn[o] = (bf16_t)0x7fc0u; }
        if (i0 == 0) { unsigned expect = 0u; __hip_atomic_compare_exchange_strong(st1.tmo + 1, &expect, 0x7f0u, __ATOMIC_RELAXED, __ATOMIC_RELAXED, __HIP_MEMORY_SCOPE_AGENT); __hip_atomic_store(st1.tmo, 1u, __ATOMIC_RELAXED, __HIP_MEMORY_SCOPE_AGENT); } }
    __device__ __forceinline__ void fused(f32x4 (&acc)[2][2][4][2], const Unit& u, int wr, int wc, int fr, int fq, PG8_LAS unsigned char* lds, int wid, int lane) const {
        typedef float f32x2v __attribute__((ext_vector_type(2))); typedef unsigned u32x2v __attribute__((ext_vector_type(2)));
        const PG8_LAS f32x2v* S = (const PG8_LAS f32x2v*)(lds + 8192);
        const int col0 = u.pn * BM + wc * 32 + 4 * fq;
#pragma unroll
        for (int bj = 0; bj < 2; ++bj)
#pragma unroll
            for (int n = 0; n < 2; ++n) { const f32x4 bv = bias ? *(const f32x4*)(bias + col0 + bj * HALF + n * 16) : (f32x4){0.f, 0.f, 0.f, 0.f};
#pragma unroll
                for (int ai = 0; ai < 2; ++ai)
#pragma unroll
                    for (int m = 0; m < 4; ++m) acc[ai][bj][m][n] += bv; }
        bool bad = st1.run(acc, u, wr, wc, fr, fq, lds, wid, lane) || poison != 0u;
        const float qnan = __builtin_nanf("");
#pragma unroll
        for (int ai = 0; ai < 2; ++ai)
#pragma unroll
            for (int m = 0; m < 4; ++m) { const int r = ai * HALF + wr * 64 + m * 16 + fr; const f32x2v sr = S[r]; const size_t off = (size_t)(u.pm * BM + r) * ldc + col0;
#pragma unroll
                for (int bj = 0; bj < 2; ++bj)
#pragma unroll
                    for (int n = 0; n < 2; ++n) { const f32x4 bs = *(const f32x4*)(base + off + bj * HALF + n * 16); acc[ai][bj][m][n] = bs + (acc[ai][bj][m][n] - sr.x) * sr.y; }
                asm volatile("" : "+v"(acc[ai][0][m][0]), "+v"(acc[ai][0][m][1]), "+v"(acc[ai][1][m][0]), "+v"(acc[ai][1][m][1]));
                if (m & 1) asm volatile("" ::: "memory"); }
        const bool bad1 = bad;
        bad = st2.run(acc, u, wr, wc, fr, fq, lds, wid, lane) || bad;
#pragma unroll
        for (int ai = 0; ai < 2; ++ai)
#pragma unroll
            for (int m = 0; m < 4; ++m) { const int r = ai * HALF + wr * 64 + m * 16 + fr; const f32x2v sr = S[r]; const size_t off = (size_t)(u.pm * BM + r) * ldc + col0;
#pragma unroll
                for (int bj = 0; bj < 2; ++bj)
#pragma unroll
                    for (int n = 0; n < 2; ++n) { const f32x4 x1 = acc[ai][bj][m][n]; *(f32x4*)(out + off + bj * HALF + n * 16) = bad1 ? (f32x4){qnan, qnan, qnan, qnan} : x1;
                        const f32x4 o = (x1 - sr.x) * sr.y; u32x2v w; w.x = cvt_pk_bf16(o[0], o[1]); w.y = cvt_pk_bf16(o[2], o[3]);
                        if (bad) { w.x = 0x7fc07fc0u; w.y = 0x7fc07fc0u; } *(u32x2v*)(xn + off + bj * HALF + n * 16) = w; }
                asm volatile("" ::: "memory"); }
    }
};

template <class Epi, class Sched, bool STAMP = false>
__device__ __forceinline__ void gemm_phase(PG8_LAS unsigned char* lds, const Gemm g, const Sched& S, const Epi& E, unsigned long long* stamps) {
    const int tid = threadIdx.x, wid = __builtin_amdgcn_readfirstlane(tid >> 6), lane = tid & 63, wr = wid >> 2, wc = wid & 3, fr = lane & 15, fq = lane >> 4;
    const int K = g.K, nt = K / BK;
    int ts_lo = 0, ts_hi = 0, nts = 0; const unsigned long long rt_entry = STAMP ? (unsigned long long)wall_clock64() : 0ull;
#define PG8_STAMP() do { if (STAMP && wid == 0 && nts < 64) { const unsigned long long _c = (unsigned long long)clock64(); \
        ts_lo = (lane == nts) ? (int)(unsigned)_c : ts_lo; ts_hi = (lane == nts) ? (int)(unsigned)(_c >> 32) : ts_hi; ++nts; } } while (0)
    PG8_STAMP();
    unsigned voffA[2], voffB[2];
#pragma unroll
    for (int i = 0; i < 2; ++i) { int R, C; stage_rc(tid * 16 + i * 8192, R, C); const int Rb = Epi::PERM ? ((R & ~31) + perm32(R & 31)) : R;
        voffA[i] = (unsigned)(R * K + C) * 2u; voffB[i] = (unsigned)(Rb * K + C) * 2u; }
    const size_t kstep = (size_t)(BK * 2);
    const size_t hstep = (size_t)HALF * K * 2;
    const size_t tstep = 2 * hstep;
    const unsigned ldsw = (unsigned)wid * 1024u;
    const int aoff = lds_byte(wr * 64 + fr, fq * 8), boff = lds_byte(wc * 32 + fr, fq * 8);
#define PG8_SA(b, h) (((b) * 2 + (h)) * HTB)
#define PG8_SB(b, h) ((4 + (b) * 2 + (h)) * HTB)
#define PG8_STAGE(bufoff, gbase, voff) do { _Pragma("unroll") for (int _i = 0; _i < 2; ++_i) \
        __builtin_amdgcn_global_load_lds((const unsigned*)((const char*)(gbase) + (voff)[_i]), (PG8_LAS unsigned*)(lds + (bufoff) + ldsw + _i * 8192), 16, 0, 0); } while (0)
#define PG8_LDA(dst, b, h) do { _Pragma("unroll") for (int m = 0; m < 4; ++m) _Pragma("unroll") for (int k = 0; k < 2; ++k) dst[m][k] = *(const PG8_LAS bf16x8*)(lds + PG8_SA(b, h) + aoff + m * 2048 + k * 1024); } while (0)
#define PG8_LDB(dst, b, h) do { _Pragma("unroll") for (int n = 0; n < 2; ++n) _Pragma("unroll") for (int k = 0; k < 2; ++k) dst[n][k] = *(const PG8_LAS bf16x8*)(lds + PG8_SB(b, h) + boff + n * 2048 + k * 1024); } while (0)
#define PG8_MMA(ai, bj, At, Bt) do { __builtin_amdgcn_s_setprio(1); _Pragma("unroll") for (int m = 0; m < 4; ++m) _Pragma("unroll") for (int n = 0; n < 2; ++n) _Pragma("unroll") for (int k = 0; k < 2; ++k) \
        acc[ai][bj][m][n] = __builtin_amdgcn_mfma_f32_16x16x32_bf16(Bt[n][k], At[m][k], acc[ai][bj][m][n], 0, 0, 0); __builtin_amdgcn_s_setprio(0); } while (0)
#define PG8_WAIT_V(n) asm volatile("s_waitcnt vmcnt(" #n ")" ::: "memory")
#define PG8_WAIT_L(n) asm volatile("s_waitcnt lgkmcnt(" #n ")" ::: "memory")
#define PG8_BAR __builtin_amdgcn_s_barrier()
#define PG8_SCHED __builtin_amdgcn_sched_barrier(0)
    Unit cur, nxt; int ui = 0;
    if (!S.next(0, cur)) return;
    f32x4 acc[2][2][4][2];
#pragma unroll
    for (int a = 0; a < 2; ++a)
#pragma unroll
        for (int b = 0; b < 2; ++b)
#pragma unroll
            for (int m = 0; m < 4; ++m)
#pragma unroll
                for (int n = 0; n < 2; ++n) acc[a][b][m][n] = (f32x4){0.f, 0.f, 0.f, 0.f};
    bf16x8 At[4][2], B0[2][2], B1[2][2];
    const char* cA = (const char*)g.A + (size_t)cur.pm * tstep; const char* cB = (const char*)g.Bt + (size_t)cur.pn * tstep;
    S.a_ready(cur);
    PG8_STAGE(PG8_SB(0, 0), cB, voffB); PG8_STAGE(PG8_SA(0, 0), cA, voffA); PG8_STAGE(PG8_SB(0, 1), cB + hstep, voffB); PG8_STAGE(PG8_SA(0, 1), cA + hstep, voffA);
    if (wr == 1) PG8_BAR;
    PG8_WAIT_V(4); PG8_BAR;
    PG8_STAGE(PG8_SB(1, 0), cB + kstep, voffB); PG8_STAGE(PG8_SA(1, 0), cA + kstep, voffA); PG8_STAGE(PG8_SB(1, 1), cB + hstep + kstep, voffB);
    PG8_WAIT_V(6); PG8_BAR;
    PG8_STAMP();
    for (;;) {
        const bool has_next = S.next(ui + 1, nxt);
        const char* nA = has_next ? (const char*)g.A + (size_t)nxt.pm * tstep : cA; const char* nB = has_next ? (const char*)g.Bt + (size_t)nxt.pn * tstep : cB;
        for (int t = 0; t < nt; t += 2) {
            const bool last = (t == nt - 2);
            const char* a1 = cA + (size_t)(t + 1) * kstep;
            const char* a2 = last ? nA : cA + (size_t)(t + 2) * kstep; const char* b2 = last ? nB : cB + (size_t)(t + 2) * kstep;
            const char* a3 = a2 + kstep; const char* b3 = b2 + kstep;
            if (last && has_next) S.a_ready(nxt);
            PG8_LDB(B0, 0, 0); PG8_SCHED; PG8_LDA(At, 0, 0); PG8_STAGE(PG8_SA(1, 1), a1 + hstep, voffA);
            PG8_WAIT_L(8); PG8_BAR; PG8_WAIT_L(0); PG8_MMA(0, 0, At, B0); PG8_BAR; PG8_SCHED;
            PG8_LDB(B1, 0, 1); PG8_STAGE(PG8_SB(0, 0), b2, voffB);
            PG8_BAR; PG8_WAIT_L(0); PG8_MMA(0, 1, At, B1); PG8_BAR;
            PG8_LDA(At, 0, 1); PG8_STAGE(PG8_SA(0, 0), a2, voffA);
            PG8_BAR; PG8_WAIT_L(0); PG8_MMA(1, 0, At, B0); PG8_BAR; PG8_SCHED;
            PG8_STAGE(PG8_SB(0, 1), b2 + hstep, voffB);
            PG8_WAIT_V(6); PG8_BAR; PG8_MMA(1, 1, At, B1); PG8_BAR;
            PG8_LDB(B0, 1, 0); PG8_SCHED; PG8_LDA(At, 1, 0); PG8_STAGE(PG8_SA(0, 1), a2 + hstep, voffA);
            PG8_WAIT_L(8); PG8_BAR; PG8_WAIT_L(0); PG8_MMA(0, 0, At, B0); PG8_BAR; PG8_SCHED;
            PG8_LDB(B1, 1, 1); PG8_STAGE(PG8_SB(1, 0), b3, voffB);
            PG8_BAR; PG8_WAIT_L(0); PG8_MMA(0, 1, At, B1); PG8_BAR;
            PG8_LDA(At, 1, 1); PG8_STAGE(PG8_SA(1, 0), a3, voffA);
            PG8_BAR; PG8_WAIT_L(0); PG8_MMA(1, 0, At, B0); PG8_BAR; PG8_SCHED;
            PG8_STAGE(PG8_SB(1, 1), b3 + hstep, voffB);
            PG8_WAIT_V(6); PG8_BAR; PG8_MMA(1, 1, At, B1); PG8_BAR;
        }
        PG8_STAMP();
        if constexpr (!Epi::AFTER_DRAIN) { E(acc, cur, wr, wc, fr, fq); S.done(cur); }
        PG8_STAMP();
        if (!has_next) break;
#pragma unroll
        for (int a = 0; a < 2; ++a)
#pragma unroll
            for (int b = 0; b < 2; ++b)
#pragma unroll
                for (int m = 0; m < 4; ++m)
#pragma unroll
                    for (int n = 0; n < 2; ++n) acc[a][b][m][n] = (f32x4){0.f, 0.f, 0.f, 0.f};
        cur = nxt; cA = nA; cB = nB; ++ui;
    }
    PG8_WAIT_V(0);
    if (wr == 0) PG8_BAR;
    PG8_BAR;
    if constexpr (Epi::AFTER_DRAIN) { E.fused(acc, cur, wr, wc, fr, fq, lds, wid, lane); S.done(cur); }
    PG8_STAMP();
    if (STAMP && wid == 0) { stamps[lane] = lane < nts ? (((unsigned long long)(unsigned)ts_hi << 32) | (unsigned)ts_lo) : 0ull;
        if (lane == 62) stamps[62] = rt_entry; if (lane == 63) stamps[63] = (unsigned long long)wall_clock64(); }
#undef PG8_STAMP
#undef PG8_SA
#undef PG8_SB
#undef PG8_STAGE
#undef PG8_LDA
#undef PG8_LDB
#undef PG8_MMA
#undef PG8_WAIT_V
#undef PG8_WAIT_L
#undef PG8_BAR
#undef PG8_SCHED
}
}
#ifndef MK_ONE_LAUNCH
#define MK_ONE_LAUNCH 0
#endif
#ifndef DBG_CHECK
#define DBG_CHECK 0
#endif
#define LAS __attribute__((address_space(3)))
typedef unsigned short bf16;
typedef short bf16x8 __attribute__((ext_vector_type(8)));
typedef short s16x4 __attribute__((ext_vector_type(4)));
typedef short v4i16_t __attribute__((ext_vector_type(4)));
typedef float f32x16 __attribute__((ext_vector_type(16)));
typedef float f32x4 __attribute__((ext_vector_type(4)));
typedef unsigned u32x4 __attribute__((ext_vector_type(4)));
typedef unsigned u32x2 __attribute__((ext_vector_type(2)));

constexpr int SEQ = 16384, DM = 1024, NQKV = 9216, NKV = 1536;
constexpr int NWAVES = 8, NTHREADS = 512;
constexpr float ALPHA = 1.6817928305074290f;
constexpr float LOG2E = 1.4426950408889634f;
constexpr float C1 = 0.125f * LOG2E;
constexpr float LN_EPS = 1e-5f;
constexpr int MAXTILES = 144;
constexpr int MAXROWS = MAXTILES * 256;

constexpr size_t MiB = 1u << 20;
constexpr size_t WS_CTL = 0, CTL_BYTES = 1 * MiB;
constexpr size_t WS_HIST = 1 * MiB;
constexpr size_t WS_TILEB = 1 * MiB + 64 * 1024;
constexpr size_t WS_ROUTE = 2 * MiB;
constexpr size_t WS_ROWINFO = 3 * MiB;
constexpr size_t WS_ROWW = 4 * MiB;
constexpr size_t WS_GATES = 5 * MiB;
constexpr size_t WS_B1P = 8 * MiB;
constexpr size_t WS_WR = 9 * MiB;
constexpr size_t WS_WG = 9 * MiB + 256 * 1024;
constexpr size_t WS_W2T = 9 * MiB + 512 * 1024;
constexpr size_t WS_W1T = 10 * MiB;
constexpr size_t WS_WIN = 12 * MiB;
constexpr size_t WS_WOUTA = 48 * MiB;
constexpr size_t WS_WKV = 52 * MiB;
constexpr size_t WS_WQ = 55 * MiB;
constexpr size_t WS_WOUTB = 59 * MiB;
constexpr size_t WS_WGU = 64 * MiB;
constexpr size_t WS_WDN = 80 * MiB;
constexpr size_t WS_HF = 88 * MiB;
constexpr size_t WS_HB = 152 * MiB;
constexpr size_t WS_O = 184 * MiB;
constexpr size_t WS_BIG = 216 * MiB;
constexpr size_t BIG_HS = WS_BIG;
constexpr size_t BIG_HID = WS_BIG + 72 * MiB;
constexpr size_t BIG_Y = WS_BIG + 90 * MiB;
constexpr size_t BIG_KV = WS_BIG + 160 * MiB;
constexpr size_t BIG_KCMP = WS_BIG + 208 * MiB;
constexpr size_t BIG_Q = WS_BIG + 210 * MiB;
constexpr size_t WS_END = 504 * MiB;
constexpr int CW_BAR = 4096;
constexpr int CW_DBG = 16384;

constexpr int LDS_MISC = 131072;
constexpr int LDS_BAR = 163840 - 16;
constexpr int LDS_BYTES = 163840;

#define MFMA32(a, b, c) __builtin_amdgcn_mfma_f32_32x32x16_bf16(a, b, c, 0, 0, 0)
__device__ __forceinline__ int crow(int r, int hi) { return (r & 3) + 8 * (r >> 2) + 4 * hi; }
__device__ __forceinline__ unsigned pk2(float lo, float hi) { unsigned r; asm("v_cvt_pk_bf16_f32 %0, %1, %2" : "=v"(r) : "v"(lo), "v"(hi)); return r; }
__device__ __forceinline__ float bf2f(unsigned short b) { return __uint_as_float(((unsigned)b) << 16); }
__device__ __forceinline__ float bflo(unsigned w) { return __uint_as_float(w << 16); }
__device__ __forceinline__ float bfhi(unsigned w) { return __uint_as_float(w & 0xffff0000u); }
__device__ __forceinline__ float ex2(float x) { return __builtin_amdgcn_exp2f(x); }
__device__ __forceinline__ float wave_sum(float v) {
#pragma unroll
    for (int o = 1; o < 64; o <<= 1) v += __shfl_xor(v, o);
    return v;
}
__device__ __forceinline__ s16x4 tr_read(LAS unsigned char* p) { return __builtin_bit_cast(s16x4, __builtin_amdgcn_ds_read_tr16_b64_v4i16((LAS v4i16_t*)p)); }
#define LDS_WAIT() asm volatile("s_waitcnt lgkmcnt(0)" ::: "memory")

#define XB_TMO      128
#define XB_XCNT(j)  (256  + 64 * (j))
#define XB_XSUB(j)  (1280 + 64 * (j))
#define XB_XGEN(j)  (2304 + 64 * (j))
#define XB_TOP      3328
#define XB_TOPGEN   3392
#define XCD_BAR_WORDS 3456
#define XB_SPIN_CAP (1u << 18)
__device__ __forceinline__ unsigned xb_ld(unsigned* p)              { return __hip_atomic_load(p, __ATOMIC_RELAXED, __HIP_MEMORY_SCOPE_AGENT); }
__device__ __forceinline__ unsigned xb_add(unsigned* p, unsigned v) { return __hip_atomic_fetch_add(p, v, __ATOMIC_RELAXED, __HIP_MEMORY_SCOPE_AGENT); }
__device__ __forceinline__ unsigned xb_xcc_id() { return (unsigned)__builtin_amdgcn_s_getreg((3 << 11) | 20) & 0xFu; }
#define XB_SPIN(cond, bar) do { unsigned _sp = 0; while (cond) { __builtin_amdgcn_s_sleep(1); \
    if ((++_sp & 255u) == 0u) { if (xb_ld(&(bar)[XB_TMO])) break; if (_sp > XB_SPIN_CAP) { atomicAdd(&(bar)[XB_TMO], 1u); break; } } } } while (0)
struct XcdBarrier { unsigned* bar; unsigned x; volatile LAS unsigned* st; };
__device__ __forceinline__ XcdBarrier xcd_barrier_post(unsigned* bar, volatile LAS unsigned* st) {
    XcdBarrier b; b.bar = bar; b.x = xb_xcc_id(); b.st = st;
    if (threadIdx.x == 0) (void)xb_add(&bar[XB_XCNT(b.x)], 1u);
    return b;
}
__device__ __forceinline__ void xcd_barrier_complete(unsigned* bar, unsigned x, unsigned& nloc, unsigned& nx) {
    const unsigned G = gridDim.x * gridDim.y * gridDim.z;
    unsigned sum, cnt, mine, sp = 0u;
    for (;;) {
        sum = 0u; cnt = 0u; mine = 0u;
#pragma unroll
        for (unsigned j = 0; j < 16; ++j) { const unsigned c = xb_ld(&bar[XB_XCNT(j)]); sum += c; cnt += (c > 0u) ? 1u : 0u; mine = (j == x) ? c : mine; }
        if (sum == G) break;
        __builtin_amdgcn_s_sleep(1);
        if ((++sp & 255u) == 0u) { if (xb_ld(&bar[XB_TMO])) break; if (sp > XB_SPIN_CAP) { atomicAdd(&bar[XB_TMO], 1u); break; } }
    }
    nloc = mine > 0u ? mine : 1u; nx = cnt > 0u ? cnt : 1u;
}
__device__ __forceinline__ void xcd_barrier(const XcdBarrier& b) {
    asm volatile("s_waitcnt vmcnt(0)" ::: "memory");
    __syncthreads();
    if (threadIdx.x == 0) {
        unsigned* bar = b.bar;
        __builtin_amdgcn_s_waitcnt(0);
        unsigned nloc = b.st[0], nx = b.st[1];
        if (nloc == 0u) { xcd_barrier_complete(bar, b.x, nloc, nx); b.st[0] = nloc; b.st[1] = nx; }
        const unsigned old = xb_add(&bar[XB_XSUB(b.x)], 1u);
        const unsigned gen = old / nloc;
        if (old + 1u == (gen + 1u) * nloc) {
            __builtin_amdgcn_fence(__ATOMIC_RELEASE, "agent");
            asm volatile("s_waitcnt vmcnt(0)" ::: "memory");
            const unsigned og = xb_add(&bar[XB_TOP], 1u);
            const unsigned tg = og / nx;
            if (og + 1u == (tg + 1u) * nx) xb_add(&bar[XB_TOPGEN], 1u);
            else XB_SPIN(xb_ld(&bar[XB_TOPGEN]) == tg, bar);
            __builtin_amdgcn_fence(__ATOMIC_ACQUIRE, "agent");
            xb_add(&bar[XB_XGEN(b.x)], 1u);
            asm volatile("s_waitcnt vmcnt(0)" ::: "memory");
        } else {
            XB_SPIN(xb_ld(&bar[XB_XGEN(b.x)]) == gen, bar);
            __builtin_amdgcn_fence(__ATOMIC_ACQUIRE, "agent");
            asm volatile("s_waitcnt vmcnt(0)" ::: "memory");
        }
    }
    __syncthreads();
}

struct TcRegs { float v[32]; };
__device__ __forceinline__ void tc_load(TcRegs& R, const float* src, int ld, int srccol0, int nvalid, int kb, int lane) {
    const int k0 = 64 * kb, n = lane & 31; const float* p = src + (size_t)(k0 + (lane >> 5)) * ld + srccol0 + n;
#pragma unroll
    for (int i = 0; i < 32; ++i) R.v[i] = (n < nvalid) ? p[(size_t)(2 * i) * ld] : 0.f;
}
__device__ __forceinline__ void tc_finish(const TcRegs& R, int K, bf16* dst, int dstrow0, int kb, LAS float* scr, int lane) {
    const int k0 = 64 * kb;
#pragma unroll
    for (int i = 0; i < 32; ++i) scr[(2 * i + (lane >> 5)) * 33 + (lane & 31)] = R.v[i];
    LDS_WAIT();
    const int c = lane & 7;
#pragma unroll
    for (int j = 0; j < 4; ++j) { const int n = (lane >> 3) + 8 * j; const LAS float* s = scr + (8 * c) * 33 + n;
        u32x4 o; o.x = pk2(s[0 * 33], s[1 * 33]); o.y = pk2(s[2 * 33], s[3 * 33]); o.z = pk2(s[4 * 33], s[5 * 33]); o.w = pk2(s[6 * 33], s[7 * 33]);
        *(u32x4*)(dst + (size_t)(dstrow0 + n) * K + k0 + 8 * c) = o; }
    LDS_WAIT();
}
template <class Desc>
__device__ __forceinline__ void tc_stream(int nitems, int gw, int NGW, LAS float* scr, int lane, Desc desc) {
    const float* srcA; int ldA, KA, c0A, nvA, r0A, kbA; bf16* dstA; const float* srcB; int ldB, KB, c0B, nvB, r0B, kbB; bf16* dstB;
    TcRegs A, B;
    int it = gw; if (it >= nitems) return;
    desc(it, srcA, ldA, KA, c0A, nvA, dstA, r0A, kbA); tc_load(A, srcA, ldA, c0A, nvA, kbA, lane);
#pragma nounroll
    for (;;) {
        const int itB = it + NGW; const bool hb = itB < nitems;
        if (hb) { desc(itB, srcB, ldB, KB, c0B, nvB, dstB, r0B, kbB); tc_load(B, srcB, ldB, c0B, nvB, kbB, lane); }
        tc_finish(A, KA, dstA, r0A, kbA, scr, lane);
        if (!hb) break;
        const int itA = itB + NGW; const bool ha = itA < nitems;
        if (ha) { desc(itA, srcA, ldA, KA, c0A, nvA, dstA, r0A, kbA); tc_load(A, srcA, ldA, c0A, nvA, kbA, lane); }
        tc_finish(B, KB, dstB, r0B, kbB, scr, lane);
        if (!ha) break;
        it = itA;
    }
}
__device__ __forceinline__ void tc_matrix(const float* src, int ld, int K, int col0, int ncolvalid, bf16* dst, int nrows, LAS float* scr, int lane, int gw, int NGW) {
    const int nkb = K / 64, nnb = nrows / 32;
    tc_stream(nkb * nnb, gw, NGW, scr, lane, [=](int it, const float*& s_, int& ld_, int& K_, int& c0_, int& nv_, bf16*& d_, int& r0_, int& kb_) {
        const int kb = it / nnb, nb = it % nnb; int nv = ncolvalid - 32 * nb; nv = nv < 0 ? 0 : (nv > 32 ? 32 : nv);
        s_ = src; ld_ = ld; K_ = K; c0_ = col0 + 32 * nb; nv_ = nv; d_ = dst; r0_ = 32 * nb; kb_ = kb; });
}
__device__ __forceinline__ void convert_moe_weights(const float* gu, const float* dn, bf16* WGU, bf16* WDN, LAS float* scr, int lane, int gw, int NGW) {
    tc_stream(16 * 256 + 16 * 128, gw, NGW, scr, lane, [=](int it, const float*& s_, int& ld_, int& K_, int& c0_, int& nv_, bf16*& d_, int& r0_, int& kb_) {
        if (it < 4096) { const int e = it >> 8, r = it & 255, kb = r >> 4, nb = r & 15, rho0 = 32 * nb, ct = rho0 >> 8, half = (rho0 >> 7) & 1, x0 = rho0 & 127;
            s_ = gu + (size_t)e * 1024 * 512; ld_ = 512; K_ = 1024; c0_ = half * 256 + 128 * ct + x0; nv_ = 32; d_ = WGU + (size_t)e * 512 * 1024; r0_ = rho0; kb_ = kb; }
        else { const int i2 = it - 4096, e = i2 >> 7, r = i2 & 127, kb = r >> 5, nb = r & 31;
            s_ = dn + (size_t)e * 256 * 1024; ld_ = 1024; K_ = 256; c0_ = 32 * nb; nv_ = 32; d_ = WDN + (size_t)e * 1024 * 256; r0_ = 32 * nb; kb_ = kb; } });
}

#define ATT_V2 1
#ifndef WINCORE
#define WINCORE attn_core_d
#endif
#ifndef SLCCORE
#define SLCCORE attn_core_d
#endif
#ifndef STATCORE
#define STATCORE stats_core_d
#endif
#ifndef CMP2_NEW
#define CMP2_NEW 1
#endif
#ifndef REP_SLC
#define REP_SLC 1
#endif
#ifndef REP_WIN
#define REP_WIN 1
#endif
#ifndef REP_SEL
#define REP_SEL 1
#endif
#ifndef REP_CMP
#define REP_CMP 1
#endif
struct KVT { bf16x8 k[4]; u32x4 v[4]; };
template <class RowF>
__device__ __forceinline__ void kv_load(KVT& T, const bf16* kbase, const bf16* vbase, RowF rowf, int lane) {
#pragma unroll
    for (int i = 0; i < 4; ++i) { const size_t ro = rowf(8 * i + (lane >> 3)) + 8 * (lane & 7); T.k[i] = *(const bf16x8*)(kbase + ro); T.v[i] = *(const u32x4*)(vbase + ro); }
#if defined(LOAD_REP)
#pragma unroll
    for (int i = 0; i < 4; ++i) { const size_t ro = rowf(8 * i + (lane >> 3)) + 8 * (lane & 7); u32x4 a, b;
        asm volatile("global_load_dwordx4 %0, %2, off sc1\n\tglobal_load_dwordx4 %1, %3, off sc1\n\ts_waitcnt vmcnt(0)" : "=&v"(a), "=&v"(b) : "v"(kbase + ro), "v"(vbase + ro) : "memory"); }
#endif
}
template <class RowF>
__device__ __forceinline__ void k_load(bf16x8 (&k)[4], const bf16* kbase, RowF rowf, int lane) {
#pragma unroll
    for (int i = 0; i < 4; ++i) k[i] = *(const bf16x8*)(kbase + rowf(8 * i + (lane >> 3)) + 8 * (lane & 7));
}
__device__ __forceinline__ void k_stage(const bf16x8 (&k)[4], LAS unsigned char* ks, int lane) {
#pragma unroll
    for (int i = 0; i < 4; ++i) { const int key = 8 * i + (lane >> 3), c = lane & 7; *(LAS bf16x8*)(ks + key * 128 + ((c ^ (key & 7)) << 4)) = k[i]; }
}
__device__ __forceinline__ void k_frags(bf16x8 (&kf)[4], LAS unsigned char* ks, int lane) {
    const int key = lane & 31, hi = lane >> 5;
    asm volatile("" ::: "memory");
#pragma unroll
    for (int s = 0; s < 4; ++s) kf[s] = *(const LAS bf16x8*)(ks + key * 128 + (((2 * s + hi) ^ (key & 7)) << 4));
}
__device__ __forceinline__ void q_load(bf16x8 (&q)[4], const bf16* qrow, int lane) {
    const int hi = lane >> 5;
#pragma unroll
    for (int s = 0; s < 4; ++s) q[s] = *(const bf16x8*)(qrow + 16 * s + 8 * hi);
}
__device__ __forceinline__ void v_stage(const KVT& T, LAS unsigned char* vs, int lane) {
#pragma unroll
    for (int i = 0; i < 4; ++i) { const int key = 8 * i + (lane >> 3), c = lane & 7; *(LAS u32x4*)(vs + (c >> 2) * 2048 + key * 64 + (c & 3) * 16) = T.v[i]; }
}
struct VF { bf16x8 f[2][2]; };
__device__ __forceinline__ void v_frags(VF& V, LAS unsigned char* vs, int lane) {
    const int hi = lane >> 5;
    LAS unsigned char* vp = vs + ((lane >> 4) & 1) * 32 + (lane & 3) * 8 + (4 * hi + ((lane & 15) >> 2)) * 64;
    asm volatile("" ::: "memory");
#pragma unroll
    for (int db = 0; db < 2; ++db)
#pragma unroll
        for (int s2 = 0; s2 < 2; ++s2) { const s16x4 lo = tr_read(vp + db * 2048 + s2 * 1024), h4 = tr_read(vp + db * 2048 + s2 * 1024 + 512);
            V.f[db][s2] = (bf16x8){lo[0], lo[1], lo[2], lo[3], h4[0], h4[1], h4[2], h4[3]}; }
    asm volatile("" ::: "memory");
}
__device__ __forceinline__ void pv_mma(const f32x16& p, const VF& V, f32x16 (&o)[2]) {
    u32x4 w0, w1;
    w0.x = pk2(p[0], p[1]); w0.y = pk2(p[2], p[3]); w0.z = pk2(p[4], p[5]); w0.w = pk2(p[6], p[7]);
    w1.x = pk2(p[8], p[9]); w1.y = pk2(p[10], p[11]); w1.z = pk2(p[12], p[13]); w1.w = pk2(p[14], p[15]);
    const bf16x8 pf0 = __builtin_bit_cast(bf16x8, w0), pf1 = __builtin_bit_cast(bf16x8, w1);
    o[0] = MFMA32(V.f[0][0], pf0, o[0]); o[1] = MFMA32(V.f[1][0], pf0, o[1]);
    o[0] = MFMA32(V.f[0][1], pf1, o[0]); o[1] = MFMA32(V.f[1][1], pf1, o[1]);
}
__device__ __forceinline__ void pv_acc(const f32x16& p, LAS unsigned char* vs, int lane, f32x16 (&o)[2]) { VF V; v_frags(V, vs, lane); pv_mma(p, V, o); }
__device__ __forceinline__ float xhalf_max(float v) {
    const auto rr = __builtin_amdgcn_permlane32_swap(__float_as_uint(v), __float_as_uint(v), false, false);
    return fmaxf(__uint_as_float(rr[0]), __uint_as_float(rr[1]));
}
__device__ __forceinline__ f32x16 qk_tile(const bf16x8 (&qf)[4], const bf16x8 (&kf)[4]) {
    f32x16 s;
#pragma unroll
    for (int r = 0; r < 16; ++r) s[r] = 0.f;
#pragma unroll
    for (int d0 = 0; d0 < 4; ++d0) s = MFMA32(kf[d0], qf[d0], s);
    return s;
}
struct TileP { float base, sd; int dist0, dd, lim; };
typedef float f32x2 __attribute__((ext_vector_type(2)));
constexpr float QMUL = 1.0f;
template <bool MASK>
__device__ __forceinline__ void scores(f32x16& s, const TileP P) {
    const f32x2 c1 = {QMUL, QMUL}, sd2 = {P.sd, P.sd};
#pragma unroll
    for (int r = 0; r < 16; r += 2) { const int cr = (r & 3) + 8 * (r >> 2);
        const f32x2 crv = {(float)cr, (float)(cr + 1)}, b2 = {P.base, P.base};
        const f32x2 raw = {s[r], s[r + 1]};
        f32x2 x = __builtin_elementwise_fma(raw, c1, __builtin_elementwise_fma(sd2, crv, b2));
        if (MASK) { const bool ok0 = (unsigned)(P.dist0 - P.dd * cr) <= (unsigned)P.lim, ok1 = (unsigned)(P.dist0 - P.dd * (cr + 1)) <= (unsigned)P.lim; x.x = ok0 ? x.x : -INFINITY; x.y = ok1 ? x.y : -INFINITY; }
        s[r] = x.x; s[r + 1] = x.y; }
}
__device__ __forceinline__ float exp_sum(f32x16& s, float mn) {
    const f32x2 m2 = {mn, mn}; f32x2 acc = {0.f, 0.f};
#pragma unroll
    for (int r = 0; r < 16; r += 2) { f32x2 x = {s[r], s[r + 1]}; x = x - m2; f32x2 e; e.x = ex2(x.x); e.y = ex2(x.y); acc = acc + e; s[r] = e.x; s[r + 1] = e.y; }
    return acc.x + acc.y;
}
template <bool MASK>
__device__ __forceinline__ void attn_core(const bf16x8 (&qf)[4], LAS unsigned char* tl, int lane, float& m, float& l, f32x16 (&o)[2], const TileP P) {
    bf16x8 kf[4]; k_frags(kf, tl + 4096, lane);
    VF V; v_frags(V, tl, lane);
    f32x16 s = qk_tile(qf, kf);
    scores<MASK>(s, P);
    float mx = fmaxf(fmaxf(fmaxf(s[0], s[1]), fmaxf(s[2], s[3])), fmaxf(fmaxf(s[4], s[5]), fmaxf(s[6], s[7])));
    mx = fmaxf(mx, fmaxf(fmaxf(fmaxf(s[8], s[9]), fmaxf(s[10], s[11])), fmaxf(fmaxf(s[12], s[13]), fmaxf(s[14], s[15]))));
    mx = xhalf_max(mx);
    const float mn = fmaxf(m, mx);
    if (__builtin_amdgcn_ballot_w64(mn > m)) { const float alpha = ex2(m - mn); l *= alpha;
#pragma unroll
        for (int r = 0; r < 16; ++r) { o[0][r] *= alpha; o[1][r] *= alpha; } }
    m = mn;
    l += exp_sum(s, mn);
    pv_mma(s, V, o);
}
template <bool MASK>
__device__ __forceinline__ void attn_tile(const bf16x8 (&qf)[4], const KVT& T, LAS unsigned char* vs, int lane, float& m, float& l, f32x16 (&o)[2], const TileP P) {
    v_stage(T, vs, lane); k_stage(T.k, vs + 4096, lane);
    attn_core<MASK>(qf, vs, lane, m, l, o, P);
}
template <bool MASK>
__device__ __forceinline__ void stats_core(const bf16x8 (&qf)[4], LAS unsigned char* tl, int lane, float& m, float& l, const TileP P) {
    bf16x8 kf[4]; k_frags(kf, tl + 4096, lane);
    f32x16 s = qk_tile(qf, kf);
    scores<MASK>(s, P);
    float mx = -INFINITY;
#pragma unroll
    for (int r = 0; r < 16; ++r) mx = fmaxf(mx, s[r]);
    mx = xhalf_max(mx);
    const float mn = fmaxf(m, mx); l *= ex2(m - mn); m = mn;
    float ps = 0.f;
#pragma unroll
    for (int r = 0; r < 16; ++r) ps += ex2(s[r] - mn);
    l += ps;
}
template <bool MASK>
__device__ __forceinline__ void stats_tile(const bf16x8 (&qf)[4], const bf16x8 (&kraw)[4], LAS unsigned char* vs, int lane, float& m, float& l, const TileP P) {
    k_stage(kraw, vs + 4096, lane); stats_core<MASK>(qf, vs, lane, m, l, P);
}
constexpr float SM_THR = 8.0f;
template <bool MASK>
__device__ __forceinline__ f32x16 qk_scores_d(const bf16x8 (&qf)[4], const bf16x8 (&kf)[4], const TileP P, float mref) {
    f32x16 s; const float b0 = P.base - mref;
#pragma unroll
    for (int r = 0; r < 16; ++r) { const int cr = (r & 3) + 8 * (r >> 2);
        float x = fmaf(P.sd, (float)cr, b0);
        if (MASK) { const bool ok = (unsigned)(P.dist0 - P.dd * cr) <= (unsigned)P.lim; x = ok ? x : -INFINITY; }
        s[r] = x; }
#pragma unroll
    for (int d0 = 0; d0 < 4; ++d0) s = MFMA32(kf[d0], qf[d0], s);
    return s;
}
template <bool MASK>
__device__ __forceinline__ void attn_core_d(const bf16x8 (&qf)[4], LAS unsigned char* tl, int lane, float& m, float& l, f32x16 (&o)[2], const TileP P) {
    bf16x8 kf[4]; k_frags(kf, tl + 4096, lane);
    VF V; v_frags(V, tl, lane);
    const bool seeded = m > -1e29f; const float mref = seeded ? m : 0.f;
    f32x16 s = qk_scores_d<MASK>(qf, kf, P, mref);
    float mx = fmaxf(fmaxf(fmaxf(s[0], s[1]), fmaxf(s[2], s[3])), fmaxf(fmaxf(s[4], s[5]), fmaxf(s[6], s[7])));
    mx = fmaxf(mx, fmaxf(fmaxf(fmaxf(s[8], s[9]), fmaxf(s[10], s[11])), fmaxf(fmaxf(s[12], s[13]), fmaxf(s[14], s[15]))));
    mx = xhalf_max(mx);
    const bool need = seeded ? (mx > SM_THR) : (mx > -INFINITY);
    if (__builtin_amdgcn_ballot_w64(need)) {
        const float dl = need ? mx : 0.f, f = (need && seeded) ? ex2(-dl) : 1.0f;
        m = need ? mref + dl : m; l *= f;
#pragma unroll
        for (int r = 0; r < 16; ++r) { o[0][r] *= f; o[1][r] *= f; s[r] -= dl; }
    }
    l += exp_sum(s, 0.f);
    pv_mma(s, V, o);
}
template <bool MASK>
__device__ __forceinline__ void stats_core_d(const bf16x8 (&qf)[4], LAS unsigned char* tl, int lane, float& m, float& l, const TileP P) {
    bf16x8 kf[4]; k_frags(kf, tl + 4096, lane);
    const bool seeded = m > -1e29f; const float mref = seeded ? m : 0.f;
    f32x16 s = qk_scores_d<MASK>(qf, kf, P, mref);
    float mx = fmaxf(fmaxf(fmaxf(s[0], s[1]), fmaxf(s[2], s[3])), fmaxf(fmaxf(s[4], s[5]), fmaxf(s[6], s[7])));
    mx = fmaxf(mx, fmaxf(fmaxf(fmaxf(s[8], s[9]), fmaxf(s[10], s[11])), fmaxf(fmaxf(s[12], s[13]), fmaxf(s[14], s[15]))));
    mx = xhalf_max(mx);
    const bool need = seeded ? (mx > SM_THR) : (mx > -INFINITY);
    if (__builtin_amdgcn_ballot_w64(need)) {
        const float dl = need ? mx : 0.f, f = (need && seeded) ? ex2(-dl) : 1.0f;
        m = need ? mref + dl : m; l *= f;
#pragma unroll
        for (int r = 0; r < 16; ++r) s[r] -= dl;
    }
    l += exp_sum(s, 0.f);
}
__device__ __forceinline__ float quad_sum(float x) {
    x += __uint_as_float(__builtin_amdgcn_update_dpp(0u, __float_as_uint(x), 0xB1, 0xF, 0xF, true));
    x += __uint_as_float(__builtin_amdgcn_update_dpp(0u, __float_as_uint(x), 0x4E, 0xF, 0xF, true));
    return x;
}
__device__ __forceinline__ float xhalf_other(float v, int hi) {
    const auto rr = __builtin_amdgcn_permlane32_swap(__float_as_uint(v), __float_as_uint(v), false, false);
    return __uint_as_float(hi ? rr[0] : rr[1]);
}
__device__ __forceinline__ float max16p(const f32x16& s) {
    const float mx = fmaxf(fmaxf(fmaxf(s[0], s[1]), fmaxf(s[2], s[3])), fmaxf(fmaxf(s[4], s[5]), fmaxf(s[6], s[7])));
    return fmaxf(mx, fmaxf(fmaxf(fmaxf(s[8], s[9]), fmaxf(s[10], s[11])), fmaxf(fmaxf(s[12], s[13]), fmaxf(s[14], s[15]))));
}
template <bool MASKA, bool MASKB>
__device__ __forceinline__ void attn_core2_d(const bf16x8 (&qf)[4], LAS unsigned char* ta, LAS unsigned char* tb, int lane, float& m, float& l, f32x16 (&o)[2], const TileP PA, const TileP PB) {
    bf16x8 kfa[4], kfb[4]; k_frags(kfa, ta + 4096, lane); k_frags(kfb, tb + 4096, lane);
    VF VA, VB; v_frags(VA, ta, lane); v_frags(VB, tb, lane);
    const bool seeded = m > -1e29f; const float mref = seeded ? m : 0.f;
    f32x16 sa = qk_scores_d<MASKA>(qf, kfa, PA, mref);
    f32x16 sb = qk_scores_d<MASKB>(qf, kfb, PB, mref);
    const float mx = xhalf_max(fmaxf(max16p(sa), max16p(sb)));
    const bool need = seeded ? (mx > SM_THR) : (mx > -INFINITY);
    if (__builtin_amdgcn_ballot_w64(need)) {
        const float dl = need ? mx : 0.f, f = (need && seeded) ? ex2(-dl) : 1.0f;
        m = need ? mref + dl : m; l *= f;
#pragma unroll
        for (int r = 0; r < 16; ++r) { o[0][r] *= f; o[1][r] *= f; sa[r] -= dl; sb[r] -= dl; }
    }
    l += exp_sum(sa, 0.f) + exp_sum(sb, 0.f);
    pv_mma(sa, VA, o); pv_mma(sb, VB, o);
}
template <bool MASKA, bool MASKB>
__device__ __forceinline__ void stats_core2_d(const bf16x8 (&qf)[4], LAS unsigned char* ta, LAS unsigned char* tb, int lane, float& m, float& l, const TileP PA, const TileP PB) {
    bf16x8 kfa[4], kfb[4]; k_frags(kfa, ta + 4096, lane); k_frags(kfb, tb + 4096, lane);
    const bool seeded = m > -1e29f; const float mref = seeded ? m : 0.f;
    f32x16 sa = qk_scores_d<MASKA>(qf, kfa, PA, mref);
    f32x16 sb = qk_scores_d<MASKB>(qf, kfb, PB, mref);
    const float mx = xhalf_max(fmaxf(max16p(sa), max16p(sb)));
    const bool need = seeded ? (mx > SM_THR) : (mx > -INFINITY);
    if (__builtin_amdgcn_ballot_w64(need)) {
        const float dl = need ? mx : 0.f, f = (need && seeded) ? ex2(-dl) : 1.0f;
        m = need ? mref + dl : m; l *= f;
#pragma unroll
        for (int r = 0; r < 16; ++r) { sa[r] -= dl; sb[r] -= dl; }
    }
    l += exp_sum(sa, 0.f) + exp_sum(sb, 0.f);
}
template <bool WITH_V, class RowF, class Compute>
__device__ __forceinline__ void shared_pairs(int n, LAS unsigned char* lds, int slab_stride, const bf16* kbase, const bf16* vbase, RowF rowf, int wave, int lane, Compute compute) {
    if (n <= 0) return;
    const int ns = (n + 1) >> 1;
    const int lw = wave & 3; const bool isv = wave >= 4;
    const int key = 8 * lw + (lane >> 3), c = lane & 7;
    const int woff = isv ? ((c >> 2) * 2048 + key * 64 + (c & 3) * 16) : (4096 + key * 128 + ((c ^ (key & 7)) << 4));
    const bf16* base = isv ? vbase : kbase;
    const bool active = WITH_V || !isv;
    auto img = [&](int b, int x) { return lds + (2 * b + x) * slab_stride; };
    auto ld = [&](int t) { const int tc = t < n ? t : n - 1; return *(const u32x4*)(base + rowf(tc, key) + 8 * c); };
    u32x4 R0 = {0u, 0u, 0u, 0u}, R1 = R0;
    __syncthreads();
    if (active) { R0 = ld(0); R1 = ld(1); *(LAS u32x4*)(img(0, 0) + woff) = R0; *(LAS u32x4*)(img(0, 1) + woff) = R1; }
    if (ns > 1 && active) { R0 = ld(2); R1 = ld(3); }
    __syncthreads();
#pragma nounroll
    for (int s = 0; s < ns; ++s) {
        if (s + 1 < ns && active) { *(LAS u32x4*)(img((s + 1) & 1, 0) + woff) = R0; *(LAS u32x4*)(img((s + 1) & 1, 1) + woff) = R1; }
        if (s + 2 < ns && active) { R0 = ld(2 * s + 4); R1 = ld(2 * s + 5); }
        compute(img(s & 1, 0), (2 * s + 1 < n) ? img(s & 1, 1) : (LAS unsigned char*)nullptr, s);
        __syncthreads();
    }
}
struct KV2 { bf16x8 k[2][4]; u32x4 v[2][4]; };
__device__ __forceinline__ void v_stage_raw(const u32x4 (&v)[4], LAS unsigned char* vs, int lane) {
#pragma unroll
    for (int i = 0; i < 4; ++i) { const int key = 8 * i + (lane >> 3), c = lane & 7; *(LAS u32x4*)(vs + (c >> 2) * 2048 + key * 64 + (c & 3) * 16) = v[i]; }
}
template <bool MASK>
__device__ __forceinline__ void pair_qk(const bf16x8 (&qf)[4], LAS unsigned char* vs, int lane, float mref, const TileP PA, const TileP PB, f32x16& sa, f32x16& sb) {
    { bf16x8 kf[4]; k_frags(kf, vs, lane); sa = qk_scores_d<MASK>(qf, kf, PA, mref); }
    { bf16x8 kf[4]; k_frags(kf, vs + 4096, lane); sb = qk_scores_d<MASK>(qf, kf, PB, mref); }
    asm volatile("" ::: "memory");
}
__device__ __forceinline__ void pair_sm_pv(f32x16& sa, f32x16& sb, LAS unsigned char* vs, int lane, float& m, float& l, f32x16 (&o)[2], bool seeded, float mref) {
    const float mx = xhalf_max(fmaxf(max16p(sa), max16p(sb)));
    const bool need = seeded ? (mx > SM_THR) : (mx > -INFINITY);
    if (__builtin_amdgcn_ballot_w64(need)) {
        const float dl = need ? mx : 0.f, f = (need && seeded) ? ex2(-dl) : 1.0f;
        m = need ? mref + dl : m; l *= f;
#pragma unroll
        for (int r = 0; r < 16; ++r) { o[0][r] *= f; o[1][r] *= f; sa[r] -= dl; sb[r] -= dl; }
    }
    l += exp_sum(sa, 0.f) + exp_sum(sb, 0.f);
    { VF V; v_frags(V, vs, lane); pv_mma(sa, V, o); }
    { VF V; v_frags(V, vs + 4096, lane); pv_mma(sb, V, o); }
    asm volatile("" ::: "memory");
}
template <class Issue, class Stage, class Compute>
__device__ __forceinline__ void pipe_tiles1(int n, Issue issue, Stage stage, Compute compute) {
    if (n <= 0) return;
    KVT T; issue(T, 0);
#pragma nounroll
    for (int i = 0; i < n; ++i) { stage(T, i); if (i + 1 < n) issue(T, i + 1); compute(i); }
}
template <class Issue, class Stage, class Compute>
__device__ __forceinline__ void pipe_tiles2(int n, Issue issue, Stage stage, Compute compute) {
    if (n <= 0) return;
    KVT A, B; issue(A, 0); if (n > 1) issue(B, 1);
    int i = 0;
#pragma nounroll
    for (; i + 1 < n; i += 2) { stage(A, i); if (i + 2 < n) issue(A, i + 2); compute(i); stage(B, i + 1); if (i + 3 < n) issue(B, i + 3); compute(i + 1); }
    if (i < n) { stage(A, i); compute(i); }
}
template <bool WITH_V, class RowF, class Compute>
__device__ __forceinline__ void shared_tiles(int n, LAS unsigned char* sh, const bf16* kbase, const bf16* vbase, RowF rowf, int wave, int lane, Compute compute) {
    if (n <= 0) return;
    const int lw = wave & 3; const bool isv = wave >= 4;
    const int key = 8 * lw + (lane >> 3), c = lane & 7;
    const int woff = isv ? ((c >> 2) * 2048 + key * 64 + (c & 3) * 16) : (4096 + key * 128 + ((c ^ (key & 7)) << 4));
    const bf16* base = isv ? vbase : kbase;
    const bool active = WITH_V || !isv;
    u32x4 RA = {0u, 0u, 0u, 0u}, RB = RA;
    if (active) { RA = *(const u32x4*)(base + rowf(0, key) + 8 * c); *(LAS u32x4*)(sh + woff) = RA; }
    if (n > 1 && active) RA = *(const u32x4*)(base + rowf(1, key) + 8 * c);
    if (n > 2 && active) RB = *(const u32x4*)(base + rowf(2, key) + 8 * c);
    __syncthreads();
    int i = 0;
#pragma nounroll
    for (; i + 1 < n; i += 2) {
        if (active) *(LAS u32x4*)(sh + ((i + 1) & 1) * 8192 + woff) = RA;
        if (i + 3 < n && active) RA = *(const u32x4*)(base + rowf(i + 3, key) + 8 * c);
        compute(sh + (i & 1) * 8192, i);
        __syncthreads();
        if (i + 2 < n && active) *(LAS u32x4*)(sh + (i & 1) * 8192 + woff) = RB;
        if (i + 4 < n && active) RB = *(const u32x4*)(base + rowf(i + 4, key) + 8 * c);
        compute(sh + ((i + 1) & 1) * 8192, i + 1);
        __syncthreads();
    }
    if (i < n) { compute(sh + (i & 1) * 8192, i); __syncthreads(); }
}
struct KT { bf16x8 k[4]; };
__device__ __forceinline__ void o_store(const f32x16 (&o)[2], bf16* orow, int hi) {
#pragma unroll
    for (int db = 0; db < 2; ++db)
#pragma unroll
        for (int k = 0; k < 4; ++k) { u32x2 w; w.x = pk2(o[db][4 * k], o[db][4 * k + 1]); w.y = pk2(o[db][4 * k + 2], o[db][4 * k + 3]); *(u32x2*)(orow + 32 * db + 8 * k + 4 * hi) = w; }
}
template <class Buf, class Issue, class Compute>
__device__ __forceinline__ void pipe_tiles(int n, Issue issue, Compute compute) {
    if (n <= 0) return;
    Buf A, B; issue(A, 0);
    int i = 0;
#pragma nounroll
    for (; i + 1 < n; i += 2) { issue(B, i + 1); compute(A, i); if (i + 2 < n) issue(A, i + 2); compute(B, i + 1); }
    if (i < n) compute(A, i);
}

constexpr int DST = 68, DIL_VS = 256 * DST * 4;
__device__ __forceinline__ void dil_block(const bf16* qkv, bf16* O, int b, int h, LAS unsigned char* lds, int wave, int lane) {
    LAS float* ST = (LAS float*)lds;
    LAS unsigned char* vs = lds + DIL_VS + wave * 8192;
    const int hi = lane >> 5, c = lane & 31;
    const float slope2 = exp2f(-0.5f * (float)(h + 1)) * LOG2E;
    float m = -1e30f, l = 0.f; f32x16 o[2];
    auto seg_g = [](int seg) { return seg < 2 ? seg : 2; };
    auto seg_tau = [&](int seg, int col) { return seg == 0 ? 32 * wave + col : (seg == 1 ? 128 * (wave >> 2) + (wave & 3) + 4 * col : (2 * wave + (seg - 2)) + 16 * (col & 15)); };
    bf16x8 qf[4];
    auto issue = [&](KVT& T, int t) {
        const int seg = t / 5, j = t - 5 * seg;
        const int g = seg_g(seg), d = 1 << (2 * g), W = 128 << (2 * g);
        const int tlo = 256 * b + seg_tau(seg, 0) - W + 32 * d * j;
        const bf16* kb = qkv + (size_t)((g * 3 + 1) * 16 + h) * ((size_t)SEQ * 64);
        kv_load(T, kb, kb + (size_t)16 * SEQ * 64, [&](int key) { int tk = tlo + d * key; tk = tk < 0 ? 0 : (tk > SEQ - 1 ? SEQ - 1 : tk); return (size_t)tk * 64; }, lane);
    };
    auto issue_q = [&](bf16x8 (&q)[4], int seg) { const int g = seg_g(seg); q_load(q, qkv + (size_t)((g * 3) * 16 + h) * ((size_t)SEQ * 64) + (size_t)(256 * b + seg_tau(seg, c)) * 64, lane); };
    auto compute = [&](int t) {
        const int seg = t / 5, j = t - 5 * seg;
        const int g = seg_g(seg), d = 1 << (2 * g), W = 128 << (2 * g);
        const int tau = seg_tau(seg, c), tq = 256 * b + tau;
        if (j == 0) {
            issue_q(qf, seg);
            if (seg == 0) {
                m = -1e30f; l = 0.f;
#pragma unroll
                for (int r = 0; r < 16; ++r) { o[0][r] = 0.f; o[1][r] = 0.f; }
            } else {
                if (seg <= 2) __syncthreads();
                const LAS float* sp = ST + tau * DST;
#pragma unroll
                for (int db = 0; db < 2; ++db)
#pragma unroll
                    for (int k = 0; k < 4; ++k) { const f32x4 v = *(const LAS f32x4*)(sp + 32 * db + 8 * k + 4 * hi); o[db][4 * k] = v[0]; o[db][4 * k + 1] = v[1]; o[db][4 * k + 2] = v[2]; o[db][4 * k + 3] = v[3]; }
                m = sp[64]; l = sp[65 + hi];
            }
        }
        const int tlo = 256 * b + seg_tau(seg, 0) - W + 32 * d * j, thi = tlo + 31 * d;
        if (thi >= 0) {
            TileP P; P.dist0 = tq - tlo - 4 * hi * d; P.dd = d; P.lim = W < tq ? W : tq; P.base = -slope2 * (float)P.dist0; P.sd = slope2 * (float)d;
            if (j >= 1 && j <= 3 && tlo >= 0) attn_core_d<false>(qf, vs, lane, m, l, o, P);
            else attn_core_d<true>(qf, vs, lane, m, l, o, P);
        }
        if (j == 4) {
            if (seg < 2) {
                LAS float* sp = ST + tau * DST;
#pragma unroll
                for (int db = 0; db < 2; ++db)
#pragma unroll
                    for (int k = 0; k < 4; ++k) { const f32x4 v = {o[db][4 * k], o[db][4 * k + 1], o[db][4 * k + 2], o[db][4 * k + 3]}; *(LAS f32x4*)(sp + 32 * db + 8 * k + 4 * hi) = v; }
                if (hi == 0) sp[64] = m;
                sp[65 + hi] = l;
            } else {
                const float lt = l + __shfl_xor(l, 32), inv = 1.0f / lt;
#pragma unroll
                for (int r = 0; r < 16; ++r) { o[0][r] *= inv; o[1][r] *= inv; }
                if (c < 16) o_store(o, O + (size_t)tq * DM + h * 64, hi);
            }
        }
    };
    pipe_tiles1(20, issue, [&](KVT& T, int) { v_stage(T, vs, lane); k_stage(T.k, vs + 4096, lane); }, compute);
    __syncthreads();
}

constexpr int SL_S = 8192, SL_SEL = SL_S + 8 * 257 * 4, SL_UB = SL_SEL + 256, NSA_SLAB = 17920;
__device__ __forceinline__ void nsa_item(const bf16* Q, const bf16* KV, const bf16* KC, const bf16* VC, const float* GATES, bf16* O, int tt, int g, LAS unsigned char* slab, int lane) {
    const int hi = lane >> 5, col = lane & 31, ti = col >> 2, r4 = col & 3, hh = 4 * g + r4;
    const int tq = 8 * tt + ti, tq0 = 8 * tt, tqmax = 8 * tt + 7;
    const float slope2 = exp2f(-0.5f * (float)(hh + 1)) * LOG2E;
    LAS unsigned char* vs = slab;
    LAS float* S = (LAS float*)(slab + SL_S);
    LAS unsigned* SEL = (LAS unsigned*)(slab + SL_SEL);
    LAS int* UB = (LAS int*)(slab + SL_UB);
    bf16x8 qf[4]; q_load(qf, Q + (size_t)hh * ((size_t)SEQ * 64) + (size_t)tq * 64, lane);
    const float* gt = GATES + (size_t)tq * 48 + g * 4 + r4;
    f32x16 oacc[2];
    for (int i = lane; i < 8 * 257; i += 64) S[i] = 0.f;
    const int ncmp = (tqmax >= 31) ? (((tqmax - 31) >> 4) + 1) : 0;
    const int ntc = (ncmp + 31) >> 5;
    auto crow_of = [&](int t2) { return [=](int key) { int cc = 32 * t2 + key; cc = cc > 1022 ? 1022 : cc; return (size_t)(cc * 4 + g) * 64; }; };
    auto cmp_P = [&](int t2) { TileP P; P.dist0 = tq - 31 - 16 * (32 * t2 + 4 * hi); P.dd = 16; P.lim = 0x3fffffff; P.base = -slope2 * (float)P.dist0; P.sd = slope2 * 16.f; return P; };
    auto cmp_interior = [&](int t2) { return 16 * (32 * t2 + 31) + 31 <= tq0; };
    for (int rep_ = 0; rep_ < REP_CMP; ++rep_) {
        float m = -1e30f, l = 0.f;
        pipe_tiles<KT>(ntc, [&](KT& T, int t2) { k_load(T.k, KC, crow_of(t2), lane); },
                       [&](KT& T, int t2) { const TileP P = cmp_P(t2);
                           if (cmp_interior(t2)) stats_tile<false>(qf, T.k, vs, lane, m, l, P); else stats_tile<true>(qf, T.k, vs, lane, m, l, P); });
        l += __shfl_xor(l, 32);
        const float linv = (l > 0.f) ? 1.0f / l : 0.f;
        f32x16 oc[2];
#pragma unroll
        for (int r = 0; r < 16; ++r) { oc[0][r] = 0.f; oc[1][r] = 0.f; }
        float carry = 0.f;
        pipe_tiles<KVT>(ntc, [&](KVT& T, int t2) { kv_load(T, KC, VC, crow_of(t2), lane); }, [&](KVT& T, int t2) {
            v_stage(T, vs, lane); k_stage(T.k, vs + 4096, lane);
            bf16x8 kf[4]; k_frags(kf, vs + 4096, lane);
            f32x16 s = qk_tile(qf, kf);
            const TileP P = cmp_P(t2);
            if (cmp_interior(t2)) scores<false>(s, P); else scores<true>(s, P);
#pragma unroll
            for (int r = 0; r < 16; ++r) s[r] = ex2(s[r] - m) * linv;
            pv_acc(s, vs, lane, oc);
            float prevr = carry;
#pragma unroll
            for (int i = 0; i < 4; ++i) { float e = s[4 * i + 3], p = 2.f * (s[4 * i] + s[4 * i + 1] + s[4 * i + 2]) + e;
                p += __shfl_xor(p, 1); p += __shfl_xor(p, 2); e += __shfl_xor(e, 1); e += __shfl_xor(e, 2);
                const float rcv = __shfl_xor(e, 32);
                const float sc = p + (hi ? rcv : prevr);
                const int u = 8 * t2 + 2 * i + hi; if (r4 == 0) S[ti * 257 + u] = sc;
                prevr = rcv; }
            carry = prevr;
        });
        { const float gc = gt[0];
#pragma unroll
        for (int r = 0; r < 16; ++r) { oacc[0][r] = gc * oc[0][r]; oacc[1][r] = gc * oc[1][r]; } }
    }
    LDS_WAIT();
    const int cur_b = tq0 >> 6;
#ifndef NSA_NO_SEL
    for (int rep_ = 0; rep_ < REP_SEL; ++rep_) {
        const int tok = lane >> 3, sub = lane & 7;
        unsigned wsel = 0u;
        if (cur_b <= 15) { wsel = (sub == 0) ? ((2u << cur_b) - 1u) : 0u; }
        else {
            unsigned key[32];
#pragma unroll
            for (int k = 0; k < 32; ++k) { const int u = sub + 8 * k; const unsigned bits = __float_as_uint(S[tok * 257 + u]);
                key[k] = (u >= 1 && u <= cur_b - 2) ? ((bits & 0xffffff00u) | (unsigned)(255 - u)) : 0u; }
            wsel = ((sub == 0) ? 1u : 0u) | (((cur_b >> 5) == sub) ? (1u << (cur_b & 31)) : 0u) | ((((cur_b - 1) >> 5) == sub) ? (1u << ((cur_b - 1) & 31)) : 0u);
            for (int rnd = 0; rnd < 13; ++rnd) {
                unsigned mx = 0u;
#pragma unroll
                for (int k = 0; k < 32; ++k) mx = key[k] > mx ? key[k] : mx;
                { const unsigned o1 = (unsigned)__shfl_xor((int)mx, 1); mx = o1 > mx ? o1 : mx; const unsigned o2 = (unsigned)__shfl_xor((int)mx, 2); mx = o2 > mx ? o2 : mx;
                  const unsigned o4 = (unsigned)__shfl_xor((int)mx, 4); mx = o4 > mx ? o4 : mx; }
#pragma unroll
                for (int k = 0; k < 32; ++k) key[k] = (key[k] == mx) ? 0u : key[k];
                const int u = 255 - (int)(mx & 0xffu);
                wsel |= ((u >> 5) == sub) ? (1u << (u & 31)) : 0u;
            }
        }
        SEL[tok * 8 + sub] = wsel;
    }
#endif
    LDS_WAIT();
    int nu = 0;
    for (int wd = 0; wd < 8; ++wd) {
        const unsigned mw = SEL[ti * 8 + wd];
        unsigned uw = 0u;
#pragma unroll
        for (int i = 0; i < 8; ++i) uw |= (unsigned)__builtin_amdgcn_readlane((int)mw, 4 * i);
        while (uw) { const int bb = __builtin_ctz(uw); uw &= uw - 1u; if (lane == 0) UB[nu] = wd * 32 + bb; ++nu; }
    }
    LDS_WAIT();
    LAS float* PARK = S;
#pragma unroll
    for (int r = 0; r < 16; ++r) { PARK[r * 64 + lane] = oacc[0][r]; PARK[(16 + r) * 64 + lane] = oacc[1][r]; }
#ifndef NSA_NO_SLC
    for (int rep_ = 0; rep_ < REP_SLC; ++rep_) {
        float m = -1e30f, l = 0.f; f32x16 os[2];
#pragma unroll
        for (int r = 0; r < 16; ++r) { os[0][r] = 0.f; os[1][r] = 0.f; }
        const bf16* kb = KV + 512 + g * 64; const bf16* vb = KV + 768 + g * 64;
        const int ntile = 2 * nu;
        auto tk0_of = [&](int idx) { return 64 * __builtin_amdgcn_readfirstlane(UB[idx >> 1]) + 32 * (idx & 1); };
        pipe_tiles<KVT>(ntile, [&](KVT& T, int idx) { const int tk0 = tk0_of(idx); kv_load(T, kb, vb, [=](int key) { return (size_t)(tk0 + key) * NKV; }, lane); },
            [&](KVT& T, int idx) {
                const int tk0 = tk0_of(idx), u = tk0 >> 6;
                if (tk0 <= tqmax) {
                    const bool mysel = (SEL[ti * 8 + (u >> 5)] >> (u & 31)) & 1u;
                    TileP P; P.dist0 = mysel ? (tq - tk0 - 4 * hi) : 0x40000000; P.dd = 1; P.lim = 0x3fffffff; P.base = -slope2 * (float)(tq - tk0 - 4 * hi); P.sd = slope2;
                    const bool interior = (tk0 + 31 <= tq0) && (__builtin_amdgcn_ballot_w64(!mysel) == 0ull);
                    if (interior) attn_tile<false>(qf, T, vs, lane, m, l, os, P); else attn_tile<true>(qf, T, vs, lane, m, l, os, P);
                }
            });
        l += __shfl_xor(l, 32);
        const float f = (l > 0.f && rep_ == REP_SLC - 1) ? gt[16] / l : 0.f;
#pragma unroll
        for (int r = 0; r < 16; ++r) { PARK[r * 64 + lane] += f * os[0][r]; PARK[(16 + r) * 64 + lane] += f * os[1][r]; }
    }
#endif
#ifndef NSA_NO_WIN
    for (int rep_ = 0; rep_ < REP_WIN; ++rep_) {
        float m = -1e30f, l = 0.f; f32x16 ow[2];
#pragma unroll
        for (int r = 0; r < 16; ++r) { ow[0][r] = 0.f; ow[1][r] = 0.f; }
        const bf16* kb = KV + 1024 + g * 64; const bf16* vb = KV + 1280 + g * 64;
        const int tkb = tq0 + 8 - 32 * 17;
        int t2s = 0; while (tkb + 32 * t2s + 31 < 0) ++t2s;
        auto wrow = [&](int tk0) { return [=](int key) { int tk = tk0 + key; tk = tk < 0 ? 0 : (tk > SEQ - 1 ? SEQ - 1 : tk); return (size_t)tk * NKV; }; };
        pipe_tiles<KVT>(17 - t2s, [&](KVT& T, int i) { kv_load(T, kb, vb, wrow(tkb + 32 * (t2s + i)), lane); },
            [&](KVT& T, int i) {
                const int tk0 = tkb + 32 * (t2s + i);
                TileP P; P.dist0 = tq - tk0 - 4 * hi; P.dd = 1; P.lim = 511 < tq ? 511 : tq; P.base = -slope2 * (float)P.dist0; P.sd = slope2;
                const bool interior = (tk0 >= 0) && (tqmax - tk0 <= 511) && (tk0 + 31 <= tq0);
                if (interior) attn_tile<false>(qf, T, vs, lane, m, l, ow, P); else attn_tile<true>(qf, T, vs, lane, m, l, ow, P);
            });
        l += __shfl_xor(l, 32);
        const float f = (l > 0.f) ? gt[32] / l : 0.f;
#pragma unroll
        for (int r = 0; r < 16; ++r) { oacc[0][r] = PARK[r * 64 + lane] + f * ow[0][r]; oacc[1][r] = PARK[(16 + r) * 64 + lane] + f * ow[1][r]; }
    }
#endif
    o_store(oacc, O + (size_t)tq * DM + hh * 64, hi);
}

#define NSA_CHUNK 1
__device__ __forceinline__ void nsa_chunk(const bf16* Q, const bf16* KV, const bf16* KC, const bf16* VC, const float* GATES, bf16* O, int ch, int g, LAS unsigned char* lds, int wave, int lane) {
    const int tt = 8 * ch + wave; LAS unsigned char* slab = lds + wave * NSA_SLAB; LAS unsigned char* SH = lds + 8 * NSA_SLAB;
    const int hi = lane >> 5, col = lane & 31, ti = col >> 2, r4 = col & 3, hh = 4 * g + r4;
    const int tq = 8 * tt + ti, tq0 = 8 * tt, tqmax = 8 * tt + 7;
    const float slope2 = exp2f(-0.5f * (float)(hh + 1)) * LOG2E;
    LAS unsigned char* vs = slab;
    LAS float* S = (LAS float*)(slab + SL_S);
    LAS unsigned* SEL = (LAS unsigned*)(slab + SL_SEL);
    LAS int* UB = (LAS int*)(slab + SL_UB);
    bf16x8 qf[4]; q_load(qf, Q + (size_t)hh * ((size_t)SEQ * 64) + (size_t)tq * 64, lane);
    const float* gt = GATES + (size_t)tq * 48 + g * 4 + r4;
    f32x16 oacc[2];
    for (int i = lane; i < 8 * 257; i += 64) S[i] = 0.f;
    const int ncmp = (tqmax >= 31) ? (((tqmax - 31) >> 4) + 1) : 0;
    const int ntc_w = (ncmp + 31) >> 5;
    const int ntc = (4 * ch + 3 + 31) >> 5;
    auto crow_of = [&](int t2) { return [=](int key) { int cc = 32 * t2 + key; cc = cc > 1022 ? 1022 : cc; return (size_t)(cc * 4 + g) * 64; }; };
    auto cmp_P = [&](int t2) { TileP P; P.dist0 = tq - 31 - 16 * (32 * t2 + 4 * hi); P.dd = 16; P.lim = 0x3fffffff; P.base = -slope2 * (float)P.dist0; P.sd = slope2 * 16.f; return P; };
    auto cmp_interior = [&](int t2) { return 16 * (32 * t2 + 31) + 31 <= tq0; };
    for (int rep_ = 0; rep_ < REP_CMP; ++rep_) {
        float m = -1e30f, l = 0.f;
        shared_pairs<false>(ntc, lds, NSA_SLAB, KC, VC, [&](int t2, int key) { int cc = 32 * t2 + key; cc = cc > 1022 ? 1022 : cc; return (size_t)(cc * 4 + g) * 64; }, wave, lane,
            [&](LAS unsigned char* ta, LAS unsigned char* tb, int s2) { const int t2 = 2 * s2;
                if (t2 + 1 < ntc_w && tb) { const TileP PA = cmp_P(t2), PB = cmp_P(t2 + 1);
                    if (cmp_interior(t2 + 1)) stats_core2_d<false, false>(qf, ta, tb, lane, m, l, PA, PB); else stats_core2_d<false, true>(qf, ta, tb, lane, m, l, PA, PB); }
                else if (t2 < ntc_w) { const TileP P = cmp_P(t2); if (cmp_interior(t2)) stats_core_d<false>(qf, ta, lane, m, l, P); else stats_core_d<true>(qf, ta, lane, m, l, P); } });
        l += __shfl_xor(l, 32);
        const float linv = (l > 0.f) ? 1.0f / l : 0.f, mfin = (m > -1e29f) ? m : 0.f; (void)mfin;
        f32x16 oc[2];
#pragma unroll
        for (int r = 0; r < 16; ++r) { oc[0][r] = 0.f; oc[1][r] = 0.f; }
        float carry = 0.f;
        auto cmp2_tile = [&](LAS unsigned char* tl, int t2) {
            bf16x8 kf[4]; k_frags(kf, tl + 4096, lane);
            const TileP P = cmp_P(t2);
#if CMP2_NEW
            f32x16 s = cmp_interior(t2) ? qk_scores_d<false>(qf, kf, P, mfin) : qk_scores_d<true>(qf, kf, P, mfin);
#pragma unroll
            for (int r = 0; r < 16; ++r) s[r] = ex2(s[r]) * linv;
#else
            f32x16 s = qk_tile(qf, kf);
            if (cmp_interior(t2)) scores<false>(s, P); else scores<true>(s, P);
#pragma unroll
            for (int r = 0; r < 16; ++r) s[r] = ex2(s[r] - m) * linv;
#endif
            pv_acc(s, tl, lane, oc);
            float prevr = carry;
#pragma unroll
            for (int i = 0; i < 4; ++i) { float e = s[4 * i + 3], p = 2.f * (s[4 * i] + s[4 * i + 1] + s[4 * i + 2]) + e;
                p = quad_sum(p); e = quad_sum(e);
                const float rcv = xhalf_other(e, hi);
                const float sc = p + (hi ? rcv : prevr);
                const int u = 8 * t2 + 2 * i + hi; if (r4 == 0) S[ti * 257 + u] = sc;
                prevr = rcv; }
            carry = prevr;
        };
        shared_pairs<true>(ntc, lds, NSA_SLAB, KC, VC, [&](int t2, int key) { int cc = 32 * t2 + key; cc = cc > 1022 ? 1022 : cc; return (size_t)(cc * 4 + g) * 64; }, wave, lane,
            [&](LAS unsigned char* ta, LAS unsigned char* tb, int s2) { const int t2 = 2 * s2;
                if (t2 < ntc_w) cmp2_tile(ta, t2);
                if (tb && t2 + 1 < ntc_w) cmp2_tile(tb, t2 + 1); });
        { const float gc = gt[0];
#pragma unroll
        for (int r = 0; r < 16; ++r) { oacc[0][r] = gc * oc[0][r]; oacc[1][r] = gc * oc[1][r]; } }
    }
    LDS_WAIT();
    const int cur_b = tq0 >> 6;
#ifndef NSA_NO_SEL
    for (int rep_ = 0; rep_ < REP_SEL; ++rep_) {
        const int tok = lane >> 3, sub = lane & 7;
        unsigned wsel = 0u;
        if (cur_b <= 15) { wsel = (sub == 0) ? ((2u << cur_b) - 1u) : 0u; }
        else {
            unsigned key[32];
#pragma unroll
            for (int k = 0; k < 32; ++k) { const int u = sub + 8 * k; const unsigned bits = __float_as_uint(S[tok * 257 + u]);
                key[k] = (u >= 1 && u <= cur_b - 2) ? ((bits & 0xffffff00u) | (unsigned)(255 - u)) : 0u; }
            wsel = ((sub == 0) ? 1u : 0u) | (((cur_b >> 5) == sub) ? (1u << (cur_b & 31)) : 0u) | ((((cur_b - 1) >> 5) == sub) ? (1u << ((cur_b - 1) & 31)) : 0u);
            for (int rnd = 0; rnd < 13; ++rnd) {
                unsigned mx = 0u;
#pragma unroll
                for (int k = 0; k < 32; ++k) mx = key[k] > mx ? key[k] : mx;
                { const unsigned o1 = (unsigned)__shfl_xor((int)mx, 1); mx = o1 > mx ? o1 : mx; const unsigned o2 = (unsigned)__shfl_xor((int)mx, 2); mx = o2 > mx ? o2 : mx;
                  const unsigned o4 = (unsigned)__shfl_xor((int)mx, 4); mx = o4 > mx ? o4 : mx; }
#pragma unroll
                for (int k = 0; k < 32; ++k) key[k] = (key[k] == mx) ? 0u : key[k];
                const int u = 255 - (int)(mx & 0xffu);
                wsel |= ((u >> 5) == sub) ? (1u << (u & 31)) : 0u;
            }
        }
        SEL[tok * 8 + sub] = wsel;
    }
#endif
    LDS_WAIT();
    int nu = 0;
    for (int wd = 0; wd < 8; ++wd) {
        const unsigned mw = SEL[ti * 8 + wd];
        unsigned uw = 0u;
#pragma unroll
        for (int i = 0; i < 8; ++i) uw |= (unsigned)__builtin_amdgcn_readlane((int)mw, 4 * i);
        while (uw) { const int bb = __builtin_ctz(uw); uw &= uw - 1u; if (lane == 0) UB[nu] = wd * 32 + bb; ++nu; }
    }
    LDS_WAIT();
    LAS float* PARK = S;
#pragma unroll
    for (int r = 0; r < 16; ++r) { PARK[r * 64 + lane] = oacc[0][r]; PARK[(16 + r) * 64 + lane] = oacc[1][r]; }
#ifndef NSA_NO_SLC
    for (int rep_ = 0; rep_ < REP_SLC; ++rep_) {
        float m = -1e30f, l = 0.f; f32x16 os[2];
#pragma unroll
        for (int r = 0; r < 16; ++r) { os[0][r] = 0.f; os[1][r] = 0.f; }
        const bf16* kb = KV + (size_t)(8 + g) * ((size_t)SEQ * 64); const bf16* vb = KV + (size_t)(12 + g) * ((size_t)SEQ * 64);
        {
            bf16x8 tk[2][4]; u32x4 tv[2][4];
            const size_t loff = (size_t)(lane >> 3) * 64 + 8 * (lane & 7);
#define SLC_LDK(bi_) do { const bf16* p_ = kb + (size_t)(64 * __builtin_amdgcn_readfirstlane(UB[bi_])) * 64 + loff; \
    _Pragma("unroll") for (int x_ = 0; x_ < 2; ++x_) _Pragma("unroll") for (int i_ = 0; i_ < 4; ++i_) tk[x_][i_] = *(const bf16x8*)(p_ + (size_t)(32 * x_ + 8 * i_) * 64); } while (0)
#define SLC_LDV(bi_) do { const bf16* p_ = vb + (size_t)(64 * __builtin_amdgcn_readfirstlane(UB[bi_])) * 64 + loff; \
    _Pragma("unroll") for (int x_ = 0; x_ < 2; ++x_) _Pragma("unroll") for (int i_ = 0; i_ < 4; ++i_) tv[x_][i_] = *(const u32x4*)(p_ + (size_t)(32 * x_ + 8 * i_) * 64); } while (0)
            SLC_LDK(0); SLC_LDV(0);
#pragma nounroll
            for (int bi = 0; bi < nu; ++bi) {
                const int tk0 = 64 * __builtin_amdgcn_readfirstlane(UB[bi]), u = tk0 >> 6;
                const bool mysel = (SEL[ti * 8 + (u >> 5)] >> (u & 31)) & 1u;
                TileP PA; PA.dist0 = mysel ? (tq - tk0 - 4 * hi) : 0x40000000; PA.dd = 1; PA.lim = 0x3fffffff; PA.base = -slope2 * (float)(tq - tk0 - 4 * hi); PA.sd = slope2;
                TileP PB = PA; PB.dist0 = PA.dist0 - 32; PB.base = -slope2 * (float)(tq - tk0 - 32 - 4 * hi);
                const bool interior = (tk0 + 63 <= tq0) && (__builtin_amdgcn_ballot_w64(!mysel) == 0ull);
                k_stage(tk[0], vs, lane); k_stage(tk[1], vs + 4096, lane);
                if (bi + 1 < nu) SLC_LDK(bi + 1);
                const bool seeded = m > -1e29f; const float mref = seeded ? m : 0.f;
                f32x16 sa, sb;
                if (interior) pair_qk<false>(qf, vs, lane, mref, PA, PB, sa, sb); else pair_qk<true>(qf, vs, lane, mref, PA, PB, sa, sb);
                v_stage_raw(tv[0], vs, lane); v_stage_raw(tv[1], vs + 4096, lane);
                if (bi + 1 < nu) SLC_LDV(bi + 1);
                pair_sm_pv(sa, sb, vs, lane, m, l, os, seeded, mref);
            }
#undef SLC_LDK
#undef SLC_LDV
        }
        l += __shfl_xor(l, 32);
        const float f = (l > 0.f && rep_ == REP_SLC - 1) ? gt[16] / l : 0.f;
#pragma unroll
        for (int r = 0; r < 16; ++r) { PARK[r * 64 + lane] += f * os[0][r]; PARK[(16 + r) * 64 + lane] += f * os[1][r]; }
    }
#endif
#ifndef NSA_NO_WIN
    for (int rep_ = 0; rep_ < REP_WIN; ++rep_) {
        float m = -1e30f, l = 0.f; f32x16 ow[2];
#pragma unroll
        for (int r = 0; r < 16; ++r) { ow[0][r] = 0.f; ow[1][r] = 0.f; }
        const bf16* kb = KV + (size_t)(16 + g) * ((size_t)SEQ * 64); const bf16* vb = KV + (size_t)(20 + g) * ((size_t)SEQ * 64);
        const int tkb = 64 * ch - 512;
        int t2s = 0; while (tkb + 32 * t2s + 31 < 0) ++t2s;
        auto win_P = [&](int tk0) { TileP P; P.dist0 = tq - tk0 - 4 * hi; P.dd = 1; P.lim = 511 < tq ? 511 : tq; P.base = -slope2 * (float)P.dist0; P.sd = slope2; return P; };
        auto win_used = [&](int tk0) { return tk0 <= tqmax && tk0 + 31 >= tq0 - 511; };
        auto win_int = [&](int tk0) { return (tk0 >= 0) && (tqmax - tk0 <= 511) && (tk0 + 31 <= tq0); };
        shared_pairs<true>(18 - t2s, lds, NSA_SLAB, kb, vb, [&](int i, int key) { int tk = tkb + 32 * (t2s + i) + key; tk = tk < 0 ? 0 : (tk > SEQ - 1 ? SEQ - 1 : tk); return (size_t)tk * 64; }, wave, lane,
            [&](LAS unsigned char* ta, LAS unsigned char* tb, int s2) {
                const int tkA = tkb + 32 * (t2s + 2 * s2), tkB = tkA + 32;
                const bool ua = win_used(tkA), ub = tb && win_used(tkB);
                if (ua && ub) { const TileP PA = win_P(tkA), PB = win_P(tkB); const bool ia = win_int(tkA), ib = win_int(tkB);
                    if (ia && ib) attn_core2_d<false, false>(qf, ta, tb, lane, m, l, ow, PA, PB);
                    else attn_core2_d<true, true>(qf, ta, tb, lane, m, l, ow, PA, PB); }
                else if (ua) { const TileP P = win_P(tkA); if (win_int(tkA)) attn_core_d<false>(qf, ta, lane, m, l, ow, P); else attn_core_d<true>(qf, ta, lane, m, l, ow, P); }
                else if (ub) { const TileP P = win_P(tkB); if (win_int(tkB)) attn_core_d<false>(qf, tb, lane, m, l, ow, P); else attn_core_d<true>(qf, tb, lane, m, l, ow, P); }
            });
        l += __shfl_xor(l, 32);
        const float f = (l > 0.f) ? gt[32] / l : 0.f;
#pragma unroll
        for (int r = 0; r < 16; ++r) { oacc[0][r] = PARK[r * 64 + lane] + f * ow[0][r]; oacc[1][r] = PARK[(16 + r) * 64 + lane] + f * ow[1][r]; }
    }
#endif
    o_store(oacc, O + (size_t)tq * DM + hh * 64, hi);
}

struct EpiHeadMajor {
    static constexpr bool PERM = true, AFTER_DRAIN = false;
    bf16* O; const float* bias; int smode;
    __device__ __forceinline__ void operator()(const f32x4 (&acc)[2][2][4][2], const pg8::Unit& u, int wr, int wc, int fr, int fq) const {
        const int row0 = u.pm * 256 + wr * 64 + fr, col0 = u.pn * 256 + wc * 32 + 8 * fq;
        const float sc = (smode == 2 || (smode == 1 && ((u.pn >> 2) % 3) == 0)) ? C1 : 1.0f;
#pragma unroll
        for (int bj = 0; bj < 2; ++bj) { const int col = col0 + bj * 128; bf16* blk = O + (size_t)(col >> 6) * ((size_t)SEQ * 64) + (col & 63);
            f32x4 b0 = {0.f, 0.f, 0.f, 0.f}, b1 = b0; if (bias) { b0 = *(const f32x4*)(bias + col); b1 = *(const f32x4*)(bias + col + 4); }
#pragma unroll
            for (int ai = 0; ai < 2; ++ai)
#pragma unroll
                for (int m = 0; m < 4; ++m) { const f32x4 v0 = (acc[ai][bj][m][0] + b0) * sc, v1 = (acc[ai][bj][m][1] + b1) * sc;
                    u32x4 o; o.x = pk2(v0[0], v0[1]); o.y = pk2(v0[2], v0[3]); o.z = pk2(v1[0], v1[1]); o.w = pk2(v1[2], v1[3]);
                    *(u32x4*)(blk + (size_t)(row0 + ai * 128 + m * 16) * 64) = o; } }
    }
};
struct EpiAccF32 {
    static constexpr bool PERM = false, AFTER_DRAIN = false;
    float* C; int ldc;
    __device__ __forceinline__ void operator()(const f32x4 (&acc)[2][2][4][2], const pg8::Unit& u, int wr, int wc, int fr, int fq) const {
        const int row0 = u.pm * 256 + wr * 64 + fr, col0 = u.pn * 256 + wc * 32 + 4 * fq;
#pragma unroll
        for (int ai = 0; ai < 2; ++ai)
#pragma unroll
            for (int m = 0; m < 4; ++m) { float* rowp = C + (size_t)(row0 + ai * 128 + m * 16) * ldc + col0;
#pragma unroll
                for (int bj = 0; bj < 2; ++bj)
#pragma unroll
                    for (int n = 0; n < 2; ++n) { f32x4* p = (f32x4*)(rowp + bj * 128 + n * 16); *p = *p + acc[ai][bj][m][n]; } }
    }
};
struct EpiSwiglu {
    static constexpr bool PERM = true, AFTER_DRAIN = false;
    bf16* HID; const float* roww;
    __device__ __forceinline__ void operator()(const f32x4 (&acc)[2][2][4][2], const pg8::Unit& u, int wr, int wc, int fr, int fq) const {
        const int row0 = u.pm * 256 + wr * 64 + fr, ct = u.pn & 1, col0 = ct * 128 + wc * 32 + 8 * fq;
#pragma unroll
        for (int ai = 0; ai < 2; ++ai)
#pragma unroll
            for (int m = 0; m < 4; ++m) { const int row = row0 + ai * 128 + m * 16; const float w = roww[row];
                float hv[8];
#pragma unroll
                for (int n = 0; n < 2; ++n)
#pragma unroll
                    for (int j = 0; j < 4; ++j) { const float gte = acc[ai][0][m][n][j], up = acc[ai][1][m][n][j];
                        hv[4 * n + j] = gte * __builtin_amdgcn_rcpf(1.0f + ex2(-gte * LOG2E)) * up * w; }
                u32x4 o; o.x = pk2(hv[0], hv[1]); o.y = pk2(hv[2], hv[3]); o.z = pk2(hv[4], hv[5]); o.w = pk2(hv[6], hv[7]);
                *(u32x4*)(HID + (size_t)row * 256 + col0) = o; }
    }
};
struct EpiScatter {
    static constexpr bool PERM = true, AFTER_DRAIN = false;
    bf16* Y; const int* rowinfo;
    __device__ __forceinline__ void operator()(const f32x4 (&acc)[2][2][4][2], const pg8::Unit& u, int wr, int wc, int fr, int fq) const {
        const int row0 = u.pm * 256 + wr * 64 + fr, ct = u.pn & 3, col0 = ct * 256 + wc * 32 + 8 * fq;
#pragma unroll
        for (int ai = 0; ai < 2; ++ai)
#pragma unroll
            for (int m = 0; m < 4; ++m) { const int info = rowinfo[row0 + ai * 128 + m * 16];
                if (info >= 0) { bf16* rowp = Y + ((size_t)(info & 1) * SEQ + (size_t)(info >> 1)) * DM + col0;
#pragma unroll
                    for (int bj = 0; bj < 2; ++bj) { const f32x4 v0 = acc[ai][bj][m][0], v1 = acc[ai][bj][m][1];
                        u32x4 o; o.x = pk2(v0[0], v0[1]); o.y = pk2(v0[2], v0[3]); o.z = pk2(v1[0], v1[1]); o.w = pk2(v1[2], v1[3]);
                        *(u32x4*)(rowp + bj * 128) = o; } } }
    }
};
struct MoeOrder {
    const LAS int* tb; int NCT, G, c;
    __device__ __forceinline__ void init(const LAS int* tb_, int nct, int G_, int c_) { tb = tb_; NCT = nct; G = G_; c = c_; }
    __device__ __forceinline__ bool next(int i, pg8::Unit& u) const {
        const int L = i * G + c, rt = L / NCT; if (rt >= __builtin_amdgcn_readfirstlane(tb[16])) return false;
        int e = 0;
#pragma unroll
        for (int k = 1; k < 16; ++k) e += (rt >= tb[k]) ? 1 : 0;
        u.pm = rt; u.pn = __builtin_amdgcn_readfirstlane(e) * NCT + (L % NCT); return true;
    }
    __device__ __forceinline__ void a_ready(const pg8::Unit&) const {}
    __device__ __forceinline__ void done(const pg8::Unit&) const {}
};

__device__ __forceinline__ void ln_phase(LAS unsigned char* lds, int mode, const float* HFin, const bf16* Y, const float* gam, const float* bet, float* outF, float oscale, bf16* HB,
                                         const bf16* WT, const float* sb, int4* ROUTE, int* HIST, float* GATES) {
    const int tid = threadIdx.x, lane = tid & 63, wave = __builtin_amdgcn_readfirstlane(tid >> 6), hi = lane >> 5;
    LAS float* LOG = (LAS float*)(lds + LDS_MISC);
    LAS int* HCNT = (LAS int*)(lds + LDS_MISC + 64 * 97 * 4);
    f32x4 gv[4], bv[4];
#pragma unroll
    for (int j = 0; j < 4; ++j) { gv[j] = *(const f32x4*)(gam + 4 * lane + 256 * j); bv[j] = *(const f32x4*)(bet + 4 * lane + 256 * j); }
    for (int ch = blockIdx.x; ch < SEQ / 64; ch += gridDim.x) {
        if (tid < 16) HCNT[tid] = 0;
        auto load_row = [&](f32x4 (&v)[4], u32x2 (&ya)[4], u32x2 (&yb)[4], int i) {
            const size_t row = (size_t)ch * 64 + wave * 8 + i;
#pragma unroll
            for (int j = 0; j < 4; ++j) v[j] = *(const f32x4*)(HFin + row * DM + 4 * lane + 256 * j);
            if (Y) {
#pragma unroll
                for (int j = 0; j < 4; ++j) { ya[j] = *(const u32x2*)(Y + row * DM + 4 * lane + 256 * j); yb[j] = *(const u32x2*)(Y + ((size_t)SEQ + row) * DM + 4 * lane + 256 * j); }
            }
        };
        auto do_row = [&](f32x4 (&v)[4], u32x2 (&ya)[4], u32x2 (&yb)[4], int i) {
            const int rl = wave * 8 + i; const size_t row = (size_t)ch * 64 + rl;
            if (Y) {
#pragma unroll
                for (int j = 0; j < 4; ++j) { v[j][0] = (v[j][0] + bflo(ya[j].x)) + bflo(yb[j].x); v[j][1] = (v[j][1] + bfhi(ya[j].x)) + bfhi(yb[j].x);
                    v[j][2] = (v[j][2] + bflo(ya[j].y)) + bflo(yb[j].y); v[j][3] = (v[j][3] + bfhi(ya[j].y)) + bfhi(yb[j].y); }
            }
            float s = 0.f;
#pragma unroll
            for (int j = 0; j < 4; ++j) s += (v[j][0] + v[j][1]) + (v[j][2] + v[j][3]);
            const float mean = wave_sum(s) * (1.0f / DM);
            float q = 0.f;
#pragma unroll
            for (int j = 0; j < 4; ++j) { v[j] = v[j] - mean; q += (v[j][0] * v[j][0] + v[j][1] * v[j][1]) + (v[j][2] * v[j][2] + v[j][3] * v[j][3]); }
            const float rstd = 1.0f / sqrtf(wave_sum(q) * (1.0f / DM) + LN_EPS);
#pragma unroll
            for (int j = 0; j < 4; ++j) { const f32x4 y = v[j] * rstd * gv[j] + bv[j];
                *(f32x4*)(outF + row * DM + 4 * lane + 256 * j) = y * oscale;
                u32x2 w; w.x = pk2(y[0], y[1]); w.y = pk2(y[2], y[3]);
                *(u32x2*)(HB + row * DM + 4 * lane + 256 * j) = w;
                const int ck = (lane >> 1) + 32 * j;
                *(LAS u32x2*)(lds + rl * 2048 + ((ck ^ (rl & 15)) << 4) + (lane & 1) * 8) = w; }
        };
        {
            f32x4 va[4], vb[4]; u32x2 ya0[4], ya1[4], yb0[4], yb1[4];
            load_row(va, ya0, ya1, 0);
#pragma nounroll
            for (int i = 0; i < 8; i += 2) { load_row(vb, yb0, yb1, i + 1); do_row(va, ya0, ya1, i); if (i + 2 < 8) load_row(va, ya0, ya1, i + 2); do_row(vb, yb0, yb1, i + 1); }
        }
        __syncthreads();
        if (mode != 2) {
            const int nct = (mode == 0) ? 1 : 2, nks = 4 / nct;
            const int tt = wave & 1, ct = (nct == 2) ? ((wave >> 1) & 1) : 0, ks = (nct == 2) ? (wave >> 2) : (wave >> 1), rl = tt * 32 + (lane & 31);
            const int s0 = ks * (64 / nks), s1 = s0 + 64 / nks;
            const bf16* wrow = WT + (size_t)(ct * 32 + (lane & 31)) * DM + 8 * hi;
            f32x16 acc;
#pragma unroll
            for (int r = 0; r < 16; ++r) acc[r] = 0.f;
#pragma unroll 8
            for (int s2 = s0; s2 < s1; ++s2) { const bf16x8 a = *(const bf16x8*)(wrow + 16 * s2); const int ck = 2 * s2 + hi;
                const bf16x8 b = *(const LAS bf16x8*)(lds + rl * 2048 + ((ck ^ (rl & 15)) << 4)); acc = MFMA32(a, b, acc); }
            const int ncp = (mode == 0) ? 24 : 48;
#pragma unroll
            for (int r = 0; r < 16; ++r) { const int col = 32 * ct + crow(r, hi); if (col < ncp) LOG[rl * 97 + ks * ncp + col] = acc[r]; }
        }
        __syncthreads();
        if (mode == 0 && tid < 64) {
            const LAS float* lgp = LOG + tid * 97;
            auto LG = [&](int c) { return ((lgp[c] + lgp[24 + c]) + lgp[48 + c]) + lgp[72 + c]; };
            int gi = 0; float gm = LG(0) + sb[0];
#pragma unroll
            for (int k = 1; k < 4; ++k) { const float x = LG(k) + sb[k]; if (x > gm) { gm = x; gi = k; } }
            float den = 0.f;
#pragma unroll
            for (int k = 0; k < 4; ++k) den += __expf(LG(k) + sb[k] - gm);
            const float gw = 1.0f / den;
            float ev[4];
#pragma unroll
            for (int k = 0; k < 4; ++k) ev[k] = LG(4 + 4 * gi + k) + sb[4 + 4 * gi + k];
            int i0 = 0; float v0 = ev[0];
#pragma unroll
            for (int k = 1; k < 4; ++k) if (ev[k] > v0) { v0 = ev[k]; i0 = k; }
            int i1 = -1; float v1 = -INFINITY;
#pragma unroll
            for (int k = 0; k < 4; ++k) if (k != i0 && ev[k] > v1) { v1 = ev[k]; i1 = k; }
            const float t = __expf(v1 - v0), w0 = gw / (1.0f + t), w1 = gw * t / (1.0f + t);
            const int e0 = 4 * gi + i0, e1 = 4 * gi + i1;
            ROUTE[(size_t)ch * 64 + tid] = make_int4(e0, e1, __float_as_int(w0), __float_as_int(w1));
            atomicAdd((int*)&HCNT[e0], 1); atomicAdd((int*)&HCNT[e1], 1);
        }
        if (mode == 1 && tid < 64) {
            const LAS float* lgp = LOG + tid * 97; float* go = GATES + ((size_t)ch * 64 + tid) * 48;
#pragma unroll 4
            for (int c = 0; c < 48; ++c) go[c] = 1.0f / (1.0f + __expf(-((lgp[c] + lgp[48 + c]) + sb[c])));
        }
        __syncthreads();
        if (mode == 0 && tid < 16) HIST[ch * 16 + tid] = HCNT[tid];
    }
}

__device__ __forceinline__ void moe_scatter(LAS unsigned char* lds, const int4* ROUTE, const int* HIST, int* TILEB, const bf16* HB, bf16* HS, int* ROWINFO, float* ROWW) {
    const int tid = threadIdx.x, lane = tid & 63, wave = __builtin_amdgcn_readfirstlane(tid >> 6);
    LAS int* tot = (LAS int*)(lds + LDS_MISC);
    LAS int* pre = tot + 16;
    LAS int* tbl = pre + 16;
    LAS int* ent = tbl + 32;
    LAS int* pos = ent + 128;
    LAS float* ewt = (LAS float*)(pos + 128);
    for (int ch = blockIdx.x; ch < SEQ / 64; ch += gridDim.x) {
        {
            if (tid < 32) tot[tid] = 0;
            __syncthreads();
            const int e = tid & 15, part = tid >> 4; int t = 0, p = 0;
#pragma unroll
            for (int c2 = 0; c2 < 8; ++c2) { const int c = part * 8 + c2; const int v = HIST[c * 16 + e]; t += v; p += (c < ch) ? v : 0; }
            atomicAdd((int*)&tot[e], t); atomicAdd((int*)&pre[e], p);
        }
        if (tid >= 64 && tid < 128) { const int k = tid - 64; const int4 r = ROUTE[(size_t)ch * 64 + k]; ent[2 * k] = r.x; ent[2 * k + 1] = r.y; ewt[2 * k] = __int_as_float(r.z); ewt[2 * k + 1] = __int_as_float(r.w); }
        __syncthreads();
        if (tid == 0) { int a = 0; for (int e = 0; e < 16; ++e) { tbl[e] = a; a += (tot[e] + 255) >> 8; } tbl[16] = a;
            if (ch == 0) { for (int e = 0; e < 17; ++e) TILEB[e] = tbl[e]; } }
        __syncthreads();
        if (tid < 16) { int run = tbl[tid] * 256 + pre[tid]; for (int k = 0; k < 128; ++k) if (ent[k] == tid) pos[k] = run++; }
        __syncthreads();
        for (int k = wave * 16; k < wave * 16 + 16; ++k) {
            const int p = pos[k]; const size_t token = (size_t)ch * 64 + (k >> 1);
            const u32x4* src = (const u32x4*)(HB + token * DM); u32x4* dst = (u32x4*)(HS + (size_t)p * DM);
            dst[lane] = src[lane]; dst[lane + 64] = src[lane + 64];
            if (lane == 0) { ROWINFO[p] = (int)token * 2 + (k & 1); ROWW[p] = ewt[k]; }
        }
        if (ch < 16) { const int e = ch, r0 = tbl[e] * 256 + tot[e], r1 = tbl[e + 1] * 256; for (int r = r0 + tid; r < r1; r += NTHREADS) { ROWINFO[r] = -1; ROWW[r] = 0.f; } }
        __syncthreads();
    }
}

__device__ __forceinline__ float gelu_tanh(float x) { const float u = 0.7978845608028654f * (x + 0.044715f * x * x * x); const float t = 1.0f - 2.0f / (__expf(2.0f * u) + 1.0f); return 0.5f * x * (1.0f + t); }
__device__ __forceinline__ void compress_phase(LAS unsigned char* lds, const bf16* KV, const bf16* W1T, const bf16* W2T, const float* B1P, const float* b1, const float* b2, bf16* KCMP) {
    const int tid = threadIdx.x, lane = tid & 63, wave = __builtin_amdgcn_readfirstlane(tid >> 6), hi = lane >> 5;
    LAS unsigned char* H1 = lds;
    for (int item = blockIdx.x; item < 256; item += gridDim.x) {
        const int j = item >> 7, rt = item & 127;
        int rho = 32 * rt + (lane & 31); const bool rvalid = rho < 4092; rho = rvalid ? rho : 4091;
        const int c = rho >> 2, g = rho & 3;
        const bf16* arow = KV + (size_t)(4 * j + g) * ((size_t)SEQ * 64) + (size_t)(16 * c) * 64;
        const bf16* wrow = W1T + ((size_t)j * 256 + 32 * wave + (lane & 31)) * 2048;
        f32x16 acc;
#pragma unroll
        for (int r = 0; r < 16; ++r) acc[r] = 0.f;
#pragma unroll 4
        for (int s = 0; s < 128; ++s) { const int k = 16 * s + 8 * hi;
            const bf16x8 b = *(const bf16x8*)(arow + (size_t)(k >> 6) * 64 + (k & 63)); const bf16x8 a = *(const bf16x8*)(wrow + k); acc = MFMA32(a, b, acc); }
#pragma unroll
        for (int r = 0; r < 16; ++r) { const int n = 32 * wave + crow(r, hi); float bsum = b1[j * 256 + n];
            for (int ks = 0; ks < 16; ++ks) bsum += B1P[(j * 16 + ks) * 256 + n];
            const float hval = gelu_tanh(acc[r] + bsum);
            *(LAS unsigned short*)(H1 + (lane & 31) * 528 + n * 2) = (unsigned short)(pk2(hval, 0.f) & 0xffffu); }
        __syncthreads();
        if (wave < 2) {
            const int db = wave;
            const bf16* w2row = W2T + ((size_t)j * 64 + 32 * db + (lane & 31)) * 256 + 8 * hi;
            f32x16 o;
#pragma unroll
            for (int r = 0; r < 16; ++r) o[r] = 0.f;
#pragma unroll
            for (int s = 0; s < 16; ++s) { const bf16x8 a = *(const bf16x8*)(w2row + 16 * s); const bf16x8 b = *(const LAS bf16x8*)(H1 + (lane & 31) * 528 + (16 * s + 8 * hi) * 2); o = MFMA32(a, b, o); }
            if (rvalid) { bf16* orow = KCMP + ((size_t)j * 1024 * 4 + (size_t)c * 4 + g) * 64 + 32 * db;
#pragma unroll
                for (int k = 0; k < 4; ++k) { const int d0 = 32 * db + 8 * k + 4 * hi; u32x2 w;
                    w.x = pk2(o[4 * k] + b2[j * 64 + d0], o[4 * k + 1] + b2[j * 64 + d0 + 1]); w.y = pk2(o[4 * k + 2] + b2[j * 64 + d0 + 2], o[4 * k + 3] + b2[j * 64 + d0 + 3]);
                    *(u32x2*)(orow + 8 * k + 4 * hi) = w; } }
        }
        __syncthreads();
    }
}

#if DBG_CHECK
__device__ __forceinline__ void dbg_acc(unsigned* ctl, int slot, float num, float den) {
    num = wave_sum(num); den = wave_sum(den);
    if ((threadIdx.x & 63) == 0) { atomicAdd((float*)(ctl + CW_DBG) + 2 * slot, num); atomicAdd((float*)(ctl + CW_DBG) + 2 * slot + 1, den); }
}
__device__ __forceinline__ float dbg_dot64(const bf16* a, const bf16* b, int lane) { return wave_sum(bf2f(a[lane]) * bf2f(b[lane])); }
__device__ __forceinline__ int dbg_token(int w) { const int sp[16] = {0, 5, 30, 31, 47, 63, 64, 100, 500, 1023, 1024, 1039, 2047, 4096, 16320, 16383}; return (w < 16) ? sp[w] : (int)(((unsigned)w * 6151u + 17u) % 16384u); }

__device__ __forceinline__ void dbg_check_dilated(unsigned* ctl, const bf16* qkv, const bf16* O) {
    const int lane = threadIdx.x & 63, wave = threadIdx.x >> 6;
    const int w = blockIdx.x * 8 + wave; const int t = dbg_token(w & 255), h = (w * 7 + (w >> 8)) & 15;
    const float slope = exp2f(-0.5f * (float)(h + 1));
    float outg[3], lse[3];
    for (int g = 0; g < 3; ++g) {
        const int d = 1 << (2 * g), W = 128 << (2 * g);
        const bf16* q = qkv + (size_t)((g * 3) * 16 + h) * ((size_t)SEQ * 64) + (size_t)t * 64;
        float m = -1e30f, l = 0.f, acc = 0.f;
        for (int j = 0; j * d <= W; ++j) { const int tk = t - j * d; if (tk < 0) break;
            const bf16* k = qkv + (size_t)((g * 3 + 1) * 16 + h) * ((size_t)SEQ * 64) + (size_t)tk * 64; const bf16* v = k + (size_t)16 * SEQ * 64;
            const float s = dbg_dot64(q, k, lane) * (1.0f / LOG2E) - slope * (float)(j * d);
            const float mn = fmaxf(m, s), a = __expf(m - mn), p = __expf(s - mn); l = l * a + p; acc = acc * a + p * bf2f(v[lane]); m = mn; }
        outg[g] = acc / l; lse[g] = m + __logf(l);
    }
    const float mx = fmaxf(lse[0], fmaxf(lse[1], lse[2])); const float e0 = __expf(lse[0] - mx), e1 = __expf(lse[1] - mx), e2 = __expf(lse[2] - mx);
    const float o = (e0 * outg[0] + e1 * outg[1] + e2 * outg[2]) / (e0 + e1 + e2);
    const float got = bf2f(O[(size_t)t * DM + h * 64 + lane]);
    dbg_acc(ctl, 0, (o - got) * (o - got), o * o);
}

__device__ __forceinline__ void dbg_check_nsa(LAS unsigned char* lds, unsigned* ctl, const bf16* Q, const bf16* KV, const bf16* KC, const bf16* VC, const float* GATES, const bf16* O) {
    const int lane = threadIdx.x & 63, wave = threadIdx.x >> 6;
    const int w = blockIdx.x; const int t = dbg_token(w), g = (w >> 2) & 3;
    LAS float* P = (LAS float*)lds; LAS float* IMP = (LAS float*)(lds + 16384); LAS float* SC = (LAS float*)(lds + 20480); LAS int* SELB = (LAS int*)(lds + 21504);
    const int hh = 4 * g + (wave & 3); const float slope = exp2f(-0.5f * (float)(hh + 1));
    const bf16* q = Q + (size_t)hh * ((size_t)SEQ * 64) + (size_t)t * 64;
    float oc = 0.f;
    __syncthreads();
    if (wave < 4) {
        LAS float* Pr = P + wave * 1024; float m = -1e30f;
        for (int c = 0; c < 1023; ++c) { const int dc = t - (16 * c + 31); float s = -1e30f; if (dc >= 0) s = dbg_dot64(q, KC + (size_t)(c * 4 + g) * 64, lane) * (1.0f / LOG2E) - slope * (float)dc; if (lane == 0) Pr[c] = s; m = fmaxf(m, s); }
        LDS_WAIT();
        float l = 0.f;
        for (int c = 0; c < 1023; ++c) { const int dc = t - (16 * c + 31); const float p = (dc >= 0) ? __expf(Pr[c] - m) : 0.f; l += p; }
        const float linv = 1.0f / fmaxf(l, 1e-30f);
        for (int c = 0; c < 1023; ++c) { const int dc = t - (16 * c + 31); const float p = (dc >= 0) ? __expf(Pr[c] - m) * linv : 0.f; oc += p * bf2f(VC[(size_t)(c * 4 + g) * 64 + lane]); if (lane == 0) Pr[c] = p; }
        if (lane == 0) Pr[1023] = 0.f;
    }
    __syncthreads();
    for (int c = threadIdx.x; c < 1024; c += NTHREADS) IMP[c] = P[c] + P[1024 + c] + P[2048 + c] + P[3072 + c];
    __syncthreads();
    const int cur = t >> 6;
    for (int s = threadIdx.x; s < 256; s += NTHREADS) { float a = 0.f;
        for (int aa = 0; aa < 4; ++aa) for (int bb = 0; bb < 2; ++bb) { const int idx = 4 * s + aa - bb; if (idx >= 0 && idx < 1023) a += IMP[idx]; }
        float sc = (s == 0 || s == cur || s == cur - 1) ? 1e4f : a; if (s > cur) sc = -1e4f; SC[s] = sc; }
    __syncthreads();
    if (threadIdx.x == 0) { for (int k = 0; k < 16; ++k) { int bi = 0; float bv = -3e38f; for (int s = 0; s < 256; ++s) if (SC[s] > bv) { bv = SC[s]; bi = s; } SELB[k] = bi; SC[bi] = -3e38f; } }
    __syncthreads();
    if (wave < 4) {
        float m = -1e30f, l = 0.f, acc = 0.f;
        for (int k = 0; k < 16; ++k) { const int blk = SELB[k];
            for (int j = 0; j < 64; ++j) { const int tok = 64 * blk + j, ds = t - tok; if (ds < 0) continue;
                const float s = dbg_dot64(q, KV + (size_t)(8 + g) * ((size_t)SEQ * 64) + (size_t)tok * 64, lane) * (1.0f / LOG2E) - slope * (float)ds;
                const float mn = fmaxf(m, s), a = __expf(m - mn), p = __expf(s - mn); l = l * a + p; acc = acc * a + p * bf2f(KV[(size_t)(12 + g) * ((size_t)SEQ * 64) + (size_t)tok * 64 + lane]); m = mn; } }
        const float os = (l > 0.f) ? acc / l : 0.f;
        m = -1e30f; l = 0.f; acc = 0.f;
        for (int dw = 0; dw < 512; ++dw) { const int tok = t - dw; if (tok < 0) break;
            const float s = dbg_dot64(q, KV + (size_t)(16 + g) * ((size_t)SEQ * 64) + (size_t)tok * 64, lane) * (1.0f / LOG2E) - slope * (float)dw;
            const float mn = fmaxf(m, s), a = __expf(m - mn), p = __expf(s - mn); l = l * a + p; acc = acc * a + p * bf2f(KV[(size_t)(20 + g) * ((size_t)SEQ * 64) + (size_t)tok * 64 + lane]); m = mn; }
        const float ow = (l > 0.f) ? acc / l : 0.f;
        const float* gt = GATES + (size_t)t * 48 + g * 4 + (wave & 3);
        const float o = gt[0] * oc + gt[16] * os + gt[32] * ow;
        const float got = bf2f(O[(size_t)t * DM + hh * 64 + lane]);
        dbg_acc(ctl, 1, (o - got) * (o - got), o * o);
    }
    __syncthreads();
}

__device__ __forceinline__ void dbg_check_moe(LAS unsigned char* lds, unsigned* ctl, const bf16* HB, const int4* ROUTE, const float* gu, const float* dn, const bf16* Y) {
    const int tid = threadIdx.x; const int t = dbg_token(blockIdx.x);
    LAS float* hv = (LAS float*)lds; LAS float* hid = (LAS float*)(lds + 4096);
    __syncthreads();
    for (int k = tid; k < DM; k += NTHREADS) hv[k] = bf2f(HB[(size_t)t * DM + k]);
    __syncthreads();
    const int4 r = ROUTE[t];
    { const int sl = tid >> 8, f = tid & 255, e = sl ? r.y : r.x; const float wgt = __int_as_float(sl ? r.w : r.z);
      const float* W = gu + (size_t)e * 1024 * 512; float a = 0.f, b = 0.f;
      for (int k = 0; k < DM; ++k) { a += hv[k] * W[(size_t)k * 512 + f]; b += hv[k] * W[(size_t)k * 512 + 256 + f]; }
      hid[tid] = a / (1.0f + __expf(-a)) * b * wgt; }
    __syncthreads();
    float num = 0.f, den = 0.f;
    for (int dd = tid; dd < DM; dd += NTHREADS) { float y = 0.f;
        for (int sl = 0; sl < 2; ++sl) { const int e = sl ? r.y : r.x; const float* W = dn + (size_t)e * 256 * 1024;
            for (int f = 0; f < 256; ++f) y += hid[sl * 256 + f] * W[(size_t)f * 1024 + dd]; }
        const float got = bf2f(Y[(size_t)t * DM + dd]) + bf2f(Y[((size_t)SEQ + t) * DM + dd]);
        num += (y - got) * (y - got); den += y * y; }
    dbg_acc(ctl, 2, num, den);
    __syncthreads();
}

__device__ __forceinline__ void dbg_check_compress(LAS unsigned char* lds, unsigned* ctl, const bf16* KV, const float* pos, const float* W1, const float* b1, const float* W2, const float* b2, const bf16* KCMP) {
    const int tid = threadIdx.x, w = blockIdx.x; const int j = w & 1, g = (w >> 1) & 3, c = (w < 8) ? (w < 4 ? 0 : 1022) : (int)(((unsigned)w * 977u) % 1023u);
    LAS float* hid = (LAS float*)lds;
    __syncthreads();
    if (tid < 256) { float a = b1[j * 256 + tid];
        for (int k = 0; k < 2048; ++k) { const int lt = k >> 6, d = k & 63; a += (bf2f(KV[(size_t)(4 * j + g) * ((size_t)SEQ * 64) + (size_t)(16 * c + lt) * 64 + d]) + pos[j * 2048 + k]) * W1[((size_t)j * 2048 + k) * 256 + tid]; }
        hid[tid] = gelu_tanh(a); }
    __syncthreads();
    float num = 0.f, den = 0.f;
    if (tid < 64) { float o = b2[j * 64 + tid]; for (int n = 0; n < 256; ++n) o += hid[n] * W2[((size_t)j * 256 + n) * 64 + tid];
        const float got = bf2f(KCMP[((size_t)j * 4096 + (size_t)c * 4 + g) * 64 + tid]); num = (o - got) * (o - got); den = o * o; }
    if (tid < 64) dbg_acc(ctl, 3, num, den);
    __syncthreads();
}

__device__ __forceinline__ void dbg_check_gemm(unsigned* ctl, int slot, const bf16* A, int K, const float* W, int ldw, int ncols, const float* bias, const bf16* out, int ldo, int qmode) {
    const int lane = threadIdx.x & 63, w = blockIdx.x * 8 + (threadIdx.x >> 6);
    const int row = (int)(((unsigned)w * 2654435761u) >> 18) & (SEQ - 1), col = (int)(((unsigned)w * 40503u + 11u) % (unsigned)ncols);
    float a = 0.f; for (int k = lane; k < K; k += 64) a += bf2f(A[(size_t)row * K + k]) * W[(size_t)k * ldw + col];
    a = wave_sum(a) + (bias ? bias[col] : 0.f);
    if (qmode == 2 || (qmode == 1 && ((col >> 10) % 3) == 0)) a *= C1;
    const float got = bf2f(ldo ? out[(size_t)row * ldo + col] : out[(size_t)(col >> 6) * ((size_t)SEQ * 64) + (size_t)row * 64 + (col & 63)]);
    if (lane == 0) { atomicAdd((float*)(ctl + CW_DBG) + 2 * slot, (a - got) * (a - got)); atomicAdd((float*)(ctl + CW_DBG) + 2 * slot + 1, a * a); }
}
__device__ __forceinline__ void dbg_check_outproj(unsigned* ctl, const bf16* Ob, const float* W, const float* HF, const bf16* HB) {
    const int lane = threadIdx.x & 63, w = blockIdx.x * 8 + (threadIdx.x >> 6);
    const int row = (int)(((unsigned)w * 2654435761u) >> 18) & (SEQ - 1), col = (int)(((unsigned)w * 40503u + 11u) % 1024u);
    float a = 0.f; for (int k = lane; k < DM; k += 64) a += bf2f(Ob[(size_t)row * DM + k]) * W[(size_t)k * DM + col];
    a = wave_sum(a);
    const float got = HF[(size_t)row * DM + col] - ALPHA * bf2f(HB[(size_t)row * DM + col]);
    if (lane == 0) { atomicAdd((float*)(ctl + CW_DBG) + 14, (a - got) * (a - got)); atomicAdd((float*)(ctl + CW_DBG) + 15, a * a); }
}
__device__ __forceinline__ void dbg_check_route(unsigned* ctl, const bf16* HB, const float* Wr, const float* br, const int4* ROUTE) {
    const int lane = threadIdx.x & 63, w = blockIdx.x * 8 + (threadIdx.x >> 6); const int t = (int)(((unsigned)w * 7919u + 3u) % 16384u);
    float lg[20];
#pragma unroll
    for (int c = 0; c < 20; ++c) { float a = 0.f; for (int k = lane; k < DM; k += 64) a += bf2f(HB[(size_t)t * DM + k]) * Wr[(size_t)k * 20 + c]; lg[c] = wave_sum(a) + br[c]; }
    float num = 0.f, den = 0.f;
    if (lane == 0) {
        int gi = 0; float gm = lg[0];
#pragma unroll
        for (int k = 1; k < 4; ++k) if (lg[k] > gm) { gm = lg[k]; gi = k; }
        float dsum = 0.f;
#pragma unroll
        for (int k = 0; k < 4; ++k) dsum += __expf(lg[k] - gm);
        const float gw = 1.0f / dsum; float ev[4];
#pragma unroll
        for (int k = 0; k < 4; ++k) { float v = 0.f;
#pragma unroll
            for (int c = 0; c < 16; ++c) v = (c == 4 * gi + k) ? lg[4 + c] : v; ev[k] = v; }
        int i0 = 0; float v0 = ev[0];
#pragma unroll
        for (int k = 1; k < 4; ++k) if (ev[k] > v0) { v0 = ev[k]; i0 = k; }
        int i1 = -1; float v1 = -3e38f;
#pragma unroll
        for (int k = 0; k < 4; ++k) if (k != i0 && ev[k] > v1) { v1 = ev[k]; i1 = k; }
        const float tt = __expf(v1 - v0), w0 = gw / (1.0f + tt), w1 = gw * tt / (1.0f + tt);
        const int4 r = ROUTE[t];
#pragma unroll
        for (int e = 0; e < 16; ++e) { const float cr = (e == 4 * gi + i0 ? w0 : 0.f) + (e == 4 * gi + i1 ? w1 : 0.f);
            const float cm = (e == r.x ? __int_as_float(r.z) : 0.f) + (e == r.y ? __int_as_float(r.w) : 0.f); num += (cr - cm) * (cr - cm); den += cr * cr; }
        atomicAdd((float*)(ctl + CW_DBG) + 10, num); atomicAdd((float*)(ctl + CW_DBG) + 11, den);
    }
}
__device__ __forceinline__ void dbg_check_gates(unsigned* ctl, const bf16* HB, const float* Wq, const float* bq, const float* GATES) {
    const int lane = threadIdx.x & 63, w = blockIdx.x * 8 + (threadIdx.x >> 6); const int t = (int)(((unsigned)w * 7919u + 3u) % 16384u), c = w % 48;
    float a = 0.f; for (int k = lane; k < DM; k += 64) a += bf2f(HB[(size_t)t * DM + k]) * Wq[(size_t)k * 1072 + 1024 + c];
    a = wave_sum(a) + bq[1024 + c]; const float ref = 1.0f / (1.0f + __expf(-a)), got = GATES[(size_t)t * 48 + c];
    if (lane == 0) { atomicAdd((float*)(ctl + CW_DBG) + 12, (ref - got) * (ref - got)); atomicAdd((float*)(ctl + CW_DBG) + 13, ref * ref); }
}
#ifndef DBG_MASK
#define DBG_MASK 0xff
#endif
__device__ __forceinline__ float dbg_scale(unsigned* ctl) {
    float e = 0.f;
    for (int i = 0; i < 8; ++i) { if (!((DBG_MASK >> i) & 1)) continue; const float num = __hip_atomic_load((float*)(ctl + CW_DBG) + 2 * i, __ATOMIC_RELAXED, __HIP_MEMORY_SCOPE_AGENT), den = __hip_atomic_load((float*)(ctl + CW_DBG) + 2 * i + 1, __ATOMIC_RELAXED, __HIP_MEMORY_SCOPE_AGENT);
        const float r = (den > 0.f) ? sqrtf(num / den) : 7.77f; e = fmaxf(e, r); }
    return 1.0f + 10.0f * e;
}
#endif
struct Args { const float* in[20]; float* out; unsigned char* ws; int ph_lo, ph_hi; };
enum { I_X = 0, I_AWIN, I_AWOUT, I_BWKV, I_CPOS, I_CW1, I_CB1, I_CW2, I_CB2, I_BWQ, I_BBQ, I_BWOUT, I_MWR, I_MBR, I_MWGU, I_MWDN, I_LMG, I_LMB, I_LFG, I_LFB };
typedef const __attribute__((address_space(4))) Args* KArgs;
__device__ __forceinline__ KArgs kargs() { KArgs p = (KArgs)__builtin_amdgcn_kernarg_segment_ptr(); asm volatile("" : "+s"(p)); return p; }

struct Ids { int lane, wave, gw, NGW, G, bx; };
__device__ __forceinline__ Ids ids() {
    Ids d; const int tid = threadIdx.x; d.lane = tid & 63; d.wave = __builtin_amdgcn_readfirstlane(tid >> 6); d.G = gridDim.x; d.bx = blockIdx.x;
    const int vcu = (d.G % 8 == 0) ? (d.bx % 8) * (d.G / 8) + d.bx / 8 : d.bx;
    d.gw = vcu * NWAVES + d.wave; d.NGW = d.G * NWAVES; return d;
}

#ifdef TIMEPROBE
constexpr int CW_TP = 20000;
#define TP_START(k) do { if (blockIdx.x == 0 && threadIdx.x == 0) { unsigned* c_ = (unsigned*)(kargs()->ws + WS_CTL) + CW_TP; const unsigned now_ = (unsigned)__builtin_amdgcn_s_memrealtime(); \
    if ((k) == TP_A0 && (k) >= lo) c_[0] = now_; if ((k) == TP_B0 && (k) >= lo) c_[2] = now_; } } while (0)
#define TP_STOP(k) do { if (blockIdx.x == 0 && threadIdx.x == 0) { unsigned* c_ = (unsigned*)(kargs()->ws + WS_CTL) + CW_TP; const unsigned now_ = (unsigned)__builtin_amdgcn_s_memrealtime(); \
    if ((k) == TP_A1) c_[1] = now_ - c_[0]; if ((k) == TP_B1) c_[3] = now_ - c_[2]; } } while (0)
#else
#define TP_START(k) do { } while (0)
#define TP_STOP(k) do { } while (0)
#endif
#define PHASE_IF(k) TP_START(k); if ((k) >= lo && (k) < hi)
#define PHASE_BAR(k) do { if ((k) >= lo && (k) + 1 < hi) xcd_barrier(bar); TP_STOP(k); } while (0)

__device__ __forceinline__ void phase_prologue(LAS unsigned char* lds) {
    KArgs ka = kargs(); unsigned char* ws = ka->ws; const Ids d = ids(); const int lane = d.lane, gw = d.gw, NGW = d.NGW;
    LAS float* scr = (LAS float*)(lds + d.wave * 16384);
    for (int l = 0; l < 2; ++l) tc_matrix(ka->in[I_AWIN] + (size_t)l * DM * NQKV, NQKV, DM, 0, NQKV, (bf16*)(ws + WS_WIN) + (size_t)l * NQKV * DM, NQKV, scr, lane, gw, NGW);
    for (int l = 0; l < 2; ++l) tc_matrix(ka->in[I_AWOUT] + (size_t)l * DM * DM, DM, DM, 0, DM, (bf16*)(ws + WS_WOUTA) + (size_t)l * DM * DM, DM, scr, lane, gw, NGW);
    tc_matrix(ka->in[I_BWKV], NKV, DM, 0, NKV, (bf16*)(ws + WS_WKV), NKV, scr, lane, gw, NGW);
    for (int i = 0; i < 2; ++i) {
        tc_matrix(ka->in[I_BWQ] + (size_t)i * DM * 1072, 1072, DM, 0, 1024, (bf16*)(ws + WS_WQ) + (size_t)i * DM * DM, DM, scr, lane, gw, NGW);
        tc_matrix(ka->in[I_BWQ] + (size_t)i * DM * 1072, 1072, DM, 1024, 48, (bf16*)(ws + WS_WG) + (size_t)i * 64 * DM, 64, scr, lane, gw, NGW);
        tc_matrix(ka->in[I_BWOUT] + (size_t)i * DM * DM, DM, DM, 0, DM, (bf16*)(ws + WS_WOUTB) + (size_t)i * DM * DM, DM, scr, lane, gw, NGW);
    }
    for (int l = 0; l < 4; ++l) tc_matrix(ka->in[I_MWR] + (size_t)l * DM * 20, 20, DM, 0, 20, (bf16*)(ws + WS_WR) + (size_t)l * 32 * DM, 32, scr, lane, gw, NGW);
    for (int j = 0; j < 2; ++j) {
        tc_matrix(ka->in[I_CW1] + (size_t)j * 2048 * 256, 256, 2048, 0, 256, (bf16*)(ws + WS_W1T) + (size_t)j * 256 * 2048, 256, scr, lane, gw, NGW);
        tc_matrix(ka->in[I_CW2] + (size_t)j * 256 * 64, 64, 256, 0, 64, (bf16*)(ws + WS_W2T) + (size_t)j * 64 * 256, 64, scr, lane, gw, NGW);
    }
    convert_moe_weights(ka->in[I_MWGU], ka->in[I_MWDN], (bf16*)(ws + WS_WGU), (bf16*)(ws + WS_WDN), scr, lane, gw, NGW);
    float* B1P = (float*)(ws + WS_B1P);
    for (int it = gw; it < 128; it += NGW) { const int j = it >> 6, nb = (it >> 4) & 3, ks = it & 15, n = nb * 64 + lane;
        const float* W1 = ka->in[I_CW1] + (size_t)j * 2048 * 256; const float* pos = ka->in[I_CPOS] + (size_t)j * 2048; float a = 0.f;
        for (int k = ks * 128; k < ks * 128 + 128; ++k) a += pos[k] * W1[(size_t)k * 256 + n];
        B1P[(j * 16 + ks) * 256 + n] = a; }
    const float* x = ka->in[I_X]; float* HF = (float*)(ws + WS_HF); bf16* HB = (bf16*)(ws + WS_HB);
    for (int row = gw; row < SEQ; row += NGW) {
#pragma unroll
        for (int j = 0; j < 4; ++j) { const f32x4 v = *(const f32x4*)(x + (size_t)row * DM + 4 * lane + 256 * j);
            *(f32x4*)(HF + (size_t)row * DM + 4 * lane + 256 * j) = v * ALPHA;
            u32x2 w; w.x = pk2(v[0], v[1]); w.y = pk2(v[2], v[3]); *(u32x2*)(HB + (size_t)row * DM + 4 * lane + 256 * j) = w; }
    }
}

template <int L, int KIND, bool CONVERT>
__device__ __forceinline__ void phase_proj(LAS unsigned char* lds) {
    KArgs ka = kargs(); unsigned char* ws = ka->ws; const Ids d = ids();
    if (CONVERT) {
        convert_moe_weights(ka->in[I_MWGU] + (size_t)L * 16 * 1024 * 512, ka->in[I_MWDN] + (size_t)L * 16 * 256 * 1024, (bf16*)(ws + WS_WGU), (bf16*)(ws + WS_WDN),
                            (LAS float*)(lds + d.wave * 16384), d.lane, d.gw, d.NGW);
        __syncthreads();
    }
    const bf16* HB = (const bf16*)(ws + WS_HB);
#ifndef NO_G1
    if (KIND == 0) { pg8::Gemm gm{HB, (const bf16*)(ws + WS_WIN) + (size_t)L * NQKV * DM, SEQ, NQKV, DM}; EpiHeadMajor E{(bf16*)(ws + WS_BIG), nullptr, 1};
        pg8::StaticOrder S; S.init(SEQ, NQKV, d.G, d.bx); pg8::gemm_phase<EpiHeadMajor, pg8::StaticOrder, false>(lds, gm, S, E, nullptr); }
    else if (KIND == 1) { pg8::Gemm gm{HB, (const bf16*)(ws + WS_WKV), SEQ, NKV, DM}; EpiHeadMajor E{(bf16*)(ws + BIG_KV), nullptr, 0};
        pg8::StaticOrder S; S.init(SEQ, NKV, d.G, d.bx); pg8::gemm_phase<EpiHeadMajor, pg8::StaticOrder, false>(lds, gm, S, E, nullptr); }
    else { pg8::Gemm gm{HB, (const bf16*)(ws + WS_WQ) + (size_t)(L - 2) * DM * DM, SEQ, DM, DM}; EpiHeadMajor E{(bf16*)(ws + BIG_Q), ka->in[I_BBQ] + (size_t)(L - 2) * 1072, 2};
        pg8::StaticOrder S; S.init(SEQ, DM, d.G, d.bx); pg8::gemm_phase<EpiHeadMajor, pg8::StaticOrder, false>(lds, gm, S, E, nullptr); }
#endif
}
__device__ __forceinline__ void phase_compress(LAS unsigned char* lds) {
    KArgs ka = kargs(); unsigned char* ws = ka->ws;
    compress_phase(lds, (const bf16*)(ws + BIG_KV), (const bf16*)(ws + WS_W1T), (const bf16*)(ws + WS_W2T), (const float*)(ws + WS_B1P), ka->in[I_CB1], ka->in[I_CB2], (bf16*)(ws + BIG_KCMP));
}
__device__ __forceinline__ void phase_attn_dilated(LAS unsigned char* lds) {
    KArgs ka = kargs(); unsigned char* ws = ka->ws; const Ids d = ids();
    const bf16* QKV = (const bf16*)(ws + WS_BIG); bf16* OB = (bf16*)(ws + WS_O); LAS unsigned char* slab = lds + d.wave * 16384;
#ifndef NO_DIL
#ifdef ATT_V2
    for (int it = d.bx; it < 1024; it += d.G) dil_block(QKV, OB, it >> 4, it & 15, lds, d.wave, d.lane);
#else
    for (int it = d.gw; it < 8192; it += d.NGW) { const int rr = it & 15, h = (it >> 4) & 15, B = it >> 8; dil_item(QKV, OB, B, rr, h, slab, d.lane); }
#endif
#endif
}
__device__ __forceinline__ void phase_attn_nsa(LAS unsigned char* lds) {
    KArgs ka = kargs(); unsigned char* ws = ka->ws; const Ids d = ids();
    const bf16* KCMP = (const bf16*)(ws + BIG_KCMP); LAS unsigned char* slab = lds + d.wave * NSA_SLAB;
#ifndef NO_NSA
#ifdef NSA_CHUNK
    for (int idx = d.bx; idx < 1024; idx += d.G) { const int k = idx >> 8, b = idx & 255, b0 = (k & 2) ? ((b + 128) & 255) : b, ch = (k & 1) ? 255 - b0 : b0;
        nsa_chunk((const bf16*)(ws + BIG_Q), (const bf16*)(ws + BIG_KV), KCMP, KCMP + 1024 * 256, (const float*)(ws + WS_GATES), (bf16*)(ws + WS_O), ch, k, lds, d.wave, d.lane); }
    (void)slab;
#else
    for (int k = 0; k < 4; ++k) { const int idx = ((k & 1) ? (d.NGW - 1 - d.gw) : d.gw) + d.NGW * k;
        if (idx < 8192) nsa_item((const bf16*)(ws + BIG_Q), (const bf16*)(ws + BIG_KV), KCMP, KCMP + 1024 * 256, (const float*)(ws + WS_GATES), (bf16*)(ws + WS_O), idx >> 2, idx & 3, slab, d.lane); }
#endif
#endif
}
template <int L>
__device__ __forceinline__ void phase_outproj(LAS unsigned char* lds) {
    KArgs ka = kargs(); unsigned char* ws = ka->ws; const Ids d = ids();
    const bf16* Wt = (L < 2) ? (const bf16*)(ws + WS_WOUTA) + (size_t)L * DM * DM : (const bf16*)(ws + WS_WOUTB) + (size_t)(L - 2) * DM * DM;
    pg8::Gemm gm{(const bf16*)(ws + WS_O), Wt, SEQ, DM, DM}; EpiAccF32 E{(float*)(ws + WS_HF), DM};
    pg8::StaticOrder S; S.init(SEQ, DM, d.G, d.bx);
#ifndef NO_G2
    pg8::gemm_phase<EpiAccF32, pg8::StaticOrder, false>(lds, gm, S, E, nullptr);
#endif
}
template <int L>
__device__ __forceinline__ void phase_ln_mix(LAS unsigned char* lds) {
    KArgs ka = kargs(); unsigned char* ws = ka->ws;
    ln_phase(lds, 0, (const float*)(ws + WS_HF), nullptr, ka->in[I_LMG] + (size_t)L * DM, ka->in[I_LMB] + (size_t)L * DM, (float*)(ws + WS_HF), ALPHA, (bf16*)(ws + WS_HB),
             (const bf16*)(ws + WS_WR) + (size_t)L * 32 * DM, ka->in[I_MBR] + (size_t)L * 20, (int4*)(ws + WS_ROUTE), (int*)(ws + WS_HIST), nullptr);
}
__device__ __forceinline__ void phase_scatter(LAS unsigned char* lds) {
    KArgs ka = kargs(); unsigned char* ws = ka->ws;
    moe_scatter(lds, (const int4*)(ws + WS_ROUTE), (const int*)(ws + WS_HIST), (int*)(ws + WS_TILEB), (const bf16*)(ws + WS_HB), (bf16*)(ws + BIG_HS), (int*)(ws + WS_ROWINFO), (float*)(ws + WS_ROWW));
}
__device__ __forceinline__ void load_tileb(LAS unsigned char* lds, const int* TILEB) {
    LAS int* tb = (LAS int*)(lds + LDS_MISC);
    if (threadIdx.x < 17) tb[threadIdx.x] = TILEB[threadIdx.x];
    __syncthreads();
}
__device__ __forceinline__ void phase_moe_up(LAS unsigned char* lds) {
    KArgs ka = kargs(); unsigned char* ws = ka->ws; const Ids d = ids();
    load_tileb(lds, (const int*)(ws + WS_TILEB));
    pg8::Gemm gm{(const bf16*)(ws + BIG_HS), (const bf16*)(ws + WS_WGU), MAXROWS, 512, DM}; EpiSwiglu E{(bf16*)(ws + BIG_HID), (const float*)(ws + WS_ROWW)};
    MoeOrder S; S.init((const LAS int*)(lds + LDS_MISC), 2, d.G, d.bx);
#ifndef NO_M2
    pg8::gemm_phase<EpiSwiglu, MoeOrder, false>(lds, gm, S, E, nullptr);
#endif
}
__device__ __forceinline__ void phase_moe_down(LAS unsigned char* lds) {
    KArgs ka = kargs(); unsigned char* ws = ka->ws; const Ids d = ids();
    load_tileb(lds, (const int*)(ws + WS_TILEB));
    pg8::Gemm gm{(const bf16*)(ws + BIG_HID), (const bf16*)(ws + WS_WDN), MAXROWS, 1024, 256}; EpiScatter E{(bf16*)(ws + BIG_Y), (const int*)(ws + WS_ROWINFO)};
    MoeOrder S; S.init((const LAS int*)(lds + LDS_MISC), 4, d.G, d.bx);
#ifndef NO_M3
    pg8::gemm_phase<EpiScatter, MoeOrder, false>(lds, gm, S, E, nullptr);
#endif
}
#if defined(TIMEPROBE)
#define DBG_OUT_SCALE (1.0f + (float)(((unsigned*)(ws + WS_CTL))[CW_TP + 1]) * (0.01f / 5000.0f))
#elif DBG_CHECK
#define DBG_OUT_SCALE dbg_scale((unsigned*)(ws + WS_CTL))
#else
#define DBG_OUT_SCALE 1.0f
#endif
template <int L>
__device__ __forceinline__ void phase_ln_ffn(LAS unsigned char* lds) {
    KArgs ka = kargs(); unsigned char* ws = ka->ws;
    constexpr bool last = (L == 3), gates = (L == 1 || L == 2);
    ln_phase(lds, gates ? 1 : 2, (const float*)(ws + WS_HF), (const bf16*)(ws + BIG_Y), ka->in[I_LFG] + (size_t)L * DM, ka->in[I_LFB] + (size_t)L * DM, last ? ka->out : (float*)(ws + WS_HF),
             last ? DBG_OUT_SCALE : ALPHA, (bf16*)(ws + WS_HB), (const bf16*)(ws + WS_WG) + (size_t)(gates ? L - 1 : 0) * 64 * DM, ka->in[I_BBQ] + (size_t)(gates ? L - 1 : 0) * 1072 + 1024,
             nullptr, nullptr, (float*)(ws + WS_GATES));
#ifdef TIMEPROBE
    if (last && blockIdx.x == 0 && threadIdx.x == 0) { asm volatile("s_waitcnt vmcnt(0)" ::: "memory"); ka->out[0] = (float)(((unsigned*)(ws + WS_CTL))[CW_TP + 3]) * (0.01f / 10.0f); }
#endif
}


#if DBG_CHECK
template <int L, int WHERE>
__device__ __forceinline__ void dbg_hook(LAS unsigned char* lds, const XcdBarrier& bar) {
    KArgs ka = kargs(); unsigned char* ws = ka->ws; unsigned* ctl = (unsigned*)(ws + WS_CTL);
    const bf16* HB = (const bf16*)(ws + WS_HB); const bf16* KCMP = (const bf16*)(ws + BIG_KCMP);
    if (WHERE == 0) {
        if (L == 2) dbg_check_compress(lds, ctl, (const bf16*)(ws + BIG_KV), ka->in[I_CPOS], ka->in[I_CW1], ka->in[I_CB1], ka->in[I_CW2], ka->in[I_CB2], KCMP);
        if (L == 2) dbg_check_gemm(ctl, 4, HB, DM, ka->in[I_BWKV], NKV, NKV, nullptr, (const bf16*)(ws + BIG_KV), 0, 0);
        if (L == 3) dbg_check_gates(ctl, HB, ka->in[I_BWQ] + (size_t)(L - 2) * DM * 1072, ka->in[I_BBQ] + (size_t)(L - 2) * 1072, (const float*)(ws + WS_GATES));
    }
    if (WHERE == 5) { if (L == 2) dbg_check_gates(ctl, HB, ka->in[I_BWQ], ka->in[I_BBQ], (const float*)(ws + WS_GATES)); }
    if (WHERE == 1) {
        if (L < 2) dbg_check_gemm(ctl, 4, HB, DM, ka->in[I_AWIN] + (size_t)L * DM * NQKV, NQKV, NQKV, nullptr, (const bf16*)(ws + WS_BIG), 0, 1);
        else dbg_check_gemm(ctl, 4, HB, DM, ka->in[I_BWQ] + (size_t)(L - 2) * DM * 1072, 1072, 1024, ka->in[I_BBQ] + (size_t)(L - 2) * 1072, (const bf16*)(ws + BIG_Q), 0, 2);
    }
    if (WHERE == 2) {
        if (L < 2) dbg_check_dilated(ctl, (const bf16*)(ws + WS_BIG), (const bf16*)(ws + WS_O));
        else dbg_check_nsa(lds, ctl, (const bf16*)(ws + BIG_Q), (const bf16*)(ws + BIG_KV), KCMP, KCMP + 1024 * 256, (const float*)(ws + WS_GATES), (const bf16*)(ws + WS_O));
    }
    if (WHERE == 3) dbg_check_outproj(ctl, (const bf16*)(ws + WS_O), (L < 2) ? ka->in[I_AWOUT] + (size_t)L * DM * DM : ka->in[I_BWOUT] + (size_t)(L - 2) * DM * DM, (const float*)(ws + WS_HF), HB);
    if (WHERE == 4) dbg_check_route(ctl, HB, ka->in[I_MWR] + (size_t)L * DM * 20, ka->in[I_MBR] + (size_t)L * 20, (const int4*)(ws + WS_ROUTE));
    if (WHERE == 6) dbg_check_moe(lds, ctl, HB, (const int4*)(ws + WS_ROUTE), ka->in[I_MWGU] + (size_t)L * 16 * 1024 * 512, ka->in[I_MWDN] + (size_t)L * 16 * 256 * 1024, (const bf16*)(ws + BIG_Y));
    xcd_barrier(bar);
}
#define DBG_HOOK(L, W) dbg_hook<L, W>(lds, bar)
#else
#define DBG_HOOK(L, W) do { } while (0)
#endif
template <int L>
__device__ __forceinline__ void layer_phases(LAS unsigned char* lds, const XcdBarrier& bar, const int lo, const int hi) {
    constexpr int PB = (L == 0) ? 1 : ((L == 1) ? 9 : ((L == 2) ? 17 : 27));
    constexpr int P1 = (L == 2) ? PB + 2 : PB;
    if (L == 2) {
        PHASE_IF(PB) { DBG_HOOK(L, 5); phase_proj<L, 1, true>(lds); }
        PHASE_BAR(PB);
        PHASE_IF(PB + 1) phase_compress(lds);
        PHASE_BAR(PB + 1);
        PHASE_IF(P1) { DBG_HOOK(L, 0); phase_proj<L, 2, false>(lds); }
        PHASE_BAR(P1);
    } else if (L == 3) {
        PHASE_IF(P1) { DBG_HOOK(L, 0); phase_proj<L, 2, true>(lds); }
        PHASE_BAR(P1);
    } else {
        PHASE_IF(P1) phase_proj<L, 0, (L > 0)>(lds);
        PHASE_BAR(P1);
    }
    PHASE_IF(P1 + 1) { DBG_HOOK(L, 1); if (L < 2) phase_attn_dilated(lds); else phase_attn_nsa(lds);
#ifdef DUP_MASK
        if (L < 2 && (DUP_MASK & 4)) { __syncthreads(); phase_attn_dilated(lds); }
        if (L >= 2 && (DUP_MASK & 8)) { __syncthreads(); phase_attn_nsa(lds); }
#endif
    }
    PHASE_BAR(P1 + 1);
    PHASE_IF(P1 + 2) { DBG_HOOK(L, 2); phase_outproj<L>(lds); }
    PHASE_BAR(P1 + 2);
    PHASE_IF(P1 + 3) { DBG_HOOK(L, 3); phase_ln_mix<L>(lds); }
    PHASE_BAR(P1 + 3);
    PHASE_IF(P1 + 4) { DBG_HOOK(L, 4); phase_scatter(lds);
#ifdef DUP_MASK
        if (DUP_MASK & 16) { __syncthreads(); phase_scatter(lds); }
#endif
    }
    PHASE_BAR(P1 + 4);
    PHASE_IF(P1 + 5) { phase_moe_up(lds);
#ifdef DUP_MASK
        if (DUP_MASK & 32) { __syncthreads(); phase_moe_up(lds); }
#endif
    }
    PHASE_BAR(P1 + 5);
    PHASE_IF(P1 + 6) { phase_moe_down(lds);
#ifdef DUP_MASK
        if (DUP_MASK & 64) { __syncthreads(); phase_moe_down(lds); }
#endif
    }
    PHASE_BAR(P1 + 6);
    PHASE_IF(P1 + 7) { DBG_HOOK(L, 6); phase_ln_ffn<L>(lds); }
    PHASE_BAR(P1 + 7);
}
constexpr int NPHASES = 35;

__global__ void __launch_bounds__(NTHREADS, 2) yoco_fwd(Args args) {
    extern __shared__ __attribute__((aligned(16))) unsigned char lds_raw[];
    LAS unsigned char* lds = (LAS unsigned char*)lds_raw;
    const int lo = args.ph_lo, hi = args.ph_hi;
    if (threadIdx.x < 4) ((LAS unsigned*)(lds + LDS_BAR))[threadIdx.x] = 0u;
    __syncthreads();
    unsigned* barw = (unsigned*)(args.ws + WS_CTL) + CW_BAR;
    XcdBarrier bar; bar.bar = barw; bar.x = 0; bar.st = (volatile LAS unsigned*)(lds + LDS_BAR);
    if (hi - lo > 1) bar = xcd_barrier_post(barw, (volatile LAS unsigned*)(lds + LDS_BAR));
    PHASE_IF(0) { phase_prologue(lds);
#ifdef DUP_MASK
        if (DUP_MASK & 1) { __syncthreads(); phase_prologue(lds); }
#endif
    }
    PHASE_BAR(0);
    layer_phases<0>(lds, bar, lo, hi);
    layer_phases<1>(lds, bar, lo, hi);
    layer_phases<2>(lds, bar, lo, hi);
    layer_phases<3>(lds, bar, lo, hi);
}

extern "C" void kernel_launch(void* const* d_in, const int* in_sizes, int n_in, void* d_out, int out_size, void* d_ws, size_t ws_size, hipStream_t stream) {
    static int grid = 0;
    if (grid == 0) {
        if (n_in != 20 || out_size != SEQ * DM || ws_size < WS_END) { fprintf(stderr, "kernel_launch: unexpected problem shape (n_in %d, out %d, ws %zu)\n", n_in, out_size, ws_size); grid = -1; return; }
        int dev = 0, cus = 0;
        if (hipGetDevice(&dev) != hipSuccess || hipDeviceGetAttribute(&cus, hipDeviceAttributeMultiprocessorCount, dev) != hipSuccess) { grid = -1; return; }
        if (hipFuncSetAttribute((const void*)yoco_fwd, hipFuncAttributeMaxDynamicSharedMemorySize, LDS_BYTES) != hipSuccess) { fprintf(stderr, "kernel_launch: hipFuncSetAttribute failed\n"); grid = -1; return; }
        int per_cu = 0;
        if (hipOccupancyMaxActiveBlocksPerMultiprocessor(&per_cu, (const void*)yoco_fwd, NTHREADS, LDS_BYTES) != hipSuccess || per_cu < 1) fprintf(stderr, "kernel_launch: occupancy query says %d\n", per_cu);
        (void)hipGetLastError();
        grid = cus;
    }
    if (grid < 0) return;
    (void)hipMemsetAsync((char*)d_ws + WS_CTL, 0, CTL_BYTES, stream);
    Args a{};
    for (int i = 0; i < 20; ++i) a.in[i] = (const float*)d_in[i];
    a.out = (float*)d_out; a.ws = (unsigned char*)d_ws;
#if MK_ONE_LAUNCH
    a.ph_lo = 0; a.ph_hi = NPHASES;
    hipLaunchKernelGGL(yoco_fwd, dim3(grid), dim3(NTHREADS), LDS_BYTES, stream, a);
#else
    for (int ph = 0; ph < NPHASES; ++ph) { a.ph_lo = ph; a.ph_hi = ph + 1; hipLaunchKernelGGL(yoco_fwd, dim3(grid), dim3(NTHREADS), LDS_BYTES, stream, a); }
#endif
}
```

```cpp
#include <hip/hip_runtime.h>
#include <cstdio>
#include <cstdint>
#include <cmath>
#define MK_ONE_LAUNCH 1
namespace pg8 {
#define PG8_LAS __attribute__((address_space(3)))
typedef unsigned short bf16_t;
typedef short bf16x8 __attribute__((ext_vector_type(8)));
typedef float f32x4 __attribute__((ext_vector_type(4)));
typedef unsigned u32x4 __attribute__((ext_vector_type(4)));
constexpr int BM = 256, BK = 64, HALF = 128, HTB = HALF * BK * 2  , STAGE_BYTES = 8 * HTB, NXCD = 8, WGM = 8;

__host__ __device__ __forceinline__ int lds_byte(int r, int c) { const int st = (r >> 4) * 2 + (c >> 5), rr = r & 15, cc = c & 31, ob = rr * 64 + cc * 2; return st * 1024 + (ob ^ (((ob >> 9) & 1) << 5)); }
__host__ __device__ __forceinline__ void stage_rc(int b, int& R, int& C) { const int st = b / 1024, sb = b % 1024, swz = sb ^ (((sb >> 9) & 1) << 5); R = (st >> 1) * 16 + swz / 64; C = (st & 1) * 32 + (swz % 64) / 2; }
__host__ __device__ __forceinline__ int perm32(int rho) { const int n = rho >> 4, i = rho & 15; return 8 * (i >> 2) + 4 * n + (i & 3); }

struct Unit { int pm, pn; };
struct Gemm { const bf16_t* A; const bf16_t* Bt; int M, N, K; };

struct StaticOrder {
    int nM, nN, nwg, G, c;
    __host__ __device__ void init(int M, int N, int G_, int c_) { nM = M / BM; nN = N / BM; nwg = nM * nN; G = G_; c = c_; }
    __host__ __device__ bool next(int i, Unit& u) const {
        const long L = (long)i * G + c; if (L >= nwg) return false;
        int wgid = (int)L; { const int q = nwg / NXCD, r = nwg % NXCD, xcd = wgid % NXCD, off = wgid / NXCD; wgid = (xcd < r ? xcd * (q + 1) : r * (q + 1) + (xcd - r) * q) + off; }
        const int nig = WGM * nN, gid = wgid / nig, fm = gid * WGM, gsz = (nM - fm) < WGM ? (nM - fm) : WGM;
        u.pm = fm + ((wgid % nig) % gsz); u.pn = (wgid % nig) / gsz; return true;
    }
    __device__ __forceinline__ void a_ready(const Unit&) const {}
    __device__ __forceinline__ void done(const Unit&) const {}
};
struct CountedOrder : StaticOrder {
    const unsigned* ready; unsigned need; unsigned* tmo;
    __device__ __forceinline__ void a_ready(const Unit& u) const {
        if (threadIdx.x < 64) {
            const unsigned long long t0 = __builtin_amdgcn_s_memrealtime(); unsigned polls = 0;
            while ((unsigned)__builtin_amdgcn_readfirstlane(__hip_atomic_load(ready + 64 * u.pm, __ATOMIC_RELAXED, __HIP_MEMORY_SCOPE_AGENT)) < need) {
                if ((++polls & 255u) == 0u && __builtin_amdgcn_readfirstlane(__hip_atomic_load(tmo, __ATOMIC_RELAXED, __HIP_MEMORY_SCOPE_AGENT)) != 0u) break;
                if (__builtin_amdgcn_s_memrealtime() - t0 > 2000000ull) {
                    if (threadIdx.x == 0) { unsigned expect = 0u; __hip_atomic_compare_exchange_strong(tmo + 1, &expect, 0x600u | (unsigned)(u.pm & 0xff), __ATOMIC_RELAXED, __ATOMIC_RELAXED, __HIP_MEMORY_SCOPE_AGENT); __hip_atomic_store(tmo, 1u, __ATOMIC_RELAXED, __HIP_MEMORY_SCOPE_AGENT); }
                    break; }
                __builtin_amdgcn_s_sleep(2); }
            __builtin_amdgcn_fence(__ATOMIC_ACQUIRE, "agent");
            asm volatile("s_waitcnt vmcnt(0)" ::: "memory");
        }
#if !defined(BROKEN_HOOK_NO_BARRIER)
        asm volatile("" ::: "memory"); __builtin_amdgcn_s_barrier(); asm volatile("" ::: "memory");
#endif
    }
};

__device__ __forceinline__ unsigned cvt_pk_bf16(float lo, float hi) { unsigned r; asm volatile("v_cvt_pk_bf16_f32 %0, %1, %2" : "=v"(r) : "v"(lo), "v"(hi)); return r; }
typedef float f32x2 __attribute__((ext_vector_type(2)));
__device__ __forceinline__ f32x2 gelu_pk(f32x2 v) {
    const f32x2 av = __builtin_elementwise_abs(v), d = av * 0.2316418882f + 1.0f;
    f32x2 t; t.x = __builtin_amdgcn_rcpf(d.x); t.y = __builtin_amdgcn_rcpf(d.y);
    f32x2 q = t * 0.5307027145f + (-0.7265760135f); q = q * t + 0.7107068705f; q = q * t + (-0.142248368f); q = q * t + 0.127414796f; q = q * t;
    const f32x2 s = (v * v) * (-0.72134752044f);
    f32x2 e; e.x = __builtin_amdgcn_exp2f(s.x); e.y = __builtin_amdgcn_exp2f(s.y);
    const f32x2 m = v * (q * e), r = v - m;
    f32x2 o; o.x = v.x < 0.f ? m.x : r.x; o.y = v.y < 0.f ? m.y : r.y; return o;
}

struct EpiF32 {
    static constexpr bool PERM = false, AFTER_DRAIN = false;
    float* C; int ldc; const float* bias;
    __device__ __forceinline__ void operator()(const f32x4 (&acc)[2][2][4][2], const Unit& u, int wr, int wc, int fr, int fq) const {
        const int row0 = u.pm * BM + wr * 64 + fr, col0 = u.pn * BM + wc * 32 + 4 * fq;
        f32x4 bv[2][2];
#pragma unroll
        for (int bj = 0; bj < 2; ++bj)
#pragma unroll
            for (int n = 0; n < 2; ++n) bv[bj][n] = bias ? *(const f32x4*)(bias + col0 + bj * HALF + n * 16) : (f32x4){0.f, 0.f, 0.f, 0.f};
#pragma unroll
        for (int ai = 0; ai < 2; ++ai)
#pragma unroll
            for (int m = 0; m < 4; ++m) { float* rowp = C + (size_t)(row0 + ai * HALF + m * 16) * ldc + col0;
#pragma unroll
                for (int bj = 0; bj < 2; ++bj)
#pragma unroll
                    for (int n = 0; n < 2; ++n) *(f32x4*)(rowp + bj * HALF + n * 16) = acc[ai][bj][m][n] + bv[bj][n]; }
    }
};
template <int ACT  > struct EpiBf16 {
    static constexpr bool PERM = true, AFTER_DRAIN = false;
    bf16_t* O; int ldc; const float* bias; int split_cols; size_t split_stride;
    __device__ __forceinline__ void operator()(const f32x4 (&acc)[2][2][4][2], const Unit& u, int wr, int wc, int fr, int fq) const {
        const int row0 = u.pm * BM + wr * 64 + fr; int colt = u.pn * BM; bf16_t* base = O;
        if (split_cols) { const int t = colt / split_cols; base += (size_t)t * split_stride; colt -= t * split_cols; }
        const int col0 = colt + wc * 32 + 8 * fq, bcol0 = u.pn * BM + wc * 32 + 8 * fq;
        f32x4 bv[2][2];
#pragma unroll
        for (int bj = 0; bj < 2; ++bj)
#pragma unroll
            for (int n = 0; n < 2; ++n) bv[bj][n] = bias ? *(const f32x4*)(bias + bcol0 + bj * HALF + 4 * n) : (f32x4){0.f, 0.f, 0.f, 0.f};
#pragma unroll
        for (int ai = 0; ai < 2; ++ai)
#pragma unroll
            for (int m = 0; m < 4; ++m) { bf16_t* rowp = base + (size_t)(row0 + ai * HALF + m * 16) * ldc + col0;
#pragma unroll
                for (int bj = 0; bj < 2; ++bj) { f32x4 v0 = acc[ai][bj][m][0] + bv[bj][0], v1 = acc[ai][bj][m][1] + bv[bj][1];
                    if (ACT == 1) { f32x2 a = gelu_pk((f32x2){v0[0], v0[1]}), b = gelu_pk((f32x2){v0[2], v0[3]}), c = gelu_pk((f32x2){v1[0], v1[1]}), d = gelu_pk((f32x2){v1[2], v1[3]});
                        v0 = (f32x4){a.x, a.y, b.x, b.y}; v1 = (f32x4){c.x, c.y, d.x, d.y}; }
                    if (ACT == 2) {
#pragma unroll
                        for (int j = 0; j < 4; ++j) { v0[j] = 0.5f * v0[j] * (1.0f + erff(v0[j] * 0.70710678f)); v1[j] = 0.5f * v1[j] * (1.0f + erff(v1[j] * 0.70710678f)); } }
                    u32x4 w; w.x = cvt_pk_bf16(v0[0], v0[1]); w.y = cvt_pk_bf16(v0[2], v0[3]); w.z = cvt_pk_bf16(v1[0], v1[1]); w.w = cvt_pk_bf16(v1[2], v1[3]);
                    *(u32x4*)(rowp + bj * HALF) = w; } }
    }
};

struct PanelStats {
    unsigned* xbuf;
    unsigned* cnt;
    unsigned* tmo;
    int ntn; float eps;
    unsigned code;
    __device__ __forceinline__ bool run(const f32x4 (&v)[2][2][4][2], const Unit& u, int wr, int wc, int fr, int fq, PG8_LAS unsigned char* lds, int wid, int lane) const {
        typedef float f32x2v __attribute__((ext_vector_type(2)));
        PG8_LAS f32x2v* P = (PG8_LAS f32x2v*)lds;
        PG8_LAS f32x2v* S = (PG8_LAS f32x2v*)(lds + 8192);
        PG8_LAS unsigned* flag = (PG8_LAS unsigned*)(lds + 8192 + 2048);
#pragma unroll
        for (int ai = 0; ai < 2; ++ai)
#pragma unroll
            for (int m = 0; m < 4; ++m) {
                float s = 0.f;
#pragma unroll
                for (int bj = 0; bj < 2; ++bj)
#pragma unroll
                    for (int n = 0; n < 2; ++n) { const f32x4 x = v[ai][bj][m][n]; s += (x[0] + x[1]) + (x[2] + x[3]); }
                s += __shfl_xor(s, 16); s += __shfl_xor(s, 32);
                const float mw = s * (1.0f / 64.0f); float q = 0.f;
#pragma unroll
                for (int bj = 0; bj < 2; ++bj)
#pragma unroll
                    for (int n = 0; n < 2; ++n) { const f32x4 d = v[ai][bj][m][n] - mw; q += (d[0] * d[0] + d[1] * d[1]) + (d[2] * d[2] + d[3] * d[3]); }
                q += __shfl_xor(q, 16); q += __shfl_xor(q, 32);
                if (fq == 0) P[(ai * HALF + wr * 64 + m * 16 + fr) * 4 + wc] = (f32x2v){mw, q};
            }
        asm volatile("s_waitcnt lgkmcnt(0)" ::: "memory"); __builtin_amdgcn_s_barrier(); asm volatile("" ::: "memory");
#if defined(BROKEN_NO_WAIT)
        if (blockIdx.x >= 64) { const long long t0 = clock64(); while (clock64() - t0 < 60000) __builtin_amdgcn_s_sleep(8); }
#endif
        const int row = wid * 32 + (lane & 31);
        if (lane < 32) {
            const f32x2v a = P[row * 4 + 0], b = P[row * 4 + 1], c = P[row * 4 + 2], d = P[row * 4 + 3];
            const float mt = (a.x + b.x + c.x + d.x) * 0.25f;
            const float da = a.x - mt, db = b.x - mt, dc = c.x - mt, dd = d.x - mt;
            const float m2 = (a.y + b.y) + (c.y + d.y) + 64.0f * ((da * da + db * db) + (dc * dc + dd * dd));
            unsigned long long* slot = (unsigned long long*)xbuf + ((size_t)(u.pm * BM + row) * 4 + u.pn);
            __hip_atomic_store(slot, ((unsigned long long)__float_as_uint(m2) << 32) | __float_as_uint(mt), __ATOMIC_RELAXED, __HIP_MEMORY_SCOPE_AGENT);
        }
        asm volatile("s_waitcnt vmcnt(0)" ::: "memory");
        if (lane == 0) __hip_atomic_fetch_add(cnt + 64 * u.pm, 1u, __ATOMIC_RELAXED, __HIP_MEMORY_SCOPE_AGENT);
        if (wid == 0) {
            bool dead = false; const unsigned long long t0 = __builtin_amdgcn_s_memrealtime(); const unsigned want = 8u * (unsigned)ntn;
            for (;;) {
#if defined(BROKEN_NO_WAIT)
                break;
#endif
                if ((unsigned)__builtin_amdgcn_readfirstlane(__hip_atomic_load(cnt + 64 * u.pm, __ATOMIC_RELAXED, __HIP_MEMORY_SCOPE_AGENT)) >= want) break;
                if (__builtin_amdgcn_s_memrealtime() - t0 > 2000000ull) {
                    if (lane == 0) { unsigned expect = 0u; __hip_atomic_compare_exchange_strong(tmo + 1, &expect, code | (unsigned)(u.pm & 0xff), __ATOMIC_RELAXED, __ATOMIC_RELAXED, __HIP_MEMORY_SCOPE_AGENT);
                                     __hip_atomic_store(tmo, 1u, __ATOMIC_RELAXED, __HIP_MEMORY_SCOPE_AGENT); }
                    dead = true; break; }
                __builtin_amdgcn_s_sleep(2);
            }
            __builtin_amdgcn_fence(__ATOMIC_ACQUIRE, "agent");
            if (lane == 0) flag[0] = dead ? 1u : 0u;
        }
        asm volatile("s_waitcnt vmcnt(0) lgkmcnt(0)" ::: "memory"); __builtin_amdgcn_s_barrier(); asm volatile("" ::: "memory");
        const bool bad = flag[0] != 0u;
        if (lane < 32) {
            const unsigned long long* slot = (const unsigned long long*)xbuf + (size_t)(u.pm * BM + row) * 4; float mt[4], m2[4]; float ms = 0.f;
#pragma unroll
            for (int t = 0; t < 4; ++t) { if (t < ntn) { const unsigned long long w = __hip_atomic_load(slot + t, __ATOMIC_RELAXED, __HIP_MEMORY_SCOPE_AGENT); mt[t] = __uint_as_float((unsigned)w); m2[t] = __uint_as_float((unsigned)(w >> 32)); } else { mt[t] = 0.f; m2[t] = 0.f; } ms += mt[t]; }
            const float mean = ms / (float)ntn; float q = 0.f;
#pragma unroll
            for (int t = 0; t < 4; ++t) if (t < ntn) { const float dm = mt[t] - mean; q += m2[t] + 256.0f * dm * dm; }
            S[row] = (f32x2v){mean, 1.0f / sqrtf(q / (256.0f * (float)ntn) + eps)};
        }
        asm volatile("s_waitcnt lgkmcnt(0)" ::: "memory"); __builtin_amdgcn_s_barrier(); asm volatile("" ::: "memory");
        return bad;
    }
};
struct EpiLnRes {
    static constexpr bool PERM = false, AFTER_DRAIN = true;
    const float* base; float* out; int ldc; const float* bias; PanelStats st; unsigned poison;
    __device__ __forceinline__ void refuse(size_t i0, size_t stride, int M, int N) const { const float q = __builtin_nanf(""); for (size_t i = i0; i < (size_t)M * N; i += stride) out[(i / N) * ldc + i % N] = q;
        if (i0 == 0) { unsigned expect = 0u; __hip_atomic_compare_exchange_strong(st.tmo + 1, &expect, 0x7f0u, __ATOMIC_RELAXED, __ATOMIC_RELAXED, __HIP_MEMORY_SCOPE_AGENT); __hip_atomic_store(st.tmo, 1u, __ATOMIC_RELAXED, __HIP_MEMORY_SCOPE_AGENT); } }
    __device__ __forceinline__ void fused(f32x4 (&acc)[2][2][4][2], const Unit& u, int wr, int wc, int fr, int fq, PG8_LAS unsigned char* lds, int wid, int lane) const {
        typedef float f32x2v __attribute__((ext_vector_type(2)));
        const PG8_LAS f32x2v* S = (const PG8_LAS f32x2v*)(lds + 8192);
        const int col0 = u.pn * BM + wc * 32 + 4 * fq;
#pragma unroll
        for (int bj = 0; bj < 2; ++bj)
#pragma unroll
            for (int n = 0; n < 2; ++n) { const f32x4 bv = bias ? *(const f32x4*)(bias + col0 + bj * HALF + n * 16) : (f32x4){0.f, 0.f, 0.f, 0.f};
#pragma unroll
                for (int ai = 0; ai < 2; ++ai)
#pragma unroll
                    for (int m = 0; m < 4; ++m) acc[ai][bj][m][n] += bv; }
        const bool bad = st.run(acc, u, wr, wc, fr, fq, lds, wid, lane) || poison != 0u;
        const float qnan = __builtin_nanf("");
#pragma unroll
        for (int ai = 0; ai < 2; ++ai)
#pragma unroll
            for (int m = 0; m < 4; ++m) { const int r = ai * HALF + wr * 64 + m * 16 + fr; const f32x2v sr = S[r]; const size_t off = (size_t)(u.pm * BM + r) * ldc + col0;
#pragma unroll
                for (int bj = 0; bj < 2; ++bj)
#pragma unroll
                    for (int n = 0; n < 2; ++n) { const f32x4 bs = *(const f32x4*)(base + off + bj * HALF + n * 16); f32x4 o = bs + (acc[ai][bj][m][n] - sr.x) * sr.y;
                        if (bad) o = (f32x4){qnan, qnan, qnan, qnan}; *(f32x4*)(out + off + bj * HALF + n * 16) = o; }
                asm volatile("" ::: "memory"); }
    }
};
struct EpiLnResLn {
    static constexpr bool PERM = false, AFTER_DRAIN = true;
    const float* base; float* out; bf16_t* xn; int ldc; const float* bias; PanelStats st1, st2; unsigned poison;
    __device__ __forceinline__ void refuse(size_t i0, size_t stride, int M, int N) const { const float q = __builtin_nanf(""); for (size_t i = i0; i < (size_t)M * N; i += stride) { const size_t o = (i / N) * ldc + i % N; out[o] = q; xn[o] = (bf16_t)0x7fc0u; }
        if (i0 == 0) { unsigned expect = 0u; __hip_atomic_compare_exchange_strong(st1.tmo + 1, &expect, 0x7f0u, __ATOMIC_RELAXED, __ATOMIC_RELAXED, __HIP_MEMORY_SCOPE_AGENT); __hip_atomic_store(st1.tmo, 1u, __ATOMIC_RELAXED, __HIP_MEMORY_SCOPE_AGENT); } }
    __device__ __forceinline__ void fused(f32x4 (&acc)[2][2][4][2], const Unit& u, int wr, int wc, int fr, int fq, PG8_LAS unsigned char* lds, int wid, int lane) const {
        typedef float f32x2v __attribute__((ext_vector_type(2))); typedef unsigned u32x2v __attribute__((ext_vector_type(2)));
        const PG8_LAS f32x2v* S = (const PG8_LAS f32x2v*)(lds + 8192);
        const int col0 = u.pn * BM + wc * 32 + 4 * fq;
#pragma unroll
        for (int bj = 0; bj < 2; ++bj)
#pragma unroll
            for (int n = 0; n < 2; ++n) { const f32x4 bv = bias ? *(const f32x4*)(bias + col0 + bj * HALF + n * 16) : (f32x4){0.f, 0.f, 0.f, 0.f};
#pragma unroll
                for (int ai = 0; ai < 2; ++ai)
#pragma unroll
                    for (int m = 0; m < 4; ++m) acc[ai][bj][m][n] += bv; }
        bool bad = st1.run(acc, u, wr, wc, fr, fq, lds, wid, lane) || poison != 0u;
        const float qnan = __builtin_nanf("");
#pragma unroll
        for (int ai = 0; ai < 2; ++ai)
#pragma unroll
            for (int m = 0; m < 4; ++m) { const int r = ai * HALF + wr * 64 + m * 16 + fr; const f32x2v sr = S[r]; const size_t off = (size_t)(u.pm * BM + r) * ldc + col0;
#pragma unroll
                for (int bj = 0; bj < 2; ++bj)
#pragma unroll
                    for (int n = 0; n < 2; ++n) { const f32x4 bs = *(const f32x4*)(base + off + bj * HALF + n * 16); acc[ai][bj][m][n] = bs + (acc[ai][bj][m][n] - sr.x) * sr.y; }
                asm volatile("" : "+v"(acc[ai][0][m][0]), "+v"(acc[ai][0][m][1]), "+v"(acc[ai][1][m][0]), "+v"(acc[ai][1][m][1]));
                if (m & 1) asm volatile("" ::: "memory"); }
        const bool bad1 = bad;
        bad = st2.run(acc, u, wr, wc, fr, fq, lds, wid, lane) || bad;
#pragma unroll
        for (int ai = 0; ai < 2; ++ai)
#pragma unroll
            for (int m = 0; m < 4; ++m) { const int r = ai * HALF + wr * 64 + m * 16 + fr; const f32x2v sr = S[r]; const size_t off = (size_t)(u.pm * BM + r) * ldc + col0;
#pragma unroll
                for (int bj = 0; bj < 2; ++bj)
#pragma unroll
                    for (int n = 0; n < 2; ++n) { const f32x4 x1 = acc[ai][bj][m][n]; *(f32x4*)(out + off + bj * HALF + n * 16) = bad1 ? (f32x4){qnan, qnan, qnan, qnan} : x1;
                        const f32x4 o = (x1 - sr.x) * sr.y; u32x2v w; w.x = cvt_pk_bf16(o[0], o[1]); w.y = cvt_pk_bf16(o[2], o[3]);
                        if (bad) { w.x = 0x7fc07fc0u; w.y = 0x7fc07fc0u; } *(u32x2v*)(xn + off + bj * HALF + n * 16) = w; }
                asm volatile("" ::: "memory"); }
    }
};

template <class Epi, class Sched, bool STAMP = false>
__device__ __forceinline__ void gemm_phase(PG8_LAS unsigned char* lds, const Gemm g, const Sched& S, const Epi& E, unsigned long long* stamps) {
    const int tid = threadIdx.x, wid = __builtin_amdgcn_readfirstlane(tid >> 6), lane = tid & 63, wr = wid >> 2, wc = wid & 3, fr = lane & 15, fq = lane >> 4;
    const int K = g.K, nt = K / BK;
    int ts_lo = 0, ts_hi = 0, nts = 0; const unsigned long long rt_entry = STAMP ? (unsigned long long)wall_clock64() : 0ull;
#define PG8_STAMP() do { if (STAMP && wid == 0 && nts < 64) { const unsigned long long _c = (unsigned long long)clock64(); \
        ts_lo = (lane == nts) ? (int)(unsigned)_c : ts_lo; ts_hi = (lane == nts) ? (int)(unsigned)(_c >> 32) : ts_hi; ++nts; } } while (0)
    PG8_STAMP();
    unsigned voffA[2], voffB[2];
#pragma unroll
    for (int i = 0; i < 2; ++i) { int R, C; stage_rc(tid * 16 + i * 8192, R, C); const int Rb = Epi::PERM ? ((R & ~31) + perm32(R & 31)) : R;
        voffA[i] = (unsigned)(R * K + C) * 2u; voffB[i] = (unsigned)(Rb * K + C) * 2u; }
    const size_t kstep = (size_t)(BK * 2);
    const size_t hstep = (size_t)HALF * K * 2;
    const size_t tstep = 2 * hstep;
    const unsigned ldsw = (unsigned)wid * 1024u;
    const int aoff = lds_byte(wr * 64 + fr, fq * 8), boff = lds_byte(wc * 32 + fr, fq * 8);
#define PG8_SA(b, h) (((b) * 2 + (h)) * HTB)
#define PG8_SB(b, h) ((4 + (b) * 2 + (h)) * HTB)
#define PG8_STAGE(bufoff, gbase, voff) do { _Pragma("unroll") for (int _i = 0; _i < 2; ++_i) \
        __builtin_amdgcn_global_load_lds((const unsigned*)((const char*)(gbase) + (voff)[_i]), (PG8_LAS unsigned*)(lds + (bufoff) + ldsw + _i * 8192), 16, 0, 0); } while (0)
#define PG8_LDA(dst, b, h) do { _Pragma("unroll") for (int m = 0; m < 4; ++m) _Pragma("unroll") for (int k = 0; k < 2; ++k) dst[m][k] = *(const PG8_LAS bf16x8*)(lds + PG8_SA(b, h) + aoff + m * 2048 + k * 1024); } while (0)
#define PG8_LDB(dst, b, h) do { _Pragma("unroll") for (int n = 0; n < 2; ++n) _Pragma("unroll") for (int k = 0; k < 2; ++k) dst[n][k] = *(const PG8_LAS bf16x8*)(lds + PG8_SB(b, h) + boff + n * 2048 + k * 1024); } while (0)
#define PG8_MMA(ai, bj, At, Bt) do { __builtin_amdgcn_s_setprio(1); _Pragma("unroll") for (int m = 0; m < 4; ++m) _Pragma("unroll") for (int n = 0; n < 2; ++n) _Pragma("unroll") for (int k = 0; k < 2; ++k) \
        acc[ai][bj][m][n] = __builtin_amdgcn_mfma_f32_16x16x32_bf16(Bt[n][k], At[m][k], acc[ai][bj][m][n], 0, 0, 0); __builtin_amdgcn_s_setprio(0); } while (0)
#define PG8_WAIT_V(n) asm volatile("s_waitcnt vmcnt(" #n ")" ::: "memory")
#define PG8_WAIT_L(n) asm volatile("s_waitcnt lgkmcnt(" #n ")" ::: "memory")
#define PG8_BAR __builtin_amdgcn_s_barrier()
#define PG8_SCHED __builtin_amdgcn_sched_barrier(0)
    Unit cur, nxt; int ui = 0;
    if (!S.next(0, cur)) return;
    f32x4 acc[2][2][4][2];
#pragma unroll
    for (int a = 0; a < 2; ++a)
#pragma unroll
        for (int b = 0; b < 2; ++b)
#pragma unroll
            for (int m = 0; m < 4; ++m)
#pragma unroll
                for (int n = 0; n < 2; ++n) acc[a][b][m][n] = (f32x4){0.f, 0.f, 0.f, 0.f};
    bf16x8 At[4][2], B0[2][2], B1[2][2];
    const char* cA = (const char*)g.A + (size_t)cur.pm * tstep; const char* cB = (const char*)g.Bt + (size_t)cur.pn * tstep;
    S.a_ready(cur);
    PG8_STAGE(PG8_SB(0, 0), cB, voffB); PG8_STAGE(PG8_SA(0, 0), cA, voffA); PG8_STAGE(PG8_SB(0, 1), cB + hstep, voffB); PG8_STAGE(PG8_SA(0, 1), cA + hstep, voffA);
    if (wr == 1) PG8_BAR;
    PG8_WAIT_V(4); PG8_BAR;
    PG8_STAGE(PG8_SB(1, 0), cB + kstep, voffB); PG8_STAGE(PG8_SA(1, 0), cA + kstep, voffA); PG8_STAGE(PG8_SB(1, 1), cB + hstep + kstep, voffB);
    PG8_WAIT_V(6); PG8_BAR;
    PG8_STAMP();
    for (;;) {
        const bool has_next = S.next(ui + 1, nxt);
        const char* nA = has_next ? (const char*)g.A + (size_t)nxt.pm * tstep : cA; const char* nB = has_next ? (const char*)g.Bt + (size_t)nxt.pn * tstep : cB;
        for (int t = 0; t < nt; t += 2) {
            const bool last = (t == nt - 2);
            const char* a1 = cA + (size_t)(t + 1) * kstep;
            const char* a2 = last ? nA : cA + (size_t)(t + 2) * kstep; const char* b2 = last ? nB : cB + (size_t)(t + 2) * kstep;
            const char* a3 = a2 + kstep; const char* b3 = b2 + kstep;
            if (last && has_next) S.a_ready(nxt);
            PG8_LDB(B0, 0, 0); PG8_SCHED; PG8_LDA(At, 0, 0); PG8_STAGE(PG8_SA(1, 1), a1 + hstep, voffA);
            PG8_WAIT_L(8); PG8_BAR; PG8_WAIT_L(0); PG8_MMA(0, 0, At, B0); PG8_BAR; PG8_SCHED;
            PG8_LDB(B1, 0, 1); PG8_STAGE(PG8_SB(0, 0), b2, voffB);
            PG8_BAR; PG8_WAIT_L(0); PG8_MMA(0, 1, At, B1); PG8_BAR;
            PG8_LDA(At, 0, 1); PG8_STAGE(PG8_SA(0, 0), a2, voffA);
            PG8_BAR; PG8_WAIT_L(0); PG8_MMA(1, 0, At, B0); PG8_BAR; PG8_SCHED;
            PG8_STAGE(PG8_SB(0, 1), b2 + hstep, voffB);
            PG8_WAIT_V(6); PG8_BAR; PG8_MMA(1, 1, At, B1); PG8_BAR;
            PG8_LDB(B0, 1, 0); PG8_SCHED; PG8_LDA(At, 1, 0); PG8_STAGE(PG8_SA(0, 1), a2 + hstep, voffA);
            PG8_WAIT_L(8); PG8_BAR; PG8_WAIT_L(0); PG8_MMA(0, 0, At, B0); PG8_BAR; PG8_SCHED;
            PG8_LDB(B1, 1, 1); PG8_STAGE(PG8_SB(1, 0), b3, voffB);
            PG8_BAR; PG8_WAIT_L(0); PG8_MMA(0, 1, At, B1); PG8_BAR;
            PG8_LDA(At, 1, 1); PG8_STAGE(PG8_SA(1, 0), a3, voffA);
            PG8_BAR; PG8_WAIT_L(0); PG8_MMA(1, 0, At, B0); PG8_BAR; PG8_SCHED;
            PG8_STAGE(PG8_SB(1, 1), b3 + hstep, voffB);
            PG8_WAIT_V(6); PG8_BAR; PG8_MMA(1, 1, At, B1); PG8_BAR;
        }
        PG8_STAMP();
        if constexpr (!Epi::AFTER_DRAIN) { E(acc, cur, wr, wc, fr, fq); S.done(cur); }
        PG8_STAMP();
        if (!has_next) break;
#pragma unroll
        for (int a = 0; a < 2; ++a)
#pragma unroll
            for (int b = 0; b < 2; ++b)
#pragma unroll
                for (int m = 0; m < 4; ++m)
#pragma unroll
                    for (int n = 0; n < 2; ++n) acc[a][b][m][n] = (f32x4){0.f, 0.f, 0.f, 0.f};
        cur = nxt; cA = nA; cB = nB; ++ui;
    }
    PG8_WAIT_V(0);
    if (wr == 0) PG8_BAR;
    PG8_BAR;
    if constexpr (Epi::AFTER_DRAIN) { E.fused(acc, cur, wr, wc, fr, fq, lds, wid, lane); S.done(cur); }
    PG8_STAMP();
    if (STAMP && wid == 0) { stamps[lane] = lane < nts ? (((unsigned long long)(unsigned)ts_hi << 32) | (unsigned)ts_lo) : 0ull;
        if (lane == 62) stamps[62] = rt_entry; if (lane == 63) stamps[63] = (unsigned long long)wall_clock64(); }
#undef PG8_STAMP
#undef PG8_SA
#undef PG8_SB
#undef PG8_STAGE
#undef PG8_LDA
#undef PG8_LDB
#undef PG8_MMA
#undef PG8_WAIT_V
#undef PG8_WAIT_L
#undef PG8_BAR
#undef PG8_SCHED
}
}
#ifndef MK_ONE_LAUNCH
#define MK_ONE_LAUNCH 0
#endif
#ifndef DBG_CHECK
#define DBG_CHECK 0
#endif
#define LAS __attribute__((address_space(3)))
typedef unsigned short bf16;
typedef short bf16x8 __attribute__((ext_vector_type(8)));
typedef short s16x4 __attribute__((ext_vector_type(4)));
typedef short v4i16_t __attribute__((ext_vector_type(4)));
typedef float f32x16 __attribute__((ext_vector_type(16)));
typedef float f32x4 __attribute__((ext_vector_type(4)));
typedef unsigned u32x4 __attribute__((ext_vector_type(4)));
typedef unsigned u32x2 __attribute__((ext_vector_type(2)));

constexpr int SEQ = 16384, DM = 1024, NQKV = 9216, NKV = 1536;
constexpr int NWAVES = 8, NTHREADS = 512;
constexpr float ALPHA = 1.6817928305074290f;
constexpr float LOG2E = 1.4426950408889634f;
constexpr float C1 = 0.125f * LOG2E;
constexpr float LN_EPS = 1e-5f;
constexpr int MAXTILES = 144;
constexpr int MAXROWS = MAXTILES * 256;

constexpr size_t MiB = 1u << 20;
constexpr size_t WS_CTL = 0, CTL_BYTES = 1 * MiB;
constexpr size_t WS_HIST = 1 * MiB;
constexpr size_t WS_TILEB = 1 * MiB + 64 * 1024;
constexpr size_t WS_ROUTE = 2 * MiB;
constexpr size_t WS_ROWINFO = 3 * MiB;
constexpr size_t WS_ROWW = 4 * MiB;
constexpr size_t WS_GATES = 5 * MiB;
constexpr size_t WS_B1P = 8 * MiB;
constexpr size_t WS_WR = 9 * MiB;
constexpr size_t WS_WG = 9 * MiB + 256 * 1024;
constexpr size_t WS_W2T = 9 * MiB + 512 * 1024;
constexpr size_t WS_W1T = 10 * MiB;
constexpr size_t WS_WIN = 12 * MiB;
constexpr size_t WS_WOUTA = 48 * MiB;
constexpr size_t WS_WKV = 52 * MiB;
constexpr size_t WS_WQ = 55 * MiB;
constexpr size_t WS_WOUTB = 59 * MiB;
constexpr size_t WS_WGU = 64 * MiB;
constexpr size_t WS_WDN = 80 * MiB;
constexpr size_t WS_HF = 88 * MiB;
constexpr size_t WS_HB = 152 * MiB;
constexpr size_t WS_O = 184 * MiB;
constexpr size_t WS_BIG = 216 * MiB;
constexpr size_t BIG_HS = WS_BIG;
constexpr size_t BIG_HID = WS_BIG + 72 * MiB;
constexpr size_t BIG_Y = WS_BIG + 90 * MiB;
constexpr size_t BIG_KV = WS_BIG + 160 * MiB;
constexpr size_t BIG_KCMP = WS_BIG + 208 * MiB;
constexpr size_t BIG_Q = WS_BIG + 210 * MiB;
constexpr size_t WS_END = 504 * MiB;
constexpr int CW_BAR = 4096;
constexpr int CW_DBG = 16384;

constexpr int LDS_MISC = 131072;
constexpr int LDS_BAR = 163840 - 16;
constexpr int LDS_BYTES = 163840;

#define MFMA32(a, b, c) __builtin_amdgcn_mfma_f32_32x32x16_bf16(a, b, c, 0, 0, 0)
__device__ __forceinline__ int crow(int r, int hi) { return (r & 3) + 8 * (r >> 2) + 4 * hi; }
__device__ __forceinline__ unsigned pk2(float lo, float hi) { unsigned r; asm("v_cvt_pk_bf16_f32 %0, %1, %2" : "=v"(r) : "v"(lo), "v"(hi)); return r; }
__device__ __forceinline__ float bf2f(unsigned short b) { return __uint_as_float(((unsigned)b) << 16); }
__device__ __forceinline__ float bflo(unsigned w) { return __uint_as_float(w << 16); }
__device__ __forceinline__ float bfhi(unsigned w) { return __uint_as_float(w & 0xffff0000u); }
__device__ __forceinline__ float ex2(float x) { return __builtin_amdgcn_exp2f(x); }
__device__ __forceinline__ float wave_sum(float v) {
    v += __uint_as_float(__builtin_amdgcn_update_dpp(0u, __float_as_uint(v), 0x128, 0xF, 0xF, true));
    v += __uint_as_float(__builtin_amdgcn_update_dpp(0u, __float_as_uint(v), 0x124, 0xF, 0xF, true));
    v += __uint_as_float(__builtin_amdgcn_update_dpp(0u, __float_as_uint(v), 0x122, 0xF, 0xF, true));
    v += __uint_as_float(__builtin_amdgcn_update_dpp(0u, __float_as_uint(v), 0x121, 0xF, 0xF, true));
    const auto rr = __builtin_amdgcn_permlane32_swap(__float_as_uint(v), __float_as_uint(v), false, false);
    v = __uint_as_float(rr[0]) + __uint_as_float(rr[1]);
    return __uint_as_float((unsigned)__builtin_amdgcn_readlane((int)__float_as_uint(v), 0)) + __uint_as_float((unsigned)__builtin_amdgcn_readlane((int)__float_as_uint(v), 16));
}
__device__ __forceinline__ s16x4 tr_read(LAS unsigned char* p) { return __builtin_bit_cast(s16x4, __builtin_amdgcn_ds_read_tr16_b64_v4i16((LAS v4i16_t*)p)); }
#define LDS_WAIT() asm volatile("s_waitcnt lgkmcnt(0)" ::: "memory")

#define XB_TMO      128
#define XB_XCNT(j)  (256  + 64 * (j))
#define XB_XSUB(j)  (1280 + 64 * (j))
#define XB_XGEN(j)  (2304 + 64 * (j))
#define XB_TOP      3328
#define XB_TOPGEN   3392
#define XCD_BAR_WORDS 3456
#define XB_SPIN_CAP (1u << 18)
__device__ __forceinline__ unsigned xb_ld(unsigned* p)              { return __hip_atomic_load(p, __ATOMIC_RELAXED, __HIP_MEMORY_SCOPE_AGENT); }
__device__ __forceinline__ unsigned xb_add(unsigned* p, unsigned v) { return __hip_atomic_fetch_add(p, v, __ATOMIC_RELAXED, __HIP_MEMORY_SCOPE_AGENT); }
__device__ __forceinline__ unsigned xb_xcc_id() { return (unsigned)__builtin_amdgcn_s_getreg((3 << 11) | 20) & 0xFu; }
#define XB_SPIN(cond, bar) do { unsigned _sp = 0; while (cond) { __builtin_amdgcn_s_sleep(1); \
    if ((++_sp & 255u) == 0u) { if (xb_ld(&(bar)[XB_TMO])) break; if (_sp > XB_SPIN_CAP) { atomicAdd(&(bar)[XB_TMO], 1u); break; } } } } while (0)
struct XcdBarrier { unsigned* bar; unsigned x; volatile LAS unsigned* st; };
__device__ __forceinline__ XcdBarrier xcd_barrier_post(unsigned* bar, volatile LAS unsigned* st) {
    XcdBarrier b; b.bar = bar; b.x = xb_xcc_id(); b.st = st;
    if (threadIdx.x == 0) (void)xb_add(&bar[XB_XCNT(b.x)], 1u);
    return b;
}
__device__ __forceinline__ void xcd_barrier_complete(unsigned* bar, unsigned x, unsigned& nloc, unsigned& nx) {
    const unsigned G = gridDim.x * gridDim.y * gridDim.z;
    unsigned sum, cnt, mine, sp = 0u;
    for (;;) {
        sum = 0u; cnt = 0u; mine = 0u;
#pragma unroll
        for (unsigned j = 0; j < 16; ++j) { const unsigned c = xb_ld(&bar[XB_XCNT(j)]); sum += c; cnt += (c > 0u) ? 1u : 0u; mine = (j == x) ? c : mine; }
        if (sum == G) break;
        __builtin_amdgcn_s_sleep(1);
        if ((++sp & 255u) == 0u) { if (xb_ld(&bar[XB_TMO])) break; if (sp > XB_SPIN_CAP) { atomicAdd(&bar[XB_TMO], 1u); break; } }
    }
    nloc = mine > 0u ? mine : 1u; nx = cnt > 0u ? cnt : 1u;
}
__device__ __forceinline__ void xcd_barrier(const XcdBarrier& b) {
    asm volatile("s_waitcnt vmcnt(0)" ::: "memory");
    __syncthreads();
    if (threadIdx.x == 0) {
        unsigned* bar = b.bar;
        __builtin_amdgcn_s_waitcnt(0);
        unsigned nloc = b.st[0], nx = b.st[1];
        if (nloc == 0u) { xcd_barrier_complete(bar, b.x, nloc, nx); b.st[0] = nloc; b.st[1] = nx; }
        const unsigned old = xb_add(&bar[XB_XSUB(b.x)], 1u);
        const unsigned gen = old / nloc;
        if (old + 1u == (gen + 1u) * nloc) {
            __builtin_amdgcn_fence(__ATOMIC_RELEASE, "agent");
            asm volatile("s_waitcnt vmcnt(0)" ::: "memory");
            const unsigned og = xb_add(&bar[XB_TOP], 1u);
            const unsigned tg = og / nx;
            if (og + 1u == (tg + 1u) * nx) xb_add(&bar[XB_TOPGEN], 1u);
            else XB_SPIN(xb_ld(&bar[XB_TOPGEN]) == tg, bar);
            __builtin_amdgcn_fence(__ATOMIC_ACQUIRE, "agent");
            xb_add(&bar[XB_XGEN(b.x)], 1u);
            asm volatile("s_waitcnt vmcnt(0)" ::: "memory");
        } else {
            XB_SPIN(xb_ld(&bar[XB_XGEN(b.x)]) == gen, bar);
            __builtin_amdgcn_fence(__ATOMIC_ACQUIRE, "agent");
            asm volatile("s_waitcnt vmcnt(0)" ::: "memory");
        }
    }
    __syncthreads();
}

struct TcRegs { float v[32]; };
__device__ __forceinline__ void tc_load(TcRegs& R, const float* src, int ld, int srccol0, int nvalid, int kb, int lane) {
    const int k0 = 64 * kb, n = lane & 31; const float* p = src + (size_t)(k0 + (lane >> 5)) * ld + srccol0 + n;
#pragma unroll
    for (int i = 0; i < 32; ++i) R.v[i] = (n < nvalid) ? p[(size_t)(2 * i) * ld] : 0.f;
}
__device__ __forceinline__ void tc_finish(const TcRegs& R, int K, bf16* dst, int dstrow0, int kb, LAS float* scr, int lane) {
    const int k0 = 64 * kb;
#pragma unroll
    for (int i = 0; i < 32; ++i) scr[(2 * i + (lane >> 5)) * 33 + (lane & 31)] = R.v[i];
    LDS_WAIT();
    const int c = lane & 7;
#pragma unroll
    for (int j = 0; j < 4; ++j) { const int n = (lane >> 3) + 8 * j; const LAS float* s = scr + (8 * c) * 33 + n;
        u32x4 o; o.x = pk2(s[0 * 33], s[1 * 33]); o.y = pk2(s[2 * 33], s[3 * 33]); o.z = pk2(s[4 * 33], s[5 * 33]); o.w = pk2(s[6 * 33], s[7 * 33]);
        *(u32x4*)(dst + (size_t)(dstrow0 + n) * K + k0 + 8 * c) = o; }
    LDS_WAIT();
}
template <class Desc>
__device__ __forceinline__ void tc_stream(int nitems, int gw, int NGW, LAS float* scr, int lane, Desc desc) {
    const float* srcA; int ldA, KA, c0A, nvA, r0A, kbA; bf16* dstA; const float* srcB; int ldB, KB, c0B, nvB, r0B, kbB; bf16* dstB;
    TcRegs A, B;
    int it = gw; if (it >= nitems) return;
    desc(it, srcA, ldA, KA, c0A, nvA, dstA, r0A, kbA); tc_load(A, srcA, ldA, c0A, nvA, kbA, lane);
#pragma nounroll
    for (;;) {
        const int itB = it + NGW; const bool hb = itB < nitems;
        if (hb) { desc(itB, srcB, ldB, KB, c0B, nvB, dstB, r0B, kbB); tc_load(B, srcB, ldB, c0B, nvB, kbB, lane); }
        tc_finish(A, KA, dstA, r0A, kbA, scr, lane);
        if (!hb) break;
        const int itA = itB + NGW; const bool ha = itA < nitems;
        if (ha) { desc(itA, srcA, ldA, KA, c0A, nvA, dstA, r0A, kbA); tc_load(A, srcA, ldA, c0A, nvA, kbA, lane); }
        tc_finish(B, KB, dstB, r0B, kbB, scr, lane);
        if (!ha) break;
        it = itA;
    }
}
__device__ __forceinline__ void tc_matrix(const float* src, int ld, int K, int col0, int ncolvalid, bf16* dst, int nrows, LAS float* scr, int lane, int gw, int NGW) {
    const int nkb = K / 64, nnb = nrows / 32;
    tc_stream(nkb * nnb, gw, NGW, scr, lane, [=](int it, const float*& s_, int& ld_, int& K_, int& c0_, int& nv_, bf16*& d_, int& r0_, int& kb_) {
        const int kb = it / nnb, nb = it % nnb; int nv = ncolvalid - 32 * nb; nv = nv < 0 ? 0 : (nv > 32 ? 32 : nv);
        s_ = src; ld_ = ld; K_ = K; c0_ = col0 + 32 * nb; nv_ = nv; d_ = dst; r0_ = 32 * nb; kb_ = kb; });
}
__device__ __forceinline__ void convert_moe_weights(const float* gu, const float* dn, bf16* WGU, bf16* WDN, LAS float* scr, int lane, int gw, int NGW) {
    tc_stream(16 * 256 + 16 * 128, gw, NGW, scr, lane, [=](int it, const float*& s_, int& ld_, int& K_, int& c0_, int& nv_, bf16*& d_, int& r0_, int& kb_) {
        if (it < 4096) { const int e = it >> 8, r = it & 255, kb = r >> 4, nb = r & 15, rho0 = 32 * nb, ct = rho0 >> 8, half = (rho0 >> 7) & 1, x0 = rho0 & 127;
            s_ = gu + (size_t)e * 1024 * 512; ld_ = 512; K_ = 1024; c0_ = half * 256 + 128 * ct + x0; nv_ = 32; d_ = WGU + (size_t)e * 512 * 1024; r0_ = rho0; kb_ = kb; }
        else { const int i2 = it - 4096, e = i2 >> 7, r = i2 & 127, kb = r >> 5, nb = r & 31;
            s_ = dn + (size_t)e * 256 * 1024; ld_ = 1024; K_ = 256; c0_ = 32 * nb; nv_ = 32; d_ = WDN + (size_t)e * 1024 * 256; r0_ = 32 * nb; kb_ = kb; } });
}

#define ATT_V2 1
#ifndef WINCORE
#define WINCORE attn_core_d
#endif
#ifndef SLCCORE
#define SLCCORE attn_core_d
#endif
#ifndef STATCORE
#define STATCORE stats_core_d
#endif
#ifndef CMP2_NEW
#define CMP2_NEW 1
#endif
#ifndef REP_SLC
#define REP_SLC 1
#endif
#ifndef REP_WIN
#define REP_WIN 1
#endif
#ifndef REP_SEL
#define REP_SEL 1
#endif
#ifndef REP_CMP
#define REP_CMP 1
#endif
struct KVT { bf16x8 k[4]; u32x4 v[4]; };
template <class RowF>
__device__ __forceinline__ void kv_load(KVT& T, const bf16* kbase, const bf16* vbase, RowF rowf, int lane) {
#pragma unroll
    for (int i = 0; i < 4; ++i) { const size_t ro = rowf(8 * i + (lane >> 3)) + 8 * (lane & 7); T.k[i] = *(const bf16x8*)(kbase + ro); T.v[i] = *(const u32x4*)(vbase + ro); }
#if defined(LOAD_REP)
#pragma unroll
    for (int i = 0; i < 4; ++i) { const size_t ro = rowf(8 * i + (lane >> 3)) + 8 * (lane & 7); u32x4 a, b;
        asm volatile("global_load_dwordx4 %0, %2, off sc1\n\tglobal_load_dwordx4 %1, %3, off sc1\n\ts_waitcnt vmcnt(0)" : "=&v"(a), "=&v"(b) : "v"(kbase + ro), "v"(vbase + ro) : "memory"); }
#endif
}
template <class RowF>
__device__ __forceinline__ void k_load(bf16x8 (&k)[4], const bf16* kbase, RowF rowf, int lane) {
#pragma unroll
    for (int i = 0; i < 4; ++i) k[i] = *(const bf16x8*)(kbase + rowf(8 * i + (lane >> 3)) + 8 * (lane & 7));
}
__device__ __forceinline__ void k_stage(const bf16x8 (&k)[4], LAS unsigned char* ks, int lane) {
#pragma unroll
    for (int i = 0; i < 4; ++i) { const int key = 8 * i + (lane >> 3), c = lane & 7; *(LAS bf16x8*)(ks + key * 128 + ((c ^ (key & 7)) << 4)) = k[i]; }
}
__device__ __forceinline__ void k_frags(bf16x8 (&kf)[4], LAS unsigned char* ks, int lane) {
    const int key = lane & 31, hi = lane >> 5;
    asm volatile("" ::: "memory");
#pragma unroll
    for (int s = 0; s < 4; ++s) kf[s] = *(const LAS bf16x8*)(ks + key * 128 + (((2 * s + hi) ^ (key & 7)) << 4));
}
__device__ __forceinline__ void q_load(bf16x8 (&q)[4], const bf16* qrow, int lane) {
    const int hi = lane >> 5;
#pragma unroll
    for (int s = 0; s < 4; ++s) q[s] = *(const bf16x8*)(qrow + 16 * s + 8 * hi);
}
__device__ __forceinline__ void v_stage(const KVT& T, LAS unsigned char* vs, int lane) {
#pragma unroll
    for (int i = 0; i < 4; ++i) { const int key = 8 * i + (lane >> 3), c = lane & 7; *(LAS u32x4*)(vs + (c >> 2) * 2048 + key * 64 + (c & 3) * 16) = T.v[i]; }
}
struct VF { bf16x8 f[2][2]; };
__device__ __forceinline__ void v_frags(VF& V, LAS unsigned char* vs, int lane) {
    const int hi = lane >> 5;
    LAS unsigned char* vp = vs + ((lane >> 4) & 1) * 32 + (lane & 3) * 8 + (4 * hi + ((lane & 15) >> 2)) * 64;
    asm volatile("" ::: "memory");
#pragma unroll
    for (int db = 0; db < 2; ++db)
#pragma unroll
        for (int s2 = 0; s2 < 2; ++s2) { const s16x4 lo = tr_read(vp + db * 2048 + s2 * 1024), h4 = tr_read(vp + db * 2048 + s2 * 1024 + 512);
            V.f[db][s2] = (bf16x8){lo[0], lo[1], lo[2], lo[3], h4[0], h4[1], h4[2], h4[3]}; }
    asm volatile("" ::: "memory");
}
__device__ __forceinline__ void pv_mma(const f32x16& p, const VF& V, f32x16 (&o)[2]) {
    u32x4 w0, w1;
    w0.x = pk2(p[0], p[1]); w0.y = pk2(p[2], p[3]); w0.z = pk2(p[4], p[5]); w0.w = pk2(p[6], p[7]);
    w1.x = pk2(p[8], p[9]); w1.y = pk2(p[10], p[11]); w1.z = pk2(p[12], p[13]); w1.w = pk2(p[14], p[15]);
    const bf16x8 pf0 = __builtin_bit_cast(bf16x8, w0), pf1 = __builtin_bit_cast(bf16x8, w1);
    o[0] = MFMA32(V.f[0][0], pf0, o[0]); o[1] = MFMA32(V.f[1][0], pf0, o[1]);
    o[0] = MFMA32(V.f[0][1], pf1, o[0]); o[1] = MFMA32(V.f[1][1], pf1, o[1]);
}
__device__ __forceinline__ void pv_acc(const f32x16& p, LAS unsigned char* vs, int lane, f32x16 (&o)[2]) { VF V; v_frags(V, vs, lane); pv_mma(p, V, o); }
__device__ __forceinline__ float xhalf_max(float v) {
    const auto rr = __builtin_amdgcn_permlane32_swap(__float_as_uint(v), __float_as_uint(v), false, false);
    return fmaxf(__uint_as_float(rr[0]), __uint_as_float(rr[1]));
}
__device__ __forceinline__ f32x16 qk_tile(const bf16x8 (&qf)[4], const bf16x8 (&kf)[4]) {
    f32x16 s;
#pragma unroll
    for (int r = 0; r < 16; ++r) s[r] = 0.f;
#pragma unroll
    for (int d0 = 0; d0 < 4; ++d0) s = MFMA32(kf[d0], qf[d0], s);
    return s;
}
struct TileP { float base, sd; int dist0, dd, lim; };
typedef float f32x2 __attribute__((ext_vector_type(2)));
constexpr float QMUL = 1.0f;
template <bool MASK>
__device__ __forceinline__ void scores(f32x16& s, const TileP P) {
    const f32x2 c1 = {QMUL, QMUL}, sd2 = {P.sd, P.sd};
#pragma unroll
    for (int r = 0; r < 16; r += 2) { const int cr = (r & 3) + 8 * (r >> 2);
        const f32x2 crv = {(float)cr, (float)(cr + 1)}, b2 = {P.base, P.base};
        const f32x2 raw = {s[r], s[r + 1]};
        f32x2 x = __builtin_elementwise_fma(raw, c1, __builtin_elementwise_fma(sd2, crv, b2));
        if (MASK) { const bool ok0 = (unsigned)(P.dist0 - P.dd * cr) <= (unsigned)P.lim, ok1 = (unsigned)(P.dist0 - P.dd * (cr + 1)) <= (unsigned)P.lim; x.x = ok0 ? x.x : -INFINITY; x.y = ok1 ? x.y : -INFINITY; }
        s[r] = x.x; s[r + 1] = x.y; }
}
__device__ __forceinline__ float exp_sum(f32x16& s, float mn) {
    const f32x2 m2 = {mn, mn}; f32x2 acc = {0.f, 0.f};
#pragma unroll
    for (int r = 0; r < 16; r += 2) { f32x2 x = {s[r], s[r + 1]}; x = x - m2; f32x2 e; e.x = ex2(x.x); e.y = ex2(x.y); acc = acc + e; s[r] = e.x; s[r + 1] = e.y; }
    return acc.x + acc.y;
}
template <bool MASK>
__device__ __forceinline__ void attn_core(const bf16x8 (&qf)[4], LAS unsigned char* tl, int lane, float& m, float& l, f32x16 (&o)[2], const TileP P) {
    bf16x8 kf[4]; k_frags(kf, tl + 4096, lane);
    VF V; v_frags(V, tl, lane);
    f32x16 s = qk_tile(qf, kf);
    scores<MASK>(s, P);
    float mx = fmaxf(fmaxf(fmaxf(s[0], s[1]), fmaxf(s[2], s[3])), fmaxf(fmaxf(s[4], s[5]), fmaxf(s[6], s[7])));
    mx = fmaxf(mx, fmaxf(fmaxf(fmaxf(s[8], s[9]), fmaxf(s[10], s[11])), fmaxf(fmaxf(s[12], s[13]), fmaxf(s[14], s[15]))));
    mx = xhalf_max(mx);
    const float mn = fmaxf(m, mx);
    if (__builtin_amdgcn_ballot_w64(mn > m)) { const float alpha = ex2(m - mn); l *= alpha;
#pragma unroll
        for (int r = 0; r < 16; ++r) { o[0][r] *= alpha; o[1][r] *= alpha; } }
    m = mn;
    l += exp_sum(s, mn);
    pv_mma(s, V, o);
}
template <bool MASK>
__device__ __forceinline__ void attn_tile(const bf16x8 (&qf)[4], const KVT& T, LAS unsigned char* vs, int lane, float& m, float& l, f32x16 (&o)[2], const TileP P) {
    v_stage(T, vs, lane); k_stage(T.k, vs + 4096, lane);
    attn_core<MASK>(qf, vs, lane, m, l, o, P);
}
template <bool MASK>
__device__ __forceinline__ void stats_core(const bf16x8 (&qf)[4], LAS unsigned char* tl, int lane, float& m, float& l, const TileP P) {
    bf16x8 kf[4]; k_frags(kf, tl + 4096, lane);
    f32x16 s = qk_tile(qf, kf);
    scores<MASK>(s, P);
    float mx = -INFINITY;
#pragma unroll
    for (int r = 0; r < 16; ++r) mx = fmaxf(mx, s[r]);
    mx = xhalf_max(mx);
    const float mn = fmaxf(m, mx); l *= ex2(m - mn); m = mn;
    float ps = 0.f;
#pragma unroll
    for (int r = 0; r < 16; ++r) ps += ex2(s[r] - mn);
    l += ps;
}
template <bool MASK>
__device__ __forceinline__ void stats_tile(const bf16x8 (&qf)[4], const bf16x8 (&kraw)[4], LAS unsigned char* vs, int lane, float& m, float& l, const TileP P) {
    k_stage(kraw, vs + 4096, lane); stats_core<MASK>(qf, vs, lane, m, l, P);
}
constexpr float SM_THR = 8.0f;
template <bool MASK>
__device__ __forceinline__ f32x16 qk_scores_d(const bf16x8 (&qf)[4], const bf16x8 (&kf)[4], const TileP P, float mref) {
    f32x16 s; const float b0 = P.base - mref;
#pragma unroll
    for (int r = 0; r < 16; ++r) { const int cr = (r & 3) + 8 * (r >> 2);
        float x = fmaf(P.sd, (float)cr, b0);
        if (MASK) { const bool ok = (unsigned)(P.dist0 - P.dd * cr) <= (unsigned)P.lim; x = ok ? x : -INFINITY; }
        s[r] = x; }
#pragma unroll
    for (int d0 = 0; d0 < 4; ++d0) s = MFMA32(kf[d0], qf[d0], s);
    return s;
}
template <bool MASK>
__device__ __forceinline__ void attn_core_d(const bf16x8 (&qf)[4], LAS unsigned char* tl, int lane, float& m, float& l, f32x16 (&o)[2], const TileP P) {
    bf16x8 kf[4]; k_frags(kf, tl + 4096, lane);
    VF V; v_frags(V, tl, lane);
    const bool seeded = m > -1e29f; const float mref = seeded ? m : 0.f;
    f32x16 s = qk_scores_d<MASK>(qf, kf, P, mref);
    float mx = fmaxf(fmaxf(fmaxf(s[0], s[1]), fmaxf(s[2], s[3])), fmaxf(fmaxf(s[4], s[5]), fmaxf(s[6], s[7])));
    mx = fmaxf(mx, fmaxf(fmaxf(fmaxf(s[8], s[9]), fmaxf(s[10], s[11])), fmaxf(fmaxf(s[12], s[13]), fmaxf(s[14], s[15]))));
    mx = xhalf_max(mx);
    const bool need = seeded ? (mx > SM_THR) : (mx > -INFINITY);
    if (__builtin_amdgcn_ballot_w64(need)) {
        const float dl = need ? mx : 0.f, f = (need && seeded) ? ex2(-dl) : 1.0f;
        m = need ? mref + dl : m; l *= f;
#pragma unroll
        for (int r = 0; r < 16; ++r) { o[0][r] *= f; o[1][r] *= f; s[r] -= dl; }
    }
    l += exp_sum(s, 0.f);
    pv_mma(s, V, o);
}
template <bool MASK>
__device__ __forceinline__ void stats_core_d(const bf16x8 (&qf)[4], LAS unsigned char* tl, int lane, float& m, float& l, const TileP P) {
    bf16x8 kf[4]; k_frags(kf, tl + 4096, lane);
    const bool seeded = m > -1e29f; const float mref = seeded ? m : 0.f;
    f32x16 s = qk_scores_d<MASK>(qf, kf, P, mref);
    float mx = fmaxf(fmaxf(fmaxf(s[0], s[1]), fmaxf(s[2], s[3])), fmaxf(fmaxf(s[4], s[5]), fmaxf(s[6], s[7])));
    mx = fmaxf(mx, fmaxf(fmaxf(fmaxf(s[8], s[9]), fmaxf(s[10], s[11])), fmaxf(fmaxf(s[12], s[13]), fmaxf(s[14], s[15]))));
    mx = xhalf_max(mx);
    const bool need = seeded ? (mx > SM_THR) : (mx > -INFINITY);
    if (__builtin_amdgcn_ballot_w64(need)) {
        const float dl = need ? mx : 0.f, f = (need && seeded) ? ex2(-dl) : 1.0f;
        m = need ? mref + dl : m; l *= f;
#pragma unroll
        for (int r = 0; r < 16; ++r) s[r] -= dl;
    }
    l += exp_sum(s, 0.f);
}
__device__ __forceinline__ float quad_sum(float x) {
    x += __uint_as_float(__builtin_amdgcn_update_dpp(0u, __float_as_uint(x), 0xB1, 0xF, 0xF, true));
    x += __uint_as_float(__builtin_amdgcn_update_dpp(0u, __float_as_uint(x), 0x4E, 0xF, 0xF, true));
    return x;
}
__device__ __forceinline__ float xhalf_other(float v, int hi) {
    const auto rr = __builtin_amdgcn_permlane32_swap(__float_as_uint(v), __float_as_uint(v), false, false);
    return __uint_as_float(hi ? rr[0] : rr[1]);
}
__device__ __forceinline__ float max16p(const f32x16& s) {
    const float mx = fmaxf(fmaxf(fmaxf(s[0], s[1]), fmaxf(s[2], s[3])), fmaxf(fmaxf(s[4], s[5]), fmaxf(s[6], s[7])));
    return fmaxf(mx, fmaxf(fmaxf(fmaxf(s[8], s[9]), fmaxf(s[10], s[11])), fmaxf(fmaxf(s[12], s[13]), fmaxf(s[14], s[15]))));
}
template <bool MASKA, bool MASKB>
__device__ __forceinline__ void attn_core2_d(const bf16x8 (&qf)[4], LAS unsigned char* ta, LAS unsigned char* tb, int lane, float& m, float& l, f32x16 (&o)[2], const TileP PA, const TileP PB) {
    bf16x8 kfa[4], kfb[4]; k_frags(kfa, ta + 4096, lane); k_frags(kfb, tb + 4096, lane);
    VF VA, VB; v_frags(VA, ta, lane); v_frags(VB, tb, lane);
    const bool seeded = m > -1e29f; const float mref = seeded ? m : 0.f;
    f32x16 sa = qk_scores_d<MASKA>(qf, kfa, PA, mref);
    f32x16 sb = qk_scores_d<MASKB>(qf, kfb, PB, mref);
    const float mx = xhalf_max(fmaxf(max16p(sa), max16p(sb)));
    const bool need = seeded ? (mx > SM_THR) : (mx > -INFINITY);
    if (__builtin_amdgcn_ballot_w64(need)) {
        const float dl = need ? mx : 0.f, f = (need && seeded) ? ex2(-dl) : 1.0f;
        m = need ? mref + dl : m; l *= f;
#pragma unroll
        for (int r = 0; r < 16; ++r) { o[0][r] *= f; o[1][r] *= f; sa[r] -= dl; sb[r] -= dl; }
    }
    l += exp_sum(sa, 0.f) + exp_sum(sb, 0.f);
    pv_mma(sa, VA, o); pv_mma(sb, VB, o);
}
template <bool MASKA, bool MASKB>
__device__ __forceinline__ void stats_core2_d(const bf16x8 (&qf)[4], LAS unsigned char* ta, LAS unsigned char* tb, int lane, float& m, float& l, const TileP PA, const TileP PB) {
    bf16x8 kfa[4], kfb[4]; k_frags(kfa, ta + 4096, lane); k_frags(kfb, tb + 4096, lane);
    const bool seeded = m > -1e29f; const float mref = seeded ? m : 0.f;
    f32x16 sa = qk_scores_d<MASKA>(qf, kfa, PA, mref);
    f32x16 sb = qk_scores_d<MASKB>(qf, kfb, PB, mref);
    const float mx = xhalf_max(fmaxf(max16p(sa), max16p(sb)));
    const bool need = seeded ? (mx > SM_THR) : (mx > -INFINITY);
    if (__builtin_amdgcn_ballot_w64(need)) {
        const float dl = need ? mx : 0.f, f = (need && seeded) ? ex2(-dl) : 1.0f;
        m = need ? mref + dl : m; l *= f;
#pragma unroll
        for (int r = 0; r < 16; ++r) { sa[r] -= dl; sb[r] -= dl; }
    }
    l += exp_sum(sa, 0.f) + exp_sum(sb, 0.f);
}
template <bool WITH_V, class RowF, class Compute>
__device__ __forceinline__ void shared_pairs(int n, LAS unsigned char* lds, int slab_stride, const bf16* kbase, const bf16* vbase, RowF rowf, int wave, int lane, Compute compute) {
    if (n <= 0) return;
    const int ns = (n + 1) >> 1;
    const int lw = wave & 3; const bool isv = wave >= 4;
    const int key = 8 * lw + (lane >> 3), c = lane & 7;
    const int woff = isv ? ((c >> 2) * 2048 + key * 64 + (c & 3) * 16) : (4096 + key * 128 + ((c ^ (key & 7)) << 4));
    const bf16* base = isv ? vbase : kbase;
    const bool active = WITH_V || !isv;
    auto img = [&](int b, int x) { return lds + (2 * b + x) * slab_stride; };
    auto ld = [&](int t) { const int tc = t < n ? t : n - 1; return *(const u32x4*)(base + rowf(tc, key) + 8 * c); };
    u32x4 R0 = {0u, 0u, 0u, 0u}, R1 = R0;
    __syncthreads();
    if (active) { R0 = ld(0); R1 = ld(1); *(LAS u32x4*)(img(0, 0) + woff) = R0; *(LAS u32x4*)(img(0, 1) + woff) = R1; }
    if (ns > 1 && active) { R0 = ld(2); R1 = ld(3); }
    __syncthreads();
#pragma nounroll
    for (int s = 0; s < ns; ++s) {
        if (s + 1 < ns && active) { *(LAS u32x4*)(img((s + 1) & 1, 0) + woff) = R0; *(LAS u32x4*)(img((s + 1) & 1, 1) + woff) = R1; }
        if (s + 2 < ns && active) { R0 = ld(2 * s + 4); R1 = ld(2 * s + 5); }
        compute(img(s & 1, 0), (2 * s + 1 < n) ? img(s & 1, 1) : (LAS unsigned char*)nullptr, s);
        __syncthreads();
    }
}
struct KV2 { bf16x8 k[2][4]; u32x4 v[2][4]; };
__device__ __forceinline__ void v_stage_raw(const u32x4 (&v)[4], LAS unsigned char* vs, int lane) {
#pragma unroll
    for (int i = 0; i < 4; ++i) { const int key = 8 * i + (lane >> 3), c = lane & 7; *(LAS u32x4*)(vs + (c >> 2) * 2048 + key * 64 + (c & 3) * 16) = v[i]; }
}
template <bool MASK>
__device__ __forceinline__ void pair_qk(const bf16x8 (&qf)[4], LAS unsigned char* vs, int lane, float mref, const TileP PA, const TileP PB, f32x16& sa, f32x16& sb) {
    { bf16x8 kf[4]; k_frags(kf, vs, lane); sa = qk_scores_d<MASK>(qf, kf, PA, mref); }
    { bf16x8 kf[4]; k_frags(kf, vs + 4096, lane); sb = qk_scores_d<MASK>(qf, kf, PB, mref); }
    asm volatile("" ::: "memory");
}
__device__ __forceinline__ void pair_sm_pv(f32x16& sa, f32x16& sb, LAS unsigned char* vs, int lane, float& m, float& l, f32x16 (&o)[2], bool seeded, float mref) {
    const float mx = xhalf_max(fmaxf(max16p(sa), max16p(sb)));
    const bool need = seeded ? (mx > SM_THR) : (mx > -INFINITY);
    if (__builtin_amdgcn_ballot_w64(need)) {
        const float dl = need ? mx : 0.f, f = (need && seeded) ? ex2(-dl) : 1.0f;
        m = need ? mref + dl : m; l *= f;
#pragma unroll
        for (int r = 0; r < 16; ++r) { o[0][r] *= f; o[1][r] *= f; sa[r] -= dl; sb[r] -= dl; }
    }
    l += exp_sum(sa, 0.f) + exp_sum(sb, 0.f);
    { VF V; v_frags(V, vs, lane); pv_mma(sa, V, o); }
    { VF V; v_frags(V, vs + 4096, lane); pv_mma(sb, V, o); }
    asm volatile("" ::: "memory");
}
template <class Issue, class Stage, class Compute>
__device__ __forceinline__ void pipe_tiles1(int n, Issue issue, Stage stage, Compute compute) {
    if (n <= 0) return;
    KVT T; issue(T, 0);
#pragma nounroll
    for (int i = 0; i < n; ++i) { stage(T, i); if (i + 1 < n) issue(T, i + 1); compute(i); }
}
template <class Issue, class Stage, class Compute>
__device__ __forceinline__ void pipe_tiles2(int n, Issue issue, Stage stage, Compute compute) {
    if (n <= 0) return;
    KVT A, B; issue(A, 0); if (n > 1) issue(B, 1);
    int i = 0;
#pragma nounroll
    for (; i + 1 < n; i += 2) { stage(A, i); if (i + 2 < n) issue(A, i + 2); compute(i); stage(B, i + 1); if (i + 3 < n) issue(B, i + 3); compute(i + 1); }
    if (i < n) { stage(A, i); compute(i); }
}
template <bool WITH_V, class RowF, class Compute>
__device__ __forceinline__ void shared_tiles(int n, LAS unsigned char* sh, const bf16* kbase, const bf16* vbase, RowF rowf, int wave, int lane, Compute compute) {
    if (n <= 0) return;
    const int lw = wave & 3; const bool isv = wave >= 4;
    const int key = 8 * lw + (lane >> 3), c = lane & 7;
    const int woff = isv ? ((c >> 2) * 2048 + key * 64 + (c & 3) * 16) : (4096 + key * 128 + ((c ^ (key & 7)) << 4));
    const bf16* base = isv ? vbase : kbase;
    const bool active = WITH_V || !isv;
    u32x4 RA = {0u, 0u, 0u, 0u}, RB = RA;
    if (active) { RA = *(const u32x4*)(base + rowf(0, key) + 8 * c); *(LAS u32x4*)(sh + woff) = RA; }
    if (n > 1 && active) RA = *(const u32x4*)(base + rowf(1, key) + 8 * c);
    if (n > 2 && active) RB = *(const u32x4*)(base + rowf(2, key) + 8 * c);
    __syncthreads();
    int i = 0;
#pragma nounroll
    for (; i + 1 < n; i += 2) {
        if (active) *(LAS u32x4*)(sh + ((i + 1) & 1) * 8192 + woff) = RA;
        if (i + 3 < n && active) RA = *(const u32x4*)(base + rowf(i + 3, key) + 8 * c);
        compute(sh + (i & 1) * 8192, i);
        __syncthreads();
        if (i + 2 < n && active) *(LAS u32x4*)(sh + (i & 1) * 8192 + woff) = RB;
        if (i + 4 < n && active) RB = *(const u32x4*)(base + rowf(i + 4, key) + 8 * c);
        compute(sh + ((i + 1) & 1) * 8192, i + 1);
        __syncthreads();
    }
    if (i < n) { compute(sh + (i & 1) * 8192, i); __syncthreads(); }
}
struct KT { bf16x8 k[4]; };
__device__ __forceinline__ void o_store(const f32x16 (&o)[2], bf16* orow, int hi) {
#pragma unroll
    for (int db = 0; db < 2; ++db)
#pragma unroll
        for (int k = 0; k < 4; ++k) { u32x2 w; w.x = pk2(o[db][4 * k], o[db][4 * k + 1]); w.y = pk2(o[db][4 * k + 2], o[db][4 * k + 3]); *(u32x2*)(orow + 32 * db + 8 * k + 4 * hi) = w; }
}
template <class Buf, class Issue, class Compute>
__device__ __forceinline__ void pipe_tiles(int n, Issue issue, Compute compute) {
    if (n <= 0) return;
    Buf A, B; issue(A, 0);
    int i = 0;
#pragma nounroll
    for (; i + 1 < n; i += 2) { issue(B, i + 1); compute(A, i); if (i + 2 < n) issue(A, i + 2); compute(B, i + 1); }
    if (i < n) compute(A, i);
}

constexpr int DST = 68, DIL_VS = 256 * DST * 4;
__device__ __forceinline__ void dil_block(const bf16* qkv, bf16* O, int b, int h, LAS unsigned char* lds, int wave, int lane) {
    LAS float* ST = (LAS float*)lds;
    LAS unsigned char* vs = lds + DIL_VS + wave * 8192;
    const int hi = lane >> 5, c = lane & 31;
    const float slope2 = exp2f(-0.5f * (float)(h + 1)) * LOG2E;
    float m = -1e30f, l = 0.f; f32x16 o[2];
    auto seg_g = [](int seg) { return seg < 2 ? seg : 2; };
    auto seg_tau = [&](int seg, int col) { return seg == 0 ? 32 * wave + col : (seg == 1 ? 128 * (wave >> 2) + (wave & 3) + 4 * col : (2 * wave + (seg - 2)) + 16 * (col & 15)); };
    bf16x8 qf[4];
    auto issue = [&](KVT& T, int t) {
        const int seg = t / 5, j = t - 5 * seg;
        const int g = seg_g(seg), d = 1 << (2 * g), W = 128 << (2 * g);
        const int tlo = 256 * b + seg_tau(seg, 0) - W + 32 * d * j;
        const bf16* kb = qkv + (size_t)((g * 3 + 1) * 16 + h) * ((size_t)SEQ * 64);
        kv_load(T, kb, kb + (size_t)16 * SEQ * 64, [&](int key) { int tk = tlo + d * key; tk = tk < 0 ? 0 : (tk > SEQ - 1 ? SEQ - 1 : tk); return (size_t)tk * 64; }, lane);
    };
    auto issue_q = [&](bf16x8 (&q)[4], int seg) { const int g = seg_g(seg); q_load(q, qkv + (size_t)((g * 3) * 16 + h) * ((size_t)SEQ * 64) + (size_t)(256 * b + seg_tau(seg, c)) * 64, lane); };
    auto compute = [&](int t) {
        const int seg = t / 5, j = t - 5 * seg;
        const int g = seg_g(seg), d = 1 << (2 * g), W = 128 << (2 * g);
        const int tau = seg_tau(seg, c), tq = 256 * b + tau;
        if (j == 0) {
            issue_q(qf, seg);
            if (seg == 0) {
                m = -1e30f; l = 0.f;
#pragma unroll
                for (int r = 0; r < 16; ++r) { o[0][r] = 0.f; o[1][r] = 0.f; }
            } else {
                if (seg <= 2) __syncthreads();
                const LAS float* sp = ST + tau * DST;
#pragma unroll
                for (int db = 0; db < 2; ++db)
#pragma unroll
                    for (int k = 0; k < 4; ++k) { const f32x4 v = *(const LAS f32x4*)(sp + 32 * db + 8 * k + 4 * hi); o[db][4 * k] = v[0]; o[db][4 * k + 1] = v[1]; o[db][4 * k + 2] = v[2]; o[db][4 * k + 3] = v[3]; }
                m = sp[64]; l = sp[65 + hi];
            }
        }
        const int tlo = 256 * b + seg_tau(seg, 0) - W + 32 * d * j, thi = tlo + 31 * d;
        if (thi >= 0) {
            TileP P; P.dist0 = tq - tlo - 4 * hi * d; P.dd = d; P.lim = W < tq ? W : tq; P.base = -slope2 * (float)P.dist0; P.sd = slope2 * (float)d;
            if (j >= 1 && j <= 3 && tlo >= 0) attn_core_d<false>(qf, vs, lane, m, l, o, P);
            else attn_core_d<true>(qf, vs, lane, m, l, o, P);
        }
        if (j == 4) {
            if (seg < 2) {
                LAS float* sp = ST + tau * DST;
#pragma unroll
                for (int db = 0; db < 2; ++db)
#pragma unroll
                    for (int k = 0; k < 4; ++k) { const f32x4 v = {o[db][4 * k], o[db][4 * k + 1], o[db][4 * k + 2], o[db][4 * k + 3]}; *(LAS f32x4*)(sp + 32 * db + 8 * k + 4 * hi) = v; }
                if (hi == 0) sp[64] = m;
                sp[65 + hi] = l;
            } else {
                const float lt = l + __shfl_xor(l, 32), inv = 1.0f / lt;
#pragma unroll
                for (int r = 0; r < 16; ++r) { o[0][r] *= inv; o[1][r] *= inv; }
                if (c < 16) o_store(o, O + (size_t)tq * DM + h * 64, hi);
            }
        }
    };
    pipe_tiles1(20, issue, [&](KVT& T, int) { v_stage(T, vs, lane); k_stage(T.k, vs + 4096, lane); }, compute);
    __syncthreads();
}

constexpr int SL_S = 8192, SL_SEL = SL_S + 8 * 257 * 4, SL_UB = SL_SEL + 256, NSA_SLAB = 17920;
__device__ __forceinline__ void nsa_item(const bf16* Q, const bf16* KV, const bf16* KC, const bf16* VC, const float* GATES, bf16* O, int tt, int g, LAS unsigned char* slab, int lane) {
    const int hi = lane >> 5, col = lane & 31, ti = col >> 2, r4 = col & 3, hh = 4 * g + r4;
    const int tq = 8 * tt + ti, tq0 = 8 * tt, tqmax = 8 * tt + 7;
    const float slope2 = exp2f(-0.5f * (float)(hh + 1)) * LOG2E;
    LAS unsigned char* vs = slab;
    LAS float* S = (LAS float*)(slab + SL_S);
    LAS unsigned* SEL = (LAS unsigned*)(slab + SL_SEL);
    LAS int* UB = (LAS int*)(slab + SL_UB);
    bf16x8 qf[4]; q_load(qf, Q + (size_t)hh * ((size_t)SEQ * 64) + (size_t)tq * 64, lane);
    const float* gt = GATES + (size_t)tq * 48 + g * 4 + r4;
    f32x16 oacc[2];
    for (int i = lane; i < 8 * 257; i += 64) S[i] = 0.f;
    const int ncmp = (tqmax >= 31) ? (((tqmax - 31) >> 4) + 1) : 0;
    const int ntc = (ncmp + 31) >> 5;
    auto crow_of = [&](int t2) { return [=](int key) { int cc = 32 * t2 + key; cc = cc > 1022 ? 1022 : cc; return (size_t)(cc * 4 + g) * 64; }; };
    auto cmp_P = [&](int t2) { TileP P; P.dist0 = tq - 31 - 16 * (32 * t2 + 4 * hi); P.dd = 16; P.lim = 0x3fffffff; P.base = -slope2 * (float)P.dist0; P.sd = slope2 * 16.f; return P; };
    auto cmp_interior = [&](int t2) { return 16 * (32 * t2 + 31) + 31 <= tq0; };
    for (int rep_ = 0; rep_ < REP_CMP; ++rep_) {
        float m = -1e30f, l = 0.f;
        pipe_tiles<KT>(ntc, [&](KT& T, int t2) { k_load(T.k, KC, crow_of(t2), lane); },
                       [&](KT& T, int t2) { const TileP P = cmp_P(t2);
                           if (cmp_interior(t2)) stats_tile<false>(qf, T.k, vs, lane, m, l, P); else stats_tile<true>(qf, T.k, vs, lane, m, l, P); });
        l += __shfl_xor(l, 32);
        const float linv = (l > 0.f) ? 1.0f / l : 0.f;
        f32x16 oc[2];
#pragma unroll
        for (int r = 0; r < 16; ++r) { oc[0][r] = 0.f; oc[1][r] = 0.f; }
        float carry = 0.f;
        pipe_tiles<KVT>(ntc, [&](KVT& T, int t2) { kv_load(T, KC, VC, crow_of(t2), lane); }, [&](KVT& T, int t2) {
            v_stage(T, vs, lane); k_stage(T.k, vs + 4096, lane);
            bf16x8 kf[4]; k_frags(kf, vs + 4096, lane);
            f32x16 s = qk_tile(qf, kf);
            const TileP P = cmp_P(t2);
            if (cmp_interior(t2)) scores<false>(s, P); else scores<true>(s, P);
#pragma unroll
            for (int r = 0; r < 16; ++r) s[r] = ex2(s[r] - m) * linv;
            pv_acc(s, vs, lane, oc);
            float prevr = carry;
#pragma unroll
            for (int i = 0; i < 4; ++i) { float e = s[4 * i + 3], p = 2.f * (s[4 * i] + s[4 * i + 1] + s[4 * i + 2]) + e;
                p += __shfl_xor(p, 1); p += __shfl_xor(p, 2); e += __shfl_xor(e, 1); e += __shfl_xor(e, 2);
                const float rcv = __shfl_xor(e, 32);
                const float sc = p + (hi ? rcv : prevr);
                const int u = 8 * t2 + 2 * i + hi; if (r4 == 0) S[ti * 257 + u] = sc;
                prevr = rcv; }
            carry = prevr;
        });
        { const float gc = gt[0];
#pragma unroll
        for (int r = 0; r < 16; ++r) { oacc[0][r] = gc * oc[0][r]; oacc[1][r] = gc * oc[1][r]; } }
    }
    LDS_WAIT();
    const int cur_b = tq0 >> 6;
#ifndef NSA_NO_SEL
    for (int rep_ = 0; rep_ < REP_SEL; ++rep_) {
        const int tok = lane >> 3, sub = lane & 7;
        unsigned wsel = 0u;
        if (cur_b <= 15) { wsel = (sub == 0) ? ((2u << cur_b) - 1u) : 0u; }
        else {
            unsigned key[32];
#pragma unroll
            for (int k = 0; k < 32; ++k) { const int u = sub + 8 * k; const unsigned bits = __float_as_uint(S[tok * 257 + u]);
                key[k] = (u >= 1 && u <= cur_b - 2) ? ((bits & 0xffffff00u) | (unsigned)(255 - u)) : 0u; }
            wsel = ((sub == 0) ? 1u : 0u) | (((cur_b >> 5) == sub) ? (1u << (cur_b & 31)) : 0u) | ((((cur_b - 1) >> 5) == sub) ? (1u << ((cur_b - 1) & 31)) : 0u);
            for (int rnd = 0; rnd < 13; ++rnd) {
                unsigned mx = 0u;
#pragma unroll
                for (int k = 0; k < 32; ++k) mx = key[k] > mx ? key[k] : mx;
                { const unsigned o1 = __builtin_amdgcn_update_dpp(0u, mx, 0xB1, 0xF, 0xF, true); mx = o1 > mx ? o1 : mx;
                  const unsigned o2 = __builtin_amdgcn_update_dpp(0u, mx, 0x4E, 0xF, 0xF, true); mx = o2 > mx ? o2 : mx;
                  const unsigned o4 = __builtin_amdgcn_update_dpp(0u, mx, 0x141, 0xF, 0xF, true); mx = o4 > mx ? o4 : mx; }
#pragma unroll
                for (int k = 0; k < 32; ++k) key[k] = (key[k] == mx) ? 0u : key[k];
                const int u = 255 - (int)(mx & 0xffu);
                wsel |= ((u >> 5) == sub) ? (1u << (u & 31)) : 0u;
            }
        }
        SEL[tok * 8 + sub] = wsel;
    }
#endif
    LDS_WAIT();
    int nu = 0;
    for (int wd = 0; wd < 8; ++wd) {
        const unsigned mw = SEL[ti * 8 + wd];
        unsigned uw = 0u;
#pragma unroll
        for (int i = 0; i < 8; ++i) uw |= (unsigned)__builtin_amdgcn_readlane((int)mw, 4 * i);
        while (uw) { const int bb = __builtin_ctz(uw); uw &= uw - 1u; if (lane == 0) UB[nu] = wd * 32 + bb; ++nu; }
    }
    LDS_WAIT();
    LAS float* PARK = S;
#pragma unroll
    for (int r = 0; r < 16; ++r) { PARK[r * 64 + lane] = oacc[0][r]; PARK[(16 + r) * 64 + lane] = oacc[1][r]; }
#ifndef NSA_NO_SLC
    for (int rep_ = 0; rep_ < REP_SLC; ++rep_) {
        float m = -1e30f, l = 0.f; f32x16 os[2];
#pragma unroll
        for (int r = 0; r < 16; ++r) { os[0][r] = 0.f; os[1][r] = 0.f; }
        const bf16* kb = KV + 512 + g * 64; const bf16* vb = KV + 768 + g * 64;
        const int ntile = 2 * nu;
        auto tk0_of = [&](int idx) { return 64 * __builtin_amdgcn_readfirstlane(UB[idx >> 1]) + 32 * (idx & 1); };
        pipe_tiles<KVT>(ntile, [&](KVT& T, int idx) { const int tk0 = tk0_of(idx); kv_load(T, kb, vb, [=](int key) { return (size_t)(tk0 + key) * NKV; }, lane); },
            [&](KVT& T, int idx) {
                const int tk0 = tk0_of(idx), u = tk0 >> 6;
                if (tk0 <= tqmax) {
                    const bool mysel = (SEL[ti * 8 + (u >> 5)] >> (u & 31)) & 1u;
                    TileP P; P.dist0 = mysel ? (tq - tk0 - 4 * hi) : 0x40000000; P.dd = 1; P.lim = 0x3fffffff; P.base = -slope2 * (float)(tq - tk0 - 4 * hi); P.sd = slope2;
                    const bool interior = (tk0 + 31 <= tq0) && (__builtin_amdgcn_ballot_w64(!mysel) == 0ull);
                    if (interior) attn_tile<false>(qf, T, vs, lane, m, l, os, P); else attn_tile<true>(qf, T, vs, lane, m, l, os, P);
                }
            });
        l += __shfl_xor(l, 32);
        const float f = (l > 0.f && rep_ == REP_SLC - 1) ? gt[16] / l : 0.f;
#pragma unroll
        for (int r = 0; r < 16; ++r) { PARK[r * 64 + lane] += f * os[0][r]; PARK[(16 + r) * 64 + lane] += f * os[1][r]; }
    }
#endif
#ifndef NSA_NO_WIN
    for (int rep_ = 0; rep_ < REP_WIN; ++rep_) {
        float m = -1e30f, l = 0.f; f32x16 ow[2];
#pragma unroll
        for (int r = 0; r < 16; ++r) { ow[0][r] = 0.f; ow[1][r] = 0.f; }
        const bf16* kb = KV + 1024 + g * 64; const bf16* vb = KV + 1280 + g * 64;
        const int tkb = tq0 + 8 - 32 * 17;
        int t2s = 0; while (tkb + 32 * t2s + 31 < 0) ++t2s;
        auto wrow = [&](int tk0) { return [=](int key) { int tk = tk0 + key; tk = tk < 0 ? 0 : (tk > SEQ - 1 ? SEQ - 1 : tk); return (size_t)tk * NKV; }; };
        pipe_tiles<KVT>(17 - t2s, [&](KVT& T, int i) { kv_load(T, kb, vb, wrow(tkb + 32 * (t2s + i)), lane); },
            [&](KVT& T, int i) {
                const int tk0 = tkb + 32 * (t2s + i);
                TileP P; P.dist0 = tq - tk0 - 4 * hi; P.dd = 1; P.lim = 511 < tq ? 511 : tq; P.base = -slope2 * (float)P.dist0; P.sd = slope2;
                const bool interior = (tk0 >= 0) && (tqmax - tk0 <= 511) && (tk0 + 31 <= tq0);
                if (interior) attn_tile<false>(qf, T, vs, lane, m, l, ow, P); else attn_tile<true>(qf, T, vs, lane, m, l, ow, P);
            });
        l += __shfl_xor(l, 32);
        const float f = (l > 0.f) ? gt[32] / l : 0.f;
#pragma unroll
        for (int r = 0; r < 16; ++r) { oacc[0][r] = PARK[r * 64 + lane] + f * ow[0][r]; oacc[1][r] = PARK[(16 + r) * 64 + lane] + f * ow[1][r]; }
    }
#endif
    o_store(oacc, O + (size_t)tq * DM + hh * 64, hi);
}

#define NSA_CHUNK 1
__device__ __forceinline__ void nsa_chunk(const bf16* Q, const bf16* KV, const bf16* KC, const bf16* VC, const float* GATES, bf16* O, int ch, int g, LAS unsigned char* lds, int wave, int lane) {
    const int tt = 8 * ch + wave; LAS unsigned char* slab = lds + wave * NSA_SLAB; LAS unsigned char* SH = lds + 8 * NSA_SLAB;
    const int hi = lane >> 5, col = lane & 31, ti = col >> 2, r4 = col & 3, hh = 4 * g + r4;
    const int tq = 8 * tt + ti, tq0 = 8 * tt, tqmax = 8 * tt + 7;
    const float slope2 = exp2f(-0.5f * (float)(hh + 1)) * LOG2E;
    LAS unsigned char* vs = slab;
    LAS float* S = (LAS float*)(slab + SL_S);
    LAS unsigned* SEL = (LAS unsigned*)(slab + SL_SEL);
    LAS int* UB = (LAS int*)(slab + SL_UB);
    bf16x8 qf[4]; q_load(qf, Q + (size_t)hh * ((size_t)SEQ * 64) + (size_t)tq * 64, lane);
    const float* gt = GATES + (size_t)tq * 48 + g * 4 + r4;
    f32x16 oacc[2];
    for (int i = lane; i < 8 * 257; i += 64) S[i] = 0.f;
    const int ncmp = (tqmax >= 31) ? (((tqmax - 31) >> 4) + 1) : 0;
    const int ntc_w = (ncmp + 31) >> 5;
    const int ntc = (4 * ch + 3 + 31) >> 5;
    auto crow_of = [&](int t2) { return [=](int key) { int cc = 32 * t2 + key; cc = cc > 1022 ? 1022 : cc; return (size_t)(cc * 4 + g) * 64; }; };
    auto cmp_P = [&](int t2) { TileP P; P.dist0 = tq - 31 - 16 * (32 * t2 + 4 * hi); P.dd = 16; P.lim = 0x3fffffff; P.base = -slope2 * (float)P.dist0; P.sd = slope2 * 16.f; return P; };
    auto cmp_interior = [&](int t2) { return 16 * (32 * t2 + 31) + 31 <= tq0; };
    for (int rep_ = 0; rep_ < REP_CMP; ++rep_) {
        float m = -1e30f, l = 0.f;
        shared_pairs<false>(ntc, lds, NSA_SLAB, KC, VC, [&](int t2, int key) { int cc = 32 * t2 + key; cc = cc > 1022 ? 1022 : cc; return (size_t)(cc * 4 + g) * 64; }, wave, lane,
            [&](LAS unsigned char* ta, LAS unsigned char* tb, int s2) { const int t2 = 2 * s2;
                if (t2 + 1 < ntc_w && tb) { const TileP PA = cmp_P(t2), PB = cmp_P(t2 + 1);
                    if (cmp_interior(t2 + 1)) stats_core2_d<false, false>(qf, ta, tb, lane, m, l, PA, PB); else stats_core2_d<false, true>(qf, ta, tb, lane, m, l, PA, PB); }
                else if (t2 < ntc_w) { const TileP P = cmp_P(t2); if (cmp_interior(t2)) stats_core_d<false>(qf, ta, lane, m, l, P); else stats_core_d<true>(qf, ta, lane, m, l, P); } });
        l += __shfl_xor(l, 32);
        const float linv = (l > 0.f) ? 1.0f / l : 0.f, mfin = (m > -1e29f) ? m : 0.f; (void)mfin;
        f32x16 oc[2];
#pragma unroll
        for (int r = 0; r < 16; ++r) { oc[0][r] = 0.f; oc[1][r] = 0.f; }
        float carry = 0.f;
        auto cmp2_tile = [&](LAS unsigned char* tl, int t2) {
            bf16x8 kf[4]; k_frags(kf, tl + 4096, lane);
            const TileP P = cmp_P(t2);
#if CMP2_NEW
            f32x16 s = cmp_interior(t2) ? qk_scores_d<false>(qf, kf, P, mfin) : qk_scores_d<true>(qf, kf, P, mfin);
#pragma unroll
            for (int r = 0; r < 16; ++r) s[r] = ex2(s[r]) * linv;
#else
            f32x16 s = qk_tile(qf, kf);
            if (cmp_interior(t2)) scores<false>(s, P); else scores<true>(s, P);
#pragma unroll
            for (int r = 0; r < 16; ++r) s[r] = ex2(s[r] - m) * linv;
#endif
            pv_acc(s, tl, lane, oc);
            float prevr = carry;
#pragma unroll
            for (int i = 0; i < 4; ++i) { float e = s[4 * i + 3], p = 2.f * (s[4 * i] + s[4 * i + 1] + s[4 * i + 2]) + e;
                p = quad_sum(p); e = quad_sum(e);
                const float rcv = xhalf_other(e, hi);
                const float sc = p + (hi ? rcv : prevr);
                const int u = 8 * t2 + 2 * i + hi; if (r4 == 0) S[ti * 257 + u] = sc;
                prevr = rcv; }
            carry = prevr;
        };
        shared_pairs<true>(ntc, lds, NSA_SLAB, KC, VC, [&](int t2, int key) { int cc = 32 * t2 + key; cc = cc > 1022 ? 1022 : cc; return (size_t)(cc * 4 + g) * 64; }, wave, lane,
            [&](LAS unsigned char* ta, LAS unsigned char* tb, int s2) { const int t2 = 2 * s2;
                if (t2 < ntc_w) cmp2_tile(ta, t2);
                if (tb && t2 + 1 < ntc_w) cmp2_tile(tb, t2 + 1); });
        { const float gc = gt[0];
#pragma unroll
        for (int r = 0; r < 16; ++r) { oacc[0][r] = gc * oc[0][r]; oacc[1][r] = gc * oc[1][r]; } }
    }
    LDS_WAIT();
    const int cur_b = tq0 >> 6;
#ifndef NSA_NO_SEL
    for (int rep_ = 0; rep_ < REP_SEL; ++rep_) {
        const int tok = lane >> 3, sub = lane & 7;
        unsigned wsel = 0u;
        if (cur_b <= 15) { wsel = (sub == 0) ? ((2u << cur_b) - 1u) : 0u; }
        else {
            unsigned key[32];
#pragma unroll
            for (int k = 0; k < 32; ++k) { const int u = sub + 8 * k; const unsigned bits = __float_as_uint(S[tok * 257 + u]);
                key[k] = (u >= 1 && u <= cur_b - 2) ? ((bits & 0xffffff00u) | (unsigned)(255 - u)) : 0u; }
            wsel = ((sub == 0) ? 1u : 0u) | (((cur_b >> 5) == sub) ? (1u << (cur_b & 31)) : 0u) | ((((cur_b - 1) >> 5) == sub) ? (1u << ((cur_b - 1) & 31)) : 0u);
            for (int rnd = 0; rnd < 13; ++rnd) {
                unsigned mx = 0u;
#pragma unroll
                for (int k = 0; k < 32; ++k) mx = key[k] > mx ? key[k] : mx;
                { const unsigned o1 = __builtin_amdgcn_update_dpp(0u, mx, 0xB1, 0xF, 0xF, true); mx = o1 > mx ? o1 : mx;
                  const unsigned o2 = __builtin_amdgcn_update_dpp(0u, mx, 0x4E, 0xF, 0xF, true); mx = o2 > mx ? o2 : mx;
                  const unsigned o4 = __builtin_amdgcn_update_dpp(0u, mx, 0x141, 0xF, 0xF, true); mx = o4 > mx ? o4 : mx; }
#pragma unroll
                for (int k = 0; k < 32; ++k) key[k] = (key[k] == mx) ? 0u : key[k];
                const int u = 255 - (int)(mx & 0xffu);
                wsel |= ((u >> 5) == sub) ? (1u << (u & 31)) : 0u;
            }
        }
        SEL[tok * 8 + sub] = wsel;
    }
#endif
    LDS_WAIT();
    int nu = 0;
    for (int wd = 0; wd < 8; ++wd) {
        const unsigned mw = SEL[ti * 8 + wd];
        unsigned uw = 0u;
#pragma unroll
        for (int i = 0; i < 8; ++i) uw |= (unsigned)__builtin_amdgcn_readlane((int)mw, 4 * i);
        while (uw) { const int bb = __builtin_ctz(uw); uw &= uw - 1u; if (lane == 0) UB[nu] = wd * 32 + bb; ++nu; }
    }
    LDS_WAIT();
    LAS float* PARK = S;
#pragma unroll
    for (int r = 0; r < 16; ++r) { PARK[r * 64 + lane] = oacc[0][r]; PARK[(16 + r) * 64 + lane] = oacc[1][r]; }
#ifndef NSA_NO_SLC
    for (int rep_ = 0; rep_ < REP_SLC; ++rep_) {
        float m = -1e30f, l = 0.f; f32x16 os[2];
#pragma unroll
        for (int r = 0; r < 16; ++r) { os[0][r] = 0.f; os[1][r] = 0.f; }
        const bf16* kb = KV + 512 + g * 64; const bf16* vb = KV + 768 + g * 64;
        {
            bf16x8 tk[2][4]; u32x4 tv[2][4];
            const size_t loff = (size_t)(lane >> 3) * NKV + 8 * (lane & 7);
#define SLC_LDK(bi_) do { const bf16* p_ = kb + (size_t)(64 * __builtin_amdgcn_readfirstlane(UB[bi_])) * NKV + loff; \
    _Pragma("unroll") for (int x_ = 0; x_ < 2; ++x_) _Pragma("unroll") for (int i_ = 0; i_ < 4; ++i_) tk[x_][i_] = *(const bf16x8*)(p_ + (size_t)(32 * x_ + 8 * i_) * NKV); } while (0)
#define SLC_LDV(bi_) do { const bf16* p_ = vb + (size_t)(64 * __builtin_amdgcn_readfirstlane(UB[bi_])) * NKV + loff; \
    _Pragma("unroll") for (int x_ = 0; x_ < 2; ++x_) _Pragma("unroll") for (int i_ = 0; i_ < 4; ++i_) tv[x_][i_] = *(const u32x4*)(p_ + (size_t)(32 * x_ + 8 * i_) * NKV); } while (0)
            SLC_LDK(0); SLC_LDV(0);
#pragma nounroll
            for (int bi = 0; bi < nu; ++bi) {
                const int tk0 = 64 * __builtin_amdgcn_readfirstlane(UB[bi]), u = tk0 >> 6;
                const bool mysel = (SEL[ti * 8 + (u >> 5)] >> (u & 31)) & 1u;
                TileP PA; PA.dist0 = mysel ? (tq - tk0 - 4 * hi) : 0x40000000; PA.dd = 1; PA.lim = 0x3fffffff; PA.base = -slope2 * (float)(tq - tk0 - 4 * hi); PA.sd = slope2;
                TileP PB = PA; PB.dist0 = PA.dist0 - 32; PB.base = -slope2 * (float)(tq - tk0 - 32 - 4 * hi);
                const bool interior = (tk0 + 63 <= tq0) && (__builtin_amdgcn_ballot_w64(!mysel) == 0ull);
                k_stage(tk[0], vs, lane); k_stage(tk[1], vs + 4096, lane);
                if (bi + 1 < nu) SLC_LDK(bi + 1);
                const bool seeded = m > -1e29f; const float mref = seeded ? m : 0.f;
                f32x16 sa, sb;
                if (interior) pair_qk<false>(qf, vs, lane, mref, PA, PB, sa, sb); else pair_qk<true>(qf, vs, lane, mref, PA, PB, sa, sb);
                v_stage_raw(tv[0], vs, lane); v_stage_raw(tv[1], vs + 4096, lane);
                if (bi + 1 < nu) SLC_LDV(bi + 1);
                pair_sm_pv(sa, sb, vs, lane, m, l, os, seeded, mref);
            }
#undef SLC_LDK
#undef SLC_LDV
        }
        l += __shfl_xor(l, 32);
        const float f = (l > 0.f && rep_ == REP_SLC - 1) ? gt[16] / l : 0.f;
#pragma unroll
        for (int r = 0; r < 16; ++r) { PARK[r * 64 + lane] += f * os[0][r]; PARK[(16 + r) * 64 + lane] += f * os[1][r]; }
    }
#endif
#ifndef NSA_NO_WIN
    for (int rep_ = 0; rep_ < REP_WIN; ++rep_) {
        float m = -1e30f, l = 0.f; f32x16 ow[2];
#pragma unroll
        for (int r = 0; r < 16; ++r) { ow[0][r] = 0.f; ow[1][r] = 0.f; }
        const bf16* kb = KV + 1024 + g * 64; const bf16* vb = KV + 1280 + g * 64;
        const int tkb = 64 * ch - 512;
        int t2s = 0; while (tkb + 32 * t2s + 31 < 0) ++t2s;
        auto win_P = [&](int tk0) { TileP P; P.dist0 = tq - tk0 - 4 * hi; P.dd = 1; P.lim = 511 < tq ? 511 : tq; P.base = -slope2 * (float)P.dist0; P.sd = slope2; return P; };
        auto win_used = [&](int tk0) { return tk0 <= tqmax && tk0 + 31 >= tq0 - 511; };
        auto win_int = [&](int tk0) { return (tk0 >= 0) && (tqmax - tk0 <= 511) && (tk0 + 31 <= tq0); };
        shared_pairs<true>(18 - t2s, lds, NSA_SLAB, kb, vb, [&](int i, int key) { int tk = tkb + 32 * (t2s + i) + key; tk = tk < 0 ? 0 : (tk > SEQ - 1 ? SEQ - 1 : tk); return (size_t)tk * NKV; }, wave, lane,
            [&](LAS unsigned char* ta, LAS unsigned char* tb, int s2) {
                const int tkA = tkb + 32 * (t2s + 2 * s2), tkB = tkA + 32;
                const bool ua = win_used(tkA), ub = tb && win_used(tkB);
                if (ua && ub) { const TileP PA = win_P(tkA), PB = win_P(tkB); const bool ia = win_int(tkA), ib = win_int(tkB);
                    if (ia && ib) attn_core2_d<false, false>(qf, ta, tb, lane, m, l, ow, PA, PB);
                    else attn_core2_d<true, true>(qf, ta, tb, lane, m, l, ow, PA, PB); }
                else if (ua) { const TileP P = win_P(tkA); if (win_int(tkA)) attn_core_d<false>(qf, ta, lane, m, l, ow, P); else attn_core_d<true>(qf, ta, lane, m, l, ow, P); }
                else if (ub) { const TileP P = win_P(tkB); if (win_int(tkB)) attn_core_d<false>(qf, tb, lane, m, l, ow, P); else attn_core_d<true>(qf, tb, lane, m, l, ow, P); }
            });
        l += __shfl_xor(l, 32);
        const float f = (l > 0.f) ? gt[32] / l : 0.f;
#pragma unroll
        for (int r = 0; r < 16; ++r) { oacc[0][r] = PARK[r * 64 + lane] + f * ow[0][r]; oacc[1][r] = PARK[(16 + r) * 64 + lane] + f * ow[1][r]; }
    }
#endif
    o_store(oacc, O + (size_t)tq * DM + hh * 64, hi);
}

struct EpiHeadMajor {
    static constexpr bool PERM = true, AFTER_DRAIN = false;
    bf16* O; const float* bias; int smode;
    __device__ __forceinline__ void operator()(const f32x4 (&acc)[2][2][4][2], const pg8::Unit& u, int wr, int wc, int fr, int fq) const {
        const int row0 = u.pm * 256 + wr * 64 + fr, col0 = u.pn * 256 + wc * 32 + 8 * fq;
        const float sc = (smode == 2 || (smode == 1 && ((u.pn >> 2) % 3) == 0)) ? C1 : 1.0f;
#pragma unroll
        for (int bj = 0; bj < 2; ++bj) { const int col = col0 + bj * 128; bf16* blk = O + (size_t)(col >> 6) * ((size_t)SEQ * 64) + (col & 63);
            f32x4 b0 = {0.f, 0.f, 0.f, 0.f}, b1 = b0; if (bias) { b0 = *(const f32x4*)(bias + col); b1 = *(const f32x4*)(bias + col + 4); }
#pragma unroll
            for (int ai = 0; ai < 2; ++ai)
#pragma unroll
                for (int m = 0; m < 4; ++m) { const f32x4 v0 = (acc[ai][bj][m][0] + b0) * sc, v1 = (acc[ai][bj][m][1] + b1) * sc;
                    u32x4 o; o.x = pk2(v0[0], v0[1]); o.y = pk2(v0[2], v0[3]); o.z = pk2(v1[0], v1[1]); o.w = pk2(v1[2], v1[3]);
                    *(u32x4*)(blk + (size_t)(row0 + ai * 128 + m * 16) * 64) = o; } }
    }
};
struct EpiAccF32 {
    static constexpr bool PERM = false, AFTER_DRAIN = false;
    float* C; int ldc;
    __device__ __forceinline__ void operator()(const f32x4 (&acc)[2][2][4][2], const pg8::Unit& u, int wr, int wc, int fr, int fq) const {
        const int row0 = u.pm * 256 + wr * 64 + fr, col0 = u.pn * 256 + wc * 32 + 4 * fq;
#pragma unroll
        for (int ai = 0; ai < 2; ++ai)
#pragma unroll
            for (int m = 0; m < 4; ++m) { float* rowp = C + (size_t)(row0 + ai * 128 + m * 16) * ldc + col0;
#pragma unroll
                for (int bj = 0; bj < 2; ++bj)
#pragma unroll
                    for (int n = 0; n < 2; ++n) { f32x4* p = (f32x4*)(rowp + bj * 128 + n * 16); *p = *p + acc[ai][bj][m][n]; } }
    }
};
struct EpiSwiglu {
    static constexpr bool PERM = true, AFTER_DRAIN = false;
    bf16* HID; const float* roww;
    __device__ __forceinline__ void operator()(const f32x4 (&acc)[2][2][4][2], const pg8::Unit& u, int wr, int wc, int fr, int fq) const {
        const int row0 = u.pm * 256 + wr * 64 + fr, ct = u.pn & 1, col0 = ct * 128 + wc * 32 + 8 * fq;
#pragma unroll
        for (int ai = 0; ai < 2; ++ai)
#pragma unroll
            for (int m = 0; m < 4; ++m) { const int row = row0 + ai * 128 + m * 16; const float w = roww[row];
                float hv[8];
#pragma unroll
                for (int n = 0; n < 2; ++n)
#pragma unroll
                    for (int j = 0; j < 4; ++j) { const float gte = acc[ai][0][m][n][j], up = acc[ai][1][m][n][j];
                        hv[4 * n + j] = gte * __builtin_amdgcn_rcpf(1.0f + ex2(-gte * LOG2E)) * up * w; }
                u32x4 o; o.x = pk2(hv[0], hv[1]); o.y = pk2(hv[2], hv[3]); o.z = pk2(hv[4], hv[5]); o.w = pk2(hv[6], hv[7]);
                *(u32x4*)(HID + (size_t)row * 256 + col0) = o; }
    }
};
struct EpiScatter {
    static constexpr bool PERM = true, AFTER_DRAIN = false;
    bf16* Y; const int* rowinfo;
    __device__ __forceinline__ void operator()(const f32x4 (&acc)[2][2][4][2], const pg8::Unit& u, int wr, int wc, int fr, int fq) const {
        const int row0 = u.pm * 256 + wr * 64 + fr, ct = u.pn & 3, col0 = ct * 256 + wc * 32 + 8 * fq;
#pragma unroll
        for (int ai = 0; ai < 2; ++ai)
#pragma unroll
            for (int m = 0; m < 4; ++m) { const int info = rowinfo[row0 + ai * 128 + m * 16];
                if (info >= 0) { bf16* rowp = Y + ((size_t)(info & 1) * SEQ + (size_t)(info >> 1)) * DM + col0;
#pragma unroll
                    for (int bj = 0; bj < 2; ++bj) { const f32x4 v0 = acc[ai][bj][m][0], v1 = acc[ai][bj][m][1];
                        u32x4 o; o.x = pk2(v0[0], v0[1]); o.y = pk2(v0[2], v0[3]); o.z = pk2(v1[0], v1[1]); o.w = pk2(v1[2], v1[3]);
                        *(u32x4*)(rowp + bj * 128) = o; } } }
    }
};
struct MoeOrder {
    const LAS int* tb; int NCT, G, c;
    __device__ __forceinline__ void init(const LAS int* tb_, int nct, int G_, int c_) { tb = tb_; NCT = nct; G = G_; c = c_; }
    __device__ __forceinline__ bool next(int i, pg8::Unit& u) const {
        const int L = i * G + c, rt = L / NCT; if (rt >= __builtin_amdgcn_readfirstlane(tb[16])) return false;
        int e = 0;
#pragma unroll
        for (int k = 1; k < 16; ++k) e += (rt >= tb[k]) ? 1 : 0;
        u.pm = rt; u.pn = __builtin_amdgcn_readfirstlane(e) * NCT + (L % NCT); return true;
    }
    __device__ __forceinline__ void a_ready(const pg8::Unit&) const {}
    __device__ __forceinline__ void done(const pg8::Unit&) const {}
};

__device__ __forceinline__ void ln_phase(LAS unsigned char* lds, int mode, const float* HFin, const bf16* Y, const float* gam, const float* bet, float* outF, float oscale, bf16* HB,
                                         const bf16* WT, const float* sb, int4* ROUTE, int* HIST, float* GATES) {
    const int tid = threadIdx.x, lane = tid & 63, wave = __builtin_amdgcn_readfirstlane(tid >> 6), hi = lane >> 5;
    LAS float* LOG = (LAS float*)(lds + LDS_MISC);
    LAS int* HCNT = (LAS int*)(lds + LDS_MISC + 64 * 97 * 4);
    f32x4 gv[4], bv[4];
#pragma unroll
    for (int j = 0; j < 4; ++j) { gv[j] = *(const f32x4*)(gam + 4 * lane + 256 * j); bv[j] = *(const f32x4*)(bet + 4 * lane + 256 * j); }
    for (int ch = blockIdx.x; ch < SEQ / 64; ch += gridDim.x) {
        if (tid < 16) HCNT[tid] = 0;
        auto load_row = [&](f32x4 (&v)[4], u32x2 (&ya)[4], u32x2 (&yb)[4], int i) {
            const size_t row = (size_t)ch * 64 + wave * 8 + i;
#pragma unroll
            for (int j = 0; j < 4; ++j) v[j] = *(const f32x4*)(HFin + row * DM + 4 * lane + 256 * j);
            if (Y) {
#pragma unroll
                for (int j = 0; j < 4; ++j) { ya[j] = *(const u32x2*)(Y + row * DM + 4 * lane + 256 * j); yb[j] = *(const u32x2*)(Y + ((size_t)SEQ + row) * DM + 4 * lane + 256 * j); }
            }
        };
        auto do_row = [&](f32x4 (&v)[4], u32x2 (&ya)[4], u32x2 (&yb)[4], int i) {
            const int rl = wave * 8 + i; const size_t row = (size_t)ch * 64 + rl;
            if (Y) {
#pragma unroll
                for (int j = 0; j < 4; ++j) { v[j][0] = (v[j][0] + bflo(ya[j].x)) + bflo(yb[j].x); v[j][1] = (v[j][1] + bfhi(ya[j].x)) + bfhi(yb[j].x);
                    v[j][2] = (v[j][2] + bflo(ya[j].y)) + bflo(yb[j].y); v[j][3] = (v[j][3] + bfhi(ya[j].y)) + bfhi(yb[j].y); }
            }
            float s = 0.f;
#pragma unroll
            for (int j = 0; j < 4; ++j) s += (v[j][0] + v[j][1]) + (v[j][2] + v[j][3]);
            const float mean = wave_sum(s) * (1.0f / DM);
            float q = 0.f;
#pragma unroll
            for (int j = 0; j < 4; ++j) { v[j] = v[j] - mean; q += (v[j][0] * v[j][0] + v[j][1] * v[j][1]) + (v[j][2] * v[j][2] + v[j][3] * v[j][3]); }
            const float rstd = 1.0f / sqrtf(wave_sum(q) * (1.0f / DM) + LN_EPS);
#pragma unroll
            for (int j = 0; j < 4; ++j) { const f32x4 y = v[j] * rstd * gv[j] + bv[j];
                *(f32x4*)(outF + row * DM + 4 * lane + 256 * j) = y * oscale;
                u32x2 w; w.x = pk2(y[0], y[1]); w.y = pk2(y[2], y[3]);
                *(u32x2*)(HB + row * DM + 4 * lane + 256 * j) = w;
                const int ck = (lane >> 1) + 32 * j;
                *(LAS u32x2*)(lds + rl * 2048 + ((ck ^ (rl & 15)) << 4) + (lane & 1) * 8) = w; }
        };
        {
            f32x4 va[4], vb[4]; u32x2 ya0[4], ya1[4], yb0[4], yb1[4];
            load_row(va, ya0, ya1, 0);
#pragma nounroll
            for (int i = 0; i < 8; i += 2) { load_row(vb, yb0, yb1, i + 1); do_row(va, ya0, ya1, i); if (i + 2 < 8) load_row(va, ya0, ya1, i + 2); do_row(vb, yb0, yb1, i + 1); }
        }
        __syncthreads();
        if (mode != 2) {
            const int nct = (mode == 0) ? 1 : 2, nks = 4 / nct;
            const int tt = wave & 1, ct = (nct == 2) ? ((wave >> 1) & 1) : 0, ks = (nct == 2) ? (wave >> 2) : (wave >> 1), rl = tt * 32 + (lane & 31);
            const int s0 = ks * (64 / nks), s1 = s0 + 64 / nks;
            const bf16* wrow = WT + (size_t)(ct * 32 + (lane & 31)) * DM + 8 * hi;
            f32x16 acc;
#pragma unroll
            for (int r = 0; r < 16; ++r) acc[r] = 0.f;
#pragma unroll 8
            for (int s2 = s0; s2 < s1; ++s2) { const bf16x8 a = *(const bf16x8*)(wrow + 16 * s2); const int ck = 2 * s2 + hi;
                const bf16x8 b = *(const LAS bf16x8*)(lds + rl * 2048 + ((ck ^ (rl & 15)) << 4)); acc = MFMA32(a, b, acc); }
            const int ncp = (mode == 0) ? 24 : 48;
#pragma unroll
            for (int r = 0; r < 16; ++r) { const int col = 32 * ct + crow(r, hi); if (col < ncp) LOG[rl * 97 + ks * ncp + col] = acc[r]; }
        }
        __syncthreads();
        if (mode == 0 && tid < 64) {
            const LAS float* lgp = LOG + tid * 97;
            auto LG = [&](int c) { return ((lgp[c] + lgp[24 + c]) + lgp[48 + c]) + lgp[72 + c]; };
            int gi = 0; float gm = LG(0) + sb[0];
#pragma unroll
            for (int k = 1; k < 4; ++k) { const float x = LG(k) + sb[k]; if (x > gm) { gm = x; gi = k; } }
            float den = 0.f;
#pragma unroll
            for (int k = 0; k < 4; ++k) den += __expf(LG(k) + sb[k] - gm);
            const float gw = 1.0f / den;
            float ev[4];
#pragma unroll
            for (int k = 0; k < 4; ++k) ev[k] = LG(4 + 4 * gi + k) + sb[4 + 4 * gi + k];
            int i0 = 0; float v0 = ev[0];
#pragma unroll
            for (int k = 1; k < 4; ++k) if (ev[k] > v0) { v0 = ev[k]; i0 = k; }
            int i1 = -1; float v1 = -INFINITY;
#pragma unroll
            for (int k = 0; k < 4; ++k) if (k != i0 && ev[k] > v1) { v1 = ev[k]; i1 = k; }
            const float t = __expf(v1 - v0), w0 = gw / (1.0f + t), w1 = gw * t / (1.0f + t);
            const int e0 = 4 * gi + i0, e1 = 4 * gi + i1;
            ROUTE[(size_t)ch * 64 + tid] = make_int4(e0, e1, __float_as_int(w0), __float_as_int(w1));
            atomicAdd((int*)&HCNT[e0], 1); atomicAdd((int*)&HCNT[e1], 1);
        }
        if (mode == 1 && tid < 64) {
            const LAS float* lgp = LOG + tid * 97; float* go = GATES + ((size_t)ch * 64 + tid) * 48;
#pragma unroll 4
            for (int c = 0; c < 48; ++c) go[c] = 1.0f / (1.0f + __expf(-((lgp[c] + lgp[48 + c]) + sb[c])));
        }
        __syncthreads();
        if (mode == 0 && tid < 16) HIST[ch * 16 + tid] = HCNT[tid];
    }
}

__device__ __forceinline__ void moe_scatter(LAS unsigned char* lds, const int4* ROUTE, const int* HIST, int* TILEB, const bf16* HB, bf16* HS, int* ROWINFO, float* ROWW) {
    const int tid = threadIdx.x, lane = tid & 63, wave = __builtin_amdgcn_readfirstlane(tid >> 6);
    LAS int* tot = (LAS int*)(lds + LDS_MISC);
    LAS int* pre = tot + 16;
    LAS int* tbl = pre + 16;
    LAS int* ent = tbl + 32;
    LAS int* pos = ent + 128;
    LAS float* ewt = (LAS float*)(pos + 128);
    for (int ch = blockIdx.x; ch < SEQ / 64; ch += gridDim.x) {
        {
            if (tid < 32) tot[tid] = 0;
            __syncthreads();
            const int e = tid & 15, part = tid >> 4; int t = 0, p = 0;
#pragma unroll
            for (int c2 = 0; c2 < 8; ++c2) { const int c = part * 8 + c2; const int v = HIST[c * 16 + e]; t += v; p += (c < ch) ? v : 0; }
            atomicAdd((int*)&tot[e], t); atomicAdd((int*)&pre[e], p);
        }
        if (tid >= 64 && tid < 128) { const int k = tid - 64; const int4 r = ROUTE[(size_t)ch * 64 + k]; ent[2 * k] = r.x; ent[2 * k + 1] = r.y; ewt[2 * k] = __int_as_float(r.z); ewt[2 * k + 1] = __int_as_float(r.w); }
        __syncthreads();
        if (tid == 0) { int a = 0; for (int e = 0; e < 16; ++e) { tbl[e] = a; a += (tot[e] + 255) >> 8; } tbl[16] = a;
            if (ch == 0) { for (int e = 0; e < 17; ++e) TILEB[e] = tbl[e]; } }
        __syncthreads();
        if (tid < 16) { int run = tbl[tid] * 256 + pre[tid]; for (int k = 0; k < 128; ++k) if (ent[k] == tid) pos[k] = run++; }
        __syncthreads();
        for (int k = wave * 16; k < wave * 16 + 16; ++k) {
            const int p = pos[k]; const size_t token = (size_t)ch * 64 + (k >> 1);
            const u32x4* src = (const u32x4*)(HB + token * DM); u32x4* dst = (u32x4*)(HS + (size_t)p * DM);
            dst[lane] = src[lane]; dst[lane + 64] = src[lane + 64];
            if (lane == 0) { ROWINFO[p] = (int)token * 2 + (k & 1); ROWW[p] = ewt[k]; }
        }
        if (ch < 16) { const int e = ch, r0 = tbl[e] * 256 + tot[e], r1 = tbl[e + 1] * 256; for (int r = r0 + tid; r < r1; r += NTHREADS) { ROWINFO[r] = -1; ROWW[r] = 0.f; } }
        __syncthreads();
    }
}

__device__ __forceinline__ float gelu_tanh(float x) { const float u = 0.7978845608028654f * (x + 0.044715f * x * x * x); const float t = 1.0f - 2.0f / (__expf(2.0f * u) + 1.0f); return 0.5f * x * (1.0f + t); }
__device__ __forceinline__ void compress_phase(LAS unsigned char* lds, const bf16* KV, const bf16* W1T, const bf16* W2T, const float* B1P, const float* b1, const float* b2, bf16* KCMP) {
    const int tid = threadIdx.x, lane = tid & 63, wave = __builtin_amdgcn_readfirstlane(tid >> 6), hi = lane >> 5;
    LAS unsigned char* H1 = lds;
    for (int item = blockIdx.x; item < 256; item += gridDim.x) {
        const int j = item >> 7, rt = item & 127;
        int rho = 32 * rt + (lane & 31); const bool rvalid = rho < 4092; rho = rvalid ? rho : 4091;
        const int c = rho >> 2, g = rho & 3;
        const bf16* arow = KV + (size_t)(16 * c) * NKV + j * 256 + g * 64;
        const bf16* wrow = W1T + ((size_t)j * 256 + 32 * wave + (lane & 31)) * 2048;
        f32x16 acc;
#pragma unroll
        for (int r = 0; r < 16; ++r) acc[r] = 0.f;
#pragma unroll 4
        for (int s = 0; s < 128; ++s) { const int k = 16 * s + 8 * hi;
            const bf16x8 b = *(const bf16x8*)(arow + (size_t)(k >> 6) * NKV + (k & 63)); const bf16x8 a = *(const bf16x8*)(wrow + k); acc = MFMA32(a, b, acc); }
#pragma unroll
        for (int r = 0; r < 16; ++r) { const int n = 32 * wave + crow(r, hi); float bsum = b1[j * 256 + n];
            for (int ks = 0; ks < 16; ++ks) bsum += B1P[(j * 16 + ks) * 256 + n];
            const float hval = gelu_tanh(acc[r] + bsum);
            *(LAS unsigned short*)(H1 + (lane & 31) * 528 + n * 2) = (unsigned short)(pk2(hval, 0.f) & 0xffffu); }
        __syncthreads();
        if (wave < 2) {
            const int db = wave;
            const bf16* w2row = W2T + ((size_t)j * 64 + 32 * db + (lane & 31)) * 256 + 8 * hi;
            f32x16 o;
#pragma unroll
            for (int r = 0; r < 16; ++r) o[r] = 0.f;
#pragma unroll
            for (int s = 0; s < 16; ++s) { const bf16x8 a = *(const bf16x8*)(w2row + 16 * s); const bf16x8 b = *(const LAS bf16x8*)(H1 + (lane & 31) * 528 + (16 * s + 8 * hi) * 2); o = MFMA32(a, b, o); }
            if (rvalid) { bf16* orow = KCMP + ((size_t)j * 1024 * 4 + (size_t)c * 4 + g) * 64 + 32 * db;
#pragma unroll
                for (int k = 0; k < 4; ++k) { const int d0 = 32 * db + 8 * k + 4 * hi; u32x2 w;
                    w.x = pk2(o[4 * k] + b2[j * 64 + d0], o[4 * k + 1] + b2[j * 64 + d0 + 1]); w.y = pk2(o[4 * k + 2] + b2[j * 64 + d0 + 2], o[4 * k + 3] + b2[j * 64 + d0 + 3]);
                    *(u32x2*)(orow + 8 * k + 4 * hi) = w; } }
        }
        __syncthreads();
    }
}

#if DBG_CHECK
__device__ __forceinline__ void dbg_acc(unsigned* ctl, int slot, float num, float den) {
    num = wave_sum(num); den = wave_sum(den);
    if ((threadIdx.x & 63) == 0) { atomicAdd((float*)(ctl + CW_DBG) + 2 * slot, num); atomicAdd((float*)(ctl + CW_DBG) + 2 * slot + 1, den); }
}
__device__ __forceinline__ float dbg_dot64(const bf16* a, const bf16* b, int lane) { return wave_sum(bf2f(a[lane]) * bf2f(b[lane])); }
__device__ __forceinline__ int dbg_token(int w) { const int sp[16] = {0, 5, 30, 31, 47, 63, 64, 100, 500, 1023, 1024, 1039, 2047, 4096, 16320, 16383}; return (w < 16) ? sp[w] : (int)(((unsigned)w * 6151u + 17u) % 16384u); }

__device__ __forceinline__ void dbg_check_dilated(unsigned* ctl, const bf16* qkv, const bf16* O) {
    const int lane = threadIdx.x & 63, wave = threadIdx.x >> 6;
    const int w = blockIdx.x * 8 + wave; const int t = dbg_token(w & 255), h = (w * 7 + (w >> 8)) & 15;
    const float slope = exp2f(-0.5f * (float)(h + 1));
    float outg[3], lse[3];
    for (int g = 0; g < 3; ++g) {
        const int d = 1 << (2 * g), W = 128 << (2 * g);
        const bf16* q = qkv + (size_t)((g * 3) * 16 + h) * ((size_t)SEQ * 64) + (size_t)t * 64;
        float m = -1e30f, l = 0.f, acc = 0.f;
        for (int j = 0; j * d <= W; ++j) { const int tk = t - j * d; if (tk < 0) break;
            const bf16* k = qkv + (size_t)((g * 3 + 1) * 16 + h) * ((size_t)SEQ * 64) + (size_t)tk * 64; const bf16* v = k + (size_t)16 * SEQ * 64;
            const float s = dbg_dot64(q, k, lane) * (1.0f / LOG2E) - slope * (float)(j * d);
            const float mn = fmaxf(m, s), a = __expf(m - mn), p = __expf(s - mn); l = l * a + p; acc = acc * a + p * bf2f(v[lane]); m = mn; }
        outg[g] = acc / l; lse[g] = m + __logf(l);
    }
    const float mx = fmaxf(lse[0], fmaxf(lse[1], lse[2])); const float e0 = __expf(lse[0] - mx), e1 = __expf(lse[1] - mx), e2 = __expf(lse[2] - mx);
    const float o = (e0 * outg[0] + e1 * outg[1] + e2 * outg[2]) / (e0 + e1 + e2);
    const float got = bf2f(O[(size_t)t * DM + h * 64 + lane]);
    dbg_acc(ctl, 0, (o - got) * (o - got), o * o);
}

__device__ __forceinline__ void dbg_check_nsa(LAS unsigned char* lds, unsigned* ctl, const bf16* Q, const bf16* KV, const bf16* KC, const bf16* VC, const float* GATES, const bf16* O) {
    const int lane = threadIdx.x & 63, wave = threadIdx.x >> 6;
    const int w = blockIdx.x; const int t = dbg_token(w), g = (w >> 2) & 3;
    LAS float* P = (LAS float*)lds; LAS float* IMP = (LAS float*)(lds + 16384); LAS float* SC = (LAS float*)(lds + 20480); LAS int* SELB = (LAS int*)(lds + 21504);
    const int hh = 4 * g + (wave & 3); const float slope = exp2f(-0.5f * (float)(hh + 1));
    const bf16* q = Q + (size_t)hh * ((size_t)SEQ * 64) + (size_t)t * 64;
    float oc = 0.f;
    __syncthreads();
    if (wave < 4) {
        LAS float* Pr = P + wave * 1024; float m = -1e30f;
        for (int c = 0; c < 1023; ++c) { const int dc = t - (16 * c + 31); float s = -1e30f; if (dc >= 0) s = dbg_dot64(q, KC + (size_t)(c * 4 + g) * 64, lane) * (1.0f / LOG2E) - slope * (float)dc; if (lane == 0) Pr[c] = s; m = fmaxf(m, s); }
        LDS_WAIT();
        float l = 0.f;
        for (int c = 0; c < 1023; ++c) { const int dc = t - (16 * c + 31); const float p = (dc >= 0) ? __expf(Pr[c] - m) : 0.f; l += p; }
        const float linv = 1.0f / fmaxf(l, 1e-30f);
        for (int c = 0; c < 1023; ++c) { const int dc = t - (16 * c + 31); const float p = (dc >= 0) ? __expf(Pr[c] - m) * linv : 0.f; oc += p * bf2f(VC[(size_t)(c * 4 + g) * 64 + lane]); if (lane == 0) Pr[c] = p; }
        if (lane == 0) Pr[1023] = 0.f;
    }
    __syncthreads();
    for (int c = threadIdx.x; c < 1024; c += NTHREADS) IMP[c] = P[c] + P[1024 + c] + P[2048 + c] + P[3072 + c];
    __syncthreads();
    const int cur = t >> 6;
    for (int s = threadIdx.x; s < 256; s += NTHREADS) { float a = 0.f;
        for (int aa = 0; aa < 4; ++aa) for (int bb = 0; bb < 2; ++bb) { const int idx = 4 * s + aa - bb; if (idx >= 0 && idx < 1023) a += IMP[idx]; }
        float sc = (s == 0 || s == cur || s == cur - 1) ? 1e4f : a; if (s > cur) sc = -1e4f; SC[s] = sc; }
    __syncthreads();
    if (threadIdx.x == 0) { for (int k = 0; k < 16; ++k) { int bi = 0; float bv = -3e38f; for (int s = 0; s < 256; ++s) if (SC[s] > bv) { bv = SC[s]; bi = s; } SELB[k] = bi; SC[bi] = -3e38f; } }
    __syncthreads();
    if (wave < 4) {
        float m = -1e30f, l = 0.f, acc = 0.f;
        for (int k = 0; k < 16; ++k) { const int blk = SELB[k];
            for (int j = 0; j < 64; ++j) { const int tok = 64 * blk + j, ds = t - tok; if (ds < 0) continue;
                const float s = dbg_dot64(q, KV + (size_t)tok * NKV + 512 + g * 64, lane) * (1.0f / LOG2E) - slope * (float)ds;
                const float mn = fmaxf(m, s), a = __expf(m - mn), p = __expf(s - mn); l = l * a + p; acc = acc * a + p * bf2f(KV[(size_t)tok * NKV + 768 + g * 64 + lane]); m = mn; } }
        const float os = (l > 0.f) ? acc / l : 0.f;
        m = -1e30f; l = 0.f; acc = 0.f;
        for (int dw = 0; dw < 512; ++dw) { const int tok = t - dw; if (tok < 0) break;
            const float s = dbg_dot64(q, KV + (size_t)tok * NKV + 1024 + g * 64, lane) * (1.0f / LOG2E) - slope * (float)dw;
            const float mn = fmaxf(m, s), a = __expf(m - mn), p = __expf(s - mn); l = l * a + p; acc = acc * a + p * bf2f(KV[(size_t)tok * NKV + 1280 + g * 64 + lane]); m = mn; }
        const float ow = (l > 0.f) ? acc / l : 0.f;
        const float* gt = GATES + (size_t)t * 48 + g * 4 + (wave & 3);
        const float o = gt[0] * oc + gt[16] * os + gt[32] * ow;
        const float got = bf2f(O[(size_t)t * DM + hh * 64 + lane]);
        dbg_acc(ctl, 1, (o - got) * (o - got), o * o);
    }
    __syncthreads();
}

__device__ __forceinline__ void dbg_check_moe(LAS unsigned char* lds, unsigned* ctl, const bf16* HB, const int4* ROUTE, const float* gu, const float* dn, const bf16* Y) {
    const int tid = threadIdx.x; const int t = dbg_token(blockIdx.x);
    LAS float* hv = (LAS float*)lds; LAS float* hid = (LAS float*)(lds + 4096);
    __syncthreads();
    for (int k = tid; k < DM; k += NTHREADS) hv[k] = bf2f(HB[(size_t)t * DM + k]);
    __syncthreads();
    const int4 r = ROUTE[t];
    { const int sl = tid >> 8, f = tid & 255, e = sl ? r.y : r.x; const float wgt = __int_as_float(sl ? r.w : r.z);
      const float* W = gu + (size_t)e * 1024 * 512; float a = 0.f, b = 0.f;
      for (int k = 0; k < DM; ++k) { a += hv[k] * W[(size_t)k * 512 + f]; b += hv[k] * W[(size_t)k * 512 + 256 + f]; }
      hid[tid] = a / (1.0f + __expf(-a)) * b * wgt; }
    __syncthreads();
    float num = 0.f, den = 0.f;
    for (int dd = tid; dd < DM; dd += NTHREADS) { float y = 0.f;
        for (int sl = 0; sl < 2; ++sl) { const int e = sl ? r.y : r.x; const float* W = dn + (size_t)e * 256 * 1024;
            for (int f = 0; f < 256; ++f) y += hid[sl * 256 + f] * W[(size_t)f * 1024 + dd]; }
        const float got = bf2f(Y[(size_t)t * DM + dd]) + bf2f(Y[((size_t)SEQ + t) * DM + dd]);
        num += (y - got) * (y - got); den += y * y; }
    dbg_acc(ctl, 2, num, den);
    __syncthreads();
}

__device__ __forceinline__ void dbg_check_compress(LAS unsigned char* lds, unsigned* ctl, const bf16* KV, const float* pos, const float* W1, const float* b1, const float* W2, const float* b2, const bf16* KCMP) {
    const int tid = threadIdx.x, w = blockIdx.x; const int j = w & 1, g = (w >> 1) & 3, c = (w < 8) ? (w < 4 ? 0 : 1022) : (int)(((unsigned)w * 977u) % 1023u);
    LAS float* hid = (LAS float*)lds;
    __syncthreads();
    if (tid < 256) { float a = b1[j * 256 + tid];
        for (int k = 0; k < 2048; ++k) { const int lt = k >> 6, d = k & 63; a += (bf2f(KV[(size_t)(16 * c + lt) * NKV + j * 256 + g * 64 + d]) + pos[j * 2048 + k]) * W1[((size_t)j * 2048 + k) * 256 + tid]; }
        hid[tid] = gelu_tanh(a); }
    __syncthreads();
    float num = 0.f, den = 0.f;
    if (tid < 64) { float o = b2[j * 64 + tid]; for (int n = 0; n < 256; ++n) o += hid[n] * W2[((size_t)j * 256 + n) * 64 + tid];
        const float got = bf2f(KCMP[((size_t)j * 4096 + (size_t)c * 4 + g) * 64 + tid]); num = (o - got) * (o - got); den = o * o; }
    if (tid < 64) dbg_acc(ctl, 3, num, den);
    __syncthreads();
}

__device__ __forceinline__ void dbg_check_gemm(unsigned* ctl, int slot, const bf16* A, int K, const float* W, int ldw, int ncols, const float* bias, const bf16* out, int ldo, int qmode) {
    const int lane = threadIdx.x & 63, w = blockIdx.x * 8 + (threadIdx.x >> 6);
    const int row = (int)(((unsigned)w * 2654435761u) >> 18) & (SEQ - 1), col = (int)(((unsigned)w * 40503u + 11u) % (unsigned)ncols);
    float a = 0.f; for (int k = lane; k < K; k += 64) a += bf2f(A[(size_t)row * K + k]) * W[(size_t)k * ldw + col];
    a = wave_sum(a) + (bias ? bias[col] : 0.f);
    if (qmode == 2 || (qmode == 1 && ((col >> 10) % 3) == 0)) a *= C1;
    const float got = bf2f(ldo ? out[(size_t)row * ldo + col] : out[(size_t)(col >> 6) * ((size_t)SEQ * 64) + (size_t)row * 64 + (col & 63)]);
    if (lane == 0) { atomicAdd((float*)(ctl + CW_DBG) + 2 * slot, (a - got) * (a - got)); atomicAdd((float*)(ctl + CW_DBG) + 2 * slot + 1, a * a); }
}
__device__ __forceinline__ void dbg_check_outproj(unsigned* ctl, const bf16* Ob, const float* W, const float* HF, const bf16* HB) {
    const int lane = threadIdx.x & 63, w = blockIdx.x * 8 + (threadIdx.x >> 6);
    const int row = (int)(((unsigned)w * 2654435761u) >> 18) & (SEQ - 1), col = (int)(((unsigned)w * 40503u + 11u) % 1024u);
    float a = 0.f; for (int k = lane; k < DM; k += 64) a += bf2f(Ob[(size_t)row * DM + k]) * W[(size_t)k * DM + col];
    a = wave_sum(a);
    const float got = HF[(size_t)row * DM + col] - ALPHA * bf2f(HB[(size_t)row * DM + col]);
    if (lane == 0) { atomicAdd((float*)(ctl + CW_DBG) + 14, (a - got) * (a - got)); atomicAdd((float*)(ctl + CW_DBG) + 15, a * a); }
}
__device__ __forceinline__ void dbg_check_route(unsigned* ctl, const bf16* HB, const float* Wr, const float* br, const int4* ROUTE) {
    const int lane = threadIdx.x & 63, w = blockIdx.x * 8 + (threadIdx.x >> 6); const int t = (int)(((unsigned)w * 7919u + 3u) % 16384u);
    float lg[20];
#pragma unroll
    for (int c = 0; c < 20; ++c) { float a = 0.f; for (int k = lane; k < DM; k += 64) a += bf2f(HB[(size_t)t * DM + k]) * Wr[(size_t)k * 20 + c]; lg[c] = wave_sum(a) + br[c]; }
    float num = 0.f, den = 0.f;
    if (lane == 0) {
        int gi = 0; float gm = lg[0];
#pragma unroll
        for (int k = 1; k < 4; ++k) if (lg[k] > gm) { gm = lg[k]; gi = k; }
        float dsum = 0.f;
#pragma unroll
        for (int k = 0; k < 4; ++k) dsum += __expf(lg[k] - gm);
        const float gw = 1.0f / dsum; float ev[4];
#pragma unroll
        for (int k = 0; k < 4; ++k) { float v = 0.f;
#pragma unroll
            for (int c = 0; c < 16; ++c) v = (c == 4 * gi + k) ? lg[4 + c] : v; ev[k] = v; }
        int i0 = 0; float v0 = ev[0];
#pragma unroll
        for (int k = 1; k < 4; ++k) if (ev[k] > v0) { v0 = ev[k]; i0 = k; }
        int i1 = -1; float v1 = -3e38f;
#pragma unroll
        for (int k = 0; k < 4; ++k) if (k != i0 && ev[k] > v1) { v1 = ev[k]; i1 = k; }
        const float tt = __expf(v1 - v0), w0 = gw / (1.0f + tt), w1 = gw * tt / (1.0f + tt);
        const int4 r = ROUTE[t];
#pragma unroll
        for (int e = 0; e < 16; ++e) { const float cr = (e == 4 * gi + i0 ? w0 : 0.f) + (e == 4 * gi + i1 ? w1 : 0.f);
            const float cm = (e == r.x ? __int_as_float(r.z) : 0.f) + (e == r.y ? __int_as_float(r.w) : 0.f); num += (cr - cm) * (cr - cm); den += cr * cr; }
        atomicAdd((float*)(ctl + CW_DBG) + 10, num); atomicAdd((float*)(ctl + CW_DBG) + 11, den);
    }
}
__device__ __forceinline__ void dbg_check_gates(unsigned* ctl, const bf16* HB, const float* Wq, const float* bq, const float* GATES) {
    const int lane = threadIdx.x & 63, w = blockIdx.x * 8 + (threadIdx.x >> 6); const int t = (int)(((unsigned)w * 7919u + 3u) % 16384u), c = w % 48;
    float a = 0.f; for (int k = lane; k < DM; k += 64) a += bf2f(HB[(size_t)t * DM + k]) * Wq[(size_t)k * 1072 + 1024 + c];
    a = wave_sum(a) + bq[1024 + c]; const float ref = 1.0f / (1.0f + __expf(-a)), got = GATES[(size_t)t * 48 + c];
    if (lane == 0) { atomicAdd((float*)(ctl + CW_DBG) + 12, (ref - got) * (ref - got)); atomicAdd((float*)(ctl + CW_DBG) + 13, ref * ref); }
}
#ifndef DBG_MASK
#define DBG_MASK 0xff
#endif
__device__ __forceinline__ float dbg_scale(unsigned* ctl) {
    float e = 0.f;
    for (int i = 0; i < 8; ++i) { if (!((DBG_MASK >> i) & 1)) continue; const float num = __hip_atomic_load((float*)(ctl + CW_DBG) + 2 * i, __ATOMIC_RELAXED, __HIP_MEMORY_SCOPE_AGENT), den = __hip_atomic_load((float*)(ctl + CW_DBG) + 2 * i + 1, __ATOMIC_RELAXED, __HIP_MEMORY_SCOPE_AGENT);
        const float r = (den > 0.f) ? sqrtf(num / den) : 7.77f; e = fmaxf(e, r); }
    return 1.0f + 10.0f * e;
}
#endif
struct Args { const float* in[20]; float* out; unsigned char* ws; int ph_lo, ph_hi; };
enum { I_X = 0, I_AWIN, I_AWOUT, I_BWKV, I_CPOS, I_CW1, I_CB1, I_CW2, I_CB2, I_BWQ, I_BBQ, I_BWOUT, I_MWR, I_MBR, I_MWGU, I_MWDN, I_LMG, I_LMB, I_LFG, I_LFB };
typedef const __attribute__((address_space(4))) Args* KArgs;
__device__ __forceinline__ KArgs kargs() { KArgs p = (KArgs)__builtin_amdgcn_kernarg_segment_ptr(); asm volatile("" : "+s"(p)); return p; }

struct Ids { int lane, wave, gw, NGW, G, bx; };
__device__ __forceinline__ Ids ids() {
    Ids d; const int tid = threadIdx.x; d.lane = tid & 63; d.wave = __builtin_amdgcn_readfirstlane(tid >> 6); d.G = gridDim.x; d.bx = blockIdx.x;
    const int vcu = (d.G % 8 == 0) ? (d.bx % 8) * (d.G / 8) + d.bx / 8 : d.bx;
    d.gw = vcu * NWAVES + d.wave; d.NGW = d.G * NWAVES; return d;
}

#ifdef TIMEPROBE
constexpr int CW_TP = 20000;
#define TP_START(k) do { if (blockIdx.x == 0 && threadIdx.x == 0) { unsigned* c_ = (unsigned*)(kargs()->ws + WS_CTL) + CW_TP; const unsigned now_ = (unsigned)__builtin_amdgcn_s_memrealtime(); \
    if ((k) == TP_A0 && (k) >= lo) c_[0] = now_; if ((k) == TP_B0 && (k) >= lo) c_[2] = now_; } } while (0)
#define TP_STOP(k) do { if (blockIdx.x == 0 && threadIdx.x == 0) { unsigned* c_ = (unsigned*)(kargs()->ws + WS_CTL) + CW_TP; const unsigned now_ = (unsigned)__builtin_amdgcn_s_memrealtime(); \
    if ((k) == TP_A1) c_[1] = now_ - c_[0]; if ((k) == TP_B1) c_[3] = now_ - c_[2]; } } while (0)
#else
#define TP_START(k) do { } while (0)
#define TP_STOP(k) do { } while (0)
#endif
#define PHASE_IF(k) TP_START(k); if ((k) >= lo && (k) < hi)
#define PHASE_BAR(k) do { if ((k) >= lo && (k) + 1 < hi) xcd_barrier(bar); TP_STOP(k); } while (0)

__device__ __forceinline__ void phase_prologue(LAS unsigned char* lds) {
    KArgs ka = kargs(); unsigned char* ws = ka->ws; const Ids d = ids(); const int lane = d.lane, gw = d.gw, NGW = d.NGW;
    LAS float* scr = (LAS float*)(lds + d.wave * 16384);
    for (int l = 0; l < 2; ++l) tc_matrix(ka->in[I_AWIN] + (size_t)l * DM * NQKV, NQKV, DM, 0, NQKV, (bf16*)(ws + WS_WIN) + (size_t)l * NQKV * DM, NQKV, scr, lane, gw, NGW);
    for (int l = 0; l < 2; ++l) tc_matrix(ka->in[I_AWOUT] + (size_t)l * DM * DM, DM, DM, 0, DM, (bf16*)(ws + WS_WOUTA) + (size_t)l * DM * DM, DM, scr, lane, gw, NGW);
    tc_matrix(ka->in[I_BWKV], NKV, DM, 0, NKV, (bf16*)(ws + WS_WKV), NKV, scr, lane, gw, NGW);
    for (int i = 0; i < 2; ++i) {
        tc_matrix(ka->in[I_BWQ] + (size_t)i * DM * 1072, 1072, DM, 0, 1024, (bf16*)(ws + WS_WQ) + (size_t)i * DM * DM, DM, scr, lane, gw, NGW);
        tc_matrix(ka->in[I_BWQ] + (size_t)i * DM * 1072, 1072, DM, 1024, 48, (bf16*)(ws + WS_WG) + (size_t)i * 64 * DM, 64, scr, lane, gw, NGW);
        tc_matrix(ka->in[I_BWOUT] + (size_t)i * DM * DM, DM, DM, 0, DM, (bf16*)(ws + WS_WOUTB) + (size_t)i * DM * DM, DM, scr, lane, gw, NGW);
    }
    for (int l = 0; l < 4; ++l) tc_matrix(ka->in[I_MWR] + (size_t)l * DM * 20, 20, DM, 0, 20, (bf16*)(ws + WS_WR) + (size_t)l * 32 * DM, 32, scr, lane, gw, NGW);
    for (int j = 0; j < 2; ++j) {
        tc_matrix(ka->in[I_CW1] + (size_t)j * 2048 * 256, 256, 2048, 0, 256, (bf16*)(ws + WS_W1T) + (size_t)j * 256 * 2048, 256, scr, lane, gw, NGW);
        tc_matrix(ka->in[I_CW2] + (size_t)j * 256 * 64, 64, 256, 0, 64, (bf16*)(ws + WS_W2T) + (size_t)j * 64 * 256, 64, scr, lane, gw, NGW);
    }
    convert_moe_weights(ka->in[I_MWGU], ka->in[I_MWDN], (bf16*)(ws + WS_WGU), (bf16*)(ws + WS_WDN), scr, lane, gw, NGW);
    float* B1P = (float*)(ws + WS_B1P);
    for (int it = gw; it < 128; it += NGW) { const int j = it >> 6, nb = (it >> 4) & 3, ks = it & 15, n = nb * 64 + lane;
        const float* W1 = ka->in[I_CW1] + (size_t)j * 2048 * 256; const float* pos = ka->in[I_CPOS] + (size_t)j * 2048; float a = 0.f;
        for (int k = ks * 128; k < ks * 128 + 128; ++k) a += pos[k] * W1[(size_t)k * 256 + n];
        B1P[(j * 16 + ks) * 256 + n] = a; }
    const float* x = ka->in[I_X]; float* HF = (float*)(ws + WS_HF); bf16* HB = (bf16*)(ws + WS_HB);
    for (int row = gw; row < SEQ; row += NGW) {
#pragma unroll
        for (int j = 0; j < 4; ++j) { const f32x4 v = *(const f32x4*)(x + (size_t)row * DM + 4 * lane + 256 * j);
            *(f32x4*)(HF + (size_t)row * DM + 4 * lane + 256 * j) = v * ALPHA;
            u32x2 w; w.x = pk2(v[0], v[1]); w.y = pk2(v[2], v[3]); *(u32x2*)(HB + (size_t)row * DM + 4 * lane + 256 * j) = w; }
    }
}

template <int L, int KIND, bool CONVERT>
__device__ __forceinline__ void phase_proj(LAS unsigned char* lds) {
    KArgs ka = kargs(); unsigned char* ws = ka->ws; const Ids d = ids();
    if (CONVERT) {
        convert_moe_weights(ka->in[I_MWGU] + (size_t)L * 16 * 1024 * 512, ka->in[I_MWDN] + (size_t)L * 16 * 256 * 1024, (bf16*)(ws + WS_WGU), (bf16*)(ws + WS_WDN),
                            (LAS float*)(lds + d.wave * 16384), d.lane, d.gw, d.NGW);
        __syncthreads();
    }
    const bf16* HB = (const bf16*)(ws + WS_HB);
#ifndef NO_G1
    if (KIND == 0) { pg8::Gemm gm{HB, (const bf16*)(ws + WS_WIN) + (size_t)L * NQKV * DM, SEQ, NQKV, DM}; EpiHeadMajor E{(bf16*)(ws + WS_BIG), nullptr, 1};
        pg8::StaticOrder S; S.init(SEQ, NQKV, d.G, d.bx); pg8::gemm_phase<EpiHeadMajor, pg8::StaticOrder, false>(lds, gm, S, E, nullptr); }
    else if (KIND == 1) { pg8::Gemm gm{HB, (const bf16*)(ws + WS_WKV), SEQ, NKV, DM}; pg8::EpiBf16<0> E{(bf16*)(ws + BIG_KV), NKV, nullptr, 0, 0};
        pg8::StaticOrder S; S.init(SEQ, NKV, d.G, d.bx); pg8::gemm_phase<pg8::EpiBf16<0>, pg8::StaticOrder, false>(lds, gm, S, E, nullptr); }
    else { pg8::Gemm gm{HB, (const bf16*)(ws + WS_WQ) + (size_t)(L - 2) * DM * DM, SEQ, DM, DM}; EpiHeadMajor E{(bf16*)(ws + BIG_Q), ka->in[I_BBQ] + (size_t)(L - 2) * 1072, 2};
        pg8::StaticOrder S; S.init(SEQ, DM, d.G, d.bx); pg8::gemm_phase<EpiHeadMajor, pg8::StaticOrder, false>(lds, gm, S, E, nullptr); }
#endif
}
__device__ __forceinline__ void phase_compress(LAS unsigned char* lds) {
    KArgs ka = kargs(); unsigned char* ws = ka->ws;
    compress_phase(lds, (const bf16*)(ws + BIG_KV), (const bf16*)(ws + WS_W1T), (const bf16*)(ws + WS_W2T), (const float*)(ws + WS_B1P), ka->in[I_CB1], ka->in[I_CB2], (bf16*)(ws + BIG_KCMP));
}
__device__ __forceinline__ void phase_attn_dilated(LAS unsigned char* lds) {
    KArgs ka = kargs(); unsigned char* ws = ka->ws; const Ids d = ids();
    const bf16* QKV = (const bf16*)(ws + WS_BIG); bf16* OB = (bf16*)(ws + WS_O); LAS unsigned char* slab = lds + d.wave * 16384;
#ifndef NO_DIL
#ifdef ATT_V2
    for (int it = d.bx; it < 1024; it += d.G) dil_block(QKV, OB, it >> 4, it & 15, lds, d.wave, d.lane);
#else
    for (int it = d.gw; it < 8192; it += d.NGW) { const int rr = it & 15, h = (it >> 4) & 15, B = it >> 8; dil_item(QKV, OB, B, rr, h, slab, d.lane); }
#endif
#endif
}
__device__ __forceinline__ void phase_attn_nsa(LAS unsigned char* lds) {
    KArgs ka = kargs(); unsigned char* ws = ka->ws; const Ids d = ids();
    const bf16* KCMP = (const bf16*)(ws + BIG_KCMP); LAS unsigned char* slab = lds + d.wave * NSA_SLAB;
#ifndef NO_NSA
#ifdef NSA_CHUNK
    for (int idx = d.bx; idx < 1024; idx += d.G) { const int k = idx >> 8, b = idx & 255, b0 = (k & 2) ? ((b + 128) & 255) : b, ch = (k & 1) ? 255 - b0 : b0;
        nsa_chunk((const bf16*)(ws + BIG_Q), (const bf16*)(ws + BIG_KV), KCMP, KCMP + 1024 * 256, (const float*)(ws + WS_GATES), (bf16*)(ws + WS_O), ch, k, lds, d.wave, d.lane); }
    (void)slab;
#else
    for (int k = 0; k < 4; ++k) { const int idx = ((k & 1) ? (d.NGW - 1 - d.gw) : d.gw) + d.NGW * k;
        if (idx < 8192) nsa_item((const bf16*)(ws + BIG_Q), (const bf16*)(ws + BIG_KV), KCMP, KCMP + 1024 * 256, (const float*)(ws + WS_GATES), (bf16*)(ws + WS_O), idx >> 2, idx & 3, slab, d.lane); }
#endif
#endif
}
template <int L>
__device__ __forceinline__ void phase_outproj(LAS unsigned char* lds) {
    KArgs ka = kargs(); unsigned char* ws = ka->ws; const Ids d = ids();
    const bf16* Wt = (L < 2) ? (const bf16*)(ws + WS_WOUTA) + (size_t)L * DM * DM : (const bf16*)(ws + WS_WOUTB) + (size_t)(L - 2) * DM * DM;
    pg8::Gemm gm{(const bf16*)(ws + WS_O), Wt, SEQ, DM, DM}; EpiAccF32 E{(float*)(ws + WS_HF), DM};
    pg8::StaticOrder S; S.init(SEQ, DM, d.G, d.bx);
#ifndef NO_G2
    pg8::gemm_phase<EpiAccF32, pg8::StaticOrder, false>(lds, gm, S, E, nullptr);
#endif
}
template <int L>
__device__ __forceinline__ void phase_ln_mix(LAS unsigned char* lds) {
    KArgs ka = kargs(); unsigned char* ws = ka->ws;
    ln_phase(lds, 0, (const float*)(ws + WS_HF), nullptr, ka->in[I_LMG] + (size_t)L * DM, ka->in[I_LMB] + (size_t)L * DM, (float*)(ws + WS_HF), ALPHA, (bf16*)(ws + WS_HB),
             (const bf16*)(ws + WS_WR) + (size_t)L * 32 * DM, ka->in[I_MBR] + (size_t)L * 20, (int4*)(ws + WS_ROUTE), (int*)(ws + WS_HIST), nullptr);
}
__device__ __forceinline__ void phase_scatter(LAS unsigned char* lds) {
    KArgs ka = kargs(); unsigned char* ws = ka->ws;
    moe_scatter(lds, (const int4*)(ws + WS_ROUTE), (const int*)(ws + WS_HIST), (int*)(ws + WS_TILEB), (const bf16*)(ws + WS_HB), (bf16*)(ws + BIG_HS), (int*)(ws + WS_ROWINFO), (float*)(ws + WS_ROWW));
}
__device__ __forceinline__ void load_tileb(LAS unsigned char* lds, const int* TILEB) {
    LAS int* tb = (LAS int*)(lds + LDS_MISC);
    if (threadIdx.x < 17) tb[threadIdx.x] = TILEB[threadIdx.x];
    __syncthreads();
}
__device__ __forceinline__ void phase_moe_up(LAS unsigned char* lds) {
    KArgs ka = kargs(); unsigned char* ws = ka->ws; const Ids d = ids();
    load_tileb(lds, (const int*)(ws + WS_TILEB));
    pg8::Gemm gm{(const bf16*)(ws + BIG_HS), (const bf16*)(ws + WS_WGU), MAXROWS, 512, DM}; EpiSwiglu E{(bf16*)(ws + BIG_HID), (const float*)(ws + WS_ROWW)};
    MoeOrder S; S.init((const LAS int*)(lds + LDS_MISC), 2, d.G, d.bx);
#ifndef NO_M2
    pg8::gemm_phase<EpiSwiglu, MoeOrder, false>(lds, gm, S, E, nullptr);
#endif
}
__device__ __forceinline__ void phase_moe_down(LAS unsigned char* lds) {
    KArgs ka = kargs(); unsigned char* ws = ka->ws; const Ids d = ids();
    load_tileb(lds, (const int*)(ws + WS_TILEB));
    pg8::Gemm gm{(const bf16*)(ws + BIG_HID), (const bf16*)(ws + WS_WDN), MAXROWS, 1024, 256}; EpiScatter E{(bf16*)(ws + BIG_Y), (const int*)(ws + WS_ROWINFO)};
    MoeOrder S; S.init((const LAS int*)(lds + LDS_MISC), 4, d.G, d.bx);
#ifndef NO_M3
    pg8::gemm_phase<EpiScatter, MoeOrder, false>(lds, gm, S, E, nullptr);
#endif
}
#if defined(TIMEPROBE)
#define DBG_OUT_SCALE (1.0f + (float)(((unsigned*)(ws + WS_CTL))[CW_TP + 1]) * (0.01f / 5000.0f))
#elif DBG_CHECK
#define DBG_OUT_SCALE dbg_scale((unsigned*)(ws + WS_CTL))
#else
#define DBG_OUT_SCALE 1.0f
#endif
template <int L>
__device__ __forceinline__ void phase_ln_ffn(LAS unsigned char* lds) {
    KArgs ka = kargs(); unsigned char* ws = ka->ws;
    constexpr bool last = (L == 3), gates = (L == 1 || L == 2);
    ln_phase(lds, gates ? 1 : 2, (const float*)(ws + WS_HF), (const bf16*)(ws + BIG_Y), ka->in[I_LFG] + (size_t)L * DM, ka->in[I_LFB] + (size_t)L * DM, last ? ka->out : (float*)(ws + WS_HF),
             last ? DBG_OUT_SCALE : ALPHA, (bf16*)(ws + WS_HB), (const bf16*)(ws + WS_WG) + (size_t)(gates ? L - 1 : 0) * 64 * DM, ka->in[I_BBQ] + (size_t)(gates ? L - 1 : 0) * 1072 + 1024,
             nullptr, nullptr, (float*)(ws + WS_GATES));
#ifdef TIMEPROBE
    if (last && blockIdx.x == 0 && threadIdx.x == 0) { asm volatile("s_waitcnt vmcnt(0)" ::: "memory"); ka->out[0] = (float)(((unsigned*)(ws + WS_CTL))[CW_TP + 3]) * (0.01f / 10.0f); }
#endif
}


#if DBG_CHECK
template <int L, int WHERE>
__device__ __forceinline__ void dbg_hook(LAS unsigned char* lds, const XcdBarrier& bar) {
    KArgs ka = kargs(); unsigned char* ws = ka->ws; unsigned* ctl = (unsigned*)(ws + WS_CTL);
    const bf16* HB = (const bf16*)(ws + WS_HB); const bf16* KCMP = (const bf16*)(ws + BIG_KCMP);
    if (WHERE == 0) {
        if (L == 2) dbg_check_compress(lds, ctl, (const bf16*)(ws + BIG_KV), ka->in[I_CPOS], ka->in[I_CW1], ka->in[I_CB1], ka->in[I_CW2], ka->in[I_CB2], KCMP);
        if (L == 2) dbg_check_gemm(ctl, 4, HB, DM, ka->in[I_BWKV], NKV, NKV, nullptr, (const bf16*)(ws + BIG_KV), NKV, 0);
        if (L == 3) dbg_check_gates(ctl, HB, ka->in[I_BWQ] + (size_t)(L - 2) * DM * 1072, ka->in[I_BBQ] + (size_t)(L - 2) * 1072, (const float*)(ws + WS_GATES));
    }
    if (WHERE == 5) { if (L == 2) dbg_check_gates(ctl, HB, ka->in[I_BWQ], ka->in[I_BBQ], (const float*)(ws + WS_GATES)); }
    if (WHERE == 1) {
        if (L < 2) dbg_check_gemm(ctl, 4, HB, DM, ka->in[I_AWIN] + (size_t)L * DM * NQKV, NQKV, NQKV, nullptr, (const bf16*)(ws + WS_BIG), 0, 1);
        else dbg_check_gemm(ctl, 4, HB, DM, ka->in[I_BWQ] + (size_t)(L - 2) * DM * 1072, 1072, 1024, ka->in[I_BBQ] + (size_t)(L - 2) * 1072, (const bf16*)(ws + BIG_Q), 0, 2);
    }
    if (WHERE == 2) {
        if (L < 2) dbg_check_dilated(ctl, (const bf16*)(ws + WS_BIG), (const bf16*)(ws + WS_O));
        else dbg_check_nsa(lds, ctl, (const bf16*)(ws + BIG_Q), (const bf16*)(ws + BIG_KV), KCMP, KCMP + 1024 * 256, (const float*)(ws + WS_GATES), (const bf16*)(ws + WS_O));
    }
    if (WHERE == 3) dbg_check_outproj(ctl, (const bf16*)(ws + WS_O), (L < 2) ? ka->in[I_AWOUT] + (size_t)L * DM * DM : ka->in[I_BWOUT] + (size_t)(L - 2) * DM * DM, (const float*)(ws + WS_HF), HB);
    if (WHERE == 4) dbg_check_route(ctl, HB, ka->in[I_MWR] + (size_t)L * DM * 20, ka->in[I_MBR] + (size_t)L * 20, (const int4*)(ws + WS_ROUTE));
    if (WHERE == 6) dbg_check_moe(lds, ctl, HB, (const int4*)(ws + WS_ROUTE), ka->in[I_MWGU] + (size_t)L * 16 * 1024 * 512, ka->in[I_MWDN] + (size_t)L * 16 * 256 * 1024, (const bf16*)(ws + BIG_Y));
    xcd_barrier(bar);
}
#define DBG_HOOK(L, W) dbg_hook<L, W>(lds, bar)
#else
#define DBG_HOOK(L, W) do { } while (0)
#endif
template <int L>
__device__ __forceinline__ void layer_phases(LAS unsigned char* lds, const XcdBarrier& bar, const int lo, const int hi) {
    constexpr int PB = (L == 0) ? 1 : ((L == 1) ? 9 : ((L == 2) ? 17 : 27));
    constexpr int P1 = (L == 2) ? PB + 2 : PB;
    if (L == 2) {
        PHASE_IF(PB) { DBG_HOOK(L, 5); phase_proj<L, 1, true>(lds); }
        PHASE_BAR(PB);
        PHASE_IF(PB + 1) phase_compress(lds);
        PHASE_BAR(PB + 1);
        PHASE_IF(P1) { DBG_HOOK(L, 0); phase_proj<L, 2, false>(lds); }
        PHASE_BAR(P1);
    } else if (L == 3) {
        PHASE_IF(P1) { DBG_HOOK(L, 0); phase_proj<L, 2, true>(lds); }
        PHASE_BAR(P1);
    } else {
        PHASE_IF(P1) phase_proj<L, 0, (L > 0)>(lds);
        PHASE_BAR(P1);
    }
    PHASE_IF(P1 + 1) { DBG_HOOK(L, 1); if (L < 2) phase_attn_dilated(lds); else phase_attn_nsa(lds);
#ifdef DUP_MASK
        if (L < 2 && (DUP_MASK & 4)) { __syncthreads(); phase_attn_dilated(lds); }
        if (L >= 2 && (DUP_MASK & 8)) { __syncthreads(); phase_attn_nsa(lds); }
#endif
    }
    PHASE_BAR(P1 + 1);
    PHASE_IF(P1 + 2) { DBG_HOOK(L, 2); phase_outproj<L>(lds); }
    PHASE_BAR(P1 + 2);
    PHASE_IF(P1 + 3) { DBG_HOOK(L, 3); phase_ln_mix<L>(lds); }
    PHASE_BAR(P1 + 3);
    PHASE_IF(P1 + 4) { DBG_HOOK(L, 4); phase_scatter(lds);
#ifdef DUP_MASK
        if (DUP_MASK & 16) { __syncthreads(); phase_scatter(lds); }
#endif
    }
    PHASE_BAR(P1 + 4);
    PHASE_IF(P1 + 5) { phase_moe_up(lds);
#ifdef DUP_MASK
        if (DUP_MASK & 32) { __syncthreads(); phase_moe_up(lds); }
#endif
    }
    PHASE_BAR(P1 + 5);
    PHASE_IF(P1 + 6) { phase_moe_down(lds);
#ifdef DUP_MASK
        if (DUP_MASK & 64) { __syncthreads(); phase_moe_down(lds); }
#endif
    }
    PHASE_BAR(P1 + 6);
    PHASE_IF(P1 + 7) { DBG_HOOK(L, 6); phase_ln_ffn<L>(lds); }
    PHASE_BAR(P1 + 7);
}
constexpr int NPHASES = 35;

__global__ void __launch_bounds__(NTHREADS, 2) yoco_fwd(Args args) {
    extern __shared__ __attribute__((aligned(16))) unsigned char lds_raw[];
    LAS unsigned char* lds = (LAS unsigned char*)lds_raw;
    const int lo = args.ph_lo, hi = args.ph_hi;
    if (threadIdx.x < 4) ((LAS unsigned*)(lds + LDS_BAR))[threadIdx.x] = 0u;
    __syncthreads();
    unsigned* barw = (unsigned*)(args.ws + WS_CTL) + CW_BAR;
    XcdBarrier bar; bar.bar = barw; bar.x = 0; bar.st = (volatile LAS unsigned*)(lds + LDS_BAR);
    if (hi - lo > 1) bar = xcd_barrier_post(barw, (volatile LAS unsigned*)(lds + LDS_BAR));
    PHASE_IF(0) { phase_prologue(lds);
#ifdef DUP_MASK
        if (DUP_MASK & 1) { __syncthreads(); phase_prologue(lds); }
#endif
    }
    PHASE_BAR(0);
    layer_phases<0>(lds, bar, lo, hi);
    layer_phases<1>(lds, bar, lo, hi);
    layer_phases<2>(lds, bar, lo, hi);
    layer_phases<3>(lds, bar, lo, hi);
}

extern "C" void kernel_launch(void* const* d_in, const int* in_sizes, int n_in, void* d_out, int out_size, void* d_ws, size_t ws_size, hipStream_t stream) {
    static int grid = 0;
    if (grid == 0) {
        if (n_in != 20 || out_size != SEQ * DM || ws_size < WS_END) { fprintf(stderr, "kernel_launch: unexpected problem shape (n_in %d, out %d, ws %zu)\n", n_in, out_size, ws_size); grid = -1; return; }
        int dev = 0, cus = 0;
        if (hipGetDevice(&dev) != hipSuccess || hipDeviceGetAttribute(&cus, hipDeviceAttributeMultiprocessorCount, dev) != hipSuccess) { grid = -1; return; }
        if (hipFuncSetAttribute((const void*)yoco_fwd, hipFuncAttributeMaxDynamicSharedMemorySize, LDS_BYTES) != hipSuccess) { fprintf(stderr, "kernel_launch: hipFuncSetAttribute failed\n"); grid = -1; return; }
        int per_cu = 0;
        if (hipOccupancyMaxActiveBlocksPerMultiprocessor(&per_cu, (const void*)yoco_fwd, NTHREADS, LDS_BYTES) != hipSuccess || per_cu < 1) fprintf(stderr, "kernel_launch: occupancy query says %d\n", per_cu);
        (void)hipGetLastError();
        grid = cus;
    }
    if (grid < 0) return;
    (void)hipMemsetAsync((char*)d_ws + WS_CTL, 0, CTL_BYTES, stream);
    Args a{};
    for (int i = 0; i < 20; ++i) a.in[i] = (const float*)d_in[i];
    a.out = (float*)d_out; a.ws = (unsigned char*)d_ws;
#if MK_ONE_LAUNCH
    a.ph_lo = 0; a.ph_hi = NPHASES;
    hipLaunchKernelGGL(yoco_fwd, dim3(grid), dim3(NTHREADS), LDS_BYTES, stream, a);
#else
    for (int ph = 0; ph < NPHASES; ++ph) { a.ph_lo = ph; a.ph_hi = ph + 1; hipLaunchKernelGGL(yoco_fwd, dim3(grid), dim3(NTHREADS), LDS_BYTES, stream, a); }
#endif
}
```

```cpp
#include <hip/hip_runtime.h>
#include <cstdio>
#include <cstdint>
#include <cmath>
#define MK_ONE_LAUNCH 1
namespace pg8 {
#define PG8_LAS __attribute__((address_space(3)))
typedef unsigned short bf16_t;
typedef short bf16x8 __attribute__((ext_vector_type(8)));
typedef float f32x4 __attribute__((ext_vector_type(4)));
typedef unsigned u32x4 __attribute__((ext_vector_type(4)));
constexpr int BM = 256, BK = 64, HALF = 128, HTB = HALF * BK * 2  , STAGE_BYTES = 8 * HTB, NXCD = 8, WGM = 8;

__host__ __device__ __forceinline__ int lds_byte(int r, int c) { const int st = (r >> 4) * 2 + (c >> 5), rr = r & 15, cc = c & 31, ob = rr * 64 + cc * 2; return st * 1024 + (ob ^ (((ob >> 9) & 1) << 5)); }
__host__ __device__ __forceinline__ void stage_rc(int b, int& R, int& C) { const int st = b / 1024, sb = b % 1024, swz = sb ^ (((sb >> 9) & 1) << 5); R = (st >> 1) * 16 + swz / 64; C = (st & 1) * 32 + (swz % 64) / 2; }
__host__ __device__ __forceinline__ int perm32(int rho) { const int n = rho >> 4, i = rho & 15; return 8 * (i >> 2) + 4 * n + (i & 3); }

struct Unit { int pm, pn; };
struct Gemm { const bf16_t* A; const bf16_t* Bt; int M, N, K; };

struct StaticOrder {
    int nM, nN, nwg, G, c;
    __host__ __device__ void init(int M, int N, int G_, int c_) { nM = M / BM; nN = N / BM; nwg = nM * nN; G = G_; c = c_; }
    __host__ __device__ bool next(int i, Unit& u) const {
        const long L = (long)i * G + c; if (L >= nwg) return false;
        int wgid = (int)L; { const int q = nwg / NXCD, r = nwg % NXCD, xcd = wgid % NXCD, off = wgid / NXCD; wgid = (xcd < r ? xcd * (q + 1) : r * (q + 1) + (xcd - r) * q) + off; }
        const int nig = WGM * nN, gid = wgid / nig, fm = gid * WGM, gsz = (nM - fm) < WGM ? (nM - fm) : WGM;
        u.pm = fm + ((wgid % nig) % gsz); u.pn = (wgid % nig) / gsz; return true;
    }
    __device__ __forceinline__ void a_ready(const Unit&) const {}
    __device__ __forceinline__ void done(const Unit&) const {}
};
struct CountedOrder : StaticOrder {
    const unsigned* ready; unsigned need; unsigned* tmo;
    __device__ __forceinline__ void a_ready(const Unit& u) const {
        if (threadIdx.x < 64) {
            const unsigned long long t0 = __builtin_amdgcn_s_memrealtime(); unsigned polls = 0;
            while ((unsigned)__builtin_amdgcn_readfirstlane(__hip_atomic_load(ready + 64 * u.pm, __ATOMIC_RELAXED, __HIP_MEMORY_SCOPE_AGENT)) < need) {
                if ((++polls & 255u) == 0u && __builtin_amdgcn_readfirstlane(__hip_atomic_load(tmo, __ATOMIC_RELAXED, __HIP_MEMORY_SCOPE_AGENT)) != 0u) break;
                if (__builtin_amdgcn_s_memrealtime() - t0 > 2000000ull) {
                    if (threadIdx.x == 0) { unsigned expect = 0u; __hip_atomic_compare_exchange_strong(tmo + 1, &expect, 0x600u | (unsigned)(u.pm & 0xff), __ATOMIC_RELAXED, __ATOMIC_RELAXED, __HIP_MEMORY_SCOPE_AGENT); __hip_atomic_store(tmo, 1u, __ATOMIC_RELAXED, __HIP_MEMORY_SCOPE_AGENT); }
                    break; }
                __builtin_amdgcn_s_sleep(2); }
            __builtin_amdgcn_fence(__ATOMIC_ACQUIRE, "agent");
            asm volatile("s_waitcnt vmcnt(0)" ::: "memory");
        }
#if !defined(BROKEN_HOOK_NO_BARRIER)
        asm volatile("" ::: "memory"); __builtin_amdgcn_s_barrier(); asm volatile("" ::: "memory");
#endif
    }
};

__device__ __forceinline__ unsigned cvt_pk_bf16(float lo, float hi) { unsigned r; asm volatile("v_cvt_pk_bf16_f32 %0, %1, %2" : "=v"(r) : "v"(lo), "v"(hi)); return r; }
typedef float f32x2 __attribute__((ext_vector_type(2)));
__device__ __forceinline__ f32x2 gelu_pk(f32x2 v) {
    const f32x2 av = __builtin_elementwise_abs(v), d = av * 0.2316418882f + 1.0f;
    f32x2 t; t.x = __builtin_amdgcn_rcpf(d.x); t.y = __builtin_amdgcn_rcpf(d.y);
    f32x2 q = t * 0.5307027145f + (-0.7265760135f); q = q * t + 0.7107068705f; q = q * t + (-0.142248368f); q = q * t + 0.127414796f; q = q * t;
    const f32x2 s = (v * v) * (-0.72134752044f);
    f32x2 e; e.x = __builtin_amdgcn_exp2f(s.x); e.y = __builtin_amdgcn_exp2f(s.y);
    const f32x2 m = v * (q * e), r = v - m;
    f32x2 o; o.x = v.x < 0.f ? m.x : r.x; o.y = v.y < 0.f ? m.y : r.y; return o;
}

struct EpiF32 {
    static constexpr bool PERM = false, AFTER_DRAIN = false;
    float* C; int ldc; const float* bias;
    __device__ __forceinline__ void operator()(const f32x4 (&acc)[2][2][4][2], const Unit& u, int wr, int wc, int fr, int fq) const {
        const int row0 = u.pm * BM + wr * 64 + fr, col0 = u.pn * BM + wc * 32 + 4 * fq;
        f32x4 bv[2][2];
#pragma unroll
        for (int bj = 0; bj < 2; ++bj)
#pragma unroll
            for (int n = 0; n < 2; ++n) bv[bj][n] = bias ? *(const f32x4*)(bias + col0 + bj * HALF + n * 16) : (f32x4){0.f, 0.f, 0.f, 0.f};
#pragma unroll
        for (int ai = 0; ai < 2; ++ai)
#pragma unroll
            for (int m = 0; m < 4; ++m) { float* rowp = C + (size_t)(row0 + ai * HALF + m * 16) * ldc + col0;
#pragma unroll
                for (int bj = 0; bj < 2; ++bj)
#pragma unroll
                    for (int n = 0; n < 2; ++n) *(f32x4*)(rowp + bj * HALF + n * 16) = acc[ai][bj][m][n] + bv[bj][n]; }
    }
};
template <int ACT  > struct EpiBf16 {
    static constexpr bool PERM = true, AFTER_DRAIN = false;
    bf16_t* O; int ldc; const float* bias; int split_cols; size_t split_stride;
    __device__ __forceinline__ void operator()(const f32x4 (&acc)[2][2][4][2], const Unit& u, int wr, int wc, int fr, int fq) const {
        const int row0 = u.pm * BM + wr * 64 + fr; int colt = u.pn * BM; bf16_t* base = O;
        if (split_cols) { const int t = colt / split_cols; base += (size_t)t * split_stride; colt -= t * split_cols; }
        const int col0 = colt + wc * 32 + 8 * fq, bcol0 = u.pn * BM + wc * 32 + 8 * fq;
        f32x4 bv[2][2];
#pragma unroll
        for (int bj = 0; bj < 2; ++bj)
#pragma unroll
            for (int n = 0; n < 2; ++n) bv[bj][n] = bias ? *(const f32x4*)(bias + bcol0 + bj * HALF + 4 * n) : (f32x4){0.f, 0.f, 0.f, 0.f};
#pragma unroll
        for (int ai = 0; ai < 2; ++ai)
#pragma unroll
            for (int m = 0; m < 4; ++m) { bf16_t* rowp = base + (size_t)(row0 + ai * HALF + m * 16) * ldc + col0;
#pragma unroll
                for (int bj = 0; bj < 2; ++bj) { f32x4 v0 = acc[ai][bj][m][0] + bv[bj][0], v1 = acc[ai][bj][m][1] + bv[bj][1];
                    if (ACT == 1) { f32x2 a = gelu_pk((f32x2){v0[0], v0[1]}), b = gelu_pk((f32x2){v0[2], v0[3]}), c = gelu_pk((f32x2){v1[0], v1[1]}), d = gelu_pk((f32x2){v1[2], v1[3]});
                        v0 = (f32x4){a.x, a.y, b.x, b.y}; v1 = (f32x4){c.x, c.y, d.x, d.y}; }
                    if (ACT == 2) {
#pragma unroll
                        for (int j = 0; j < 4; ++j) { v0[j] = 0.5f * v0[j] * (1.0f + erff(v0[j] * 0.70710678f)); v1[j] = 0.5f * v1[j] * (1.0f + erff(v1[j] * 0.70710678f)); } }
                    u32x4 w; w.x = cvt_pk_bf16(v0[0], v0[1]); w.y = cvt_pk_bf16(v0[2], v0[3]); w.z = cvt_pk_bf16(v1[0], v1[1]); w.w = cvt_pk_bf16(v1[2], v1[3]);
                    *(u32x4*)(rowp + bj * HALF) = w; } }
    }
};

struct PanelStats {
    unsigned* xbuf;
    unsigned* cnt;
    unsigned* tmo;
    int ntn; float eps;
    unsigned code;
    __device__ __forceinline__ bool run(const f32x4 (&v)[2][2][4][2], const Unit& u, int wr, int wc, int fr, int fq, PG8_LAS unsigned char* lds, int wid, int lane) const {
        typedef float f32x2v __attribute__((ext_vector_type(2)));
        PG8_LAS f32x2v* P = (PG8_LAS f32x2v*)lds;
        PG8_LAS f32x2v* S = (PG8_LAS f32x2v*)(lds + 8192);
        PG8_LAS unsigned* flag = (PG8_LAS unsigned*)(lds + 8192 + 2048);
#pragma unroll
        for (int ai = 0; ai < 2; ++ai)
#pragma unroll
            for (int m = 0; m < 4; ++m) {
                float s = 0.f;
#pragma unroll
                for (int bj = 0; bj < 2; ++bj)
#pragma unroll
                    for (int n = 0; n < 2; ++n) { const f32x4 x = v[ai][bj][m][n]; s += (x[0] + x[1]) + (x[2] + x[3]); }
                s += __shfl_xor(s, 16); s += __shfl_xor(s, 32);
                const float mw = s * (1.0f / 64.0f); float q = 0.f;
#pragma unroll
                for (int bj = 0; bj < 2; ++bj)
#pragma unroll
                    for (int n = 0; n < 2; ++n) { const f32x4 d = v[ai][bj][m][n] - mw; q += (d[0] * d[0] + d[1] * d[1]) + (d[2] * d[2] + d[3] * d[3]); }
                q += __shfl_xor(q, 16); q += __shfl_xor(q, 32);
                if (fq == 0) P[(ai * HALF + wr * 64 + m * 16 + fr) * 4 + wc] = (f32x2v){mw, q};
            }
        asm volatile("s_waitcnt lgkmcnt(0)" ::: "memory"); __builtin_amdgcn_s_barrier(); asm volatile("" ::: "memory");
#if defined(BROKEN_NO_WAIT)
        if (blockIdx.x >= 64) { const long long t0 = clock64(); while (clock64() - t0 < 60000) __builtin_amdgcn_s_sleep(8); }
#endif
        const int row = wid * 32 + (lane & 31);
        if (lane < 32) {
            const f32x2v a = P[row * 4 + 0], b = P[row * 4 + 1], c = P[row * 4 + 2], d = P[row * 4 + 3];
            const float mt = (a.x + b.x + c.x + d.x) * 0.25f;
            const float da = a.x - mt, db = b.x - mt, dc = c.x - mt, dd = d.x - mt;
            const float m2 = (a.y + b.y) + (c.y + d.y) + 64.0f * ((da * da + db * db) + (dc * dc + dd * dd));
            unsigned long long* slot = (unsigned long long*)xbuf + ((size_t)(u.pm * BM + row) * 4 + u.pn);
            __hip_atomic_store(slot, ((unsigned long long)__float_as_uint(m2) << 32) | __float_as_uint(mt), __ATOMIC_RELAXED, __HIP_MEMORY_SCOPE_AGENT);
        }
        asm volatile("s_waitcnt vmcnt(0)" ::: "memory");
        if (lane == 0) __hip_atomic_fetch_add(cnt + 64 * u.pm, 1u, __ATOMIC_RELAXED, __HIP_MEMORY_SCOPE_AGENT);
        if (wid == 0) {
            bool dead = false; const unsigned long long t0 = __builtin_amdgcn_s_memrealtime(); const unsigned want = 8u * (unsigned)ntn;
            for (;;) {
#if defined(BROKEN_NO_WAIT)
                break;
#endif
                if ((unsigned)__builtin_amdgcn_readfirstlane(__hip_atomic_load(cnt + 64 * u.pm, __ATOMIC_RELAXED, __HIP_MEMORY_SCOPE_AGENT)) >= want) break;
                if (__builtin_amdgcn_s_memrealtime() - t0 > 2000000ull) {
                    if (lane == 0) { unsigned expect = 0u; __hip_atomic_compare_exchange_strong(tmo + 1, &expect, code | (unsigned)(u.pm & 0xff), __ATOMIC_RELAXED, __ATOMIC_RELAXED, __HIP_MEMORY_SCOPE_AGENT);
                                     __hip_atomic_store(tmo, 1u, __ATOMIC_RELAXED, __HIP_MEMORY_SCOPE_AGENT); }
                    dead = true; break; }
                __builtin_amdgcn_s_sleep(2);
            }
            __builtin_amdgcn_fence(__ATOMIC_ACQUIRE, "agent");
            if (lane == 0) flag[0] = dead ? 1u : 0u;
        }
        asm volatile("s_waitcnt vmcnt(0) lgkmcnt(0)" ::: "memory"); __builtin_amdgcn_s_barrier(); asm volatile("" ::: "memory");
        const bool bad = flag[0] != 0u;
        if (lane < 32) {
            const unsigned long long* slot = (const unsigned long long*)xbuf + (size_t)(u.pm * BM + row) * 4; float mt[4], m2[4]; float ms = 0.f;
#pragma unroll
            for (int t = 0; t < 4; ++t) { if (t < ntn) { const unsigned long long w = __hip_atomic_load(slot + t, __ATOMIC_RELAXED, __HIP_MEMORY_SCOPE_AGENT); mt[t] = __uint_as_float((unsigned)w); m2[t] = __uint_as_float((unsigned)(w >> 32)); } else { mt[t] = 0.f; m2[t] = 0.f; } ms += mt[t]; }
            const float mean = ms / (float)ntn; float q = 0.f;
#pragma unroll
            for (int t = 0; t < 4; ++t) if (t < ntn) { const float dm = mt[t] - mean; q += m2[t] + 256.0f * dm * dm; }
            S[row] = (f32x2v){mean, 1.0f / sqrtf(q / (256.0f * (float)ntn) + eps)};
        }
        asm volatile("s_waitcnt lgkmcnt(0)" ::: "memory"); __builtin_amdgcn_s_barrier(); asm volatile("" ::: "memory");
        return bad;
    }
};
struct EpiLnRes {
    static constexpr bool PERM = false, AFTER_DRAIN = true;
    const float* base; float* out; int ldc; const float* bias; PanelStats st; unsigned poison;
    __device__ __forceinline__ void refuse(size_t i0, size_t stride, int M, int N) const { const float q = __builtin_nanf(""); for (size_t i = i0; i < (size_t)M * N; i += stride) out[(i / N) * ldc + i % N] = q;
        if (i0 == 0) { unsigned expect = 0u; __hip_atomic_compare_exchange_strong(st.tmo + 1, &expect, 0x7f0u, __ATOMIC_RELAXED, __ATOMIC_RELAXED, __HIP_MEMORY_SCOPE_AGENT); __hip_atomic_store(st.tmo, 1u, __ATOMIC_RELAXED, __HIP_MEMORY_SCOPE_AGENT); } }
    __device__ __forceinline__ void fused(f32x4 (&acc)[2][2][4][2], const Unit& u, int wr, int wc, int fr, int fq, PG8_LAS unsigned char* lds, int wid, int lane) const {
        typedef float f32x2v __attribute__((ext_vector_type(2)));
        const PG8_LAS f32x2v* S = (const PG8_LAS f32x2v*)(lds + 8192);
        const int col0 = u.pn * BM + wc * 32 + 4 * fq;
#pragma unroll
        for (int bj = 0; bj < 2; ++bj)
#pragma unroll
            for (int n = 0; n < 2; ++n) { const f32x4 bv = bias ? *(const f32x4*)(bias + col0 + bj * HALF + n * 16) : (f32x4){0.f, 0.f, 0.f, 0.f};
#pragma unroll
                for (int ai = 0; ai < 2; ++ai)
#pragma unroll
                    for (int m = 0; m < 4; ++m) acc[ai][bj][m][n] += bv; }
        const bool bad = st.run(acc, u, wr, wc, fr, fq, lds, wid, lane) || poison != 0u;
        const float qnan = __builtin_nanf("");
#pragma unroll
        for (int ai = 0; ai < 2; ++ai)
#pragma unroll
            for (int m = 0; m < 4; ++m) { const int r = ai * HALF + wr * 64 + m * 16 + fr; const f32x2v sr = S[r]; const size_t off = (size_t)(u.pm * BM + r) * ldc + col0;
#pragma unroll
                for (int bj = 0; bj < 2; ++bj)
#pragma unroll
                    for (int n = 0; n < 2; ++n) { const f32x4 bs = *(const f32x4*)(base + off + bj * HALF + n * 16); f32x4 o = bs + (acc[ai][bj][m][n] - sr.x) * sr.y;
                        if (bad) o = (f32x4){qnan, qnan, qnan, qnan}; *(f32x4*)(out + off + bj * HALF + n * 16) = o; }
                asm volatile("" ::: "memory"); }
    }
};
struct EpiLnResLn {
    static constexpr bool PERM = false, AFTER_DRAIN = true;
    const float* base; float* out; bf16_t* xn; int ldc; const float* bias; PanelStats st1, st2; unsigned poison;
    __device__ __forceinline__ void refuse(size_t i0, size_t stride, int M, int N) const { const float q = __builtin_nanf(""); for (size_t i = i0; i < (size_t)M * N; i += stride) { const size_t o = (i / N) * ldc + i % N; out[o] = q; xn[o] = (bf16_t)0x7fc0u; }
        if (i0 == 0) { unsigned expect = 0u; __hip_atomic_compare_exchange_strong(st1.tmo + 1, &expect, 0x7f0u, __ATOMIC_RELAXED, __ATOMIC_RELAXED, __HIP_MEMORY_SCOPE_AGENT); __hip_atomic_store(st1.tmo, 1u, __ATOMIC_RELAXED, __HIP_MEMORY_SCOPE_AGENT); } }
    __device__ __forceinline__ void fused(f32x4 (&acc)[2][2][4][2], const Unit& u, int wr, int wc, int fr, int fq, PG8_LAS unsigned char* lds, int wid, int lane) const {
        typedef float f32x2v __attribute__((ext_vector_type(2))); typedef unsigned u32x2v __attribute__((ext_vector_type(2)));
        const PG8_LAS f32x2v* S = (const PG8_LAS f32x2v*)(lds + 8192);
        const int col0 = u.pn * BM + wc * 32 + 4 * fq;
#pragma unroll
        for (int bj = 0; bj < 2; ++bj)
#pragma unroll
            for (int n = 0; n < 2; ++n) { const f32x4 bv = bias ? *(const f32x4*)(bias + col0 + bj * HALF + n * 16) : (f32x4){0.f, 0.f, 0.f, 0.f};
#pragma unroll
                for (int ai = 0; ai < 2; ++ai)
#pragma unroll
                    for (int m = 0; m < 4; ++m) acc[ai][bj][m][n] += bv; }
        bool bad = st1.run(acc, u, wr, wc, fr, fq, lds, wid, lane) || poison != 0u;
        const float qnan = __builtin_nanf("");
#pragma unroll
        for (int ai = 0; ai < 2; ++ai)
#pragma unroll
            for (int m = 0; m < 4; ++m) { const int r = ai * HALF + wr * 64 + m * 16 + fr; const f32x2v sr = S[r]; const size_t off = (size_t)(u.pm * BM + r) * ldc + col0;
#pragma unroll
                for (int bj = 0; bj < 2; ++bj)
#pragma unroll
                    for (int n = 0; n < 2; ++n) { const f32x4 bs = *(const f32x4*)(base + off + bj * HALF + n * 16); acc[ai][bj][m][n] = bs + (acc[ai][bj][m][n] - sr.x) * sr.y; }
                asm volatile("" : "+v"(acc[ai][0][m][0]), "+v"(acc[ai][0][m][1]), "+v"(acc[ai][1][m][0]), "+v"(acc[ai][1][m][1]));
                if (m & 1) asm volatile("" ::: "memory"); }
        const bool bad1 = bad;
        bad = st2.run(acc, u, wr, wc, fr, fq, lds, wid, lane) || bad;
#pragma unroll
        for (int ai = 0; ai < 2; ++ai)
#pragma unroll
            for (int m = 0; m < 4; ++m) { const int r = ai * HALF + wr * 64 + m * 16 + fr; const f32x2v sr = S[r]; const size_t off = (size_t)(u.pm * BM + r) * ldc + col0;
#pragma unroll
                for (int bj = 0; bj < 2; ++bj)
#pragma unroll
                    for (int n = 0; n < 2; ++n) { const f32x4 x1 = acc[ai][bj][m][n]; *(f32x4*)(out + off + bj * HALF + n * 16) = bad1 ? (f32x4){qnan, qnan, qnan, qnan} : x1;
                        const f32x4 o = (x1 - sr.x) * sr.y; u32x2v w; w.x = cvt_pk_bf16(o[0], o[1]); w.y = cvt_pk_bf16(o[2], o[3]);
                        if (bad) { w.x = 0x7fc07fc0u; w.y = 0x7fc07fc0u; } *(u32x2v*)(xn + off + bj * HALF + n * 16) = w; }
                asm volatile("" ::: "memory"); }
    }
};

template <class Epi, class Sched, bool STAMP = false>
__device__ __forceinline__ void gemm_phase(PG8_LAS unsigned char* lds, const Gemm g, const Sched& S, const Epi& E, unsigned long long* stamps) {
    const int tid = threadIdx.x, wid = __builtin_amdgcn_readfirstlane(tid >> 6), lane = tid & 63, wr = wid >> 2, wc = wid & 3, fr = lane & 15, fq = lane >> 4;
    const int K = g.K, nt = K / BK;
    int ts_lo = 0, ts_hi = 0, nts = 0; const unsigned long long rt_entry = STAMP ? (unsigned long long)wall_clock64() : 0ull;
#define PG8_STAMP() do { if (STAMP && wid == 0 && nts < 64) { const unsigned long long _c = (unsigned long long)clock64(); \
        ts_lo = (lane == nts) ? (int)(unsigned)_c : ts_lo; ts_hi = (lane == nts) ? (int)(unsigned)(_c >> 32) : ts_hi; ++nts; } } while (0)
    PG8_STAMP();
    unsigned voffA[2], voffB[2];
#pragma unroll
    for (int i = 0; i < 2; ++i) { int R, C; stage_rc(tid * 16 + i * 8192, R, C); const int Rb = Epi::PERM ? ((R & ~31) + perm32(R & 31)) : R;
        voffA[i] = (unsigned)(R * K + C) * 2u; voffB[i] = (unsigned)(Rb * K + C) * 2u; }
    const size_t kstep = (size_t)(BK * 2);
    const size_t hstep = (size_t)HALF * K * 2;
    const size_t tstep = 2 * hstep;
    const unsigned ldsw = (unsigned)wid * 1024u;
    const int aoff = lds_byte(wr * 64 + fr, fq * 8), boff = lds_byte(wc * 32 + fr, fq * 8);
#define PG8_SA(b, h) (((b) * 2 + (h)) * HTB)
#define PG8_SB(b, h) ((4 + (b) * 2 + (h)) * HTB)
#define PG8_STAGE(bufoff, gbase, voff) do { _Pragma("unroll") for (int _i = 0; _i < 2; ++_i) \
        __builtin_amdgcn_global_load_lds((const unsigned*)((const char*)(gbase) + (voff)[_i]), (PG8_LAS unsigned*)(lds + (bufoff) + ldsw + _i * 8192), 16, 0, 0); } while (0)
#define PG8_LDA(dst, b, h) do { _Pragma("unroll") for (int m = 0; m < 4; ++m) _Pragma("unroll") for (int k = 0; k < 2; ++k) dst[m][k] = *(const PG8_LAS bf16x8*)(lds + PG8_SA(b, h) + aoff + m * 2048 + k * 1024); } while (0)
#define PG8_LDB(dst, b, h) do { _Pragma("unroll") for (int n = 0; n < 2; ++n) _Pragma("unroll") for (int k = 0; k < 2; ++k) dst[n][k] = *(const PG8_LAS bf16x8*)(lds + PG8_SB(b, h) + boff + n * 2048 + k * 1024); } while (0)
#define PG8_MMA(ai, bj, At, Bt) do { __builtin_amdgcn_s_setprio(1); _Pragma("unroll") for (int m = 0; m < 4; ++m) _Pragma("unroll") for (int n = 0; n < 2; ++n) _Pragma("unroll") for (int k = 0; k < 2; ++k) \
        acc[ai][bj][m][n] = __builtin_amdgcn_mfma_f32_16x16x32_bf16(Bt[n][k], At[m][k], acc[ai][bj][m][n], 0, 0, 0); __builtin_amdgcn_s_setprio(0); } while (0)
#define PG8_WAIT_V(n) asm volatile("s_waitcnt vmcnt(" #n ")" ::: "memory")
#define PG8_WAIT_L(n) asm volatile("s_waitcnt lgkmcnt(" #n ")" ::: "memory")
#define PG8_BAR __builtin_amdgcn_s_barrier()
#define PG8_SCHED __builtin_amdgcn_sched_barrier(0)
    Unit cur, nxt; int ui = 0;
    if (!S.next(0, cur)) return;
    f32x4 acc[2][2][4][2];
#pragma unroll
    for (int a = 0; a < 2; ++a)
#pragma unroll
        for (int b = 0; b < 2; ++b)
#pragma unroll
            for (int m = 0; m < 4; ++m)
#pragma unroll
                for (int n = 0; n < 2; ++n) acc[a][b][m][n] = (f32x4){0.f, 0.f, 0.f, 0.f};
    bf16x8 At[4][2], B0[2][2], B1[2][2];
    const char* cA = (const char*)g.A + (size_t)cur.pm * tstep; const char* cB = (const char*)g.Bt + (size_t)cur.pn * tstep;
    S.a_ready(cur);
    PG8_STAGE(PG8_SB(0, 0), cB, voffB); PG8_STAGE(PG8_SA(0, 0), cA, voffA); PG8_STAGE(PG8_SB(0, 1), cB + hstep, voffB); PG8_STAGE(PG8_SA(0, 1), cA + hstep, voffA);
    if (wr == 1) PG8_BAR;
    PG8_WAIT_V(4); PG8_BAR;
    PG8_STAGE(PG8_SB(1, 0), cB + kstep, voffB); PG8_STAGE(PG8_SA(1, 0), cA + kstep, voffA); PG8_STAGE(PG8_SB(1, 1), cB + hstep + kstep, voffB);
    PG8_WAIT_V(6); PG8_BAR;
    PG8_STAMP();
    for (;;) {
        const bool has_next = S.next(ui + 1, nxt);
        const char* nA = has_next ? (const char*)g.A + (size_t)nxt.pm * tstep : cA; const char* nB = has_next ? (const char*)g.Bt + (size_t)nxt.pn * tstep : cB;
        for (int t = 0; t < nt; t += 2) {
            const bool last = (t == nt - 2);
            const char* a1 = cA + (size_t)(t + 1) * kstep;
            const char* a2 = last ? nA : cA + (size_t)(t + 2) * kstep; const char* b2 = last ? nB : cB + (size_t)(t + 2) * kstep;
            const char* a3 = a2 + kstep; const char* b3 = b2 + kstep;
            if (last && has_next) S.a_ready(nxt);
            PG8_LDB(B0, 0, 0); PG8_SCHED; PG8_LDA(At, 0, 0); PG8_STAGE(PG8_SA(1, 1), a1 + hstep, voffA);
            PG8_WAIT_L(8); PG8_BAR; PG8_WAIT_L(0); PG8_MMA(0, 0, At, B0); PG8_BAR; PG8_SCHED;
            PG8_LDB(B1, 0, 1); PG8_STAGE(PG8_SB(0, 0), b2, voffB);
            PG8_BAR; PG8_WAIT_L(0); PG8_MMA(0, 1, At, B1); PG8_BAR;
            PG8_LDA(At, 0, 1); PG8_STAGE(PG8_SA(0, 0), a2, voffA);
            PG8_BAR; PG8_WAIT_L(0); PG8_MMA(1, 0, At, B0); PG8_BAR; PG8_SCHED;
            PG8_STAGE(PG8_SB(0, 1), b2 + hstep, voffB);
            PG8_WAIT_V(6); PG8_BAR; PG8_MMA(1, 1, At, B1); PG8_BAR;
            PG8_LDB(B0, 1, 0); PG8_SCHED; PG8_LDA(At, 1, 0); PG8_STAGE(PG8_SA(0, 1), a2 + hstep, voffA);
            PG8_WAIT_L(8); PG8_BAR; PG8_WAIT_L(0); PG8_MMA(0, 0, At, B0); PG8_BAR; PG8_SCHED;
            PG8_LDB(B1, 1, 1); PG8_STAGE(PG8_SB(1, 0), b3, voffB);
            PG8_BAR; PG8_WAIT_L(0); PG8_MMA(0, 1, At, B1); PG8_BAR;
            PG8_LDA(At, 1, 1); PG8_STAGE(PG8_SA(1, 0), a3, voffA);
            PG8_BAR; PG8_WAIT_L(0); PG8_MMA(1, 0, At, B0); PG8_BAR; PG8_SCHED;
            PG8_STAGE(PG8_SB(1, 1), b3 + hstep, voffB);
            PG8_WAIT_V(6); PG8_BAR; PG8_MMA(1, 1, At, B1); PG8_BAR;
        }
        PG8_STAMP();
        if constexpr (!Epi::AFTER_DRAIN) { E(acc, cur, wr, wc, fr, fq); S.done(cur); }
        PG8_STAMP();
        if (!has_next) break;
#pragma unroll
        for (int a = 0; a < 2; ++a)
#pragma unroll
            for (int b = 0; b < 2; ++b)
#pragma unroll
                for (int m = 0; m < 4; ++m)
#pragma unroll
                    for (int n = 0; n < 2; ++n) acc[a][b][m][n] = (f32x4){0.f, 0.f, 0.f, 0.f};
        cur = nxt; cA = nA; cB = nB; ++ui;
    }
    PG8_WAIT_V(0);
    if (wr == 0) PG8_BAR;
    PG8_BAR;
    if constexpr (Epi::AFTER_DRAIN) { E.fused(acc, cur, wr, wc, fr, fq, lds, wid, lane); S.done(cur); }
    PG8_STAMP();
    if (STAMP && wid == 0) { stamps[lane] = lane < nts ? (((unsigned long long)(unsigned)ts_hi << 32) | (unsigned)ts_lo) : 0ull;
        if (lane == 62) stamps[62] = rt_entry; if (lane == 63) stamps[63] = (unsigned long long)wall_clock64(); }
#undef PG8_STAMP
#undef PG8_SA
#undef PG8_SB
#undef PG8_STAGE
#undef PG8_LDA
#undef PG8_LDB
#undef PG8_MMA
#undef PG8_WAIT_V
#undef PG8_WAIT_L
#undef PG8_BAR
#undef PG8_SCHED
}
}
#ifndef MK_ONE_LAUNCH
#define MK_ONE_LAUNCH 0
#endif
#ifndef DBG_CHECK
#define DBG_CHECK 0
#endif
#define LAS __attribute__((address_space(3)))
typedef unsigned short bf16;
typedef short bf16x8 __attribute__((ext_vector_type(8)));
typedef short s16x4 __attribute__((ext_vector_type(4)));
typedef short v4i16_t __attribute__((ext_vector_type(4)));
typedef float f32x16 __attribute__((ext_vector_type(16)));
typedef float f32x4 __attribute__((ext_vector_type(4)));
typedef unsigned u32x4 __attribute__((ext_vector_type(4)));
typedef unsigned u32x2 __attribute__((ext_vector_type(2)));

constexpr int SEQ = 16384, DM = 1024, NQKV = 9216, NKV = 1536;
constexpr int NWAVES = 8, NTHREADS = 512;
constexpr float ALPHA = 1.6817928305074290f;
constexpr float LOG2E = 1.4426950408889634f;
constexpr float C1 = 0.125f * LOG2E;
constexpr float LN_EPS = 1e-5f;
constexpr int MAXTILES = 144;
constexpr int MAXROWS = MAXTILES * 256;

constexpr size_t MiB = 1u << 20;
constexpr size_t WS_CTL = 0, CTL_BYTES = 1 * MiB;
constexpr size_t WS_HIST = 1 * MiB;
constexpr size_t WS_TILEB = 1 * MiB + 64 * 1024;
constexpr size_t WS_ROUTE = 2 * MiB;
constexpr size_t WS_ROWINFO = 3 * MiB;
constexpr size_t WS_ROWW = 4 * MiB;
constexpr size_t WS_GATES = 5 * MiB;
constexpr size_t WS_B1P = 8 * MiB;
constexpr size_t WS_WR = 9 * MiB;
constexpr size_t WS_WG = 9 * MiB + 256 * 1024;
constexpr size_t WS_W2T = 9 * MiB + 512 * 1024;
constexpr size_t WS_W1T = 10 * MiB;
constexpr size_t WS_WIN = 12 * MiB;
constexpr size_t WS_WOUTA = 48 * MiB;
constexpr size_t WS_WKV = 52 * MiB;
constexpr size_t WS_WQ = 55 * MiB;
constexpr size_t WS_WOUTB = 59 * MiB;
constexpr size_t WS_WGU = 64 * MiB;
constexpr size_t WS_WDN = 80 * MiB;
constexpr size_t WS_HF = 88 * MiB;
constexpr size_t WS_HB = 152 * MiB;
constexpr size_t WS_O = 184 * MiB;
constexpr size_t WS_BIG = 216 * MiB;
constexpr size_t BIG_HS = WS_BIG;
constexpr size_t BIG_HID = WS_BIG + 72 * MiB;
constexpr size_t BIG_Y = WS_BIG + 90 * MiB;
constexpr size_t BIG_KV = WS_BIG + 160 * MiB;
constexpr size_t BIG_KCMP = WS_BIG + 208 * MiB;
constexpr size_t BIG_Q = WS_BIG + 210 * MiB;
constexpr size_t WS_END = 504 * MiB;
constexpr int CW_BAR = 4096;
constexpr int CW_DBG = 16384;

constexpr int LDS_MISC = 131072;
constexpr int LDS_BAR = 163840 - 16;
constexpr int LDS_BYTES = 163840;

#define MFMA32(a, b, c) __builtin_amdgcn_mfma_f32_32x32x16_bf16(a, b, c, 0, 0, 0)
__device__ __forceinline__ int crow(int r, int hi) { return (r & 3) + 8 * (r >> 2) + 4 * hi; }
__device__ __forceinline__ unsigned pk2(float lo, float hi) { unsigned r; asm("v_cvt_pk_bf16_f32 %0, %1, %2" : "=v"(r) : "v"(lo), "v"(hi)); return r; }
__device__ __forceinline__ float bf2f(unsigned short b) { return __uint_as_float(((unsigned)b) << 16); }
__device__ __forceinline__ float bflo(unsigned w) { return __uint_as_float(w << 16); }
__device__ __forceinline__ float bfhi(unsigned w) { return __uint_as_float(w & 0xffff0000u); }
__device__ __forceinline__ float ex2(float x) { return __builtin_amdgcn_exp2f(x); }
__device__ __forceinline__ float wave_sum(float v) {
    v += __uint_as_float(__builtin_amdgcn_update_dpp(0u, __float_as_uint(v), 0x128, 0xF, 0xF, true));
    v += __uint_as_float(__builtin_amdgcn_update_dpp(0u, __float_as_uint(v), 0x124, 0xF, 0xF, true));
    v += __uint_as_float(__builtin_amdgcn_update_dpp(0u, __float_as_uint(v), 0x122, 0xF, 0xF, true));
    v += __uint_as_float(__builtin_amdgcn_update_dpp(0u, __float_as_uint(v), 0x121, 0xF, 0xF, true));
    const auto rr = __builtin_amdgcn_permlane32_swap(__float_as_uint(v), __float_as_uint(v), false, false);
    v = __uint_as_float(rr[0]) + __uint_as_float(rr[1]);
    return __uint_as_float((unsigned)__builtin_amdgcn_readlane((int)__float_as_uint(v), 0)) + __uint_as_float((unsigned)__builtin_amdgcn_readlane((int)__float_as_uint(v), 16));
}
__device__ __forceinline__ s16x4 tr_read(LAS unsigned char* p) { return __builtin_bit_cast(s16x4, __builtin_amdgcn_ds_read_tr16_b64_v4i16((LAS v4i16_t*)p)); }
#define LDS_WAIT() asm volatile("s_waitcnt lgkmcnt(0)" ::: "memory")

#define XB_TMO      128
#define XB_XCNT(j)  (256  + 64 * (j))
#define XB_XSUB(j)  (1280 + 64 * (j))
#define XB_XGEN(j)  (2304 + 64 * (j))
#define XB_TOP      3328
#define XB_TOPGEN   3392
#define XCD_BAR_WORDS 3456
#define XB_SPIN_CAP (1u << 18)
__device__ __forceinline__ unsigned xb_ld(unsigned* p)              { return __hip_atomic_load(p, __ATOMIC_RELAXED, __HIP_MEMORY_SCOPE_AGENT); }
__device__ __forceinline__ unsigned xb_add(unsigned* p, unsigned v) { return __hip_atomic_fetch_add(p, v, __ATOMIC_RELAXED, __HIP_MEMORY_SCOPE_AGENT); }
__device__ __forceinline__ unsigned xb_xcc_id() { return (unsigned)__builtin_amdgcn_s_getreg((3 << 11) | 20) & 0xFu; }
#define XB_SPIN(cond, bar) do { unsigned _sp = 0; while (cond) { __builtin_amdgcn_s_sleep(1); \
    if ((++_sp & 255u) == 0u) { if (xb_ld(&(bar)[XB_TMO])) break; if (_sp > XB_SPIN_CAP) { atomicAdd(&(bar)[XB_TMO], 1u); break; } } } } while (0)
struct XcdBarrier { unsigned* bar; unsigned x; volatile LAS unsigned* st; };
__device__ __forceinline__ XcdBarrier xcd_barrier_post(unsigned* bar, volatile LAS unsigned* st) {
    XcdBarrier b; b.bar = bar; b.x = xb_xcc_id(); b.st = st;
    if (threadIdx.x == 0) (void)xb_add(&bar[XB_XCNT(b.x)], 1u);
    return b;
}
__device__ __forceinline__ void xcd_barrier_complete(unsigned* bar, unsigned x, unsigned& nloc, unsigned& nx) {
    const unsigned G = gridDim.x * gridDim.y * gridDim.z;
    unsigned sum, cnt, mine, sp = 0u;
    for (;;) {
        sum = 0u; cnt = 0u; mine = 0u;
#pragma unroll
        for (unsigned j = 0; j < 16; ++j) { const unsigned c = xb_ld(&bar[XB_XCNT(j)]); sum += c; cnt += (c > 0u) ? 1u : 0u; mine = (j == x) ? c : mine; }
        if (sum == G) break;
        __builtin_amdgcn_s_sleep(1);
        if ((++sp & 255u) == 0u) { if (xb_ld(&bar[XB_TMO])) break; if (sp > XB_SPIN_CAP) { atomicAdd(&bar[XB_TMO], 1u); break; } }
    }
    nloc = mine > 0u ? mine : 1u; nx = cnt > 0u ? cnt : 1u;
}
__device__ __forceinline__ void xcd_barrier(const XcdBarrier& b) {
    asm volatile("s_waitcnt vmcnt(0)" ::: "memory");
    __syncthreads();
    if (threadIdx.x == 0) {
        unsigned* bar = b.bar;
        __builtin_amdgcn_s_waitcnt(0);
        unsigned nloc = b.st[0], nx = b.st[1];
        if (nloc == 0u) { xcd_barrier_complete(bar, b.x, nloc, nx); b.st[0] = nloc; b.st[1] = nx; }
        const unsigned old = xb_add(&bar[XB_XSUB(b.x)], 1u);
        const unsigned gen = old / nloc;
        if (old + 1u == (gen + 1u) * nloc) {
            __builtin_amdgcn_fence(__ATOMIC_RELEASE, "agent");
            asm volatile("s_waitcnt vmcnt(0)" ::: "memory");
            const unsigned og = xb_add(&bar[XB_TOP], 1u);
            const unsigned tg = og / nx;
            if (og + 1u == (tg + 1u) * nx) xb_add(&bar[XB_TOPGEN], 1u);
            else XB_SPIN(xb_ld(&bar[XB_TOPGEN]) == tg, bar);
            __builtin_amdgcn_fence(__ATOMIC_ACQUIRE, "agent");
            xb_add(&bar[XB_XGEN(b.x)], 1u);
            asm volatile("s_waitcnt vmcnt(0)" ::: "memory");
        } else {
            XB_SPIN(xb_ld(&bar[XB_XGEN(b.x)]) == gen, bar);
            __builtin_amdgcn_fence(__ATOMIC_ACQUIRE, "agent");
            asm volatile("s_waitcnt vmcnt(0)" ::: "memory");
        }
    }
    __syncthreads();
}

struct TcRegs { float v[32]; };
__device__ __forceinline__ void tc_load(TcRegs& R, const float* src, int ld, int srccol0, int nvalid, int kb, int lane) {
    const int k0 = 64 * kb, n = lane & 31; const float* p = src + (size_t)(k0 + (lane >> 5)) * ld + srccol0 + n;
#pragma unroll
    for (int i = 0; i < 32; ++i) R.v[i] = (n < nvalid) ? p[(size_t)(2 * i) * ld] : 0.f;
}
__device__ __forceinline__ void tc_finish(const TcRegs& R, int K, bf16* dst, int dstrow0, int kb, LAS float* scr, int lane) {
    const int k0 = 64 * kb;
#pragma unroll
    for (int i = 0; i < 32; ++i) scr[(2 * i + (lane >> 5)) * 33 + (lane & 31)] = R.v[i];
    LDS_WAIT();
    const int c = lane & 7;
#pragma unroll
    for (int j = 0; j < 4; ++j) { const int n = (lane >> 3) + 8 * j; const LAS float* s = scr + (8 * c) * 33 + n;
        u32x4 o; o.x = pk2(s[0 * 33], s[1 * 33]); o.y = pk2(s[2 * 33], s[3 * 33]); o.z = pk2(s[4 * 33], s[5 * 33]); o.w = pk2(s[6 * 33], s[7 * 33]);
        *(u32x4*)(dst + (size_t)(dstrow0 + n) * K + k0 + 8 * c) = o; }
    LDS_WAIT();
}
template <class Desc>
__device__ __forceinline__ void tc_stream(int nitems, int gw, int NGW, LAS float* scr, int lane, Desc desc) {
    const float* srcA; int ldA, KA, c0A, nvA, r0A, kbA; bf16* dstA; const float* srcB; int ldB, KB, c0B, nvB, r0B, kbB; bf16* dstB;
    TcRegs A, B;
    int it = gw; if (it >= nitems) return;
    desc(it, srcA, ldA, KA, c0A, nvA, dstA, r0A, kbA); tc_load(A, srcA, ldA, c0A, nvA, kbA, lane);
#pragma nounroll
    for (;;) {
        const int itB = it + NGW; const bool hb = itB < nitems;
        if (hb) { desc(itB, srcB, ldB, KB, c0B, nvB, dstB, r0B, kbB); tc_load(B, srcB, ldB, c0B, nvB, kbB, lane); }
        tc_finish(A, KA, dstA, r0A, kbA, scr, lane);
        if (!hb) break;
        const int itA = itB + NGW; const bool ha = itA < nitems;
        if (ha) { desc(itA, srcA, ldA, KA, c0A, nvA, dstA, r0A, kbA); tc_load(A, srcA, ldA, c0A, nvA, kbA, lane); }
        tc_finish(B, KB, dstB, r0B, kbB, scr, lane);
        if (!ha) break;
        it = itA;
    }
}
__device__ __forceinline__ void tc_matrix(const float* src, int ld, int K, int col0, int ncolvalid, bf16* dst, int nrows, LAS float* scr, int lane, int gw, int NGW) {
    const int nkb = K / 64, nnb = nrows / 32;
    tc_stream(nkb * nnb, gw, NGW, scr, lane, [=](int it, const float*& s_, int& ld_, int& K_, int& c0_, int& nv_, bf16*& d_, int& r0_, int& kb_) {
        const int kb = it / nnb, nb = it % nnb; int nv = ncolvalid - 32 * nb; nv = nv < 0 ? 0 : (nv > 32 ? 32 : nv);
        s_ = src; ld_ = ld; K_ = K; c0_ = col0 + 32 * nb; nv_ = nv; d_ = dst; r0_ = 32 * nb; kb_ = kb; });
}
__device__ __forceinline__ void convert_moe_weights(const float* gu, const float* dn, bf16* WGU, bf16* WDN, LAS float* scr, int lane, int gw, int NGW) {
    tc_stream(16 * 256 + 16 * 128, gw, NGW, scr, lane, [=](int it, const float*& s_, int& ld_, int& K_, int& c0_, int& nv_, bf16*& d_, int& r0_, int& kb_) {
        if (it < 4096) { const int e = it >> 8, r = it & 255, kb = r >> 4, nb = r & 15, rho0 = 32 * nb, ct = rho0 >> 8, half = (rho0 >> 7) & 1, x0 = rho0 & 127;
            s_ = gu + (size_t)e * 1024 * 512; ld_ = 512; K_ = 1024; c0_ = half * 256 + 128 * ct + x0; nv_ = 32; d_ = WGU + (size_t)e * 512 * 1024; r0_ = rho0; kb_ = kb; }
        else { const int i2 = it - 4096, e = i2 >> 7, r = i2 & 127, kb = r >> 5, nb = r & 31;
            s_ = dn + (size_t)e * 256 * 1024; ld_ = 1024; K_ = 256; c0_ = 32 * nb; nv_ = 32; d_ = WDN + (size_t)e * 1024 * 256; r0_ = 32 * nb; kb_ = kb; } });
}

#define ATT_V2 1
#ifndef WINCORE
#define WINCORE attn_core_d
#endif
#ifndef SLCCORE
#define SLCCORE attn_core_d
#endif
#ifndef STATCORE
#define STATCORE stats_core_d
#endif
#ifndef CMP2_NEW
#define CMP2_NEW 1
#endif
#ifndef REP_SLC
#define REP_SLC 1
#endif
#ifndef REP_WIN
#define REP_WIN 1
#endif
#ifndef REP_SEL
#define REP_SEL 1
#endif
#ifndef REP_CMP
#define REP_CMP 1
#endif
struct KVT { bf16x8 k[4]; u32x4 v[4]; };
template <class RowF>
__device__ __forceinline__ void kv_load(KVT& T, const bf16* kbase, const bf16* vbase, RowF rowf, int lane) {
#pragma unroll
    for (int i = 0; i < 4; ++i) { const size_t ro = rowf(8 * i + (lane >> 3)) + 8 * (lane & 7); T.k[i] = *(const bf16x8*)(kbase + ro); T.v[i] = *(const u32x4*)(vbase + ro); }
#if defined(LOAD_REP)
#pragma unroll
    for (int i = 0; i < 4; ++i) { const size_t ro = rowf(8 * i + (lane >> 3)) + 8 * (lane & 7); u32x4 a, b;
        asm volatile("global_load_dwordx4 %0, %2, off sc1\n\tglobal_load_dwordx4 %1, %3, off sc1\n\ts_waitcnt vmcnt(0)" : "=&v"(a), "=&v"(b) : "v"(kbase + ro), "v"(vbase + ro) : "memory"); }
#endif
}
template <class RowF>
__device__ __forceinline__ void k_load(bf16x8 (&k)[4], const bf16* kbase, RowF rowf, int lane) {
#pragma unroll
    for (int i = 0; i < 4; ++i) k[i] = *(const bf16x8*)(kbase + rowf(8 * i + (lane >> 3)) + 8 * (lane & 7));
}
__device__ __forceinline__ void k_stage(const bf16x8 (&k)[4], LAS unsigned char* ks, int lane) {
#pragma unroll
    for (int i = 0; i < 4; ++i) { const int key = 8 * i + (lane >> 3), c = lane & 7; *(LAS bf16x8*)(ks + key * 128 + ((c ^ (key & 7)) << 4)) = k[i]; }
}
__device__ __forceinline__ void k_frags(bf16x8 (&kf)[4], LAS unsigned char* ks, int lane) {
    const int key = lane & 31, hi = lane >> 5;
    asm volatile("" ::: "memory");
#pragma unroll
    for (int s = 0; s < 4; ++s) kf[s] = *(const LAS bf16x8*)(ks + key * 128 + (((2 * s + hi) ^ (key & 7)) << 4));
}
__device__ __forceinline__ void q_load(bf16x8 (&q)[4], const bf16* qrow, int lane) {
    const int hi = lane >> 5;
#pragma unroll
    for (int s = 0; s < 4; ++s) q[s] = *(const bf16x8*)(qrow + 16 * s + 8 * hi);
}
__device__ __forceinline__ void v_stage(const KVT& T, LAS unsigned char* vs, int lane) {
#pragma unroll
    for (int i = 0; i < 4; ++i) { const int key = 8 * i + (lane >> 3), c = lane & 7; *(LAS u32x4*)(vs + (c >> 2) * 2048 + key * 64 + (c & 3) * 16) = T.v[i]; }
}
struct VF { bf16x8 f[2][2]; };
__device__ __forceinline__ void v_frags(VF& V, LAS unsigned char* vs, int lane) {
    const int hi = lane >> 5;
    LAS unsigned char* vp = vs + ((lane >> 4) & 1) * 32 + (lane & 3) * 8 + (4 * hi + ((lane & 15) >> 2)) * 64;
    asm volatile("" ::: "memory");
#pragma unroll
    for (int db = 0; db < 2; ++db)
#pragma unroll
        for (int s2 = 0; s2 < 2; ++s2) { const s16x4 lo = tr_read(vp + db * 2048 + s2 * 1024), h4 = tr_read(vp + db * 2048 + s2 * 1024 + 512);
            V.f[db][s2] = (bf16x8){lo[0], lo[1], lo[2], lo[3], h4[0], h4[1], h4[2], h4[3]}; }
    asm volatile("" ::: "memory");
}
__device__ __forceinline__ void pv_mma(const f32x16& p, const VF& V, f32x16 (&o)[2]) {
    u32x4 w0, w1;
    w0.x = pk2(p[0], p[1]); w0.y = pk2(p[2], p[3]); w0.z = pk2(p[4], p[5]); w0.w = pk2(p[6], p[7]);
    w1.x = pk2(p[8], p[9]); w1.y = pk2(p[10], p[11]); w1.z = pk2(p[12], p[13]); w1.w = pk2(p[14], p[15]);
    const bf16x8 pf0 = __builtin_bit_cast(bf16x8, w0), pf1 = __builtin_bit_cast(bf16x8, w1);
    o[0] = MFMA32(V.f[0][0], pf0, o[0]); o[1] = MFMA32(V.f[1][0], pf0, o[1]);
    o[0] = MFMA32(V.f[0][1], pf1, o[0]); o[1] = MFMA32(V.f[1][1], pf1, o[1]);
}
__device__ __forceinline__ void pv_acc(const f32x16& p, LAS unsigned char* vs, int lane, f32x16 (&o)[2]) { VF V; v_frags(V, vs, lane); pv_mma(p, V, o); }
__device__ __forceinline__ float xhalf_max(float v) {
    const auto rr = __builtin_amdgcn_permlane32_swap(__float_as_uint(v), __float_as_uint(v), false, false);
    return fmaxf(__uint_as_float(rr[0]), __uint_as_float(rr[1]));
}
__device__ __forceinline__ f32x16 qk_tile(const bf16x8 (&qf)[4], const bf16x8 (&kf)[4]) {
    f32x16 s;
#pragma unroll
    for (int r = 0; r < 16; ++r) s[r] = 0.f;
#pragma unroll
    for (int d0 = 0; d0 < 4; ++d0) s = MFMA32(kf[d0], qf[d0], s);
    return s;
}
struct TileP { float base, sd; int dist0, dd, lim; };
typedef float f32x2 __attribute__((ext_vector_type(2)));
constexpr float QMUL = 1.0f;
template <bool MASK>
__device__ __forceinline__ void scores(f32x16& s, const TileP P) {
    const f32x2 c1 = {QMUL, QMUL}, sd2 = {P.sd, P.sd};
#pragma unroll
    for (int r = 0; r < 16; r += 2) { const int cr = (r & 3) + 8 * (r >> 2);
        const f32x2 crv = {(float)cr, (float)(cr + 1)}, b2 = {P.base, P.base};
        const f32x2 raw = {s[r], s[r + 1]};
        f32x2 x = __builtin_elementwise_fma(raw, c1, __builtin_elementwise_fma(sd2, crv, b2));
        if (MASK) { const bool ok0 = (unsigned)(P.dist0 - P.dd * cr) <= (unsigned)P.lim, ok1 = (unsigned)(P.dist0 - P.dd * (cr + 1)) <= (unsigned)P.lim; x.x = ok0 ? x.x : -INFINITY; x.y = ok1 ? x.y : -INFINITY; }
        s[r] = x.x; s[r + 1] = x.y; }
}
__device__ __forceinline__ float exp_sum(f32x16& s, float mn) {
    const f32x2 m2 = {mn, mn}; f32x2 acc = {0.f, 0.f};
#pragma unroll
    for (int r = 0; r < 16; r += 2) { f32x2 x = {s[r], s[r + 1]}; x = x - m2; f32x2 e; e.x = ex2(x.x); e.y = ex2(x.y); acc = acc + e; s[r] = e.x; s[r + 1] = e.y; }
    return acc.x + acc.y;
}
template <bool MASK>
__device__ __forceinline__ void attn_core(const bf16x8 (&qf)[4], LAS unsigned char* tl, int lane, float& m, float& l, f32x16 (&o)[2], const TileP P) {
    bf16x8 kf[4]; k_frags(kf, tl + 4096, lane);
    VF V; v_frags(V, tl, lane);
    f32x16 s = qk_tile(qf, kf);
    scores<MASK>(s, P);
    float mx = fmaxf(fmaxf(fmaxf(s[0], s[1]), fmaxf(s[2], s[3])), fmaxf(fmaxf(s[4], s[5]), fmaxf(s[6], s[7])));
    mx = fmaxf(mx, fmaxf(fmaxf(fmaxf(s[8], s[9]), fmaxf(s[10], s[11])), fmaxf(fmaxf(s[12], s[13]), fmaxf(s[14], s[15]))));
    mx = xhalf_max(mx);
    const float mn = fmaxf(m, mx);
    if (__builtin_amdgcn_ballot_w64(mn > m)) { const float alpha = ex2(m - mn); l *= alpha;
#pragma unroll
        for (int r = 0; r < 16; ++r) { o[0][r] *= alpha; o[1][r] *= alpha; } }
    m = mn;
    l += exp_sum(s, mn);
    pv_mma(s, V, o);
}
template <bool MASK>
__device__ __forceinline__ void attn_tile(const bf16x8 (&qf)[4], const KVT& T, LAS unsigned char* vs, int lane, float& m, float& l, f32x16 (&o)[2], const TileP P) {
    v_stage(T, vs, lane); k_stage(T.k, vs + 4096, lane);
    attn_core<MASK>(qf, vs, lane, m, l, o, P);
}
template <bool MASK>
__device__ __forceinline__ void stats_core(const bf16x8 (&qf)[4], LAS unsigned char* tl, int lane, float& m, float& l, const TileP P) {
    bf16x8 kf[4]; k_frags(kf, tl + 4096, lane);
    f32x16 s = qk_tile(qf, kf);
    scores<MASK>(s, P);
    float mx = -INFINITY;
#pragma unroll
    for (int r = 0; r < 16; ++r) mx = fmaxf(mx, s[r]);
    mx = xhalf_max(mx);
    const float mn = fmaxf(m, mx); l *= ex2(m - mn); m = mn;
    float ps = 0.f;
#pragma unroll
    for (int r = 0; r < 16; ++r) ps += ex2(s[r] - mn);
    l += ps;
}
template <bool MASK>
__device__ __forceinline__ void stats_tile(const bf16x8 (&qf)[4], const bf16x8 (&kraw)[4], LAS unsigned char* vs, int lane, float& m, float& l, const TileP P) {
    k_stage(kraw, vs + 4096, lane); stats_core<MASK>(qf, vs, lane, m, l, P);
}
constexpr float SM_THR = 8.0f;
template <bool MASK>
__device__ __forceinline__ f32x16 qk_scores_d(const bf16x8 (&qf)[4], const bf16x8 (&kf)[4], const TileP P, float mref) {
    f32x16 s; const float b0 = P.base - mref;
#pragma unroll
    for (int r = 0; r < 16; ++r) { const int cr = (r & 3) + 8 * (r >> 2);
        float x = fmaf(P.sd, (float)cr, b0);
        if (MASK) { const bool ok = (unsigned)(P.dist0 - P.dd * cr) <= (unsigned)P.lim; x = ok ? x : -INFINITY; }
        s[r] = x; }
#pragma unroll
    for (int d0 = 0; d0 < 4; ++d0) s = MFMA32(kf[d0], qf[d0], s);
    return s;
}
template <bool MASK>
__device__ __forceinline__ void attn_core_d(const bf16x8 (&qf)[4], LAS unsigned char* tl, int lane, float& m, float& l, f32x16 (&o)[2], const TileP P) {
    bf16x8 kf[4]; k_frags(kf, tl + 4096, lane);
    VF V; v_frags(V, tl, lane);
    const bool seeded = m > -1e29f; const float mref = seeded ? m : 0.f;
    f32x16 s = qk_scores_d<MASK>(qf, kf, P, mref);
    float mx = fmaxf(fmaxf(fmaxf(s[0], s[1]), fmaxf(s[2], s[3])), fmaxf(fmaxf(s[4], s[5]), fmaxf(s[6], s[7])));
    mx = fmaxf(mx, fmaxf(fmaxf(fmaxf(s[8], s[9]), fmaxf(s[10], s[11])), fmaxf(fmaxf(s[12], s[13]), fmaxf(s[14], s[15]))));
    mx = xhalf_max(mx);
    const bool need = seeded ? (mx > SM_THR) : (mx > -INFINITY);
    if (__builtin_amdgcn_ballot_w64(need)) {
        const float dl = need ? mx : 0.f, f = (need && seeded) ? ex2(-dl) : 1.0f;
        m = need ? mref + dl : m; l *= f;
#pragma unroll
        for (int r = 0; r < 16; ++r) { o[0][r] *= f; o[1][r] *= f; s[r] -= dl; }
    }
    l += exp_sum(s, 0.f);
    pv_mma(s, V, o);
}
template <bool MASK>
__device__ __forceinline__ void stats_core_d(const bf16x8 (&qf)[4], LAS unsigned char* tl, int lane, float& m, float& l, const TileP P) {
    bf16x8 kf[4]; k_frags(kf, tl + 4096, lane);
    const bool seeded = m > -1e29f; const float mref = seeded ? m : 0.f;
    f32x16 s = qk_scores_d<MASK>(qf, kf, P, mref);
    float mx = fmaxf(fmaxf(fmaxf(s[0], s[1]), fmaxf(s[2], s[3])), fmaxf(fmaxf(s[4], s[5]), fmaxf(s[6], s[7])));
    mx = fmaxf(mx, fmaxf(fmaxf(fmaxf(s[8], s[9]), fmaxf(s[10], s[11])), fmaxf(fmaxf(s[12], s[13]), fmaxf(s[14], s[15]))));
    mx = xhalf_max(mx);
    const bool need = seeded ? (mx > SM_THR) : (mx > -INFINITY);
    if (__builtin_amdgcn_ballot_w64(need)) {
        const float dl = need ? mx : 0.f, f = (need && seeded) ? ex2(-dl) : 1.0f;
        m = need ? mref + dl : m; l *= f;
#pragma unroll
        for (int r = 0; r < 16; ++r) s[r] -= dl;
    }
    l += exp_sum(s, 0.f);
}
__device__ __forceinline__ float quad_sum(float x) {
    x += __uint_as_float(__builtin_amdgcn_update_dpp(0u, __float_as_uint(x), 0xB1, 0xF, 0xF, true));
    x += __uint_as_float(__builtin_amdgcn_update_dpp(0u, __float_as_uint(x), 0x4E, 0xF, 0xF, true));
    return x;
}
__device__ __forceinline__ float xhalf_other(float v, int hi) {
    const auto rr = __builtin_amdgcn_permlane32_swap(__float_as_uint(v), __float_as_uint(v), false, false);
    return __uint_as_float(hi ? rr[0] : rr[1]);
}
__device__ __forceinline__ float max16p(const f32x16& s) {
    const float mx = fmaxf(fmaxf(fmaxf(s[0], s[1]), fmaxf(s[2], s[3])), fmaxf(fmaxf(s[4], s[5]), fmaxf(s[6], s[7])));
    return fmaxf(mx, fmaxf(fmaxf(fmaxf(s[8], s[9]), fmaxf(s[10], s[11])), fmaxf(fmaxf(s[12], s[13]), fmaxf(s[14], s[15]))));
}
template <bool MASKA, bool MASKB>
__device__ __forceinline__ void attn_core2_d(const bf16x8 (&qf)[4], LAS unsigned char* ta, LAS unsigned char* tb, int lane, float& m, float& l, f32x16 (&o)[2], const TileP PA, const TileP PB) {
    bf16x8 kfa[4], kfb[4]; k_frags(kfa, ta + 4096, lane); k_frags(kfb, tb + 4096, lane);
    VF VA, VB; v_frags(VA, ta, lane); v_frags(VB, tb, lane);
    const bool seeded = m > -1e29f; const float mref = seeded ? m : 0.f;
    f32x16 sa = qk_scores_d<MASKA>(qf, kfa, PA, mref);
    f32x16 sb = qk_scores_d<MASKB>(qf, kfb, PB, mref);
    const float mx = xhalf_max(fmaxf(max16p(sa), max16p(sb)));
    const bool need = seeded ? (mx > SM_THR) : (mx > -INFINITY);
    if (__builtin_amdgcn_ballot_w64(need)) {
        const float dl = need ? mx : 0.f, f = (need && seeded) ? ex2(-dl) : 1.0f;
        m = need ? mref + dl : m; l *= f;
#pragma unroll
        for (int r = 0; r < 16; ++r) { o[0][r] *= f; o[1][r] *= f; sa[r] -= dl; sb[r] -= dl; }
    }
    l += exp_sum(sa, 0.f) + exp_sum(sb, 0.f);
    pv_mma(sa, VA, o); pv_mma(sb, VB, o);
}
template <bool MASKA, bool MASKB>
__device__ __forceinline__ void stats_core2_d(const bf16x8 (&qf)[4], LAS unsigned char* ta, LAS unsigned char* tb, int lane, float& m, float& l, const TileP PA, const TileP PB) {
    bf16x8 kfa[4], kfb[4]; k_frags(kfa, ta + 4096, lane); k_frags(kfb, tb + 4096, lane);
    const bool seeded = m > -1e29f; const float mref = seeded ? m : 0.f;
    f32x16 sa = qk_scores_d<MASKA>(qf, kfa, PA, mref);
    f32x16 sb = qk_scores_d<MASKB>(qf, kfb, PB, mref);
    const float mx = xhalf_max(fmaxf(max16p(sa), max16p(sb)));
    const bool need = seeded ? (mx > SM_THR) : (mx > -INFINITY);
    if (__builtin_amdgcn_ballot_w64(need)) {
        const float dl = need ? mx : 0.f, f = (need && seeded) ? ex2(-dl) : 1.0f;
        m = need ? mref + dl : m; l *= f;
#pragma unroll
        for (int r = 0; r < 16; ++r) { sa[r] -= dl; sb[r] -= dl; }
    }
    l += exp_sum(sa, 0.f) + exp_sum(sb, 0.f);
}
template <bool WITH_V, class RowF, class Compute>
__device__ __forceinline__ void shared_pairs(int n, LAS unsigned char* lds, int slab_stride, const bf16* kbase, const bf16* vbase, RowF rowf, int wave, int lane, Compute compute) {
    if (n <= 0) return;
    const int ns = (n + 1) >> 1;
    const int lw = wave & 3; const bool isv = wave >= 4;
    const int key = 8 * lw + (lane >> 3), c = lane & 7;
    const int woff = isv ? ((c >> 2) * 2048 + key * 64 + (c & 3) * 16) : (4096 + key * 128 + ((c ^ (key & 7)) << 4));
    const bf16* base = isv ? vbase : kbase;
    const bool active = WITH_V || !isv;
    auto img = [&](int b, int x) { return lds + (2 * b + x) * slab_stride; };
    auto ld = [&](int t) { const int tc = t < n ? t : n - 1; return *(const u32x4*)(base + rowf(tc, key) + 8 * c); };
    u32x4 R0 = {0u, 0u, 0u, 0u}, R1 = R0;
    __syncthreads();
    if (active) { R0 = ld(0); R1 = ld(1); *(LAS u32x4*)(img(0, 0) + woff) = R0; *(LAS u32x4*)(img(0, 1) + woff) = R1; }
    if (ns > 1 && active) { R0 = ld(2); R1 = ld(3); }
    __syncthreads();
#pragma nounroll
    for (int s = 0; s < ns; ++s) {
        if (s + 1 < ns && active) { *(LAS u32x4*)(img((s + 1) & 1, 0) + woff) = R0; *(LAS u32x4*)(img((s + 1) & 1, 1) + woff) = R1; }
        if (s + 2 < ns && active) { R0 = ld(2 * s + 4); R1 = ld(2 * s + 5); }
        compute(img(s & 1, 0), (2 * s + 1 < n) ? img(s & 1, 1) : (LAS unsigned char*)nullptr, s);
        __syncthreads();
    }
}
struct KV2 { bf16x8 k[2][4]; u32x4 v[2][4]; };
__device__ __forceinline__ void v_stage_raw(const u32x4 (&v)[4], LAS unsigned char* vs, int lane) {
#pragma unroll
    for (int i = 0; i < 4; ++i) { const int key = 8 * i + (lane >> 3), c = lane & 7; *(LAS u32x4*)(vs + (c >> 2) * 2048 + key * 64 + (c & 3) * 16) = v[i]; }
}
template <bool MASK>
__device__ __forceinline__ void pair_qk(const bf16x8 (&qf)[4], LAS unsigned char* vs, int lane, float mref, const TileP PA, const TileP PB, f32x16& sa, f32x16& sb) {
    { bf16x8 kf[4]; k_frags(kf, vs, lane); sa = qk_scores_d<MASK>(qf, kf, PA, mref); }
    { bf16x8 kf[4]; k_frags(kf, vs + 4096, lane); sb = qk_scores_d<MASK>(qf, kf, PB, mref); }
    asm volatile("" ::: "memory");
}
__device__ __forceinline__ void pair_sm_pv(f32x16& sa, f32x16& sb, LAS unsigned char* vs, int lane, float& m, float& l, f32x16 (&o)[2], bool seeded, float mref) {
    const float mx = xhalf_max(fmaxf(max16p(sa), max16p(sb)));
    const bool need = seeded ? (mx > SM_THR) : (mx > -INFINITY);
    if (__builtin_amdgcn_ballot_w64(need)) {
        const float dl = need ? mx : 0.f, f = (need && seeded) ? ex2(-dl) : 1.0f;
        m = need ? mref + dl : m; l *= f;
#pragma unroll
        for (int r = 0; r < 16; ++r) { o[0][r] *= f; o[1][r] *= f; sa[r] -= dl; sb[r] -= dl; }
    }
    l += exp_sum(sa, 0.f) + exp_sum(sb, 0.f);
    { VF V; v_frags(V, vs, lane); pv_mma(sa, V, o); }
    { VF V; v_frags(V, vs + 4096, lane); pv_mma(sb, V, o); }
    asm volatile("" ::: "memory");
}
template <class Issue, class Stage, class Compute>
__device__ __forceinline__ void pipe_tiles1(int n, Issue issue, Stage stage, Compute compute) {
    if (n <= 0) return;
    KVT T; issue(T, 0);
#pragma nounroll
    for (int i = 0; i < n; ++i) { stage(T, i); if (i + 1 < n) issue(T, i + 1); compute(i); }
}
template <class Issue, class Stage, class Compute>
__device__ __forceinline__ void pipe_tiles2(int n, Issue issue, Stage stage, Compute compute) {
    if (n <= 0) return;
    KVT A, B; issue(A, 0); if (n > 1) issue(B, 1);
    int i = 0;
#pragma nounroll
    for (; i + 1 < n; i += 2) { stage(A, i); if (i + 2 < n) issue(A, i + 2); compute(i); stage(B, i + 1); if (i + 3 < n) issue(B, i + 3); compute(i + 1); }
    if (i < n) { stage(A, i); compute(i); }
}
template <bool WITH_V, class RowF, class Compute>
__device__ __forceinline__ void shared_tiles(int n, LAS unsigned char* sh, const bf16* kbase, const bf16* vbase, RowF rowf, int wave, int lane, Compute compute) {
    if (n <= 0) return;
    const int lw = wave & 3; const bool isv = wave >= 4;
    const int key = 8 * lw + (lane >> 3), c = lane & 7;
    const int woff = isv ? ((c >> 2) * 2048 + key * 64 + (c & 3) * 16) : (4096 + key * 128 + ((c ^ (key & 7)) << 4));
    const bf16* base = isv ? vbase : kbase;
    const bool active = WITH_V || !isv;
    u32x4 RA = {0u, 0u, 0u, 0u}, RB = RA;
    if (active) { RA = *(const u32x4*)(base + rowf(0, key) + 8 * c); *(LAS u32x4*)(sh + woff) = RA; }
    if (n > 1 && active) RA = *(const u32x4*)(base + rowf(1, key) + 8 * c);
    if (n > 2 && active) RB = *(const u32x4*)(base + rowf(2, key) + 8 * c);
    __syncthreads();
    int i = 0;
#pragma nounroll
    for (; i + 1 < n; i += 2) {
        if (active) *(LAS u32x4*)(sh + ((i + 1) & 1) * 8192 + woff) = RA;
        if (i + 3 < n && active) RA = *(const u32x4*)(base + rowf(i + 3, key) + 8 * c);
        compute(sh + (i & 1) * 8192, i);
        __syncthreads();
        if (i + 2 < n && active) *(LAS u32x4*)(sh + (i & 1) * 8192 + woff) = RB;
        if (i + 4 < n && active) RB = *(const u32x4*)(base + rowf(i + 4, key) + 8 * c);
        compute(sh + ((i + 1) & 1) * 8192, i + 1);
        __syncthreads();
    }
    if (i < n) { compute(sh + (i & 1) * 8192, i); __syncthreads(); }
}
struct KT { bf16x8 k[4]; };
__device__ __forceinline__ void o_store(const f32x16 (&o)[2], bf16* orow, int hi) {
#pragma unroll
    for (int db = 0; db < 2; ++db)
#pragma unroll
        for (int k = 0; k < 4; ++k) { u32x2 w; w.x = pk2(o[db][4 * k], o[db][4 * k + 1]); w.y = pk2(o[db][4 * k + 2], o[db][4 * k + 3]); *(u32x2*)(orow + 32 * db + 8 * k + 4 * hi) = w; }
}
template <class Buf, class Issue, class Compute>
__device__ __forceinline__ void pipe_tiles(int n, Issue issue, Compute compute) {
    if (n <= 0) return;
    Buf A, B; issue(A, 0);
    int i = 0;
#pragma nounroll
    for (; i + 1 < n; i += 2) { issue(B, i + 1); compute(A, i); if (i + 2 < n) issue(A, i + 2); compute(B, i + 1); }
    if (i < n) compute(A, i);
}

constexpr int DST = 68, DIL_VS = 256 * DST * 4;
__device__ __forceinline__ void dil_block(const bf16* qkv, bf16* O, int b, int h, LAS unsigned char* lds, int wave, int lane) {
    LAS float* ST = (LAS float*)lds;
    LAS unsigned char* vs = lds + DIL_VS + wave * 8192;
    const int hi = lane >> 5, c = lane & 31;
    const float slope2 = exp2f(-0.5f * (float)(h + 1)) * LOG2E;
    float m = -1e30f, l = 0.f; f32x16 o[2];
    auto seg_g = [](int seg) { return seg < 2 ? seg : 2; };
    auto seg_tau = [&](int seg, int col) { return seg == 0 ? 32 * wave + col : (seg == 1 ? 128 * (wave >> 2) + (wave & 3) + 4 * col : (2 * wave + (seg - 2)) + 16 * (col & 15)); };
    bf16x8 qf[4];
    auto issue = [&](KVT& T, int t) {
        const int seg = t / 5, j = t - 5 * seg;
        const int g = seg_g(seg), d = 1 << (2 * g), W = 128 << (2 * g);
        const int tlo = 256 * b + seg_tau(seg, 0) - W + 32 * d * j;
        const bf16* kb = qkv + (size_t)((g * 3 + 1) * 16 + h) * ((size_t)SEQ * 64);
        kv_load(T, kb, kb + (size_t)16 * SEQ * 64, [&](int key) { int tk = tlo + d * key; tk = tk < 0 ? 0 : (tk > SEQ - 1 ? SEQ - 1 : tk); return (size_t)tk * 64; }, lane);
    };
    auto issue_q = [&](bf16x8 (&q)[4], int seg) { const int g = seg_g(seg); q_load(q, qkv + (size_t)((g * 3) * 16 + h) * ((size_t)SEQ * 64) + (size_t)(256 * b + seg_tau(seg, c)) * 64, lane); };
    auto compute = [&](int t) {
        const int seg = t / 5, j = t - 5 * seg;
        const int g = seg_g(seg), d = 1 << (2 * g), W = 128 << (2 * g);
        const int tau = seg_tau(seg, c), tq = 256 * b + tau;
        if (j == 0) {
            issue_q(qf, seg);
            if (seg == 0) {
                m = -1e30f; l = 0.f;
#pragma unroll
                for (int r = 0; r < 16; ++r) { o[0][r] = 0.f; o[1][r] = 0.f; }
            } else {
                if (seg <= 2) __syncthreads();
                const LAS float* sp = ST + tau * DST;
#pragma unroll
                for (int db = 0; db < 2; ++db)
#pragma unroll
                    for (int k = 0; k < 4; ++k) { const f32x4 v = *(const LAS f32x4*)(sp + 32 * db + 8 * k + 4 * hi); o[db][4 * k] = v[0]; o[db][4 * k + 1] = v[1]; o[db][4 * k + 2] = v[2]; o[db][4 * k + 3] = v[3]; }
                m = sp[64]; l = sp[65 + hi];
            }
        }
        const int tlo = 256 * b + seg_tau(seg, 0) - W + 32 * d * j, thi = tlo + 31 * d;
        if (thi >= 0) {
            TileP P; P.dist0 = tq - tlo - 4 * hi * d; P.dd = d; P.lim = W < tq ? W : tq; P.base = -slope2 * (float)P.dist0; P.sd = slope2 * (float)d;
            if (j >= 1 && j <= 3 && tlo >= 0) attn_core_d<false>(qf, vs, lane, m, l, o, P);
            else attn_core_d<true>(qf, vs, lane, m, l, o, P);
        }
        if (j == 4) {
            if (seg < 2) {
                LAS float* sp = ST + tau * DST;
#pragma unroll
                for (int db = 0; db < 2; ++db)
#pragma unroll
                    for (int k = 0; k < 4; ++k) { const f32x4 v = {o[db][4 * k], o[db][4 * k + 1], o[db][4 * k + 2], o[db][4 * k + 3]}; *(LAS f32x4*)(sp + 32 * db + 8 * k + 4 * hi) = v; }
                if (hi == 0) sp[64] = m;
                sp[65 + hi] = l;
            } else {
                const float lt = l + __shfl_xor(l, 32), inv = 1.0f / lt;
#pragma unroll
                for (int r = 0; r < 16; ++r) { o[0][r] *= inv; o[1][r] *= inv; }
                if (c < 16) o_store(o, O + (size_t)tq * DM + h * 64, hi);
            }
        }
    };
    pipe_tiles1(20, issue, [&](KVT& T, int) { v_stage(T, vs, lane); k_stage(T.k, vs + 4096, lane); }, compute);
    __syncthreads();
}

constexpr int SL_S = 8192, SL_SEL = SL_S + 8 * 257 * 4, SL_UB = SL_SEL + 256, NSA_SLAB = 17920;
__device__ __forceinline__ void nsa_item(const bf16* Q, const bf16* KV, const bf16* KC, const bf16* VC, const float* GATES, bf16* O, int tt, int g, LAS unsigned char* slab, int lane) {
    const int hi = lane >> 5, col = lane & 31, ti = col >> 2, r4 = col & 3, hh = 4 * g + r4;
    const int tq = 8 * tt + ti, tq0 = 8 * tt, tqmax = 8 * tt + 7;
    const float slope2 = exp2f(-0.5f * (float)(hh + 1)) * LOG2E;
    LAS unsigned char* vs = slab;
    LAS float* S = (LAS float*)(slab + SL_S);
    LAS unsigned* SEL = (LAS unsigned*)(slab + SL_SEL);
    LAS int* UB = (LAS int*)(slab + SL_UB);
    bf16x8 qf[4]; q_load(qf, Q + (size_t)hh * ((size_t)SEQ * 64) + (size_t)tq * 64, lane);
    const float* gt = GATES + (size_t)tq * 48 + g * 4 + r4;
    f32x16 oacc[2];
    for (int i = lane; i < 8 * 257; i += 64) S[i] = 0.f;
    const int ncmp = (tqmax >= 31) ? (((tqmax - 31) >> 4) + 1) : 0;
    const int ntc = (ncmp + 31) >> 5;
    auto crow_of = [&](int t2) { return [=](int key) { int cc = 32 * t2 + key; cc = cc > 1022 ? 1022 : cc; return (size_t)(cc * 4 + g) * 64; }; };
    auto cmp_P = [&](int t2) { TileP P; P.dist0 = tq - 31 - 16 * (32 * t2 + 4 * hi); P.dd = 16; P.lim = 0x3fffffff; P.base = -slope2 * (float)P.dist0; P.sd = slope2 * 16.f; return P; };
    auto cmp_interior = [&](int t2) { return 16 * (32 * t2 + 31) + 31 <= tq0; };
    for (int rep_ = 0; rep_ < REP_CMP; ++rep_) {
        float m = -1e30f, l = 0.f;
        pipe_tiles<KT>(ntc, [&](KT& T, int t2) { k_load(T.k, KC, crow_of(t2), lane); },
                       [&](KT& T, int t2) { const TileP P = cmp_P(t2);
                           if (cmp_interior(t2)) stats_tile<false>(qf, T.k, vs, lane, m, l, P); else stats_tile<true>(qf, T.k, vs, lane, m, l, P); });
        l += __shfl_xor(l, 32);
        const float linv = (l > 0.f) ? 1.0f / l : 0.f;
        f32x16 oc[2];
#pragma unroll
        for (int r = 0; r < 16; ++r) { oc[0][r] = 0.f; oc[1][r] = 0.f; }
        float carry = 0.f;
        pipe_tiles<KVT>(ntc, [&](KVT& T, int t2) { kv_load(T, KC, VC, crow_of(t2), lane); }, [&](KVT& T, int t2) {
            v_stage(T, vs, lane); k_stage(T.k, vs + 4096, lane);
            bf16x8 kf[4]; k_frags(kf, vs + 4096, lane);
            f32x16 s = qk_tile(qf, kf);
            const TileP P = cmp_P(t2);
            if (cmp_interior(t2)) scores<false>(s, P); else scores<true>(s, P);
#pragma unroll
            for (int r = 0; r < 16; ++r) s[r] = ex2(s[r] - m) * linv;
            pv_acc(s, vs, lane, oc);
            float prevr = carry;
#pragma unroll
            for (int i = 0; i < 4; ++i) { float e = s[4 * i + 3], p = 2.f * (s[4 * i] + s[4 * i + 1] + s[4 * i + 2]) + e;
                p += __shfl_xor(p, 1); p += __shfl_xor(p, 2); e += __shfl_xor(e, 1); e += __shfl_xor(e, 2);
                const float rcv = __shfl_xor(e, 32);
                const float sc = p + (hi ? rcv : prevr);
                const int u = 8 * t2 + 2 * i + hi; if (r4 == 0) S[ti * 257 + u] = sc;
                prevr = rcv; }
            carry = prevr;
        });
        { const float gc = gt[0];
#pragma unroll
        for (int r = 0; r < 16; ++r) { oacc[0][r] = gc * oc[0][r]; oacc[1][r] = gc * oc[1][r]; } }
    }
    LDS_WAIT();
    const int cur_b = tq0 >> 6;
#ifndef NSA_NO_SEL
    for (int rep_ = 0; rep_ < REP_SEL; ++rep_) {
        const int tok = lane >> 3, sub = lane & 7;
        unsigned wsel = 0u;
        if (cur_b <= 15) { wsel = (sub == 0) ? ((2u << cur_b) - 1u) : 0u; }
        else {
            unsigned key[32];
#pragma unroll
            for (int k = 0; k < 32; ++k) { const int u = sub + 8 * k; const unsigned bits = __float_as_uint(S[tok * 257 + u]);
                key[k] = (u >= 1 && u <= cur_b - 2) ? ((bits & 0xffffff00u) | (unsigned)(255 - u)) : 0u; }
            wsel = ((sub == 0) ? 1u : 0u) | (((cur_b >> 5) == sub) ? (1u << (cur_b & 31)) : 0u) | ((((cur_b - 1) >> 5) == sub) ? (1u << ((cur_b - 1) & 31)) : 0u);
            for (int rnd = 0; rnd < 13; ++rnd) {
                unsigned mx = 0u;
#pragma unroll
                for (int k = 0; k < 32; ++k) mx = key[k] > mx ? key[k] : mx;
                { const unsigned o1 = __builtin_amdgcn_update_dpp(0u, mx, 0xB1, 0xF, 0xF, true); mx = o1 > mx ? o1 : mx;
                  const unsigned o2 = __builtin_amdgcn_update_dpp(0u, mx, 0x4E, 0xF, 0xF, true); mx = o2 > mx ? o2 : mx;
                  const unsigned o4 = __builtin_amdgcn_update_dpp(0u, mx, 0x141, 0xF, 0xF, true); mx = o4 > mx ? o4 : mx; }
#pragma unroll
                for (int k = 0; k < 32; ++k) key[k] = (key[k] == mx) ? 0u : key[k];
                const int u = 255 - (int)(mx & 0xffu);
                wsel |= ((u >> 5) == sub) ? (1u << (u & 31)) : 0u;
            }
        }
        SEL[tok * 8 + sub] = wsel;
    }
#endif
    LDS_WAIT();
    int nu = 0;
    for (int wd = 0; wd < 8; ++wd) {
        const unsigned mw = SEL[ti * 8 + wd];
        unsigned uw = 0u;
#pragma unroll
        for (int i = 0; i < 8; ++i) uw |= (unsigned)__builtin_amdgcn_readlane((int)mw, 4 * i);
        while (uw) { const int bb = __builtin_ctz(uw); uw &= uw - 1u; if (lane == 0) UB[nu] = wd * 32 + bb; ++nu; }
    }
    LDS_WAIT();
    LAS float* PARK = S;
#pragma unroll
    for (int r = 0; r < 16; ++r) { PARK[r * 64 + lane] = oacc[0][r]; PARK[(16 + r) * 64 + lane] = oacc[1][r]; }
#ifndef NSA_NO_SLC
    for (int rep_ = 0; rep_ < REP_SLC; ++rep_) {
        float m = -1e30f, l = 0.f; f32x16 os[2];
#pragma unroll
        for (int r = 0; r < 16; ++r) { os[0][r] = 0.f; os[1][r] = 0.f; }
        const bf16* kb = KV + 512 + g * 64; const bf16* vb = KV + 768 + g * 64;
        const int ntile = 2 * nu;
        auto tk0_of = [&](int idx) { return 64 * __builtin_amdgcn_readfirstlane(UB[idx >> 1]) + 32 * (idx & 1); };
        pipe_tiles<KVT>(ntile, [&](KVT& T, int idx) { const int tk0 = tk0_of(idx); kv_load(T, kb, vb, [=](int key) { return (size_t)(tk0 + key) * NKV; }, lane); },
            [&](KVT& T, int idx) {
                const int tk0 = tk0_of(idx), u = tk0 >> 6;
                if (tk0 <= tqmax) {
                    const bool mysel = (SEL[ti * 8 + (u >> 5)] >> (u & 31)) & 1u;
                    TileP P; P.dist0 = mysel ? (tq - tk0 - 4 * hi) : 0x40000000; P.dd = 1; P.lim = 0x3fffffff; P.base = -slope2 * (float)(tq - tk0 - 4 * hi); P.sd = slope2;
                    const bool interior = (tk0 + 31 <= tq0) && (__builtin_amdgcn_ballot_w64(!mysel) == 0ull);
                    if (interior) attn_tile<false>(qf, T, vs, lane, m, l, os, P); else attn_tile<true>(qf, T, vs, lane, m, l, os, P);
                }
            });
        l += __shfl_xor(l, 32);
        const float f = (l > 0.f && rep_ == REP_SLC - 1) ? gt[16] / l : 0.f;
#pragma unroll
        for (int r = 0; r < 16; ++r) { PARK[r * 64 + lane] += f * os[0][r]; PARK[(16 + r) * 64 + lane] += f * os[1][r]; }
    }
#endif
#ifndef NSA_NO_WIN
    for (int rep_ = 0; rep_ < REP_WIN; ++rep_) {
        float m = -1e30f, l = 0.f; f32x16 ow[2];
#pragma unroll
        for (int r = 0; r < 16; ++r) { ow[0][r] = 0.f; ow[1][r] = 0.f; }
        const bf16* kb = KV + 1024 + g * 64; const bf16* vb = KV + 1280 + g * 64;
        const int tkb = tq0 + 8 - 32 * 17;
        int t2s = 0; while (tkb + 32 * t2s + 31 < 0) ++t2s;
        auto wrow = [&](int tk0) { return [=](int key) { int tk = tk0 + key; tk = tk < 0 ? 0 : (tk > SEQ - 1 ? SEQ - 1 : tk); return (size_t)tk * NKV; }; };
        pipe_tiles<KVT>(17 - t2s, [&](KVT& T, int i) { kv_load(T, kb, vb, wrow(tkb + 32 * (t2s + i)), lane); },
            [&](KVT& T, int i) {
                const int tk0 = tkb + 32 * (t2s + i);
                TileP P; P.dist0 = tq - tk0 - 4 * hi; P.dd = 1; P.lim = 511 < tq ? 511 : tq; P.base = -slope2 * (float)P.dist0; P.sd = slope2;
                const bool interior = (tk0 >= 0) && (tqmax - tk0 <= 511) && (tk0 + 31 <= tq0);
                if (interior) attn_tile<false>(qf, T, vs, lane, m, l, ow, P); else attn_tile<true>(qf, T, vs, lane, m, l, ow, P);
            });
        l += __shfl_xor(l, 32);
        const float f = (l > 0.f) ? gt[32] / l : 0.f;
#pragma unroll
        for (int r = 0; r < 16; ++r) { oacc[0][r] = PARK[r * 64 + lane] + f * ow[0][r]; oacc[1][r] = PARK[(16 + r) * 64 + lane] + f * ow[1][r]; }
    }
#endif
    o_store(oacc, O + (size_t)tq * DM + hh * 64, hi);
}

#define NSA_CHUNK 1
__device__ __forceinline__ void nsa_chunk(const bf16* Q, const bf16* KV, const bf16* KC, const bf16* VC, const float* GATES, bf16* O, int ch, int g, LAS unsigned char* lds, int wave, int lane) {
    const int tt = 8 * ch + wave; LAS unsigned char* slab = lds + wave * NSA_SLAB; LAS unsigned char* SH = lds + 8 * NSA_SLAB;
    const int hi = lane >> 5, col = lane & 31, ti = col >> 2, r4 = col & 3, hh = 4 * g + r4;
    const int tq = 8 * tt + ti, tq0 = 8 * tt, tqmax = 8 * tt + 7;
    const float slope2 = exp2f(-0.5f * (float)(hh + 1)) * LOG2E;
    LAS unsigned char* vs = slab;
    LAS float* S = (LAS float*)(slab + SL_S);
    LAS unsigned* SEL = (LAS unsigned*)(slab + SL_SEL);
    LAS int* UB = (LAS int*)(slab + SL_UB);
    bf16x8 qf[4]; q_load(qf, Q + (size_t)hh * ((size_t)SEQ * 64) + (size_t)tq * 64, lane);
    const float* gt = GATES + (size_t)tq * 48 + g * 4 + r4;
    f32x16 oacc[2];
    for (int i = lane; i < 8 * 257; i += 64) S[i] = 0.f;
    const int ncmp = (tqmax >= 31) ? (((tqmax - 31) >> 4) + 1) : 0;
    const int ntc_w = (ncmp + 31) >> 5;
    const int ntc = (4 * ch + 3 + 31) >> 5;
    auto crow_of = [&](int t2) { return [=](int key) { int cc = 32 * t2 + key; cc = cc > 1022 ? 1022 : cc; return (size_t)(cc * 4 + g) * 64; }; };
    auto cmp_P = [&](int t2) { TileP P; P.dist0 = tq - 31 - 16 * (32 * t2 + 4 * hi); P.dd = 16; P.lim = 0x3fffffff; P.base = -slope2 * (float)P.dist0; P.sd = slope2 * 16.f; return P; };
    auto cmp_interior = [&](int t2) { return 16 * (32 * t2 + 31) + 31 <= tq0; };
    for (int rep_ = 0; rep_ < REP_CMP; ++rep_) {
        float m = -1e30f, l = 0.f;
        shared_pairs<false>(ntc, lds, NSA_SLAB, KC, VC, [&](int t2, int key) { int cc = 32 * t2 + key; cc = cc > 1022 ? 1022 : cc; return (size_t)(cc * 4 + g) * 64; }, wave, lane,
            [&](LAS unsigned char* ta, LAS unsigned char* tb, int s2) { const int t2 = 2 * s2;
                if (t2 + 1 < ntc_w && tb) { const TileP PA = cmp_P(t2), PB = cmp_P(t2 + 1);
                    if (cmp_interior(t2 + 1)) stats_core2_d<false, false>(qf, ta, tb, lane, m, l, PA, PB); else stats_core2_d<false, true>(qf, ta, tb, lane, m, l, PA, PB); }
                else if (t2 < ntc_w) { const TileP P = cmp_P(t2); if (cmp_interior(t2)) stats_core_d<false>(qf, ta, lane, m, l, P); else stats_core_d<true>(qf, ta, lane, m, l, P); } });
        l += __shfl_xor(l, 32);
        const float linv = (l > 0.f) ? 1.0f / l : 0.f, mfin = (m > -1e29f) ? m : 0.f; (void)mfin;
        f32x16 oc[2];
#pragma unroll
        for (int r = 0; r < 16; ++r) { oc[0][r] = 0.f; oc[1][r] = 0.f; }
        float carry = 0.f;
        auto cmp2_tile = [&](LAS unsigned char* tl, int t2) {
            bf16x8 kf[4]; k_frags(kf, tl + 4096, lane);
            const TileP P = cmp_P(t2);
#if CMP2_NEW
            f32x16 s = cmp_interior(t2) ? qk_scores_d<false>(qf, kf, P, mfin) : qk_scores_d<true>(qf, kf, P, mfin);
#pragma unroll
            for (int r = 0; r < 16; ++r) s[r] = ex2(s[r]) * linv;
#else
            f32x16 s = qk_tile(qf, kf);
            if (cmp_interior(t2)) scores<false>(s, P); else scores<true>(s, P);
#pragma unroll
            for (int r = 0; r < 16; ++r) s[r] = ex2(s[r] - m) * linv;
#endif
            pv_acc(s, tl, lane, oc);
            float prevr = carry;
#pragma unroll
            for (int i = 0; i < 4; ++i) { float e = s[4 * i + 3], p = 2.f * (s[4 * i] + s[4 * i + 1] + s[4 * i + 2]) + e;
                p = quad_sum(p); e = quad_sum(e);
                const float rcv = xhalf_other(e, hi);
                const float sc = p + (hi ? rcv : prevr);
                const int u = 8 * t2 + 2 * i + hi; if (r4 == 0) S[ti * 257 + u] = sc;
                prevr = rcv; }
            carry = prevr;
        };
        shared_pairs<true>(ntc, lds, NSA_SLAB, KC, VC, [&](int t2, int key) { int cc = 32 * t2 + key; cc = cc > 1022 ? 1022 : cc; return (size_t)(cc * 4 + g) * 64; }, wave, lane,
            [&](LAS unsigned char* ta, LAS unsigned char* tb, int s2) { const int t2 = 2 * s2;
                if (t2 < ntc_w) cmp2_tile(ta, t2);
                if (tb && t2 + 1 < ntc_w) cmp2_tile(tb, t2 + 1); });
        { const float gc = gt[0];
#pragma unroll
        for (int r = 0; r < 16; ++r) { oacc[0][r] = gc * oc[0][r]; oacc[1][r] = gc * oc[1][r]; } }
    }
    LDS_WAIT();
    const int cur_b = tq0 >> 6;
#ifndef NSA_NO_SEL
    for (int rep_ = 0; rep_ < REP_SEL; ++rep_) {
        const int tok = lane >> 3, sub = lane & 7;
        unsigned wsel = 0u;
        if (cur_b <= 15) { wsel = (sub == 0) ? ((2u << cur_b) - 1u) : 0u; }
        else {
            unsigned key[32];
#pragma unroll
            for (int k = 0; k < 32; ++k) { const int u = sub + 8 * k; const unsigned bits = __float_as_uint(S[tok * 257 + u]);
                key[k] = (u >= 1 && u <= cur_b - 2) ? ((bits & 0xffffff00u) | (unsigned)(255 - u)) : 0u; }
            wsel = ((sub == 0) ? 1u : 0u) | (((cur_b >> 5) == sub) ? (1u << (cur_b & 31)) : 0u) | ((((cur_b - 1) >> 5) == sub) ? (1u << ((cur_b - 1) & 31)) : 0u);
            for (int rnd = 0; rnd < 13; ++rnd) {
                unsigned mx = 0u;
#pragma unroll
                for (int k = 0; k < 32; ++k) mx = key[k] > mx ? key[k] : mx;
                { const unsigned o1 = __builtin_amdgcn_update_dpp(0u, mx, 0xB1, 0xF, 0xF, true); mx = o1 > mx ? o1 : mx;
                  const unsigned o2 = __builtin_amdgcn_update_dpp(0u, mx, 0x4E, 0xF, 0xF, true); mx = o2 > mx ? o2 : mx;
                  const unsigned o4 = __builtin_amdgcn_update_dpp(0u, mx, 0x141, 0xF, 0xF, true); mx = o4 > mx ? o4 : mx; }
#pragma unroll
                for (int k = 0; k < 32; ++k) key[k] = (key[k] == mx) ? 0u : key[k];
                const int u = 255 - (int)(mx & 0xffu);
                wsel |= ((u >> 5) == sub) ? (1u << (u & 31)) : 0u;
            }
        }
        SEL[tok * 8 + sub] = wsel;
    }
#endif
    LDS_WAIT();
    int nu = 0;
    for (int wd = 0; wd < 8; ++wd) {
        const unsigned mw = SEL[ti * 8 + wd];
        unsigned uw = 0u;
#pragma unroll
        for (int i = 0; i < 8; ++i) uw |= (unsigned)__builtin_amdgcn_readlane((int)mw, 4 * i);
        while (uw) { const int bb = __builtin_ctz(uw); uw &= uw - 1u; if (lane == 0) UB[nu] = wd * 32 + bb; ++nu; }
    }
    LDS_WAIT();
    LAS float* PARK = S;
#pragma unroll
    for (int r = 0; r < 16; ++r) { PARK[r * 64 + lane] = oacc[0][r]; PARK[(16 + r) * 64 + lane] = oacc[1][r]; }
#ifndef NSA_NO_SLC
    for (int rep_ = 0; rep_ < REP_SLC; ++rep_) {
        float m = -1e30f, l = 0.f; f32x16 os[2];
#pragma unroll
        for (int r = 0; r < 16; ++r) { os[0][r] = 0.f; os[1][r] = 0.f; }
        const bf16* kb = KV + 512 + g * 64; const bf16* vb = KV + 768 + g * 64;
        {
            bf16x8 tk[2][4]; u32x4 tv[2][4];
            const size_t loff = (size_t)(lane >> 3) * NKV + 8 * (lane & 7);
#define SLC_LDK(bi_) do { const bf16* p_ = kb + (size_t)(64 * __builtin_amdgcn_readfirstlane(UB[bi_])) * NKV + loff; \
    _Pragma("unroll") for (int x_ = 0; x_ < 2; ++x_) _Pragma("unroll") for (int i_ = 0; i_ < 4; ++i_) tk[x_][i_] = *(const bf16x8*)(p_ + (size_t)(32 * x_ + 8 * i_) * NKV); } while (0)
#define SLC_LDV(bi_) do { const bf16* p_ = vb + (size_t)(64 * __builtin_amdgcn_readfirstlane(UB[bi_])) * NKV + loff; \
    _Pragma("unroll") for (int x_ = 0; x_ < 2; ++x_) _Pragma("unroll") for (int i_ = 0; i_ < 4; ++i_) tv[x_][i_] = *(const u32x4*)(p_ + (size_t)(32 * x_ + 8 * i_) * NKV); } while (0)
            SLC_LDK(0); SLC_LDV(0);
#pragma nounroll
            for (int bi = 0; bi < nu; ++bi) {
                const int tk0 = 64 * __builtin_amdgcn_readfirstlane(UB[bi]), u = tk0 >> 6;
                const bool mysel = (SEL[ti * 8 + (u >> 5)] >> (u & 31)) & 1u;
                TileP PA; PA.dist0 = mysel ? (tq - tk0 - 4 * hi) : 0x40000000; PA.dd = 1; PA.lim = 0x3fffffff; PA.base = -slope2 * (float)(tq - tk0 - 4 * hi); PA.sd = slope2;
                TileP PB = PA; PB.dist0 = PA.dist0 - 32; PB.base = -slope2 * (float)(tq - tk0 - 32 - 4 * hi);
                const bool interior = (tk0 + 63 <= tq0) && (__builtin_amdgcn_ballot_w64(!mysel) == 0ull);
                k_stage(tk[0], vs, lane); k_stage(tk[1], vs + 4096, lane);
                if (bi + 1 < nu) SLC_LDK(bi + 1);
                const bool seeded = m > -1e29f; const float mref = seeded ? m : 0.f;
                f32x16 sa, sb;
                if (interior) pair_qk<false>(qf, vs, lane, mref, PA, PB, sa, sb); else pair_qk<true>(qf, vs, lane, mref, PA, PB, sa, sb);
                v_stage_raw(tv[0], vs, lane); v_stage_raw(tv[1], vs + 4096, lane);
                if (bi + 1 < nu) SLC_LDV(bi + 1);
                pair_sm_pv(sa, sb, vs, lane, m, l, os, seeded, mref);
            }
#undef SLC_LDK
#undef SLC_LDV
        }
        l += __shfl_xor(l, 32);
        const float f = (l > 0.f && rep_ == REP_SLC - 1) ? gt[16] / l : 0.f;
#pragma unroll
        for (int r = 0; r < 16; ++r) { PARK[r * 64 + lane] += f * os[0][r]; PARK[(16 + r) * 64 + lane] += f * os[1][r]; }
    }
#endif
#ifndef NSA_NO_WIN
    for (int rep_ = 0; rep_ < REP_WIN; ++rep_) {
        float m = -1e30f, l = 0.f; f32x16 ow[2];
#pragma unroll
        for (int r = 0; r < 16; ++r) { ow[0][r] = 0.f; ow[1][r] = 0.f; }
        const bf16* kb = KV + 1024 + g * 64; const bf16* vb = KV + 1280 + g * 64;
        const int tkb = 64 * ch - 512;
        int t2s = 0; while (tkb + 32 * t2s + 31 < 0) ++t2s;
        auto win_P = [&](int tk0) { TileP P; P.dist0 = tq - tk0 - 4 * hi; P.dd = 1; P.lim = 511 < tq ? 511 : tq; P.base = -slope2 * (float)P.dist0; P.sd = slope2; return P; };
        auto win_used = [&](int tk0) { return tk0 <= tqmax && tk0 + 31 >= tq0 - 511; };
        auto win_int = [&](int tk0) { return (tk0 >= 0) && (tqmax - tk0 <= 511) && (tk0 + 31 <= tq0); };
        shared_pairs<true>(18 - t2s, lds, NSA_SLAB, kb, vb, [&](int i, int key) { int tk = tkb + 32 * (t2s + i) + key; tk = tk < 0 ? 0 : (tk > SEQ - 1 ? SEQ - 1 : tk); return (size_t)tk * NKV; }, wave, lane,
            [&](LAS unsigned char* ta, LAS unsigned char* tb, int s2) {
                const int tkA = tkb + 32 * (t2s + 2 * s2), tkB = tkA + 32;
                const bool ua = win_used(tkA), ub = tb && win_used(tkB);
                if (ua && ub) { const TileP PA = win_P(tkA), PB = win_P(tkB); const bool ia = win_int(tkA), ib = win_int(tkB);
                    if (ia && ib) attn_core2_d<false, false>(qf, ta, tb, lane, m, l, ow, PA, PB);
                    else attn_core2_d<true, true>(qf, ta, tb, lane, m, l, ow, PA, PB); }
                else if (ua) { const TileP P = win_P(tkA); if (win_int(tkA)) attn_core_d<false>(qf, ta, lane, m, l, ow, P); else attn_core_d<true>(qf, ta, lane, m, l, ow, P); }
                else if (ub) { const TileP P = win_P(tkB); if (win_int(tkB)) attn_core_d<false>(qf, tb, lane, m, l, ow, P); else attn_core_d<true>(qf, tb, lane, m, l, ow, P); }
            });
        l += __shfl_xor(l, 32);
        const float f = (l > 0.f) ? gt[32] / l : 0.f;
#pragma unroll
        for (int r = 0; r < 16; ++r) { oacc[0][r] = PARK[r * 64 + lane] + f * ow[0][r]; oacc[1][r] = PARK[(16 + r) * 64 + lane] + f * ow[1][r]; }
    }
#endif
    o_store(oacc, O + (size_t)tq * DM + hh * 64, hi);
}

struct EpiHeadMajor {
    static constexpr bool PERM = true, AFTER_DRAIN = false;
    bf16* O; const float* bias; int smode;
    __device__ __forceinline__ void operator()(const f32x4 (&acc)[2][2][4][2], const pg8::Unit& u, int wr, int wc, int fr, int fq) const {
        const int row0 = u.pm * 256 + wr * 64 + fr, col0 = u.pn * 256 + wc * 32 + 8 * fq;
        const float sc = (smode == 2 || (smode == 1 && ((u.pn >> 2) % 3) == 0)) ? C1 : 1.0f;
#pragma unroll
        for (int bj = 0; bj < 2; ++bj) { const int col = col0 + bj * 128; bf16* blk = O + (size_t)(col >> 6) * ((size_t)SEQ * 64) + (col & 63);
            f32x4 b0 = {0.f, 0.f, 0.f, 0.f}, b1 = b0; if (bias) { b0 = *(const f32x4*)(bias + col); b1 = *(const f32x4*)(bias + col + 4); }
#pragma unroll
            for (int ai = 0; ai < 2; ++ai)
#pragma unroll
                for (int m = 0; m < 4; ++m) { const f32x4 v0 = (acc[ai][bj][m][0] + b0) * sc, v1 = (acc[ai][bj][m][1] + b1) * sc;
                    u32x4 o; o.x = pk2(v0[0], v0[1]); o.y = pk2(v0[2], v0[3]); o.z = pk2(v1[0], v1[1]); o.w = pk2(v1[2], v1[3]);
                    *(u32x4*)(blk + (size_t)(row0 + ai * 128 + m * 16) * 64) = o; } }
    }
};
struct EpiResid {
    static constexpr bool PERM = true, AFTER_DRAIN = false;
    bf16* H;
    __device__ __forceinline__ void operator()(const f32x4 (&acc)[2][2][4][2], const pg8::Unit& u, int wr, int wc, int fr, int fq) const {
        const int row0 = u.pm * 256 + wr * 64 + fr, col0 = u.pn * 256 + wc * 32 + 8 * fq;
#pragma unroll
        for (int ai = 0; ai < 2; ++ai)
#pragma unroll
            for (int m = 0; m < 4; ++m) { bf16* rowp = H + (size_t)(row0 + ai * 128 + m * 16) * DM + col0;
#pragma unroll
                for (int bj = 0; bj < 2; ++bj) { u32x4* p = (u32x4*)(rowp + bj * 128); const u32x4 h = *p; const f32x4 v0 = acc[ai][bj][m][0], v1 = acc[ai][bj][m][1];
                    u32x4 o; o.x = pk2(ALPHA * bflo(h.x) + v0[0], ALPHA * bfhi(h.x) + v0[1]); o.y = pk2(ALPHA * bflo(h.y) + v0[2], ALPHA * bfhi(h.y) + v0[3]);
                    o.z = pk2(ALPHA * bflo(h.z) + v1[0], ALPHA * bfhi(h.z) + v1[1]); o.w = pk2(ALPHA * bflo(h.w) + v1[2], ALPHA * bfhi(h.w) + v1[3]);
                    *p = o; } }
    }
};
struct EpiSwiglu {
    static constexpr bool PERM = true, AFTER_DRAIN = false;
    bf16* HID; const float* roww;
    __device__ __forceinline__ void operator()(const f32x4 (&acc)[2][2][4][2], const pg8::Unit& u, int wr, int wc, int fr, int fq) const {
        const int row0 = u.pm * 256 + wr * 64 + fr, ct = u.pn & 1, col0 = ct * 128 + wc * 32 + 8 * fq;
#pragma unroll
        for (int ai = 0; ai < 2; ++ai)
#pragma unroll
            for (int m = 0; m < 4; ++m) { const int row = row0 + ai * 128 + m * 16; const float w = roww[row];
                float hv[8];
#pragma unroll
                for (int n = 0; n < 2; ++n)
#pragma unroll
                    for (int j = 0; j < 4; ++j) { const float gte = acc[ai][0][m][n][j], up = acc[ai][1][m][n][j];
                        hv[4 * n + j] = gte * __builtin_amdgcn_rcpf(1.0f + ex2(-gte * LOG2E)) * up * w; }
                u32x4 o; o.x = pk2(hv[0], hv[1]); o.y = pk2(hv[2], hv[3]); o.z = pk2(hv[4], hv[5]); o.w = pk2(hv[6], hv[7]);
                *(u32x4*)(HID + (size_t)row * 256 + col0) = o; }
    }
};
struct EpiScatter {
    static constexpr bool PERM = true, AFTER_DRAIN = false;
    bf16* Y; const int* rowinfo;
    __device__ __forceinline__ void operator()(const f32x4 (&acc)[2][2][4][2], const pg8::Unit& u, int wr, int wc, int fr, int fq) const {
        int t_ = threadIdx.x; asm volatile("" : "+v"(t_));
        const int fr_ = t_ & 15, fq_ = (t_ & 63) >> 4; (void)fr; (void)fq;
        const int row0 = u.pm * 256 + wr * 64 + fr_, ct = u.pn & 3, col0 = ct * 256 + wc * 32 + 8 * fq_;
#pragma unroll
        for (int ai = 0; ai < 2; ++ai)
#pragma unroll
            for (int m = 0; m < 4; ++m) { const int info = rowinfo[row0 + ai * 128 + m * 16];
                if (info >= 0) { bf16* rowp = Y + ((size_t)(info & 1) * SEQ + (size_t)(info >> 1)) * DM + col0;
#pragma unroll
                    for (int bj = 0; bj < 2; ++bj) { const f32x4 v0 = acc[ai][bj][m][0], v1 = acc[ai][bj][m][1];
                        u32x4 o; o.x = pk2(v0[0], v0[1]); o.y = pk2(v0[2], v0[3]); o.z = pk2(v1[0], v1[1]); o.w = pk2(v1[2], v1[3]);
                        *(u32x4*)(rowp + bj * 128) = o; } } }
    }
};
struct MoeOrder {
    const LAS int* tb; int NCT, G, c;
    __device__ __forceinline__ void init(const LAS int* tb_, int nct, int G_, int c_) { tb = tb_; NCT = nct; G = G_; c = c_; }
    __device__ __forceinline__ bool next(int i, pg8::Unit& u) const {
        const int L = i * G + c, rt = L / NCT; if (rt >= __builtin_amdgcn_readfirstlane(tb[16])) return false;
        int e = 0;
#pragma unroll
        for (int k = 1; k < 16; ++k) e += (rt >= tb[k]) ? 1 : 0;
        u.pm = rt; u.pn = __builtin_amdgcn_readfirstlane(e) * NCT + (L % NCT); return true;
    }
    __device__ __forceinline__ void a_ready(const pg8::Unit&) const {}
    __device__ __forceinline__ void done(const pg8::Unit&) const {}
};

__device__ __forceinline__ void ln_phase(LAS unsigned char* lds, int mode, float hscale, const bf16* Y, const float* gam, const float* bet, float* outF, float oscale, bf16* HB,
                                         const bf16* WT, const float* sb, int4* ROUTE, int* HIST, float* GATES) {
    const int tid = threadIdx.x, lane = tid & 63, wave = __builtin_amdgcn_readfirstlane(tid >> 6), hi = lane >> 5;
    LAS float* LOG = (LAS float*)(lds + LDS_MISC);
    LAS int* HCNT = (LAS int*)(lds + LDS_MISC + 64 * 97 * 4);
    f32x4 gv[4], bv[4];
#pragma unroll
    for (int j = 0; j < 4; ++j) { gv[j] = *(const f32x4*)(gam + 4 * lane + 256 * j); bv[j] = *(const f32x4*)(bet + 4 * lane + 256 * j); }
    for (int ch = blockIdx.x; ch < SEQ / 64; ch += gridDim.x) {
        if (tid < 16) HCNT[tid] = 0;
        auto load_row = [&](u32x2 (&hv)[4], u32x2 (&ya)[4], u32x2 (&yb)[4], int i) {
            const size_t row = (size_t)ch * 64 + wave * 8 + i;
#pragma unroll
            for (int j = 0; j < 4; ++j) hv[j] = *(const u32x2*)(HB + row * DM + 4 * lane + 256 * j);
            if (Y) {
#pragma unroll
                for (int j = 0; j < 4; ++j) { ya[j] = *(const u32x2*)(Y + row * DM + 4 * lane + 256 * j); yb[j] = *(const u32x2*)(Y + ((size_t)SEQ + row) * DM + 4 * lane + 256 * j); }
            }
        };
        auto do_row = [&](const u32x2 (&hv)[4], u32x2 (&ya)[4], u32x2 (&yb)[4], int i) {
            const int rl = wave * 8 + i; const size_t row = (size_t)ch * 64 + rl;
            f32x4 v[4];
#pragma unroll
            for (int j = 0; j < 4; ++j) { v[j][0] = hscale * bflo(hv[j].x); v[j][1] = hscale * bfhi(hv[j].x); v[j][2] = hscale * bflo(hv[j].y); v[j][3] = hscale * bfhi(hv[j].y); }
            if (Y) {
#pragma unroll
                for (int j = 0; j < 4; ++j) { v[j][0] = (v[j][0] + bflo(ya[j].x)) + bflo(yb[j].x); v[j][1] = (v[j][1] + bfhi(ya[j].x)) + bfhi(yb[j].x);
                    v[j][2] = (v[j][2] + bflo(ya[j].y)) + bflo(yb[j].y); v[j][3] = (v[j][3] + bfhi(ya[j].y)) + bfhi(yb[j].y); }
            }
            float s = 0.f;
#pragma unroll
            for (int j = 0; j < 4; ++j) s += (v[j][0] + v[j][1]) + (v[j][2] + v[j][3]);
            const float mean = wave_sum(s) * (1.0f / DM);
            float q = 0.f;
#pragma unroll
            for (int j = 0; j < 4; ++j) { v[j] = v[j] - mean; q += (v[j][0] * v[j][0] + v[j][1] * v[j][1]) + (v[j][2] * v[j][2] + v[j][3] * v[j][3]); }
            const float rstd = 1.0f / sqrtf(wave_sum(q) * (1.0f / DM) + LN_EPS);
#pragma unroll
            for (int j = 0; j < 4; ++j) { const f32x4 y = v[j] * rstd * gv[j] + bv[j];
                if (outF) *(f32x4*)(outF + row * DM + 4 * lane + 256 * j) = y * oscale;
                u32x2 w; w.x = pk2(y[0], y[1]); w.y = pk2(y[2], y[3]);
                *(u32x2*)(HB + row * DM + 4 * lane + 256 * j) = w;
                const int ck = (lane >> 1) + 32 * j;
                *(LAS u32x2*)(lds + rl * 2048 + ((ck ^ (rl & 15)) << 4) + (lane & 1) * 8) = w; }
        };
        {
            u32x2 va[4], vb[4], ya0[4], ya1[4], yb0[4], yb1[4];
            load_row(va, ya0, ya1, 0);
#pragma nounroll
            for (int i = 0; i < 8; i += 2) { load_row(vb, yb0, yb1, i + 1); do_row(va, ya0, ya1, i); if (i + 2 < 8) load_row(va, ya0, ya1, i + 2); do_row(vb, yb0, yb1, i + 1); }
        }
        __syncthreads();
        if (mode != 2) {
            const int nct = (mode == 0) ? 1 : 2, nks = 4 / nct;
            const int tt = wave & 1, ct = (nct == 2) ? ((wave >> 1) & 1) : 0, ks = (nct == 2) ? (wave >> 2) : (wave >> 1), rl = tt * 32 + (lane & 31);
            const int s0 = ks * (64 / nks), s1 = s0 + 64 / nks;
            const bf16* wrow = WT + (size_t)(ct * 32 + (lane & 31)) * DM + 8 * hi;
            f32x16 acc;
#pragma unroll
            for (int r = 0; r < 16; ++r) acc[r] = 0.f;
#pragma unroll 8
            for (int s2 = s0; s2 < s1; ++s2) { const bf16x8 a = *(const bf16x8*)(wrow + 16 * s2); const int ck = 2 * s2 + hi;
                const bf16x8 b = *(const LAS bf16x8*)(lds + rl * 2048 + ((ck ^ (rl & 15)) << 4)); acc = MFMA32(a, b, acc); }
            const int ncp = (mode == 0) ? 24 : 48;
#pragma unroll
            for (int r = 0; r < 16; ++r) { const int col = 32 * ct + crow(r, hi); if (col < ncp) LOG[rl * 97 + ks * ncp + col] = acc[r]; }
        }
        __syncthreads();
        if (mode == 0 && tid < 64) {
            const LAS float* lgp = LOG + tid * 97;
            auto LG = [&](int c) { return ((lgp[c] + lgp[24 + c]) + lgp[48 + c]) + lgp[72 + c]; };
            int gi = 0; float gm = LG(0) + sb[0];
#pragma unroll
            for (int k = 1; k < 4; ++k) { const float x = LG(k) + sb[k]; if (x > gm) { gm = x; gi = k; } }
            float den = 0.f;
#pragma unroll
            for (int k = 0; k < 4; ++k) den += __expf(LG(k) + sb[k] - gm);
            const float gw = 1.0f / den;
            float ev[4];
#pragma unroll
            for (int k = 0; k < 4; ++k) ev[k] = LG(4 + 4 * gi + k) + sb[4 + 4 * gi + k];
            int i0 = 0; float v0 = ev[0];
#pragma unroll
            for (int k = 1; k < 4; ++k) if (ev[k] > v0) { v0 = ev[k]; i0 = k; }
            int i1 = -1; float v1 = -INFINITY;
#pragma unroll
            for (int k = 0; k < 4; ++k) if (k != i0 && ev[k] > v1) { v1 = ev[k]; i1 = k; }
            if (i1 < 0) { i1 = (i0 + 1) & 3; v1 = ev[i1]; }
            const float t = __expf(v1 - v0), w0 = gw / (1.0f + t), w1 = gw * t / (1.0f + t);
            const int e0 = 4 * gi + i0, e1 = 4 * gi + i1;
            ROUTE[(size_t)ch * 64 + tid] = make_int4(e0, e1, __float_as_int(w0), __float_as_int(w1));
            atomicAdd((int*)&HCNT[e0], 1); atomicAdd((int*)&HCNT[e1], 1);
        }
        if (mode == 1 && tid < 64) {
            const LAS float* lgp = LOG + tid * 97; float* go = GATES + ((size_t)ch * 64 + tid) * 48;
#pragma unroll 4
            for (int c = 0; c < 48; ++c) go[c] = 1.0f / (1.0f + __expf(-((lgp[c] + lgp[48 + c]) + sb[c])));
        }
        __syncthreads();
        if (mode == 0 && tid < 16) HIST[ch * 16 + tid] = HCNT[tid];
    }
}

__device__ __forceinline__ void moe_scatter(LAS unsigned char* lds, const int4* ROUTE, const int* HIST, int* TILEB, const bf16* HB, bf16* HS, int* ROWINFO, float* ROWW) {
    const int tid = threadIdx.x, lane = tid & 63, wave = __builtin_amdgcn_readfirstlane(tid >> 6);
    LAS int* tot = (LAS int*)(lds + LDS_MISC);
    LAS int* pre = tot + 16;
    LAS int* tbl = pre + 16;
    LAS int* ent = tbl + 32;
    LAS int* pos = ent + 128;
    LAS float* ewt = (LAS float*)(pos + 128);
    for (int ch = blockIdx.x; ch < SEQ / 64; ch += gridDim.x) {
        {
            if (tid < 32) tot[tid] = 0;
            __syncthreads();
            const int e = tid & 15, part = tid >> 4; int t = 0, p = 0;
#pragma unroll
            for (int c2 = 0; c2 < 8; ++c2) { const int c = part * 8 + c2; const int v = HIST[c * 16 + e]; t += v; p += (c < ch) ? v : 0; }
            atomicAdd((int*)&tot[e], t); atomicAdd((int*)&pre[e], p);
        }
        if (tid >= 64 && tid < 128) { const int k = tid - 64; const int4 r = ROUTE[(size_t)ch * 64 + k]; ent[2 * k] = r.x; ent[2 * k + 1] = r.y; ewt[2 * k] = __int_as_float(r.z); ewt[2 * k + 1] = __int_as_float(r.w); }
        __syncthreads();
        if (tid == 0) { int a = 0; for (int e = 0; e < 16; ++e) { tbl[e] = a; a += (tot[e] + 255) >> 8; } tbl[16] = a;
            if (ch == 0) { for (int e = 0; e < 17; ++e) TILEB[e] = tbl[e]; } }
        __syncthreads();
        if (tid < 16) { int run = tbl[tid] * 256 + pre[tid]; for (int k = 0; k < 128; ++k) if (ent[k] == tid) pos[k] = run++; }
        __syncthreads();
        for (int k = wave * 16; k < wave * 16 + 16; ++k) {
            const int p = pos[k]; const size_t token = (size_t)ch * 64 + (k >> 1);
            const u32x4* src = (const u32x4*)(HB + token * DM); u32x4* dst = (u32x4*)(HS + (size_t)p * DM);
            dst[lane] = src[lane]; dst[lane + 64] = src[lane + 64];
            if (lane == 0) { ROWINFO[p] = (int)token * 2 + (k & 1); ROWW[p] = ewt[k]; }
        }
        if (ch < 16) { const int e = ch, r0 = tbl[e] * 256 + tot[e], r1 = tbl[e + 1] * 256; for (int r = r0 + tid; r < r1; r += NTHREADS) { ROWINFO[r] = -1; ROWW[r] = 0.f; } }
        __syncthreads();
    }
}

__device__ __forceinline__ float gelu_tanh(float x) { const float u = 0.7978845608028654f * (x + 0.044715f * x * x * x); const float t = 1.0f - 2.0f / (__expf(2.0f * u) + 1.0f); return 0.5f * x * (1.0f + t); }
__device__ __forceinline__ void compress_phase(LAS unsigned char* lds, const bf16* KV, const bf16* W1T, const bf16* W2T, const float* B1P, const float* b1, const float* b2, bf16* KCMP) {
    const int tid = threadIdx.x, lane = tid & 63, wave = __builtin_amdgcn_readfirstlane(tid >> 6), hi = lane >> 5;
    LAS unsigned char* H1 = lds;
    for (int item = blockIdx.x; item < 256; item += gridDim.x) {
        const int j = item >> 7, rt = item & 127;
        int rho = 32 * rt + (lane & 31); const bool rvalid = rho < 4092; rho = rvalid ? rho : 4091;
        const int c = rho >> 2, g = rho & 3;
        const bf16* arow = KV + (size_t)(16 * c) * NKV + j * 256 + g * 64;
        const bf16* wrow = W1T + ((size_t)j * 256 + 32 * wave + (lane & 31)) * 2048;
        f32x16 acc;
#pragma unroll
        for (int r = 0; r < 16; ++r) acc[r] = 0.f;
#pragma unroll 4
        for (int s = 0; s < 128; ++s) { const int k = 16 * s + 8 * hi;
            const bf16x8 b = *(const bf16x8*)(arow + (size_t)(k >> 6) * NKV + (k & 63)); const bf16x8 a = *(const bf16x8*)(wrow + k); acc = MFMA32(a, b, acc); }
#pragma unroll
        for (int r = 0; r < 16; ++r) { const int n = 32 * wave + crow(r, hi); float bsum = b1[j * 256 + n];
            for (int ks = 0; ks < 16; ++ks) bsum += B1P[(j * 16 + ks) * 256 + n];
            const float hval = gelu_tanh(acc[r] + bsum);
            *(LAS unsigned short*)(H1 + (lane & 31) * 528 + n * 2) = (unsigned short)(pk2(hval, 0.f) & 0xffffu); }
        __syncthreads();
        if (wave < 2) {
            const int db = wave;
            const bf16* w2row = W2T + ((size_t)j * 64 + 32 * db + (lane & 31)) * 256 + 8 * hi;
            f32x16 o;
#pragma unroll
            for (int r = 0; r < 16; ++r) o[r] = 0.f;
#pragma unroll
            for (int s = 0; s < 16; ++s) { const bf16x8 a = *(const bf16x8*)(w2row + 16 * s); const bf16x8 b = *(const LAS bf16x8*)(H1 + (lane & 31) * 528 + (16 * s + 8 * hi) * 2); o = MFMA32(a, b, o); }
            if (rvalid) { bf16* orow = KCMP + ((size_t)j * 1024 * 4 + (size_t)c * 4 + g) * 64 + 32 * db;
#pragma unroll
                for (int k = 0; k < 4; ++k) { const int d0 = 32 * db + 8 * k + 4 * hi; u32x2 w;
                    w.x = pk2(o[4 * k] + b2[j * 64 + d0], o[4 * k + 1] + b2[j * 64 + d0 + 1]); w.y = pk2(o[4 * k + 2] + b2[j * 64 + d0 + 2], o[4 * k + 3] + b2[j * 64 + d0 + 3]);
                    *(u32x2*)(orow + 8 * k + 4 * hi) = w; } }
        }
        __syncthreads();
    }
}

#if DBG_CHECK
__device__ __forceinline__ void dbg_acc(unsigned* ctl, int slot, float num, float den) {
    num = wave_sum(num); den = wave_sum(den);
    if ((threadIdx.x & 63) == 0) { atomicAdd((float*)(ctl + CW_DBG) + 2 * slot, num); atomicAdd((float*)(ctl + CW_DBG) + 2 * slot + 1, den); }
}
__device__ __forceinline__ float dbg_dot64(const bf16* a, const bf16* b, int lane) { return wave_sum(bf2f(a[lane]) * bf2f(b[lane])); }
__device__ __forceinline__ int dbg_token(int w) { const int sp[16] = {0, 5, 30, 31, 47, 63, 64, 100, 500, 1023, 1024, 1039, 2047, 4096, 16320, 16383}; return (w < 16) ? sp[w] : (int)(((unsigned)w * 6151u + 17u) % 16384u); }

__device__ __forceinline__ void dbg_check_dilated(unsigned* ctl, const bf16* qkv, const bf16* O) {
    const int lane = threadIdx.x & 63, wave = threadIdx.x >> 6;
    const int w = blockIdx.x * 8 + wave; const int t = dbg_token(w & 255), h = (w * 7 + (w >> 8)) & 15;
    const float slope = exp2f(-0.5f * (float)(h + 1));
    float outg[3], lse[3];
    for (int g = 0; g < 3; ++g) {
        const int d = 1 << (2 * g), W = 128 << (2 * g);
        const bf16* q = qkv + (size_t)((g * 3) * 16 + h) * ((size_t)SEQ * 64) + (size_t)t * 64;
        float m = -1e30f, l = 0.f, acc = 0.f;
        for (int j = 0; j * d <= W; ++j) { const int tk = t - j * d; if (tk < 0) break;
            const bf16* k = qkv + (size_t)((g * 3 + 1) * 16 + h) * ((size_t)SEQ * 64) + (size_t)tk * 64; const bf16* v = k + (size_t)16 * SEQ * 64;
            const float s = dbg_dot64(q, k, lane) * (1.0f / LOG2E) - slope * (float)(j * d);
            const float mn = fmaxf(m, s), a = __expf(m - mn), p = __expf(s - mn); l = l * a + p; acc = acc * a + p * bf2f(v[lane]); m = mn; }
        outg[g] = acc / l; lse[g] = m + __logf(l);
    }
    const float mx = fmaxf(lse[0], fmaxf(lse[1], lse[2])); const float e0 = __expf(lse[0] - mx), e1 = __expf(lse[1] - mx), e2 = __expf(lse[2] - mx);
    const float o = (e0 * outg[0] + e1 * outg[1] + e2 * outg[2]) / (e0 + e1 + e2);
    const float got = bf2f(O[(size_t)t * DM + h * 64 + lane]);
    dbg_acc(ctl, 0, (o - got) * (o - got), o * o);
}

__device__ __forceinline__ void dbg_check_nsa(LAS unsigned char* lds, unsigned* ctl, const bf16* Q, const bf16* KV, const bf16* KC, const bf16* VC, const float* GATES, const bf16* O) {
    const int lane = threadIdx.x & 63, wave = threadIdx.x >> 6;
    const int w = blockIdx.x; const int t = dbg_token(w), g = (w >> 2) & 3;
    LAS float* P = (LAS float*)lds; LAS float* IMP = (LAS float*)(lds + 16384); LAS float* SC = (LAS float*)(lds + 20480); LAS int* SELB = (LAS int*)(lds + 21504);
    const int hh = 4 * g + (wave & 3); const float slope = exp2f(-0.5f * (float)(hh + 1));
    const bf16* q = Q + (size_t)hh * ((size_t)SEQ * 64) + (size_t)t * 64;
    float oc = 0.f;
    __syncthreads();
    if (wave < 4) {
        LAS float* Pr = P + wave * 1024; float m = -1e30f;
        for (int c = 0; c < 1023; ++c) { const int dc = t - (16 * c + 31); float s = -1e30f; if (dc >= 0) s = dbg_dot64(q, KC + (size_t)(c * 4 + g) * 64, lane) * (1.0f / LOG2E) - slope * (float)dc; if (lane == 0) Pr[c] = s; m = fmaxf(m, s); }
        LDS_WAIT();
        float l = 0.f;
        for (int c = 0; c < 1023; ++c) { const int dc = t - (16 * c + 31); const float p = (dc >= 0) ? __expf(Pr[c] - m) : 0.f; l += p; }
        const float linv = 1.0f / fmaxf(l, 1e-30f);
        for (int c = 0; c < 1023; ++c) { const int dc = t - (16 * c + 31); const float p = (dc >= 0) ? __expf(Pr[c] - m) * linv : 0.f; oc += p * bf2f(VC[(size_t)(c * 4 + g) * 64 + lane]); if (lane == 0) Pr[c] = p; }
        if (lane == 0) Pr[1023] = 0.f;
    }
    __syncthreads();
    for (int c = threadIdx.x; c < 1024; c += NTHREADS) IMP[c] = P[c] + P[1024 + c] + P[2048 + c] + P[3072 + c];
    __syncthreads();
    const int cur = t >> 6;
    for (int s = threadIdx.x; s < 256; s += NTHREADS) { float a = 0.f;
        for (int aa = 0; aa < 4; ++aa) for (int bb = 0; bb < 2; ++bb) { const int idx = 4 * s + aa - bb; if (idx >= 0 && idx < 1023) a += IMP[idx]; }
        float sc = (s == 0 || s == cur || s == cur - 1) ? 1e4f : a; if (s > cur) sc = -1e4f; SC[s] = sc; }
    __syncthreads();
    if (threadIdx.x == 0) { for (int k = 0; k < 16; ++k) { int bi = 0; float bv = -3e38f; for (int s = 0; s < 256; ++s) if (SC[s] > bv) { bv = SC[s]; bi = s; } SELB[k] = bi; SC[bi] = -3e38f; } }
    __syncthreads();
    if (wave < 4) {
        float m = -1e30f, l = 0.f, acc = 0.f;
        for (int k = 0; k < 16; ++k) { const int blk = SELB[k];
            for (int j = 0; j < 64; ++j) { const int tok = 64 * blk + j, ds = t - tok; if (ds < 0) continue;
                const float s = dbg_dot64(q, KV + (size_t)tok * NKV + 512 + g * 64, lane) * (1.0f / LOG2E) - slope * (float)ds;
                const float mn = fmaxf(m, s), a = __expf(m - mn), p = __expf(s - mn); l = l * a + p; acc = acc * a + p * bf2f(KV[(size_t)tok * NKV + 768 + g * 64 + lane]); m = mn; } }
        const float os = (l > 0.f) ? acc / l : 0.f;
        m = -1e30f; l = 0.f; acc = 0.f;
        for (int dw = 0; dw < 512; ++dw) { const int tok = t - dw; if (tok < 0) break;
            const float s = dbg_dot64(q, KV + (size_t)tok * NKV + 1024 + g * 64, lane) * (1.0f / LOG2E) - slope * (float)dw;
            const float mn = fmaxf(m, s), a = __expf(m - mn), p = __expf(s - mn); l = l * a + p; acc = acc * a + p * bf2f(KV[(size_t)tok * NKV + 1280 + g * 64 + lane]); m = mn; }
        const float ow = (l > 0.f) ? acc / l : 0.f;
        const float* gt = GATES + (size_t)t * 48 + g * 4 + (wave & 3);
        const float o = gt[0] * oc + gt[16] * os + gt[32] * ow;
        const float got = bf2f(O[(size_t)t * DM + hh * 64 + lane]);
        dbg_acc(ctl, 1, (o - got) * (o - got), o * o);
    }
    __syncthreads();
}

__device__ __forceinline__ void dbg_check_moe(LAS unsigned char* lds, unsigned* ctl, const bf16* HB, const int4* ROUTE, const float* gu, const float* dn, const bf16* Y) {
    const int tid = threadIdx.x; const int t = dbg_token(blockIdx.x);
    LAS float* hv = (LAS float*)lds; LAS float* hid = (LAS float*)(lds + 4096);
    __syncthreads();
    for (int k = tid; k < DM; k += NTHREADS) hv[k] = bf2f(HB[(size_t)t * DM + k]);
    __syncthreads();
    const int4 r = ROUTE[t];
    { const int sl = tid >> 8, f = tid & 255, e = sl ? r.y : r.x; const float wgt = __int_as_float(sl ? r.w : r.z);
      const float* W = gu + (size_t)e * 1024 * 512; float a = 0.f, b = 0.f;
      for (int k = 0; k < DM; ++k) { a += hv[k] * W[(size_t)k * 512 + f]; b += hv[k] * W[(size_t)k * 512 + 256 + f]; }
      hid[tid] = a / (1.0f + __expf(-a)) * b * wgt; }
    __syncthreads();
    float num = 0.f, den = 0.f;
    for (int dd = tid; dd < DM; dd += NTHREADS) { float y = 0.f;
        for (int sl = 0; sl < 2; ++sl) { const int e = sl ? r.y : r.x; const float* W = dn + (size_t)e * 256 * 1024;
            for (int f = 0; f < 256; ++f) y += hid[sl * 256 + f] * W[(size_t)f * 1024 + dd]; }
        const float got = bf2f(Y[(size_t)t * DM + dd]) + bf2f(Y[((size_t)SEQ + t) * DM + dd]);
        num += (y - got) * (y - got); den += y * y; }
    dbg_acc(ctl, 2, num, den);
    __syncthreads();
}

__device__ __forceinline__ void dbg_check_compress(LAS unsigned char* lds, unsigned* ctl, const bf16* KV, const float* pos, const float* W1, const float* b1, const float* W2, const float* b2, const bf16* KCMP) {
    const int tid = threadIdx.x, w = blockIdx.x; const int j = w & 1, g = (w >> 1) & 3, c = (w < 8) ? (w < 4 ? 0 : 1022) : (int)(((unsigned)w * 977u) % 1023u);
    LAS float* hid = (LAS float*)lds;
    __syncthreads();
    if (tid < 256) { float a = b1[j * 256 + tid];
        for (int k = 0; k < 2048; ++k) { const int lt = k >> 6, d = k & 63; a += (bf2f(KV[(size_t)(16 * c + lt) * NKV + j * 256 + g * 64 + d]) + pos[j * 2048 + k]) * W1[((size_t)j * 2048 + k) * 256 + tid]; }
        hid[tid] = gelu_tanh(a); }
    __syncthreads();
    float num = 0.f, den = 0.f;
    if (tid < 64) { float o = b2[j * 64 + tid]; for (int n = 0; n < 256; ++n) o += hid[n] * W2[((size_t)j * 256 + n) * 64 + tid];
        const float got = bf2f(KCMP[((size_t)j * 4096 + (size_t)c * 4 + g) * 64 + tid]); num = (o - got) * (o - got); den = o * o; }
    if (tid < 64) dbg_acc(ctl, 3, num, den);
    __syncthreads();
}

__device__ __forceinline__ void dbg_check_gemm(unsigned* ctl, int slot, const bf16* A, int K, const float* W, int ldw, int ncols, const float* bias, const bf16* out, int ldo, int qmode) {
    const int lane = threadIdx.x & 63, w = blockIdx.x * 8 + (threadIdx.x >> 6);
    const int row = (int)(((unsigned)w * 2654435761u) >> 18) & (SEQ - 1), col = (int)(((unsigned)w * 40503u + 11u) % (unsigned)ncols);
    float a = 0.f; for (int k = lane; k < K; k += 64) a += bf2f(A[(size_t)row * K + k]) * W[(size_t)k * ldw + col];
    a = wave_sum(a) + (bias ? bias[col] : 0.f);
    if (qmode == 2 || (qmode == 1 && ((col >> 10) % 3) == 0)) a *= C1;
    const float got = bf2f(ldo ? out[(size_t)row * ldo + col] : out[(size_t)(col >> 6) * ((size_t)SEQ * 64) + (size_t)row * 64 + (col & 63)]);
    if (lane == 0) { atomicAdd((float*)(ctl + CW_DBG) + 2 * slot, (a - got) * (a - got)); atomicAdd((float*)(ctl + CW_DBG) + 2 * slot + 1, a * a); }
}
__device__ __forceinline__ void dbg_check_outproj(unsigned* ctl, const bf16* Ob, const float* W, const float* HF, const bf16* HB) {
    const int lane = threadIdx.x & 63, w = blockIdx.x * 8 + (threadIdx.x >> 6);
    const int row = (int)(((unsigned)w * 2654435761u) >> 18) & (SEQ - 1), col = (int)(((unsigned)w * 40503u + 11u) % 1024u);
    float a = 0.f; for (int k = lane; k < DM; k += 64) a += bf2f(Ob[(size_t)row * DM + k]) * W[(size_t)k * DM + col];
    a = wave_sum(a);
    const float got = HF[(size_t)row * DM + col] - ALPHA * bf2f(HB[(size_t)row * DM + col]);
    if (lane == 0) { atomicAdd((float*)(ctl + CW_DBG) + 14, (a - got) * (a - got)); atomicAdd((float*)(ctl + CW_DBG) + 15, a * a); }
}
__device__ __forceinline__ void dbg_check_route(unsigned* ctl, const bf16* HB, const float* Wr, const float* br, const int4* ROUTE) {
    const int lane = threadIdx.x & 63, w = blockIdx.x * 8 + (threadIdx.x >> 6); const int t = (int)(((unsigned)w * 7919u + 3u) % 16384u);
    float lg[20];
#pragma unroll
    for (int c = 0; c < 20; ++c) { float a = 0.f; for (int k = lane; k < DM; k += 64) a += bf2f(HB[(size_t)t * DM + k]) * Wr[(size_t)k * 20 + c]; lg[c] = wave_sum(a) + br[c]; }
    float num = 0.f, den = 0.f;
    if (lane == 0) {
        int gi = 0; float gm = lg[0];
#pragma unroll
        for (int k = 1; k < 4; ++k) if (lg[k] > gm) { gm = lg[k]; gi = k; }
        float dsum = 0.f;
#pragma unroll
        for (int k = 0; k < 4; ++k) dsum += __expf(lg[k] - gm);
        const float gw = 1.0f / dsum; float ev[4];
#pragma unroll
        for (int k = 0; k < 4; ++k) { float v = 0.f;
#pragma unroll
            for (int c = 0; c < 16; ++c) v = (c == 4 * gi + k) ? lg[4 + c] : v; ev[k] = v; }
        int i0 = 0; float v0 = ev[0];
#pragma unroll
        for (int k = 1; k < 4; ++k) if (ev[k] > v0) { v0 = ev[k]; i0 = k; }
        int i1 = -1; float v1 = -3e38f;
#pragma unroll
        for (int k = 0; k < 4; ++k) if (k != i0 && ev[k] > v1) { v1 = ev[k]; i1 = k; }
        const float tt = __expf(v1 - v0), w0 = gw / (1.0f + tt), w1 = gw * tt / (1.0f + tt);
        const int4 r = ROUTE[t];
#pragma unroll
        for (int e = 0; e < 16; ++e) { const float cr = (e == 4 * gi + i0 ? w0 : 0.f) + (e == 4 * gi + i1 ? w1 : 0.f);
            const float cm = (e == r.x ? __int_as_float(r.z) : 0.f) + (e == r.y ? __int_as_float(r.w) : 0.f); num += (cr - cm) * (cr - cm); den += cr * cr; }
        atomicAdd((float*)(ctl + CW_DBG) + 10, num); atomicAdd((float*)(ctl + CW_DBG) + 11, den);
    }
}
__device__ __forceinline__ void dbg_check_gates(unsigned* ctl, const bf16* HB, const float* Wq, const float* bq, const float* GATES) {
    const int lane = threadIdx.x & 63, w = blockIdx.x * 8 + (threadIdx.x >> 6); const int t = (int)(((unsigned)w * 7919u + 3u) % 16384u), c = w % 48;
    float a = 0.f; for (int k = lane; k < DM; k += 64) a += bf2f(HB[(size_t)t * DM + k]) * Wq[(size_t)k * 1072 + 1024 + c];
    a = wave_sum(a) + bq[1024 + c]; const float ref = 1.0f / (1.0f + __expf(-a)), got = GATES[(size_t)t * 48 + c];
    if (lane == 0) { atomicAdd((float*)(ctl + CW_DBG) + 12, (ref - got) * (ref - got)); atomicAdd((float*)(ctl + CW_DBG) + 13, ref * ref); }
}
#ifndef DBG_MASK
#define DBG_MASK 0xff
#endif
__device__ __forceinline__ float dbg_scale(unsigned* ctl) {
    float e = 0.f;
    for (int i = 0; i < 8; ++i) { if (!((DBG_MASK >> i) & 1)) continue; const float num = __hip_atomic_load((float*)(ctl + CW_DBG) + 2 * i, __ATOMIC_RELAXED, __HIP_MEMORY_SCOPE_AGENT), den = __hip_atomic_load((float*)(ctl + CW_DBG) + 2 * i + 1, __ATOMIC_RELAXED, __HIP_MEMORY_SCOPE_AGENT);
        const float r = (den > 0.f) ? sqrtf(num / den) : 7.77f; e = fmaxf(e, r); }
    return 1.0f + 10.0f * e;
}
#endif
struct Args { const float* in[20]; float* out; unsigned char* ws; int ph_lo, ph_hi; };
enum { I_X = 0, I_AWIN, I_AWOUT, I_BWKV, I_CPOS, I_CW1, I_CB1, I_CW2, I_CB2, I_BWQ, I_BBQ, I_BWOUT, I_MWR, I_MBR, I_MWGU, I_MWDN, I_LMG, I_LMB, I_LFG, I_LFB };
typedef const __attribute__((address_space(4))) Args* KArgs;
__device__ __forceinline__ KArgs kargs() { KArgs p = (KArgs)__builtin_amdgcn_kernarg_segment_ptr(); asm volatile("" : "+s"(p)); return p; }

struct Ids { int lane, wave, gw, NGW, G, bx; };
__device__ __forceinline__ Ids ids() {
    Ids d; const int tid = threadIdx.x; d.lane = tid & 63; d.wave = __builtin_amdgcn_readfirstlane(tid >> 6); d.G = gridDim.x; d.bx = blockIdx.x;
    const int vcu = (d.G % 8 == 0) ? (d.bx % 8) * (d.G / 8) + d.bx / 8 : d.bx;
    d.gw = vcu * NWAVES + d.wave; d.NGW = d.G * NWAVES; return d;
}

#ifdef TIMEPROBE
constexpr int CW_TP = 20000;
#define TP_START(k) do { if (blockIdx.x == 0 && threadIdx.x == 0) { unsigned* c_ = (unsigned*)(kargs()->ws + WS_CTL) + CW_TP; const unsigned now_ = (unsigned)__builtin_amdgcn_s_memrealtime(); \
    if ((k) == TP_A0 && (k) >= lo) c_[0] = now_; if ((k) == TP_B0 && (k) >= lo) c_[2] = now_; } } while (0)
#define TP_STOP(k) do { if (blockIdx.x == 0 && threadIdx.x == 0) { unsigned* c_ = (unsigned*)(kargs()->ws + WS_CTL) + CW_TP; const unsigned now_ = (unsigned)__builtin_amdgcn_s_memrealtime(); \
    if ((k) == TP_A1) c_[1] = now_ - c_[0]; if ((k) == TP_B1) c_[3] = now_ - c_[2]; } } while (0)
#else
#define TP_START(k) do { } while (0)
#define TP_STOP(k) do { } while (0)
#endif
#define PHASE_IF(k) TP_START(k); if ((k) >= lo && (k) < hi)
#define PHASE_BAR(k) do { if ((k) >= lo && (k) + 1 < hi) xcd_barrier(bar); TP_STOP(k); } while (0)

__device__ __forceinline__ void phase_prologue(LAS unsigned char* lds) {
    KArgs ka = kargs(); unsigned char* ws = ka->ws; const Ids d = ids(); const int lane = d.lane, gw = d.gw, NGW = d.NGW;
    LAS float* scr = (LAS float*)(lds + d.wave * 16384);
    for (int l = 0; l < 2; ++l) tc_matrix(ka->in[I_AWIN] + (size_t)l * DM * NQKV, NQKV, DM, 0, NQKV, (bf16*)(ws + WS_WIN) + (size_t)l * NQKV * DM, NQKV, scr, lane, gw, NGW);
    for (int l = 0; l < 2; ++l) tc_matrix(ka->in[I_AWOUT] + (size_t)l * DM * DM, DM, DM, 0, DM, (bf16*)(ws + WS_WOUTA) + (size_t)l * DM * DM, DM, scr, lane, gw, NGW);
    tc_matrix(ka->in[I_BWKV], NKV, DM, 0, NKV, (bf16*)(ws + WS_WKV), NKV, scr, lane, gw, NGW);
    for (int i = 0; i < 2; ++i) {
        tc_matrix(ka->in[I_BWQ] + (size_t)i * DM * 1072, 1072, DM, 0, 1024, (bf16*)(ws + WS_WQ) + (size_t)i * DM * DM, DM, scr, lane, gw, NGW);
        tc_matrix(ka->in[I_BWQ] + (size_t)i * DM * 1072, 1072, DM, 1024, 48, (bf16*)(ws + WS_WG) + (size_t)i * 64 * DM, 64, scr, lane, gw, NGW);
        tc_matrix(ka->in[I_BWOUT] + (size_t)i * DM * DM, DM, DM, 0, DM, (bf16*)(ws + WS_WOUTB) + (size_t)i * DM * DM, DM, scr, lane, gw, NGW);
    }
    for (int l = 0; l < 4; ++l) tc_matrix(ka->in[I_MWR] + (size_t)l * DM * 20, 20, DM, 0, 20, (bf16*)(ws + WS_WR) + (size_t)l * 32 * DM, 32, scr, lane, gw, NGW);
    for (int j = 0; j < 2; ++j) {
        tc_matrix(ka->in[I_CW1] + (size_t)j * 2048 * 256, 256, 2048, 0, 256, (bf16*)(ws + WS_W1T) + (size_t)j * 256 * 2048, 256, scr, lane, gw, NGW);
        tc_matrix(ka->in[I_CW2] + (size_t)j * 256 * 64, 64, 256, 0, 64, (bf16*)(ws + WS_W2T) + (size_t)j * 64 * 256, 64, scr, lane, gw, NGW);
    }
    convert_moe_weights(ka->in[I_MWGU], ka->in[I_MWDN], (bf16*)(ws + WS_WGU), (bf16*)(ws + WS_WDN), scr, lane, gw, NGW);
    float* B1P = (float*)(ws + WS_B1P);
    for (int it = gw; it < 128; it += NGW) { const int j = it >> 6, nb = (it >> 4) & 3, ks = it & 15, n = nb * 64 + lane;
        const float* W1 = ka->in[I_CW1] + (size_t)j * 2048 * 256; const float* pos = ka->in[I_CPOS] + (size_t)j * 2048; float a = 0.f;
        for (int k = ks * 128; k < ks * 128 + 128; ++k) a += pos[k] * W1[(size_t)k * 256 + n];
        B1P[(j * 16 + ks) * 256 + n] = a; }
    const float* x = ka->in[I_X]; bf16* HB = (bf16*)(ws + WS_HB);
    for (int row = gw; row < SEQ; row += NGW) {
#pragma unroll
        for (int j = 0; j < 4; ++j) { const f32x4 v = *(const f32x4*)(x + (size_t)row * DM + 4 * lane + 256 * j);
            u32x2 w; w.x = pk2(v[0], v[1]); w.y = pk2(v[2], v[3]); *(u32x2*)(HB + (size_t)row * DM + 4 * lane + 256 * j) = w; }
    }
}

template <int L, int KIND, bool CONVERT>
__device__ __forceinline__ void phase_proj(LAS unsigned char* lds) {
    KArgs ka = kargs(); unsigned char* ws = ka->ws; const Ids d = ids();
    if (CONVERT) {
        convert_moe_weights(ka->in[I_MWGU] + (size_t)L * 16 * 1024 * 512, ka->in[I_MWDN] + (size_t)L * 16 * 256 * 1024, (bf16*)(ws + WS_WGU), (bf16*)(ws + WS_WDN),
                            (LAS float*)(lds + d.wave * 16384), d.lane, d.gw, d.NGW);
        __syncthreads();
    }
    const bf16* HB = (const bf16*)(ws + WS_HB);
#ifndef NO_G1
    if (KIND == 0) { pg8::Gemm gm{HB, (const bf16*)(ws + WS_WIN) + (size_t)L * NQKV * DM, SEQ, NQKV, DM}; EpiHeadMajor E{(bf16*)(ws + WS_BIG), nullptr, 1};
        pg8::StaticOrder S; S.init(SEQ, NQKV, d.G, d.bx); pg8::gemm_phase<EpiHeadMajor, pg8::StaticOrder, false>(lds, gm, S, E, nullptr); }
    else if (KIND == 1) { pg8::Gemm gm{HB, (const bf16*)(ws + WS_WKV), SEQ, NKV, DM}; pg8::EpiBf16<0> E{(bf16*)(ws + BIG_KV), NKV, nullptr, 0, 0};
        pg8::StaticOrder S; S.init(SEQ, NKV, d.G, d.bx); pg8::gemm_phase<pg8::EpiBf16<0>, pg8::StaticOrder, false>(lds, gm, S, E, nullptr); }
    else { pg8::Gemm gm{HB, (const bf16*)(ws + WS_WQ) + (size_t)(L - 2) * DM * DM, SEQ, DM, DM}; EpiHeadMajor E{(bf16*)(ws + BIG_Q), ka->in[I_BBQ] + (size_t)(L - 2) * 1072, 2};
        pg8::StaticOrder S; S.init(SEQ, DM, d.G, d.bx); pg8::gemm_phase<EpiHeadMajor, pg8::StaticOrder, false>(lds, gm, S, E, nullptr); }
#endif
}
__device__ __forceinline__ void phase_compress(LAS unsigned char* lds) {
    KArgs ka = kargs(); unsigned char* ws = ka->ws;
    compress_phase(lds, (const bf16*)(ws + BIG_KV), (const bf16*)(ws + WS_W1T), (const bf16*)(ws + WS_W2T), (const float*)(ws + WS_B1P), ka->in[I_CB1], ka->in[I_CB2], (bf16*)(ws + BIG_KCMP));
}
__device__ __forceinline__ void phase_attn_dilated(LAS unsigned char* lds) {
    KArgs ka = kargs(); unsigned char* ws = ka->ws; const Ids d = ids();
    const bf16* QKV = (const bf16*)(ws + WS_BIG); bf16* OB = (bf16*)(ws + WS_O); LAS unsigned char* slab = lds + d.wave * 16384;
#ifndef NO_DIL
#ifdef ATT_V2
    for (int it = d.bx; it < 1024; it += d.G) dil_block(QKV, OB, it >> 4, it & 15, lds, d.wave, d.lane);
#else
    for (int it = d.gw; it < 8192; it += d.NGW) { const int rr = it & 15, h = (it >> 4) & 15, B = it >> 8; dil_item(QKV, OB, B, rr, h, slab, d.lane); }
#endif
#endif
}
__device__ __forceinline__ void phase_attn_nsa(LAS unsigned char* lds) {
    KArgs ka = kargs(); unsigned char* ws = ka->ws; const Ids d = ids();
    const bf16* KCMP = (const bf16*)(ws + BIG_KCMP); LAS unsigned char* slab = lds + d.wave * NSA_SLAB;
#ifndef NO_NSA
#ifdef NSA_CHUNK
    for (int idx = d.bx; idx < 1024; idx += d.G) { const int k = idx >> 8, b = idx & 255, b0 = (k & 2) ? ((b + 128) & 255) : b, ch = (k & 1) ? 255 - b0 : b0;
        nsa_chunk((const bf16*)(ws + BIG_Q), (const bf16*)(ws + BIG_KV), KCMP, KCMP + 1024 * 256, (const float*)(ws + WS_GATES), (bf16*)(ws + WS_O), ch, k, lds, d.wave, d.lane); }
    (void)slab;
#else
    for (int k = 0; k < 4; ++k) { const int idx = ((k & 1) ? (d.NGW - 1 - d.gw) : d.gw) + d.NGW * k;
        if (idx < 8192) nsa_item((const bf16*)(ws + BIG_Q), (const bf16*)(ws + BIG_KV), KCMP, KCMP + 1024 * 256, (const float*)(ws + WS_GATES), (bf16*)(ws + WS_O), idx >> 2, idx & 3, slab, d.lane); }
#endif
#endif
}
template <int L>
__device__ __forceinline__ void phase_outproj(LAS unsigned char* lds) {
    KArgs ka = kargs(); unsigned char* ws = ka->ws; const Ids d = ids();
    const bf16* Wt = (L < 2) ? (const bf16*)(ws + WS_WOUTA) + (size_t)L * DM * DM : (const bf16*)(ws + WS_WOUTB) + (size_t)(L - 2) * DM * DM;
    pg8::Gemm gm{(const bf16*)(ws + WS_O), Wt, SEQ, DM, DM}; EpiResid E{(bf16*)(ws + WS_HB)};
    pg8::StaticOrder S; S.init(SEQ, DM, d.G, d.bx);
#ifndef NO_G2
    pg8::gemm_phase<EpiResid, pg8::StaticOrder, false>(lds, gm, S, E, nullptr);
#endif
}
template <int L>
__device__ __forceinline__ void phase_ln_mix(LAS unsigned char* lds) {
    KArgs ka = kargs(); unsigned char* ws = ka->ws;
    ln_phase(lds, 0, 1.0f, nullptr, ka->in[I_LMG] + (size_t)L * DM, ka->in[I_LMB] + (size_t)L * DM, nullptr, 1.0f, (bf16*)(ws + WS_HB),
             (const bf16*)(ws + WS_WR) + (size_t)L * 32 * DM, ka->in[I_MBR] + (size_t)L * 20, (int4*)(ws + WS_ROUTE), (int*)(ws + WS_HIST), nullptr);
}
__device__ __forceinline__ void phase_scatter(LAS unsigned char* lds) {
    KArgs ka = kargs(); unsigned char* ws = ka->ws;
    moe_scatter(lds, (const int4*)(ws + WS_ROUTE), (const int*)(ws + WS_HIST), (int*)(ws + WS_TILEB), (const bf16*)(ws + WS_HB), (bf16*)(ws + BIG_HS), (int*)(ws + WS_ROWINFO), (float*)(ws + WS_ROWW));
}
__device__ __forceinline__ void load_tileb(LAS unsigned char* lds, const int* TILEB) {
    LAS int* tb = (LAS int*)(lds + LDS_MISC);
    if (threadIdx.x < 17) tb[threadIdx.x] = TILEB[threadIdx.x];
    __syncthreads();
}
__device__ __forceinline__ void phase_moe_up(LAS unsigned char* lds) {
    KArgs ka = kargs(); unsigned char* ws = ka->ws; const Ids d = ids();
    load_tileb(lds, (const int*)(ws + WS_TILEB));
    pg8::Gemm gm{(const bf16*)(ws + BIG_HS), (const bf16*)(ws + WS_WGU), MAXROWS, 512, DM}; EpiSwiglu E{(bf16*)(ws + BIG_HID), (const float*)(ws + WS_ROWW)};
    MoeOrder S; S.init((const LAS int*)(lds + LDS_MISC), 2, d.G, d.bx);
#ifndef NO_M2
    pg8::gemm_phase<EpiSwiglu, MoeOrder, false>(lds, gm, S, E, nullptr);
#endif
}
__device__ __forceinline__ void phase_moe_down(LAS unsigned char* lds) {
    KArgs ka = kargs(); unsigned char* ws = ka->ws; const Ids d = ids();
    load_tileb(lds, (const int*)(ws + WS_TILEB));
    pg8::Gemm gm{(const bf16*)(ws + BIG_HID), (const bf16*)(ws + WS_WDN), MAXROWS, 1024, 256}; EpiScatter E{(bf16*)(ws + BIG_Y), (const int*)(ws + WS_ROWINFO)};
    MoeOrder S; S.init((const LAS int*)(lds + LDS_MISC), 4, d.G, d.bx);
#ifndef NO_M3
    pg8::gemm_phase<EpiScatter, MoeOrder, false>(lds, gm, S, E, nullptr);
#endif
}
#if defined(TIMEPROBE)
#define DBG_OUT_SCALE (1.0f + (float)(((unsigned*)(ws + WS_CTL))[CW_TP + 1]) * (0.01f / 5000.0f))
#elif DBG_CHECK
#define DBG_OUT_SCALE dbg_scale((unsigned*)(ws + WS_CTL))
#else
#define DBG_OUT_SCALE 1.0f
#endif
template <int L>
__device__ __forceinline__ void phase_ln_ffn(LAS unsigned char* lds) {
    KArgs ka = kargs(); unsigned char* ws = ka->ws;
    constexpr bool last = (L == 3), gates = (L == 1 || L == 2);
    ln_phase(lds, gates ? 1 : 2, ALPHA, (const bf16*)(ws + BIG_Y), ka->in[I_LFG] + (size_t)L * DM, ka->in[I_LFB] + (size_t)L * DM, last ? ka->out : nullptr,
             last ? DBG_OUT_SCALE : 1.0f, (bf16*)(ws + WS_HB), (const bf16*)(ws + WS_WG) + (size_t)(gates ? L - 1 : 0) * 64 * DM, ka->in[I_BBQ] + (size_t)(gates ? L - 1 : 0) * 1072 + 1024,
             nullptr, nullptr, (float*)(ws + WS_GATES));
#ifdef TIMEPROBE
    if (last && blockIdx.x == 0 && threadIdx.x == 0) { asm volatile("s_waitcnt vmcnt(0)" ::: "memory"); ka->out[0] = (float)(((unsigned*)(ws + WS_CTL))[CW_TP + 3]) * (0.01f / 10.0f); }
#endif
}


#if DBG_CHECK
template <int L, int WHERE>
__device__ __forceinline__ void dbg_hook(LAS unsigned char* lds, const XcdBarrier& bar) {
    KArgs ka = kargs(); unsigned char* ws = ka->ws; unsigned* ctl = (unsigned*)(ws + WS_CTL);
    const bf16* HB = (const bf16*)(ws + WS_HB); const bf16* KCMP = (const bf16*)(ws + BIG_KCMP);
    if (WHERE == 0) {
        if (L == 2) dbg_check_compress(lds, ctl, (const bf16*)(ws + BIG_KV), ka->in[I_CPOS], ka->in[I_CW1], ka->in[I_CB1], ka->in[I_CW2], ka->in[I_CB2], KCMP);
        if (L == 2) dbg_check_gemm(ctl, 4, HB, DM, ka->in[I_BWKV], NKV, NKV, nullptr, (const bf16*)(ws + BIG_KV), NKV, 0);
        if (L == 3) dbg_check_gates(ctl, HB, ka->in[I_BWQ] + (size_t)(L - 2) * DM * 1072, ka->in[I_BBQ] + (size_t)(L - 2) * 1072, (const float*)(ws + WS_GATES));
    }
    if (WHERE == 5) { if (L == 2) dbg_check_gates(ctl, HB, ka->in[I_BWQ], ka->in[I_BBQ], (const float*)(ws + WS_GATES)); }
    if (WHERE == 1) {
        if (L < 2) dbg_check_gemm(ctl, 4, HB, DM, ka->in[I_AWIN] + (size_t)L * DM * NQKV, NQKV, NQKV, nullptr, (const bf16*)(ws + WS_BIG), 0, 1);
        else dbg_check_gemm(ctl, 4, HB, DM, ka->in[I_BWQ] + (size_t)(L - 2) * DM * 1072, 1072, 1024, ka->in[I_BBQ] + (size_t)(L - 2) * 1072, (const bf16*)(ws + BIG_Q), 0, 2);
    }
    if (WHERE == 2) {
        if (L < 2) dbg_check_dilated(ctl, (const bf16*)(ws + WS_BIG), (const bf16*)(ws + WS_O));
        else dbg_check_nsa(lds, ctl, (const bf16*)(ws + BIG_Q), (const bf16*)(ws + BIG_KV), KCMP, KCMP + 1024 * 256, (const float*)(ws + WS_GATES), (const bf16*)(ws + WS_O));
    }
    if (WHERE == 3) dbg_check_outproj(ctl, (const bf16*)(ws + WS_O), (L < 2) ? ka->in[I_AWOUT] + (size_t)L * DM * DM : ka->in[I_BWOUT] + (size_t)(L - 2) * DM * DM, (const float*)(ws + WS_HF), HB);
    if (WHERE == 4) dbg_check_route(ctl, HB, ka->in[I_MWR] + (size_t)L * DM * 20, ka->in[I_MBR] + (size_t)L * 20, (const int4*)(ws + WS_ROUTE));
    if (WHERE == 6) dbg_check_moe(lds, ctl, HB, (const int4*)(ws + WS_ROUTE), ka->in[I_MWGU] + (size_t)L * 16 * 1024 * 512, ka->in[I_MWDN] + (size_t)L * 16 * 256 * 1024, (const bf16*)(ws + BIG_Y));
    xcd_barrier(bar);
}
#define DBG_HOOK(L, W) dbg_hook<L, W>(lds, bar)
#else
#define DBG_HOOK(L, W) do { } while (0)
#endif
template <int L>
__device__ __forceinline__ void layer_phases(LAS unsigned char* lds, const XcdBarrier& bar, const int lo, const int hi) {
    constexpr int PB = (L == 0) ? 1 : ((L == 1) ? 9 : ((L == 2) ? 17 : 27));
    constexpr int P1 = (L == 2) ? PB + 2 : PB;
    if (L == 2) {
        PHASE_IF(PB) { DBG_HOOK(L, 5); phase_proj<L, 1, true>(lds); }
        PHASE_BAR(PB);
        PHASE_IF(PB + 1) phase_compress(lds);
        PHASE_BAR(PB + 1);
        PHASE_IF(P1) { DBG_HOOK(L, 0); phase_proj<L, 2, false>(lds); }
        PHASE_BAR(P1);
    } else if (L == 3) {
        PHASE_IF(P1) { DBG_HOOK(L, 0); phase_proj<L, 2, true>(lds); }
        PHASE_BAR(P1);
    } else {
        PHASE_IF(P1) phase_proj<L, 0, (L > 0)>(lds);
        PHASE_BAR(P1);
    }
    PHASE_IF(P1 + 1) { DBG_HOOK(L, 1); if (L < 2) phase_attn_dilated(lds); else phase_attn_nsa(lds);
#ifdef DUP_MASK
        if (L < 2 && (DUP_MASK & 4)) { __syncthreads(); phase_attn_dilated(lds); }
        if (L >= 2 && (DUP_MASK & 8)) { __syncthreads(); phase_attn_nsa(lds); }
#endif
    }
    PHASE_BAR(P1 + 1);
    PHASE_IF(P1 + 2) { DBG_HOOK(L, 2); phase_outproj<L>(lds); }
    PHASE_BAR(P1 + 2);
    PHASE_IF(P1 + 3) { DBG_HOOK(L, 3); phase_ln_mix<L>(lds); }
    PHASE_BAR(P1 + 3);
    PHASE_IF(P1 + 4) { DBG_HOOK(L, 4); phase_scatter(lds);
#ifdef DUP_MASK
        if (DUP_MASK & 16) { __syncthreads(); phase_scatter(lds); }
#endif
    }
    PHASE_BAR(P1 + 4);
    PHASE_IF(P1 + 5) { phase_moe_up(lds);
#ifdef DUP_MASK
        if (DUP_MASK & 32) { __syncthreads(); phase_moe_up(lds); }
#endif
    }
    PHASE_BAR(P1 + 5);
    PHASE_IF(P1 + 6) { phase_moe_down(lds);
#ifdef DUP_MASK
        if (DUP_MASK & 64) { __syncthreads(); phase_moe_down(lds); }
#endif
    }
    PHASE_BAR(P1 + 6);
    PHASE_IF(P1 + 7) { DBG_HOOK(L, 6); phase_ln_ffn<L>(lds); }
    PHASE_BAR(P1 + 7);
}
constexpr int NPHASES = 35;

__global__ void __launch_bounds__(NTHREADS, 2) yoco_fwd(Args args) {
    extern __shared__ __attribute__((aligned(16))) unsigned char lds_raw[];
    LAS unsigned char* lds = (LAS unsigned char*)lds_raw;
    const int lo = args.ph_lo, hi = args.ph_hi;
    if (threadIdx.x < 4) ((LAS unsigned*)(lds + LDS_BAR))[threadIdx.x] = 0u;
    __syncthreads();
    unsigned* barw = (unsigned*)(args.ws + WS_CTL) + CW_BAR;
    XcdBarrier bar; bar.bar = barw; bar.x = 0; bar.st = (volatile LAS unsigned*)(lds + LDS_BAR);
    if (hi - lo > 1) bar = xcd_barrier_post(barw, (volatile LAS unsigned*)(lds + LDS_BAR));
    PHASE_IF(0) { phase_prologue(lds);
#ifdef DUP_MASK
        if (DUP_MASK & 1) { __syncthreads(); phase_prologue(lds); }
#endif
    }
    PHASE_BAR(0);
    layer_phases<0>(lds, bar, lo, hi);
    layer_phases<1>(lds, bar, lo, hi);
    layer_phases<2>(lds, bar, lo, hi);
    layer_phases<3>(lds, bar, lo, hi);
}

extern "C" void kernel_launch(void* const* d_in, const int* in_sizes, int n_in, void* d_out, int out_size, void* d_ws, size_t ws_size, hipStream_t stream) {
    static int grid = 0;
    if (grid == 0) {
        if (n_in != 20 || out_size != SEQ * DM || ws_size < WS_END) { fprintf(stderr, "kernel_launch: unexpected problem shape (n_in %d, out %d, ws %zu)\n", n_in, out_size, ws_size); grid = -1; return; }
        int dev = 0, cus = 0;
        if (hipGetDevice(&dev) != hipSuccess || hipDeviceGetAttribute(&cus, hipDeviceAttributeMultiprocessorCount, dev) != hipSuccess) { grid = -1; return; }
        if (hipFuncSetAttribute((const void*)yoco_fwd, hipFuncAttributeMaxDynamicSharedMemorySize, LDS_BYTES) != hipSuccess) { fprintf(stderr, "kernel_launch: hipFuncSetAttribute failed\n"); grid = -1; return; }
        int per_cu = 0;
        if (hipOccupancyMaxActiveBlocksPerMultiprocessor(&per_cu, (const void*)yoco_fwd, NTHREADS, LDS_BYTES) != hipSuccess || per_cu < 1) fprintf(stderr, "kernel_launch: occupancy query says %d\n", per_cu);
        (void)hipGetLastError();
        grid = cus;
    }
    if (grid < 0) return;
    (void)hipMemsetAsync((char*)d_ws + WS_CTL, 0, CTL_BYTES, stream);
    Args a{};
    for (int i = 0; i < 20; ++i) a.in[i] = (const float*)d_in[i];
    a.out = (float*)d_out; a.ws = (unsigned char*)d_ws;
#if MK_ONE_LAUNCH
    a.ph_lo = 0; a.ph_hi = NPHASES;
    hipLaunchKernelGGL(yoco_fwd, dim3(grid), dim3(NTHREADS), LDS_BYTES, stream, a);
#else
    for (int ph = 0; ph < NPHASES; ++ph) { a.ph_lo = ph; a.ph_hi = ph + 1; hipLaunchKernelGGL(yoco_fwd, dim3(grid), dim3(NTHREADS), LDS_BYTES, stream, a); }
#endif
}
```

```cpp
#include <hip/hip_runtime.h>
#include <cstdio>
#include <cstdint>
#include <cmath>
#define MK_ONE_LAUNCH 1
namespace pg8 {
#define PG8_LAS __attribute__((address_space(3)))
typedef unsigned short bf16_t;
typedef short bf16x8 __attribute__((ext_vector_type(8)));
typedef float f32x4 __attribute__((ext_vector_type(4)));
typedef unsigned u32x4 __attribute__((ext_vector_type(4)));
constexpr int BM = 256, BK = 64, HALF = 128, HTB = HALF * BK * 2  , STAGE_BYTES = 8 * HTB, NXCD = 8, WGM = 8;

__host__ __device__ __forceinline__ int lds_byte(int r, int c) { const int st = (r >> 4) * 2 + (c >> 5), rr = r & 15, cc = c & 31, ob = rr * 64 + cc * 2; return st * 1024 + (ob ^ (((ob >> 9) & 1) << 5)); }
__host__ __device__ __forceinline__ void stage_rc(int b, int& R, int& C) { const int st = b / 1024, sb = b % 1024, swz = sb ^ (((sb >> 9) & 1) << 5); R = (st >> 1) * 16 + swz / 64; C = (st & 1) * 32 + (swz % 64) / 2; }
__host__ __device__ __forceinline__ int perm32(int rho) { const int n = rho >> 4, i = rho & 15; return 8 * (i >> 2) + 4 * n + (i & 3); }

struct Unit { int pm, pn; };
struct Gemm { const bf16_t* A; const bf16_t* Bt; int M, N, K; };

struct StaticOrder {
    static constexpr bool GATHER = false;
    int nM, nN, nwg, G, c;
    __host__ __device__ void init(int M, int N, int G_, int c_) { nM = M / BM; nN = N / BM; nwg = nM * nN; G = G_; c = c_; }
    __host__ __device__ bool next(int i, Unit& u) const {
        const long L = (long)i * G + c; if (L >= nwg) return false;
        int wgid = (int)L; { const int q = nwg / NXCD, r = nwg % NXCD, xcd = wgid % NXCD, off = wgid / NXCD; wgid = (xcd < r ? xcd * (q + 1) : r * (q + 1) + (xcd - r) * q) + off; }
        const int nig = WGM * nN, gid = wgid / nig, fm = gid * WGM, gsz = (nM - fm) < WGM ? (nM - fm) : WGM;
        u.pm = fm + ((wgid % nig) % gsz); u.pn = (wgid % nig) / gsz; return true;
    }
    __device__ __forceinline__ void a_ready(const Unit&) const {}
    __device__ __forceinline__ void done(const Unit&) const {}
};
struct CountedOrder : StaticOrder {
    const unsigned* ready; unsigned need; unsigned* tmo;
    __device__ __forceinline__ void a_ready(const Unit& u) const {
        if (threadIdx.x < 64) {
            const unsigned long long t0 = __builtin_amdgcn_s_memrealtime(); unsigned polls = 0;
            while ((unsigned)__builtin_amdgcn_readfirstlane(__hip_atomic_load(ready + 64 * u.pm, __ATOMIC_RELAXED, __HIP_MEMORY_SCOPE_AGENT)) < need) {
                if ((++polls & 255u) == 0u && __builtin_amdgcn_readfirstlane(__hip_atomic_load(tmo, __ATOMIC_RELAXED, __HIP_MEMORY_SCOPE_AGENT)) != 0u) break;
                if (__builtin_amdgcn_s_memrealtime() - t0 > 2000000ull) {
                    if (threadIdx.x == 0) { unsigned expect = 0u; __hip_atomic_compare_exchange_strong(tmo + 1, &expect, 0x600u | (unsigned)(u.pm & 0xff), __ATOMIC_RELAXED, __ATOMIC_RELAXED, __HIP_MEMORY_SCOPE_AGENT); __hip_atomic_store(tmo, 1u, __ATOMIC_RELAXED, __HIP_MEMORY_SCOPE_AGENT); }
                    break; }
                __builtin_amdgcn_s_sleep(2); }
            __builtin_amdgcn_fence(__ATOMIC_ACQUIRE, "agent");
            asm volatile("s_waitcnt vmcnt(0)" ::: "memory");
        }
#if !defined(BROKEN_HOOK_NO_BARRIER)
        asm volatile("" ::: "memory"); __builtin_amdgcn_s_barrier(); asm volatile("" ::: "memory");
#endif
    }
};

__device__ __forceinline__ unsigned cvt_pk_bf16(float lo, float hi) { unsigned r; asm volatile("v_cvt_pk_bf16_f32 %0, %1, %2" : "=v"(r) : "v"(lo), "v"(hi)); return r; }
typedef float f32x2 __attribute__((ext_vector_type(2)));
__device__ __forceinline__ f32x2 gelu_pk(f32x2 v) {
    const f32x2 av = __builtin_elementwise_abs(v), d = av * 0.2316418882f + 1.0f;
    f32x2 t; t.x = __builtin_amdgcn_rcpf(d.x); t.y = __builtin_amdgcn_rcpf(d.y);
    f32x2 q = t * 0.5307027145f + (-0.7265760135f); q = q * t + 0.7107068705f; q = q * t + (-0.142248368f); q = q * t + 0.127414796f; q = q * t;
    const f32x2 s = (v * v) * (-0.72134752044f);
    f32x2 e; e.x = __builtin_amdgcn_exp2f(s.x); e.y = __builtin_amdgcn_exp2f(s.y);
    const f32x2 m = v * (q * e), r = v - m;
    f32x2 o; o.x = v.x < 0.f ? m.x : r.x; o.y = v.y < 0.f ? m.y : r.y; return o;
}

struct EpiF32 {
    static constexpr bool PERM = false, AFTER_DRAIN = false;
    float* C; int ldc; const float* bias;
    __device__ __forceinline__ void operator()(const f32x4 (&acc)[2][2][4][2], const Unit& u, int wr, int wc, int fr, int fq) const {
        const int row0 = u.pm * BM + wr * 64 + fr, col0 = u.pn * BM + wc * 32 + 4 * fq;
        f32x4 bv[2][2];
#pragma unroll
        for (int bj = 0; bj < 2; ++bj)
#pragma unroll
            for (int n = 0; n < 2; ++n) bv[bj][n] = bias ? *(const f32x4*)(bias + col0 + bj * HALF + n * 16) : (f32x4){0.f, 0.f, 0.f, 0.f};
#pragma unroll
        for (int ai = 0; ai < 2; ++ai)
#pragma unroll
            for (int m = 0; m < 4; ++m) { float* rowp = C + (size_t)(row0 + ai * HALF + m * 16) * ldc + col0;
#pragma unroll
                for (int bj = 0; bj < 2; ++bj)
#pragma unroll
                    for (int n = 0; n < 2; ++n) *(f32x4*)(rowp + bj * HALF + n * 16) = acc[ai][bj][m][n] + bv[bj][n]; }
    }
};
template <int ACT  > struct EpiBf16 {
    static constexpr bool PERM = true, AFTER_DRAIN = false;
    bf16_t* O; int ldc; const float* bias; int split_cols; size_t split_stride;
    __device__ __forceinline__ void operator()(const f32x4 (&acc)[2][2][4][2], const Unit& u, int wr, int wc, int fr, int fq) const {
        const int row0 = u.pm * BM + wr * 64 + fr; int colt = u.pn * BM; bf16_t* base = O;
        if (split_cols) { const int t = colt / split_cols; base += (size_t)t * split_stride; colt -= t * split_cols; }
        const int col0 = colt + wc * 32 + 8 * fq, bcol0 = u.pn * BM + wc * 32 + 8 * fq;
        f32x4 bv[2][2];
#pragma unroll
        for (int bj = 0; bj < 2; ++bj)
#pragma unroll
            for (int n = 0; n < 2; ++n) bv[bj][n] = bias ? *(const f32x4*)(bias + bcol0 + bj * HALF + 4 * n) : (f32x4){0.f, 0.f, 0.f, 0.f};
#pragma unroll
        for (int ai = 0; ai < 2; ++ai)
#pragma unroll
            for (int m = 0; m < 4; ++m) { bf16_t* rowp = base + (size_t)(row0 + ai * HALF + m * 16) * ldc + col0;
#pragma unroll
                for (int bj = 0; bj < 2; ++bj) { f32x4 v0 = acc[ai][bj][m][0] + bv[bj][0], v1 = acc[ai][bj][m][1] + bv[bj][1];
                    if (ACT == 1) { f32x2 a = gelu_pk((f32x2){v0[0], v0[1]}), b = gelu_pk((f32x2){v0[2], v0[3]}), c = gelu_pk((f32x2){v1[0], v1[1]}), d = gelu_pk((f32x2){v1[2], v1[3]});
                        v0 = (f32x4){a.x, a.y, b.x, b.y}; v1 = (f32x4){c.x, c.y, d.x, d.y}; }
                    if (ACT == 2) {
#pragma unroll
                        for (int j = 0; j < 4; ++j) { v0[j] = 0.5f * v0[j] * (1.0f + erff(v0[j] * 0.70710678f)); v1[j] = 0.5f * v1[j] * (1.0f + erff(v1[j] * 0.70710678f)); } }
                    u32x4 w; w.x = cvt_pk_bf16(v0[0], v0[1]); w.y = cvt_pk_bf16(v0[2], v0[3]); w.z = cvt_pk_bf16(v1[0], v1[1]); w.w = cvt_pk_bf16(v1[2], v1[3]);
                    *(u32x4*)(rowp + bj * HALF) = w; } }
    }
};

struct PanelStats {
    unsigned* xbuf;
    unsigned* cnt;
    unsigned* tmo;
    int ntn; float eps;
    unsigned code;
    __device__ __forceinline__ bool run(const f32x4 (&v)[2][2][4][2], const Unit& u, int wr, int wc, int fr, int fq, PG8_LAS unsigned char* lds, int wid, int lane) const {
        typedef float f32x2v __attribute__((ext_vector_type(2)));
        PG8_LAS f32x2v* P = (PG8_LAS f32x2v*)lds;
        PG8_LAS f32x2v* S = (PG8_LAS f32x2v*)(lds + 8192);
        PG8_LAS unsigned* flag = (PG8_LAS unsigned*)(lds + 8192 + 2048);
#pragma unroll
        for (int ai = 0; ai < 2; ++ai)
#pragma unroll
            for (int m = 0; m < 4; ++m) {
                float s = 0.f;
#pragma unroll
                for (int bj = 0; bj < 2; ++bj)
#pragma unroll
                    for (int n = 0; n < 2; ++n) { const f32x4 x = v[ai][bj][m][n]; s += (x[0] + x[1]) + (x[2] + x[3]); }
                s += __shfl_xor(s, 16); s += __shfl_xor(s, 32);
                const float mw = s * (1.0f / 64.0f); float q = 0.f;
#pragma unroll
                for (int bj = 0; bj < 2; ++bj)
#pragma unroll
                    for (int n = 0; n < 2; ++n) { const f32x4 d = v[ai][bj][m][n] - mw; q += (d[0] * d[0] + d[1] * d[1]) + (d[2] * d[2] + d[3] * d[3]); }
                q += __shfl_xor(q, 16); q += __shfl_xor(q, 32);
                if (fq == 0) P[(ai * HALF + wr * 64 + m * 16 + fr) * 4 + wc] = (f32x2v){mw, q};
            }
        asm volatile("s_waitcnt lgkmcnt(0)" ::: "memory"); __builtin_amdgcn_s_barrier(); asm volatile("" ::: "memory");
#if defined(BROKEN_NO_WAIT)
        if (blockIdx.x >= 64) { const long long t0 = clock64(); while (clock64() - t0 < 60000) __builtin_amdgcn_s_sleep(8); }
#endif
        const int row = wid * 32 + (lane & 31);
        if (lane < 32) {
            const f32x2v a = P[row * 4 + 0], b = P[row * 4 + 1], c = P[row * 4 + 2], d = P[row * 4 + 3];
            const float mt = (a.x + b.x + c.x + d.x) * 0.25f;
            const float da = a.x - mt, db = b.x - mt, dc = c.x - mt, dd = d.x - mt;
            const float m2 = (a.y + b.y) + (c.y + d.y) + 64.0f * ((da * da + db * db) + (dc * dc + dd * dd));
            unsigned long long* slot = (unsigned long long*)xbuf + ((size_t)(u.pm * BM + row) * 4 + u.pn);
            __hip_atomic_store(slot, ((unsigned long long)__float_as_uint(m2) << 32) | __float_as_uint(mt), __ATOMIC_RELAXED, __HIP_MEMORY_SCOPE_AGENT);
        }
        asm volatile("s_waitcnt vmcnt(0)" ::: "memory");
        if (lane == 0) __hip_atomic_fetch_add(cnt + 64 * u.pm, 1u, __ATOMIC_RELAXED, __HIP_MEMORY_SCOPE_AGENT);
        if (wid == 0) {
            bool dead = false; const unsigned long long t0 = __builtin_amdgcn_s_memrealtime(); const unsigned want = 8u * (unsigned)ntn;
            for (;;) {
#if defined(BROKEN_NO_WAIT)
                break;
#endif
                if ((unsigned)__builtin_amdgcn_readfirstlane(__hip_atomic_load(cnt + 64 * u.pm, __ATOMIC_RELAXED, __HIP_MEMORY_SCOPE_AGENT)) >= want) break;
                if (__builtin_amdgcn_s_memrealtime() - t0 > 2000000ull) {
                    if (lane == 0) { unsigned expect = 0u; __hip_atomic_compare_exchange_strong(tmo + 1, &expect, code | (unsigned)(u.pm & 0xff), __ATOMIC_RELAXED, __ATOMIC_RELAXED, __HIP_MEMORY_SCOPE_AGENT);
                                     __hip_atomic_store(tmo, 1u, __ATOMIC_RELAXED, __HIP_MEMORY_SCOPE_AGENT); }
                    dead = true; break; }
                __builtin_amdgcn_s_sleep(2);
            }
            __builtin_amdgcn_fence(__ATOMIC_ACQUIRE, "agent");
            if (lane == 0) flag[0] = dead ? 1u : 0u;
        }
        asm volatile("s_waitcnt vmcnt(0) lgkmcnt(0)" ::: "memory"); __builtin_amdgcn_s_barrier(); asm volatile("" ::: "memory");
        const bool bad = flag[0] != 0u;
        if (lane < 32) {
            const unsigned long long* slot = (const unsigned long long*)xbuf + (size_t)(u.pm * BM + row) * 4; float mt[4], m2[4]; float ms = 0.f;
#pragma unroll
            for (int t = 0; t < 4; ++t) { if (t < ntn) { const unsigned long long w = __hip_atomic_load(slot + t, __ATOMIC_RELAXED, __HIP_MEMORY_SCOPE_AGENT); mt[t] = __uint_as_float((unsigned)w); m2[t] = __uint_as_float((unsigned)(w >> 32)); } else { mt[t] = 0.f; m2[t] = 0.f; } ms += mt[t]; }
            const float mean = ms / (float)ntn; float q = 0.f;
#pragma unroll
            for (int t = 0; t < 4; ++t) if (t < ntn) { const float dm = mt[t] - mean; q += m2[t] + 256.0f * dm * dm; }
            S[row] = (f32x2v){mean, 1.0f / sqrtf(q / (256.0f * (float)ntn) + eps)};
        }
        asm volatile("s_waitcnt lgkmcnt(0)" ::: "memory"); __builtin_amdgcn_s_barrier(); asm volatile("" ::: "memory");
        return bad;
    }
};
struct EpiLnRes {
    static constexpr bool PERM = false, AFTER_DRAIN = true;
    const float* base; float* out; int ldc; const float* bias; PanelStats st; unsigned poison;
    __device__ __forceinline__ void refuse(size_t i0, size_t stride, int M, int N) const { const float q = __builtin_nanf(""); for (size_t i = i0; i < (size_t)M * N; i += stride) out[(i / N) * ldc + i % N] = q;
        if (i0 == 0) { unsigned expect = 0u; __hip_atomic_compare_exchange_strong(st.tmo + 1, &expect, 0x7f0u, __ATOMIC_RELAXED, __ATOMIC_RELAXED, __HIP_MEMORY_SCOPE_AGENT); __hip_atomic_store(st.tmo, 1u, __ATOMIC_RELAXED, __HIP_MEMORY_SCOPE_AGENT); } }
    __device__ __forceinline__ void fused(f32x4 (&acc)[2][2][4][2], const Unit& u, int wr, int wc, int fr, int fq, PG8_LAS unsigned char* lds, int wid, int lane) const {
        typedef float f32x2v __attribute__((ext_vector_type(2)));
        const PG8_LAS f32x2v* S = (const PG8_LAS f32x2v*)(lds + 8192);
        const int col0 = u.pn * BM + wc * 32 + 4 * fq;
#pragma unroll
        for (int bj = 0; bj < 2; ++bj)
#pragma unroll
            for (int n = 0; n < 2; ++n) { const f32x4 bv = bias ? *(const f32x4*)(bias + col0 + bj * HALF + n * 16) : (f32x4){0.f, 0.f, 0.f, 0.f};
#pragma unroll
                for (int ai = 0; ai < 2; ++ai)
#pragma unroll
                    for (int m = 0; m < 4; ++m) acc[ai][bj][m][n] += bv; }
        const bool bad = st.run(acc, u, wr, wc, fr, fq, lds, wid, lane) || poison != 0u;
        const float qnan = __builtin_nanf("");
#pragma unroll
        for (int ai = 0; ai < 2; ++ai)
#pragma unroll
            for (int m = 0; m < 4; ++m) { const int r = ai * HALF + wr * 64 + m * 16 + fr; const f32x2v sr = S[r]; const size_t off = (size_t)(u.pm * BM + r) * ldc + col0;
#pragma unroll
                for (int bj = 0; bj < 2; ++bj)
#pragma unroll
                    for (int n = 0; n < 2; ++n) { const f32x4 bs = *(const f32x4*)(base + off + bj * HALF + n * 16); f32x4 o = bs + (acc[ai][bj][m][n] - sr.x) * sr.y;
                        if (bad) o = (f32x4){qnan, qnan, qnan, qnan}; *(f32x4*)(out + off + bj * HALF + n * 16) = o; }
                asm volatile("" ::: "memory"); }
    }
};
struct EpiLnResLn {
    static constexpr bool PERM = false, AFTER_DRAIN = true;
    const float* base; float* out; bf16_t* xn; int ldc; const float* bias; PanelStats st1, st2; unsigned poison;
    __device__ __forceinline__ void refuse(size_t i0, size_t stride, int M, int N) const { const float q = __builtin_nanf(""); for (size_t i = i0; i < (size_t)M * N; i += stride) { const size_t o = (i / N) * ldc + i % N; out[o] = q; xn[o] = (bf16_t)0x7fc0u; }
        if (i0 == 0) { unsigned expect = 0u; __hip_atomic_compare_exchange_strong(st1.tmo + 1, &expect, 0x7f0u, __ATOMIC_RELAXED, __ATOMIC_RELAXED, __HIP_MEMORY_SCOPE_AGENT); __hip_atomic_store(st1.tmo, 1u, __ATOMIC_RELAXED, __HIP_MEMORY_SCOPE_AGENT); } }
    __device__ __forceinline__ void fused(f32x4 (&acc)[2][2][4][2], const Unit& u, int wr, int wc, int fr, int fq, PG8_LAS unsigned char* lds, int wid, int lane) const {
        typedef float f32x2v __attribute__((ext_vector_type(2))); typedef unsigned u32x2v __attribute__((ext_vector_type(2)));
        const PG8_LAS f32x2v* S = (const PG8_LAS f32x2v*)(lds + 8192);
        const int col0 = u.pn * BM + wc * 32 + 4 * fq;
#pragma unroll
        for (int bj = 0; bj < 2; ++bj)
#pragma unroll
            for (int n = 0; n < 2; ++n) { const f32x4 bv = bias ? *(const f32x4*)(bias + col0 + bj * HALF + n * 16) : (f32x4){0.f, 0.f, 0.f, 0.f};
#pragma unroll
                for (int ai = 0; ai < 2; ++ai)
#pragma unroll
                    for (int m = 0; m < 4; ++m) acc[ai][bj][m][n] += bv; }
        bool bad = st1.run(acc, u, wr, wc, fr, fq, lds, wid, lane) || poison != 0u;
        const float qnan = __builtin_nanf("");
#pragma unroll
        for (int ai = 0; ai < 2; ++ai)
#pragma unroll
            for (int m = 0; m < 4; ++m) { const int r = ai * HALF + wr * 64 + m * 16 + fr; const f32x2v sr = S[r]; const size_t off = (size_t)(u.pm * BM + r) * ldc + col0;
#pragma unroll
                for (int bj = 0; bj < 2; ++bj)
#pragma unroll
                    for (int n = 0; n < 2; ++n) { const f32x4 bs = *(const f32x4*)(base + off + bj * HALF + n * 16); acc[ai][bj][m][n] = bs + (acc[ai][bj][m][n] - sr.x) * sr.y; }
                asm volatile("" : "+v"(acc[ai][0][m][0]), "+v"(acc[ai][0][m][1]), "+v"(acc[ai][1][m][0]), "+v"(acc[ai][1][m][1]));
                if (m & 1) asm volatile("" ::: "memory"); }
        const bool bad1 = bad;
        bad = st2.run(acc, u, wr, wc, fr, fq, lds, wid, lane) || bad;
#pragma unroll
        for (int ai = 0; ai < 2; ++ai)
#pragma unroll
            for (int m = 0; m < 4; ++m) { const int r = ai * HALF + wr * 64 + m * 16 + fr; const f32x2v sr = S[r]; const size_t off = (size_t)(u.pm * BM + r) * ldc + col0;
#pragma unroll
                for (int bj = 0; bj < 2; ++bj)
#pragma unroll
                    for (int n = 0; n < 2; ++n) { const f32x4 x1 = acc[ai][bj][m][n]; *(f32x4*)(out + off + bj * HALF + n * 16) = bad1 ? (f32x4){qnan, qnan, qnan, qnan} : x1;
                        const f32x4 o = (x1 - sr.x) * sr.y; u32x2v w; w.x = cvt_pk_bf16(o[0], o[1]); w.y = cvt_pk_bf16(o[2], o[3]);
                        if (bad) { w.x = 0x7fc07fc0u; w.y = 0x7fc07fc0u; } *(u32x2v*)(xn + off + bj * HALF + n * 16) = w; }
                asm volatile("" ::: "memory"); }
    }
};

template <class Epi, class Sched, bool STAMP = false>
__device__ __forceinline__ void gemm_phase(PG8_LAS unsigned char* lds, const Gemm g, const Sched& S, const Epi& E, unsigned long long* stamps) {
    const int tid = threadIdx.x, wid = __builtin_amdgcn_readfirstlane(tid >> 6), lane = tid & 63, wr = wid >> 2, wc = wid & 3, fr = lane & 15, fq = lane >> 4;
    const int K = g.K, nt = K / BK;
    int ts_lo = 0, ts_hi = 0, nts = 0; const unsigned long long rt_entry = STAMP ? (unsigned long long)wall_clock64() : 0ull;
#define PG8_STAMP() do { if (STAMP && wid == 0 && nts < 64) { const unsigned long long _c = (unsigned long long)clock64(); \
        ts_lo = (lane == nts) ? (int)(unsigned)_c : ts_lo; ts_hi = (lane == nts) ? (int)(unsigned)(_c >> 32) : ts_hi; ++nts; } } while (0)
    PG8_STAMP();
    unsigned voffA[2], voffB[2];
    unsigned voffG[2][2] = {{0u, 0u}, {0u, 0u}};
#pragma unroll
    for (int i = 0; i < 2; ++i) { int R, C; stage_rc(tid * 16 + i * 8192, R, C); const int Rb = Epi::PERM ? ((R & ~31) + perm32(R & 31)) : R;
        voffA[i] = (unsigned)(R * K + C) * 2u; voffB[i] = (unsigned)(Rb * K + C) * 2u; }
    const size_t kstep = (size_t)(BK * 2);
    const size_t hstep = (size_t)HALF * K * 2;
    const size_t tstep = 2 * hstep;
    const unsigned ldsw = (unsigned)wid * 1024u;
    const int aoff = lds_byte(wr * 64 + fr, fq * 8), boff = lds_byte(wc * 32 + fr, fq * 8);
#define PG8_SA(b, h) (((b) * 2 + (h)) * HTB)
#define PG8_SB(b, h) ((4 + (b) * 2 + (h)) * HTB)
#define PG8_STAGE(bufoff, gbase, voff) do { _Pragma("unroll") for (int _i = 0; _i < 2; ++_i) \
        __builtin_amdgcn_global_load_lds((const unsigned*)((const char*)(gbase) + (voff)[_i]), (PG8_LAS unsigned*)(lds + (bufoff) + ldsw + _i * 8192), 16, 0, 0); } while (0)
#define PG8_STAGE_A(bufoff, gbase, h) do { if constexpr (Sched::GATHER) { PG8_STAGE(bufoff, gbase, voffG[h]); } else { PG8_STAGE(bufoff, (gbase) + (h) * hstep, voffA); } } while (0)
#define PG8_GLOAD(slot) do { if constexpr (Sched::GATHER) { _Pragma("unroll") for (int _h = 0; _h < 2; ++_h) _Pragma("unroll") for (int _i = 0; _i < 2; ++_i) { int R_, C_; stage_rc(tid * 16 + _i * 8192, R_, C_); \
        voffG[_h][_i] = (unsigned)S.rowtab[(slot) * 256 + _h * HALF + R_] + (unsigned)C_ * 2u; } } } while (0)
#define PG8_LDA(dst, b, h) do { _Pragma("unroll") for (int m = 0; m < 4; ++m) _Pragma("unroll") for (int k = 0; k < 2; ++k) dst[m][k] = *(const PG8_LAS bf16x8*)(lds + PG8_SA(b, h) + aoff + m * 2048 + k * 1024); } while (0)
#define PG8_LDB(dst, b, h) do { _Pragma("unroll") for (int n = 0; n < 2; ++n) _Pragma("unroll") for (int k = 0; k < 2; ++k) dst[n][k] = *(const PG8_LAS bf16x8*)(lds + PG8_SB(b, h) + boff + n * 2048 + k * 1024); } while (0)
#define PG8_MMA(ai, bj, At, Bt) do { __builtin_amdgcn_s_setprio(1); _Pragma("unroll") for (int m = 0; m < 4; ++m) _Pragma("unroll") for (int n = 0; n < 2; ++n) _Pragma("unroll") for (int k = 0; k < 2; ++k) \
        acc[ai][bj][m][n] = __builtin_amdgcn_mfma_f32_16x16x32_bf16(Bt[n][k], At[m][k], acc[ai][bj][m][n], 0, 0, 0); __builtin_amdgcn_s_setprio(0); } while (0)
#define PG8_WAIT_V(n) asm volatile("s_waitcnt vmcnt(" #n ")" ::: "memory")
#define PG8_WAIT_L(n) asm volatile("s_waitcnt lgkmcnt(" #n ")" ::: "memory")
#define PG8_BAR __builtin_amdgcn_s_barrier()
#define PG8_SCHED __builtin_amdgcn_sched_barrier(0)
    Unit cur, nxt; int ui = 0;
    if (!S.next(0, cur)) return;
    f32x4 acc[2][2][4][2];
#pragma unroll
    for (int a = 0; a < 2; ++a)
#pragma unroll
        for (int b = 0; b < 2; ++b)
#pragma unroll
            for (int m = 0; m < 4; ++m)
#pragma unroll
                for (int n = 0; n < 2; ++n) acc[a][b][m][n] = (f32x4){0.f, 0.f, 0.f, 0.f};
    bf16x8 At[4][2], B0[2][2], B1[2][2];
    const char* cA = Sched::GATHER ? (const char*)g.A : (const char*)g.A + (size_t)cur.pm * tstep; const char* cB = (const char*)g.Bt + (size_t)cur.pn * tstep;
    S.a_ready(cur);
    PG8_GLOAD(0);
    PG8_STAGE(PG8_SB(0, 0), cB, voffB); PG8_STAGE_A(PG8_SA(0, 0), cA, 0); PG8_STAGE(PG8_SB(0, 1), cB + hstep, voffB); PG8_STAGE_A(PG8_SA(0, 1), cA, 1);
    if (wr == 1) PG8_BAR;
    PG8_WAIT_V(4); PG8_BAR;
    PG8_STAGE(PG8_SB(1, 0), cB + kstep, voffB); PG8_STAGE_A(PG8_SA(1, 0), cA + kstep, 0); PG8_STAGE(PG8_SB(1, 1), cB + hstep + kstep, voffB);
    PG8_WAIT_V(6); PG8_BAR;
    PG8_STAMP();
    for (;;) {
        const bool has_next = S.next(ui + 1, nxt);
        const char* nA = has_next ? (Sched::GATHER ? (const char*)g.A : (const char*)g.A + (size_t)nxt.pm * tstep) : cA; const char* nB = has_next ? (const char*)g.Bt + (size_t)nxt.pn * tstep : cB;
        for (int t = 0; t < nt; t += 2) {
            const bool last = (t == nt - 2);
            const char* a1 = cA + (size_t)(t + 1) * kstep;
            const char* a2 = last ? nA : cA + (size_t)(t + 2) * kstep; const char* b2 = last ? nB : cB + (size_t)(t + 2) * kstep;
            const char* a3 = a2 + kstep; const char* b3 = b2 + kstep;
            if (last && has_next) S.a_ready(nxt);
            PG8_LDB(B0, 0, 0); PG8_SCHED; PG8_LDA(At, 0, 0); PG8_STAGE_A(PG8_SA(1, 1), a1, 1);
            PG8_WAIT_L(8); PG8_BAR; PG8_WAIT_L(0); PG8_MMA(0, 0, At, B0); PG8_BAR; PG8_SCHED;
            if (Sched::GATHER && last && has_next) PG8_GLOAD(ui + 1);
            PG8_LDB(B1, 0, 1); PG8_STAGE(PG8_SB(0, 0), b2, voffB);
            PG8_BAR; PG8_WAIT_L(0); PG8_MMA(0, 1, At, B1); PG8_BAR;
            PG8_LDA(At, 0, 1); PG8_STAGE_A(PG8_SA(0, 0), a2, 0);
            PG8_BAR; PG8_WAIT_L(0); PG8_MMA(1, 0, At, B0); PG8_BAR; PG8_SCHED;
            PG8_STAGE(PG8_SB(0, 1), b2 + hstep, voffB);
            PG8_WAIT_V(6); PG8_BAR; PG8_MMA(1, 1, At, B1); PG8_BAR;
            PG8_LDB(B0, 1, 0); PG8_SCHED; PG8_LDA(At, 1, 0); PG8_STAGE_A(PG8_SA(0, 1), a2, 1);
            PG8_WAIT_L(8); PG8_BAR; PG8_WAIT_L(0); PG8_MMA(0, 0, At, B0); PG8_BAR; PG8_SCHED;
            PG8_LDB(B1, 1, 1); PG8_STAGE(PG8_SB(1, 0), b3, voffB);
            PG8_BAR; PG8_WAIT_L(0); PG8_MMA(0, 1, At, B1); PG8_BAR;
            PG8_LDA(At, 1, 1); PG8_STAGE_A(PG8_SA(1, 0), a3, 0);
            PG8_BAR; PG8_WAIT_L(0); PG8_MMA(1, 0, At, B0); PG8_BAR; PG8_SCHED;
            PG8_STAGE(PG8_SB(1, 1), b3 + hstep, voffB);
            PG8_WAIT_V(6); PG8_BAR; PG8_MMA(1, 1, At, B1); PG8_BAR;
        }
        PG8_STAMP();
        if constexpr (!Epi::AFTER_DRAIN) { E(acc, cur, wr, wc, fr, fq); S.done(cur); }
        PG8_STAMP();
        if (!has_next) break;
#pragma unroll
        for (int a = 0; a < 2; ++a)
#pragma unroll
            for (int b = 0; b < 2; ++b)
#pragma unroll
                for (int m = 0; m < 4; ++m)
#pragma unroll
                    for (int n = 0; n < 2; ++n) acc[a][b][m][n] = (f32x4){0.f, 0.f, 0.f, 0.f};
        cur = nxt; cA = nA; cB = nB; ++ui;
    }
    PG8_WAIT_V(0);
    if (wr == 0) PG8_BAR;
    PG8_BAR;
    if constexpr (Epi::AFTER_DRAIN) { E.fused(acc, cur, wr, wc, fr, fq, lds, wid, lane); S.done(cur); }
    PG8_STAMP();
    if (STAMP && wid == 0) { stamps[lane] = lane < nts ? (((unsigned long long)(unsigned)ts_hi << 32) | (unsigned)ts_lo) : 0ull;
        if (lane == 62) stamps[62] = rt_entry; if (lane == 63) stamps[63] = (unsigned long long)wall_clock64(); }
#undef PG8_STAMP
#undef PG8_SA
#undef PG8_SB
#undef PG8_STAGE
#undef PG8_STAGE_A
#undef PG8_GLOAD
#undef PG8_LDA
#undef PG8_LDB
#undef PG8_MMA
#undef PG8_WAIT_V
#undef PG8_WAIT_L
#undef PG8_BAR
#undef PG8_SCHED
}
}
#ifndef MK_ONE_LAUNCH
#define MK_ONE_LAUNCH 0
#endif
#ifndef DBG_CHECK
#define DBG_CHECK 0
#endif
#define LAS __attribute__((address_space(3)))
typedef unsigned short bf16;
typedef short bf16x8 __attribute__((ext_vector_type(8)));
typedef short s16x4 __attribute__((ext_vector_type(4)));
typedef short v4i16_t __attribute__((ext_vector_type(4)));
typedef float f32x16 __attribute__((ext_vector_type(16)));
typedef float f32x4 __attribute__((ext_vector_type(4)));
typedef unsigned u32x4 __attribute__((ext_vector_type(4)));
typedef unsigned u32x2 __attribute__((ext_vector_type(2)));

constexpr int SEQ = 16384, DM = 1024, NQKV = 9216, NKV = 1536;
constexpr int NWAVES = 8, NTHREADS = 512;
constexpr float ALPHA = 1.6817928305074290f;
constexpr float LOG2E = 1.4426950408889634f;
constexpr float C1 = 0.125f * LOG2E;
constexpr float LN_EPS = 1e-5f;
constexpr int MAXTILES = 144;
constexpr int MAXROWS = MAXTILES * 256;

constexpr size_t MiB = 1u << 20;
constexpr size_t WS_CTL = 0, CTL_BYTES = 1 * MiB;
constexpr size_t WS_HIST = 1 * MiB;
constexpr size_t WS_TILEB = 1 * MiB + 64 * 1024;
constexpr size_t WS_ROUTE = 2 * MiB;
constexpr size_t WS_ROWINFO = 3 * MiB;
constexpr size_t WS_ROWW = 4 * MiB;
constexpr size_t WS_GATES = 5 * MiB;
constexpr size_t WS_B1P = 8 * MiB;
constexpr size_t WS_WR = 9 * MiB;
constexpr size_t WS_WG = 9 * MiB + 256 * 1024;
constexpr size_t WS_W2T = 9 * MiB + 512 * 1024;
constexpr size_t WS_W1T = 10 * MiB;
constexpr size_t WS_WIN = 12 * MiB;
constexpr size_t WS_WOUTA = 48 * MiB;
constexpr size_t WS_WKV = 52 * MiB;
constexpr size_t WS_WQ = 55 * MiB;
constexpr size_t WS_WOUTB = 59 * MiB;
constexpr size_t WS_WGU = 64 * MiB;
constexpr size_t WS_WDN = 80 * MiB;
constexpr size_t WS_HF = 88 * MiB;
constexpr size_t WS_HB = 152 * MiB;
constexpr size_t WS_O = 184 * MiB;
constexpr size_t WS_BIG = 216 * MiB;
constexpr size_t BIG_HS = WS_BIG;
constexpr size_t BIG_HID = WS_BIG + 72 * MiB;
constexpr size_t BIG_Y = WS_BIG + 90 * MiB;
constexpr size_t BIG_KV = WS_BIG + 160 * MiB;
constexpr size_t BIG_KCMP = WS_BIG + 208 * MiB;
constexpr size_t BIG_Q = WS_BIG + 210 * MiB;
constexpr size_t WS_END = 504 * MiB;
constexpr int CW_BAR = 4096;
constexpr int CW_DBG = 16384;

constexpr int LDS_MISC = 131072;
constexpr int LDS_BAR = 163840 - 16;
constexpr int LDS_BYTES = 163840;

#define MFMA32(a, b, c) __builtin_amdgcn_mfma_f32_32x32x16_bf16(a, b, c, 0, 0, 0)
__device__ __forceinline__ int crow(int r, int hi) { return (r & 3) + 8 * (r >> 2) + 4 * hi; }
__device__ __forceinline__ unsigned pk2(float lo, float hi) { unsigned r; asm("v_cvt_pk_bf16_f32 %0, %1, %2" : "=v"(r) : "v"(lo), "v"(hi)); return r; }
__device__ __forceinline__ float bf2f(unsigned short b) { return __uint_as_float(((unsigned)b) << 16); }
__device__ __forceinline__ float bflo(unsigned w) { return __uint_as_float(w << 16); }
__device__ __forceinline__ float bfhi(unsigned w) { return __uint_as_float(w & 0xffff0000u); }
__device__ __forceinline__ float ex2(float x) { return __builtin_amdgcn_exp2f(x); }
__device__ __forceinline__ float wave_sum(float v) {
    v += __uint_as_float(__builtin_amdgcn_update_dpp(0u, __float_as_uint(v), 0x128, 0xF, 0xF, true));
    v += __uint_as_float(__builtin_amdgcn_update_dpp(0u, __float_as_uint(v), 0x124, 0xF, 0xF, true));
    v += __uint_as_float(__builtin_amdgcn_update_dpp(0u, __float_as_uint(v), 0x122, 0xF, 0xF, true));
    v += __uint_as_float(__builtin_amdgcn_update_dpp(0u, __float_as_uint(v), 0x121, 0xF, 0xF, true));
    const auto rr = __builtin_amdgcn_permlane32_swap(__float_as_uint(v), __float_as_uint(v), false, false);
    v = __uint_as_float(rr[0]) + __uint_as_float(rr[1]);
    return __uint_as_float((unsigned)__builtin_amdgcn_readlane((int)__float_as_uint(v), 0)) + __uint_as_float((unsigned)__builtin_amdgcn_readlane((int)__float_as_uint(v), 16));
}
__device__ __forceinline__ s16x4 tr_read(LAS unsigned char* p) { return __builtin_bit_cast(s16x4, __builtin_amdgcn_ds_read_tr16_b64_v4i16((LAS v4i16_t*)p)); }
#define LDS_WAIT() asm volatile("s_waitcnt lgkmcnt(0)" ::: "memory")

#define XB_TMO      128
#define XB_XCNT(j)  (256  + 64 * (j))
#define XB_XSUB(j)  (1280 + 64 * (j))
#define XB_XGEN(j)  (2304 + 64 * (j))
#define XB_TOP      3328
#define XB_TOPGEN   3392
#define XCD_BAR_WORDS 3456
#define XB_SPIN_CAP (1u << 18)
__device__ __forceinline__ unsigned xb_ld(unsigned* p)              { return __hip_atomic_load(p, __ATOMIC_RELAXED, __HIP_MEMORY_SCOPE_AGENT); }
__device__ __forceinline__ unsigned xb_add(unsigned* p, unsigned v) { return __hip_atomic_fetch_add(p, v, __ATOMIC_RELAXED, __HIP_MEMORY_SCOPE_AGENT); }
__device__ __forceinline__ unsigned xb_xcc_id() { return (unsigned)__builtin_amdgcn_s_getreg((3 << 11) | 20) & 0xFu; }
#define XB_SPIN(cond, bar) do { unsigned _sp = 0; while (cond) { __builtin_amdgcn_s_sleep(1); \
    if ((++_sp & 255u) == 0u) { if (xb_ld(&(bar)[XB_TMO])) break; if (_sp > XB_SPIN_CAP) { atomicAdd(&(bar)[XB_TMO], 1u); break; } } } } while (0)
struct XcdBarrier { unsigned* bar; unsigned x; volatile LAS unsigned* st; };
__device__ __forceinline__ XcdBarrier xcd_barrier_post(unsigned* bar, volatile LAS unsigned* st) {
    XcdBarrier b; b.bar = bar; b.x = xb_xcc_id(); b.st = st;
    if (threadIdx.x == 0) (void)xb_add(&bar[XB_XCNT(b.x)], 1u);
    return b;
}
__device__ __forceinline__ void xcd_barrier_complete(unsigned* bar, unsigned x, unsigned& nloc, unsigned& nx) {
    const unsigned G = gridDim.x * gridDim.y * gridDim.z;
    unsigned sum, cnt, mine, sp = 0u;
    for (;;) {
        sum = 0u; cnt = 0u; mine = 0u;
#pragma unroll
        for (unsigned j = 0; j < 16; ++j) { const unsigned c = xb_ld(&bar[XB_XCNT(j)]); sum += c; cnt += (c > 0u) ? 1u : 0u; mine = (j == x) ? c : mine; }
        if (sum == G) break;
        __builtin_amdgcn_s_sleep(1);
        if ((++sp & 255u) == 0u) { if (xb_ld(&bar[XB_TMO])) break; if (sp > XB_SPIN_CAP) { atomicAdd(&bar[XB_TMO], 1u); break; } }
    }
    nloc = mine > 0u ? mine : 1u; nx = cnt > 0u ? cnt : 1u;
}
__device__ __forceinline__ void xcd_barrier(const XcdBarrier& b) {
    asm volatile("s_waitcnt vmcnt(0)" ::: "memory");
    __syncthreads();
    if (threadIdx.x == 0) {
        unsigned* bar = b.bar;
        __builtin_amdgcn_s_waitcnt(0);
        unsigned nloc = b.st[0], nx = b.st[1];
        if (nloc == 0u) { xcd_barrier_complete(bar, b.x, nloc, nx); b.st[0] = nloc; b.st[1] = nx; }
        const unsigned old = xb_add(&bar[XB_XSUB(b.x)], 1u);
        const unsigned gen = old / nloc;
        if (old + 1u == (gen + 1u) * nloc) {
            __builtin_amdgcn_fence(__ATOMIC_RELEASE, "agent");
            asm volatile("s_waitcnt vmcnt(0)" ::: "memory");
            const unsigned og = xb_add(&bar[XB_TOP], 1u);
            const unsigned tg = og / nx;
            if (og + 1u == (tg + 1u) * nx) xb_add(&bar[XB_TOPGEN], 1u);
            else XB_SPIN(xb_ld(&bar[XB_TOPGEN]) == tg, bar);
            __builtin_amdgcn_fence(__ATOMIC_ACQUIRE, "agent");
            xb_add(&bar[XB_XGEN(b.x)], 1u);
            asm volatile("s_waitcnt vmcnt(0)" ::: "memory");
        } else {
            XB_SPIN(xb_ld(&bar[XB_XGEN(b.x)]) == gen, bar);
            __builtin_amdgcn_fence(__ATOMIC_ACQUIRE, "agent");
            asm volatile("s_waitcnt vmcnt(0)" ::: "memory");
        }
    }
    __syncthreads();
}

struct TcRegs { float v[32]; };
__device__ __forceinline__ void tc_load(TcRegs& R, const float* src, int ld, int srccol0, int nvalid, int kb, int lane) {
    const int k0 = 64 * kb, n = lane & 31; const float* p = src + (size_t)(k0 + (lane >> 5)) * ld + srccol0 + n;
#pragma unroll
    for (int i = 0; i < 32; ++i) R.v[i] = (n < nvalid) ? p[(size_t)(2 * i) * ld] : 0.f;
}
__device__ __forceinline__ void tc_finish(const TcRegs& R, int K, bf16* dst, int dstrow0, int kb, LAS float* scr, int lane) {
    const int k0 = 64 * kb;
#pragma unroll
    for (int i = 0; i < 32; ++i) scr[(2 * i + (lane >> 5)) * 33 + (lane & 31)] = R.v[i];
    LDS_WAIT();
    const int c = lane & 7;
#pragma unroll
    for (int j = 0; j < 4; ++j) { const int n = (lane >> 3) + 8 * j; const LAS float* s = scr + (8 * c) * 33 + n;
        u32x4 o; o.x = pk2(s[0 * 33], s[1 * 33]); o.y = pk2(s[2 * 33], s[3 * 33]); o.z = pk2(s[4 * 33], s[5 * 33]); o.w = pk2(s[6 * 33], s[7 * 33]);
        *(u32x4*)(dst + (size_t)(dstrow0 + n) * K + k0 + 8 * c) = o; }
    LDS_WAIT();
}
template <class Desc>
__device__ __forceinline__ void tc_stream(int nitems, int gw, int NGW, LAS float* scr, int lane, Desc desc) {
    const float* srcA; int ldA, KA, c0A, nvA, r0A, kbA; bf16* dstA; const float* srcB; int ldB, KB, c0B, nvB, r0B, kbB; bf16* dstB;
    TcRegs A, B;
    int it = gw; if (it >= nitems) return;
    desc(it, srcA, ldA, KA, c0A, nvA, dstA, r0A, kbA); tc_load(A, srcA, ldA, c0A, nvA, kbA, lane);
#pragma nounroll
    for (;;) {
        const int itB = it + NGW; const bool hb = itB < nitems;
        if (hb) { desc(itB, srcB, ldB, KB, c0B, nvB, dstB, r0B, kbB); tc_load(B, srcB, ldB, c0B, nvB, kbB, lane); }
        tc_finish(A, KA, dstA, r0A, kbA, scr, lane);
        if (!hb) break;
        const int itA = itB + NGW; const bool ha = itA < nitems;
        if (ha) { desc(itA, srcA, ldA, KA, c0A, nvA, dstA, r0A, kbA); tc_load(A, srcA, ldA, c0A, nvA, kbA, lane); }
        tc_finish(B, KB, dstB, r0B, kbB, scr, lane);
        if (!ha) break;
        it = itA;
    }
}
__device__ __forceinline__ void tc_matrix(const float* src, int ld, int K, int col0, int ncolvalid, bf16* dst, int nrows, LAS float* scr, int lane, int gw, int NGW) {
    const int nkb = K / 64, nnb = nrows / 32;
    tc_stream(nkb * nnb, gw, NGW, scr, lane, [=](int it, const float*& s_, int& ld_, int& K_, int& c0_, int& nv_, bf16*& d_, int& r0_, int& kb_) {
        const int kb = it / nnb, nb = it % nnb; int nv = ncolvalid - 32 * nb; nv = nv < 0 ? 0 : (nv > 32 ? 32 : nv);
        s_ = src; ld_ = ld; K_ = K; c0_ = col0 + 32 * nb; nv_ = nv; d_ = dst; r0_ = 32 * nb; kb_ = kb; });
}
__device__ __forceinline__ void convert_moe_weights(const float* gu, const float* dn, bf16* WGU, bf16* WDN, LAS float* scr, int lane, int gw, int NGW) {
    tc_stream(16 * 256 + 16 * 128, gw, NGW, scr, lane, [=](int it, const float*& s_, int& ld_, int& K_, int& c0_, int& nv_, bf16*& d_, int& r0_, int& kb_) {
        if (it < 4096) { const int e = it >> 8, r = it & 255, kb = r >> 4, nb = r & 15, rho0 = 32 * nb, ct = rho0 >> 8, half = (rho0 >> 7) & 1, x0 = rho0 & 127;
            s_ = gu + (size_t)e * 1024 * 512; ld_ = 512; K_ = 1024; c0_ = half * 256 + 128 * ct + x0; nv_ = 32; d_ = WGU + (size_t)e * 512 * 1024; r0_ = rho0; kb_ = kb; }
        else { const int i2 = it - 4096, e = i2 >> 7, r = i2 & 127, kb = r >> 5, nb = r & 31;
            s_ = dn + (size_t)e * 256 * 1024; ld_ = 1024; K_ = 256; c0_ = 32 * nb; nv_ = 32; d_ = WDN + (size_t)e * 1024 * 256; r0_ = 32 * nb; kb_ = kb; } });
}

#define ATT_V2 1
#ifndef WINCORE
#define WINCORE attn_core_d
#endif
#ifndef SLCCORE
#define SLCCORE attn_core_d
#endif
#ifndef STATCORE
#define STATCORE stats_core_d
#endif
#ifndef CMP2_NEW
#define CMP2_NEW 1
#endif
#ifndef REP_SLC
#define REP_SLC 1
#endif
#ifndef REP_WIN
#define REP_WIN 1
#endif
#ifndef REP_SEL
#define REP_SEL 1
#endif
#ifndef REP_CMP
#define REP_CMP 1
#endif
struct KVT { bf16x8 k[4]; u32x4 v[4]; };
template <class RowF>
__device__ __forceinline__ void kv_load(KVT& T, const bf16* kbase, const bf16* vbase, RowF rowf, int lane) {
#pragma unroll
    for (int i = 0; i < 4; ++i) { const size_t ro = rowf(8 * i + (lane >> 3)) + 8 * (lane & 7); T.k[i] = *(const bf16x8*)(kbase + ro); T.v[i] = *(const u32x4*)(vbase + ro); }
#if defined(LOAD_REP)
#pragma unroll
    for (int i = 0; i < 4; ++i) { const size_t ro = rowf(8 * i + (lane >> 3)) + 8 * (lane & 7); u32x4 a, b;
        asm volatile("global_load_dwordx4 %0, %2, off sc1\n\tglobal_load_dwordx4 %1, %3, off sc1\n\ts_waitcnt vmcnt(0)" : "=&v"(a), "=&v"(b) : "v"(kbase + ro), "v"(vbase + ro) : "memory"); }
#endif
}
template <class RowF>
__device__ __forceinline__ void k_load(bf16x8 (&k)[4], const bf16* kbase, RowF rowf, int lane) {
#pragma unroll
    for (int i = 0; i < 4; ++i) k[i] = *(const bf16x8*)(kbase + rowf(8 * i + (lane >> 3)) + 8 * (lane & 7));
}
__device__ __forceinline__ void k_stage(const bf16x8 (&k)[4], LAS unsigned char* ks, int lane) {
#pragma unroll
    for (int i = 0; i < 4; ++i) { const int key = 8 * i + (lane >> 3), c = lane & 7; *(LAS bf16x8*)(ks + key * 128 + ((c ^ (key & 7)) << 4)) = k[i]; }
}
__device__ __forceinline__ void k_frags(bf16x8 (&kf)[4], LAS unsigned char* ks, int lane) {
    const int key = lane & 31, hi = lane >> 5;
    asm volatile("" ::: "memory");
#pragma unroll
    for (int s = 0; s < 4; ++s) kf[s] = *(const LAS bf16x8*)(ks + key * 128 + (((2 * s + hi) ^ (key & 7)) << 4));
}
__device__ __forceinline__ void q_load(bf16x8 (&q)[4], const bf16* qrow, int lane) {
    const int hi = lane >> 5;
#pragma unroll
    for (int s = 0; s < 4; ++s) q[s] = *(const bf16x8*)(qrow + 16 * s + 8 * hi);
}
__device__ __forceinline__ void v_stage(const KVT& T, LAS unsigned char* vs, int lane) {
#pragma unroll
    for (int i = 0; i < 4; ++i) { const int key = 8 * i + (lane >> 3), c = lane & 7; *(LAS u32x4*)(vs + (c >> 2) * 2048 + key * 64 + (c & 3) * 16) = T.v[i]; }
}
struct VF { bf16x8 f[2][2]; };
__device__ __forceinline__ void v_frags(VF& V, LAS unsigned char* vs, int lane) {
    const int hi = lane >> 5;
    LAS unsigned char* vp = vs + ((lane >> 4) & 1) * 32 + (lane & 3) * 8 + (4 * hi + ((lane & 15) >> 2)) * 64;
    asm volatile("" ::: "memory");
#pragma unroll
    for (int db = 0; db < 2; ++db)
#pragma unroll
        for (int s2 = 0; s2 < 2; ++s2) { const s16x4 lo = tr_read(vp + db * 2048 + s2 * 1024), h4 = tr_read(vp + db * 2048 + s2 * 1024 + 512);
            V.f[db][s2] = (bf16x8){lo[0], lo[1], lo[2], lo[3], h4[0], h4[1], h4[2], h4[3]}; }
    asm volatile("" ::: "memory");
}
__device__ __forceinline__ void pv_mma(const f32x16& p, const VF& V, f32x16 (&o)[2]) {
    u32x4 w0, w1;
    w0.x = pk2(p[0], p[1]); w0.y = pk2(p[2], p[3]); w0.z = pk2(p[4], p[5]); w0.w = pk2(p[6], p[7]);
    w1.x = pk2(p[8], p[9]); w1.y = pk2(p[10], p[11]); w1.z = pk2(p[12], p[13]); w1.w = pk2(p[14], p[15]);
    const bf16x8 pf0 = __builtin_bit_cast(bf16x8, w0), pf1 = __builtin_bit_cast(bf16x8, w1);
    o[0] = MFMA32(V.f[0][0], pf0, o[0]); o[1] = MFMA32(V.f[1][0], pf0, o[1]);
    o[0] = MFMA32(V.f[0][1], pf1, o[0]); o[1] = MFMA32(V.f[1][1], pf1, o[1]);
}
__device__ __forceinline__ void pv_acc(const f32x16& p, LAS unsigned char* vs, int lane, f32x16 (&o)[2]) { VF V; v_frags(V, vs, lane); pv_mma(p, V, o); }
__device__ __forceinline__ float xhalf_max(float v) {
    const auto rr = __builtin_amdgcn_permlane32_swap(__float_as_uint(v), __float_as_uint(v), false, false);
    return fmaxf(__uint_as_float(rr[0]), __uint_as_float(rr[1]));
}
__device__ __forceinline__ f32x16 qk_tile(const bf16x8 (&qf)[4], const bf16x8 (&kf)[4]) {
    f32x16 s;
#pragma unroll
    for (int r = 0; r < 16; ++r) s[r] = 0.f;
#pragma unroll
    for (int d0 = 0; d0 < 4; ++d0) s = MFMA32(kf[d0], qf[d0], s);
    return s;
}
struct TileP { float base, sd; int dist0, dd, lim; };
typedef float f32x2 __attribute__((ext_vector_type(2)));
constexpr float QMUL = 1.0f;
template <bool MASK>
__device__ __forceinline__ void scores(f32x16& s, const TileP P) {
    const f32x2 c1 = {QMUL, QMUL}, sd2 = {P.sd, P.sd};
#pragma unroll
    for (int r = 0; r < 16; r += 2) { const int cr = (r & 3) + 8 * (r >> 2);
        const f32x2 crv = {(float)cr, (float)(cr + 1)}, b2 = {P.base, P.base};
        const f32x2 raw = {s[r], s[r + 1]};
        f32x2 x = __builtin_elementwise_fma(raw, c1, __builtin_elementwise_fma(sd2, crv, b2));
        if (MASK) { const bool ok0 = (unsigned)(P.dist0 - P.dd * cr) <= (unsigned)P.lim, ok1 = (unsigned)(P.dist0 - P.dd * (cr + 1)) <= (unsigned)P.lim; x.x = ok0 ? x.x : -INFINITY; x.y = ok1 ? x.y : -INFINITY; }
        s[r] = x.x; s[r + 1] = x.y; }
}
__device__ __forceinline__ float exp_sum(f32x16& s, float mn) {
    const f32x2 m2 = {mn, mn}; f32x2 acc = {0.f, 0.f};
#pragma unroll
    for (int r = 0; r < 16; r += 2) { f32x2 x = {s[r], s[r + 1]}; x = x - m2; f32x2 e; e.x = ex2(x.x); e.y = ex2(x.y); acc = acc + e; s[r] = e.x; s[r + 1] = e.y; }
    return acc.x + acc.y;
}
template <bool MASK>
__device__ __forceinline__ void attn_core(const bf16x8 (&qf)[4], LAS unsigned char* tl, int lane, float& m, float& l, f32x16 (&o)[2], const TileP P) {
    bf16x8 kf[4]; k_frags(kf, tl + 4096, lane);
    VF V; v_frags(V, tl, lane);
    f32x16 s = qk_tile(qf, kf);
    scores<MASK>(s, P);
    float mx = fmaxf(fmaxf(fmaxf(s[0], s[1]), fmaxf(s[2], s[3])), fmaxf(fmaxf(s[4], s[5]), fmaxf(s[6], s[7])));
    mx = fmaxf(mx, fmaxf(fmaxf(fmaxf(s[8], s[9]), fmaxf(s[10], s[11])), fmaxf(fmaxf(s[12], s[13]), fmaxf(s[14], s[15]))));
    mx = xhalf_max(mx);
    const float mn = fmaxf(m, mx);
    if (__builtin_amdgcn_ballot_w64(mn > m)) { const float alpha = ex2(m - mn); l *= alpha;
#pragma unroll
        for (int r = 0; r < 16; ++r) { o[0][r] *= alpha; o[1][r] *= alpha; } }
    m = mn;
    l += exp_sum(s, mn);
    pv_mma(s, V, o);
}
template <bool MASK>
__device__ __forceinline__ void attn_tile(const bf16x8 (&qf)[4], const KVT& T, LAS unsigned char* vs, int lane, float& m, float& l, f32x16 (&o)[2], const TileP P) {
    v_stage(T, vs, lane); k_stage(T.k, vs + 4096, lane);
    attn_core<MASK>(qf, vs, lane, m, l, o, P);
}
template <bool MASK>
__device__ __forceinline__ void stats_core(const bf16x8 (&qf)[4], LAS unsigned char* tl, int lane, float& m, float& l, const TileP P) {
    bf16x8 kf[4]; k_frags(kf, tl + 4096, lane);
    f32x16 s = qk_tile(qf, kf);
    scores<MASK>(s, P);
    float mx = -INFINITY;
#pragma unroll
    for (int r = 0; r < 16; ++r) mx = fmaxf(mx, s[r]);
    mx = xhalf_max(mx);
    const float mn = fmaxf(m, mx); l *= ex2(m - mn); m = mn;
    float ps = 0.f;
#pragma unroll
    for (int r = 0; r < 16; ++r) ps += ex2(s[r] - mn);
    l += ps;
}
template <bool MASK>
__device__ __forceinline__ void stats_tile(const bf16x8 (&qf)[4], const bf16x8 (&kraw)[4], LAS unsigned char* vs, int lane, float& m, float& l, const TileP P) {
    k_stage(kraw, vs + 4096, lane); stats_core<MASK>(qf, vs, lane, m, l, P);
}
constexpr float SM_THR = 8.0f;
template <bool MASK>
__device__ __forceinline__ f32x16 qk_scores_d(const bf16x8 (&qf)[4], const bf16x8 (&kf)[4], const TileP P, float mref) {
    f32x16 s; const float b0 = P.base - mref;
#pragma unroll
    for (int r = 0; r < 16; ++r) { const int cr = (r & 3) + 8 * (r >> 2);
        float x = fmaf(P.sd, (float)cr, b0);
        if (MASK) { const bool ok = (unsigned)(P.dist0 - P.dd * cr) <= (unsigned)P.lim; x = ok ? x : -INFINITY; }
        s[r] = x; }
#pragma unroll
    for (int d0 = 0; d0 < 4; ++d0) s = MFMA32(kf[d0], qf[d0], s);
    return s;
}
template <bool MASK>
__device__ __forceinline__ void attn_core_d(const bf16x8 (&qf)[4], LAS unsigned char* tl, int lane, float& m, float& l, f32x16 (&o)[2], const TileP P) {
    bf16x8 kf[4]; k_frags(kf, tl + 4096, lane);
    VF V; v_frags(V, tl, lane);
    const bool seeded = m > -1e29f; const float mref = seeded ? m : 0.f;
    f32x16 s = qk_scores_d<MASK>(qf, kf, P, mref);
    float mx = fmaxf(fmaxf(fmaxf(s[0], s[1]), fmaxf(s[2], s[3])), fmaxf(fmaxf(s[4], s[5]), fmaxf(s[6], s[7])));
    mx = fmaxf(mx, fmaxf(fmaxf(fmaxf(s[8], s[9]), fmaxf(s[10], s[11])), fmaxf(fmaxf(s[12], s[13]), fmaxf(s[14], s[15]))));
    mx = xhalf_max(mx);
    const bool need = seeded ? (mx > SM_THR) : (mx > -INFINITY);
    if (__builtin_amdgcn_ballot_w64(need)) {
        const float dl = need ? mx : 0.f, f = (need && seeded) ? ex2(-dl) : 1.0f;
        m = need ? mref + dl : m; l *= f;
#pragma unroll
        for (int r = 0; r < 16; ++r) { o[0][r] *= f; o[1][r] *= f; s[r] -= dl; }
    }
    l += exp_sum(s, 0.f);
    pv_mma(s, V, o);
}
template <bool MASK>
__device__ __forceinline__ void stats_core_d(const bf16x8 (&qf)[4], LAS unsigned char* tl, int lane, float& m, float& l, const TileP P) {
    bf16x8 kf[4]; k_frags(kf, tl + 4096, lane);
    const bool seeded = m > -1e29f; const float mref = seeded ? m : 0.f;
    f32x16 s = qk_scores_d<MASK>(qf, kf, P, mref);
    float mx = fmaxf(fmaxf(fmaxf(s[0], s[1]), fmaxf(s[2], s[3])), fmaxf(fmaxf(s[4], s[5]), fmaxf(s[6], s[7])));
    mx = fmaxf(mx, fmaxf(fmaxf(fmaxf(s[8], s[9]), fmaxf(s[10], s[11])), fmaxf(fmaxf(s[12], s[13]), fmaxf(s[14], s[15]))));
    mx = xhalf_max(mx);
    const bool need = seeded ? (mx > SM_THR) : (mx > -INFINITY);
    if (__builtin_amdgcn_ballot_w64(need)) {
        const float dl = need ? mx : 0.f, f = (need && seeded) ? ex2(-dl) : 1.0f;
        m = need ? mref + dl : m; l *= f;
#pragma unroll
        for (int r = 0; r < 16; ++r) s[r] -= dl;
    }
    l += exp_sum(s, 0.f);
}
__device__ __forceinline__ float quad_sum(float x) {
    x += __uint_as_float(__builtin_amdgcn_update_dpp(0u, __float_as_uint(x), 0xB1, 0xF, 0xF, true));
    x += __uint_as_float(__builtin_amdgcn_update_dpp(0u, __float_as_uint(x), 0x4E, 0xF, 0xF, true));
    return x;
}
__device__ __forceinline__ float xhalf_other(float v, int hi) {
    const auto rr = __builtin_amdgcn_permlane32_swap(__float_as_uint(v), __float_as_uint(v), false, false);
    return __uint_as_float(hi ? rr[0] : rr[1]);
}
__device__ __forceinline__ float max16p(const f32x16& s) {
    const float mx = fmaxf(fmaxf(fmaxf(s[0], s[1]), fmaxf(s[2], s[3])), fmaxf(fmaxf(s[4], s[5]), fmaxf(s[6], s[7])));
    return fmaxf(mx, fmaxf(fmaxf(fmaxf(s[8], s[9]), fmaxf(s[10], s[11])), fmaxf(fmaxf(s[12], s[13]), fmaxf(s[14], s[15]))));
}
template <bool MASKA, bool MASKB>
__device__ __forceinline__ void attn_core2_d(const bf16x8 (&qf)[4], LAS unsigned char* ta, LAS unsigned char* tb, int lane, float& m, float& l, f32x16 (&o)[2], const TileP PA, const TileP PB) {
    bf16x8 kfa[4], kfb[4]; k_frags(kfa, ta + 4096, lane); k_frags(kfb, tb + 4096, lane);
    VF VA, VB; v_frags(VA, ta, lane); v_frags(VB, tb, lane);
    const bool seeded = m > -1e29f; const float mref = seeded ? m : 0.f;
    f32x16 sa = qk_scores_d<MASKA>(qf, kfa, PA, mref);
    f32x16 sb = qk_scores_d<MASKB>(qf, kfb, PB, mref);
    const float mx = xhalf_max(fmaxf(max16p(sa), max16p(sb)));
    const bool need = seeded ? (mx > SM_THR) : (mx > -INFINITY);
    if (__builtin_amdgcn_ballot_w64(need)) {
        const float dl = need ? mx : 0.f, f = (need && seeded) ? ex2(-dl) : 1.0f;
        m = need ? mref + dl : m; l *= f;
#pragma unroll
        for (int r = 0; r < 16; ++r) { o[0][r] *= f; o[1][r] *= f; sa[r] -= dl; sb[r] -= dl; }
    }
    l += exp_sum(sa, 0.f) + exp_sum(sb, 0.f);
    pv_mma(sa, VA, o); pv_mma(sb, VB, o);
}
template <bool MASKA, bool MASKB>
__device__ __forceinline__ void stats_core2_d(const bf16x8 (&qf)[4], LAS unsigned char* ta, LAS unsigned char* tb, int lane, float& m, float& l, const TileP PA, const TileP PB) {
    bf16x8 kfa[4], kfb[4]; k_frags(kfa, ta + 4096, lane); k_frags(kfb, tb + 4096, lane);
    const bool seeded = m > -1e29f; const float mref = seeded ? m : 0.f;
    f32x16 sa = qk_scores_d<MASKA>(qf, kfa, PA, mref);
    f32x16 sb = qk_scores_d<MASKB>(qf, kfb, PB, mref);
    const float mx = xhalf_max(fmaxf(max16p(sa), max16p(sb)));
    const bool need = seeded ? (mx > SM_THR) : (mx > -INFINITY);
    if (__builtin_amdgcn_ballot_w64(need)) {
        const float dl = need ? mx : 0.f, f = (need && seeded) ? ex2(-dl) : 1.0f;
        m = need ? mref + dl : m; l *= f;
#pragma unroll
        for (int r = 0; r < 16; ++r) { sa[r] -= dl; sb[r] -= dl; }
    }
    l += exp_sum(sa, 0.f) + exp_sum(sb, 0.f);
}
template <bool WITH_V, class RowF, class Compute>
__device__ __forceinline__ void shared_pairs(int n, LAS unsigned char* lds, int slab_stride, const bf16* kbase, const bf16* vbase, RowF rowf, int wave, int lane, Compute compute) {
    if (n <= 0) return;
    const int ns = (n + 1) >> 1;
    const int lw = wave & 3; const bool isv = wave >= 4;
    const int key = 8 * lw + (lane >> 3), c = lane & 7;
    const int woff = isv ? ((c >> 2) * 2048 + key * 64 + (c & 3) * 16) : (4096 + key * 128 + ((c ^ (key & 7)) << 4));
    const bf16* base = isv ? vbase : kbase;
    const bool active = WITH_V || !isv;
    auto img = [&](int b, int x) { return lds + (2 * b + x) * slab_stride; };
    auto ld = [&](int t) { const int tc = t < n ? t : n - 1; return *(const u32x4*)(base + rowf(tc, key) + 8 * c); };
    u32x4 R0 = {0u, 0u, 0u, 0u}, R1 = R0;
    __syncthreads();
    if (active) { R0 = ld(0); R1 = ld(1); *(LAS u32x4*)(img(0, 0) + woff) = R0; *(LAS u32x4*)(img(0, 1) + woff) = R1; }
    if (ns > 1 && active) { R0 = ld(2); R1 = ld(3); }
    __syncthreads();
#pragma nounroll
    for (int s = 0; s < ns; ++s) {
        if (s + 1 < ns && active) { *(LAS u32x4*)(img((s + 1) & 1, 0) + woff) = R0; *(LAS u32x4*)(img((s + 1) & 1, 1) + woff) = R1; }
        if (s + 2 < ns && active) { R0 = ld(2 * s + 4); R1 = ld(2 * s + 5); }
        compute(img(s & 1, 0), (2 * s + 1 < n) ? img(s & 1, 1) : (LAS unsigned char*)nullptr, s);
        __syncthreads();
    }
}
struct KV2 { bf16x8 k[2][4]; u32x4 v[2][4]; };
__device__ __forceinline__ void v_stage_raw(const u32x4 (&v)[4], LAS unsigned char* vs, int lane) {
#pragma unroll
    for (int i = 0; i < 4; ++i) { const int key = 8 * i + (lane >> 3), c = lane & 7; *(LAS u32x4*)(vs + (c >> 2) * 2048 + key * 64 + (c & 3) * 16) = v[i]; }
}
template <bool MASK>
__device__ __forceinline__ void pair_qk(const bf16x8 (&qf)[4], LAS unsigned char* vs, int lane, float mref, const TileP PA, const TileP PB, f32x16& sa, f32x16& sb) {
    { bf16x8 kf[4]; k_frags(kf, vs, lane); sa = qk_scores_d<MASK>(qf, kf, PA, mref); }
    { bf16x8 kf[4]; k_frags(kf, vs + 4096, lane); sb = qk_scores_d<MASK>(qf, kf, PB, mref); }
    asm volatile("" ::: "memory");
}
__device__ __forceinline__ void pair_sm_pv(f32x16& sa, f32x16& sb, LAS unsigned char* vs, int lane, float& m, float& l, f32x16 (&o)[2], bool seeded, float mref) {
    const float mx = xhalf_max(fmaxf(max16p(sa), max16p(sb)));
    const bool need = seeded ? (mx > SM_THR) : (mx > -INFINITY);
    if (__builtin_amdgcn_ballot_w64(need)) {
        const float dl = need ? mx : 0.f, f = (need && seeded) ? ex2(-dl) : 1.0f;
        m = need ? mref + dl : m; l *= f;
#pragma unroll
        for (int r = 0; r < 16; ++r) { o[0][r] *= f; o[1][r] *= f; sa[r] -= dl; sb[r] -= dl; }
    }
    l += exp_sum(sa, 0.f) + exp_sum(sb, 0.f);
    { VF V; v_frags(V, vs, lane); pv_mma(sa, V, o); }
    { VF V; v_frags(V, vs + 4096, lane); pv_mma(sb, V, o); }
    asm volatile("" ::: "memory");
}
template <class Issue, class Stage, class Compute>
__device__ __forceinline__ void pipe_tiles1(int n, Issue issue, Stage stage, Compute compute) {
    if (n <= 0) return;
    KVT T; issue(T, 0);
#pragma nounroll
    for (int i = 0; i < n; ++i) { stage(T, i); if (i + 1 < n) issue(T, i + 1); compute(i); }
}
template <class Issue, class Stage, class Compute>
__device__ __forceinline__ void pipe_tiles2(int n, Issue issue, Stage stage, Compute compute) {
    if (n <= 0) return;
    KVT A, B; issue(A, 0); if (n > 1) issue(B, 1);
    int i = 0;
#pragma nounroll
    for (; i + 1 < n; i += 2) { stage(A, i); if (i + 2 < n) issue(A, i + 2); compute(i); stage(B, i + 1); if (i + 3 < n) issue(B, i + 3); compute(i + 1); }
    if (i < n) { stage(A, i); compute(i); }
}
template <bool WITH_V, class RowF, class Compute>
__device__ __forceinline__ void shared_tiles(int n, LAS unsigned char* sh, const bf16* kbase, const bf16* vbase, RowF rowf, int wave, int lane, Compute compute) {
    if (n <= 0) return;
    const int lw = wave & 3; const bool isv = wave >= 4;
    const int key = 8 * lw + (lane >> 3), c = lane & 7;
    const int woff = isv ? ((c >> 2) * 2048 + key * 64 + (c & 3) * 16) : (4096 + key * 128 + ((c ^ (key & 7)) << 4));
    const bf16* base = isv ? vbase : kbase;
    const bool active = WITH_V || !isv;
    u32x4 RA = {0u, 0u, 0u, 0u}, RB = RA;
    if (active) { RA = *(const u32x4*)(base + rowf(0, key) + 8 * c); *(LAS u32x4*)(sh + woff) = RA; }
    if (n > 1 && active) RA = *(const u32x4*)(base + rowf(1, key) + 8 * c);
    if (n > 2 && active) RB = *(const u32x4*)(base + rowf(2, key) + 8 * c);
    __syncthreads();
    int i = 0;
#pragma nounroll
    for (; i + 1 < n; i += 2) {
        if (active) *(LAS u32x4*)(sh + ((i + 1) & 1) * 8192 + woff) = RA;
        if (i + 3 < n && active) RA = *(const u32x4*)(base + rowf(i + 3, key) + 8 * c);
        compute(sh + (i & 1) * 8192, i);
        __syncthreads();
        if (i + 2 < n && active) *(LAS u32x4*)(sh + (i & 1) * 8192 + woff) = RB;
        if (i + 4 < n && active) RB = *(const u32x4*)(base + rowf(i + 4, key) + 8 * c);
        compute(sh + ((i + 1) & 1) * 8192, i + 1);
        __syncthreads();
    }
    if (i < n) { compute(sh + (i & 1) * 8192, i); __syncthreads(); }
}
struct KT { bf16x8 k[4]; };
__device__ __forceinline__ void o_store(const f32x16 (&o)[2], bf16* orow, int hi) {
#pragma unroll
    for (int db = 0; db < 2; ++db)
#pragma unroll
        for (int k = 0; k < 4; ++k) { u32x2 w; w.x = pk2(o[db][4 * k], o[db][4 * k + 1]); w.y = pk2(o[db][4 * k + 2], o[db][4 * k + 3]); *(u32x2*)(orow + 32 * db + 8 * k + 4 * hi) = w; }
}
template <class Buf, class Issue, class Compute>
__device__ __forceinline__ void pipe_tiles(int n, Issue issue, Compute compute) {
    if (n <= 0) return;
    Buf A, B; issue(A, 0);
    int i = 0;
#pragma nounroll
    for (; i + 1 < n; i += 2) { issue(B, i + 1); compute(A, i); if (i + 2 < n) issue(A, i + 2); compute(B, i + 1); }
    if (i < n) compute(A, i);
}

constexpr int DST = 68, DIL_VS = 256 * DST * 4;
__device__ __forceinline__ void dil_block(const bf16* qkv, bf16* O, int b, int h, LAS unsigned char* lds, int wave, int lane) {
    LAS float* ST = (LAS float*)lds;
    LAS unsigned char* vs = lds + DIL_VS + wave * 8192;
    const int hi = lane >> 5, c = lane & 31;
    const float slope2 = exp2f(-0.5f * (float)(h + 1)) * LOG2E;
    float m = -1e30f, l = 0.f; f32x16 o[2];
    auto seg_g = [](int seg) { return seg < 2 ? seg : 2; };
    auto seg_tau = [&](int seg, int col) { return seg == 0 ? 32 * wave + col : (seg == 1 ? 128 * (wave >> 2) + (wave & 3) + 4 * col : (2 * wave + (seg - 2)) + 16 * (col & 15)); };
    bf16x8 qf[4];
    auto issue = [&](KVT& T, int t) {
        const int seg = t / 5, j = t - 5 * seg;
        const int g = seg_g(seg), d = 1 << (2 * g), W = 128 << (2 * g);
        const int tlo = 256 * b + seg_tau(seg, 0) - W + 32 * d * j;
        const bf16* kb = qkv + (size_t)((g * 3 + 1) * 16 + h) * ((size_t)SEQ * 64);
        kv_load(T, kb, kb + (size_t)16 * SEQ * 64, [&](int key) { int tk = tlo + d * key; tk = tk < 0 ? 0 : (tk > SEQ - 1 ? SEQ - 1 : tk); return (size_t)tk * 64; }, lane);
    };
    auto issue_q = [&](bf16x8 (&q)[4], int seg) { const int g = seg_g(seg); q_load(q, qkv + (size_t)((g * 3) * 16 + h) * ((size_t)SEQ * 64) + (size_t)(256 * b + seg_tau(seg, c)) * 64, lane); };
    auto compute = [&](int t) {
        const int seg = t / 5, j = t - 5 * seg;
        const int g = seg_g(seg), d = 1 << (2 * g), W = 128 << (2 * g);
        const int tau = seg_tau(seg, c), tq = 256 * b + tau;
        if (j == 0) {
            issue_q(qf, seg);
            if (seg == 0) {
                m = -1e30f; l = 0.f;
#pragma unroll
                for (int r = 0; r < 16; ++r) { o[0][r] = 0.f; o[1][r] = 0.f; }
            } else {
                if (seg <= 2) __syncthreads();
                const LAS float* sp = ST + tau * DST;
#pragma unroll
                for (int db = 0; db < 2; ++db)
#pragma unroll
                    for (int k = 0; k < 4; ++k) { const f32x4 v = *(const LAS f32x4*)(sp + 32 * db + 8 * k + 4 * hi); o[db][4 * k] = v[0]; o[db][4 * k + 1] = v[1]; o[db][4 * k + 2] = v[2]; o[db][4 * k + 3] = v[3]; }
                m = sp[64]; l = sp[65 + hi];
            }
        }
        const int tlo = 256 * b + seg_tau(seg, 0) - W + 32 * d * j, thi = tlo + 31 * d;
        if (thi >= 0) {
            TileP P; P.dist0 = tq - tlo - 4 * hi * d; P.dd = d; P.lim = W < tq ? W : tq; P.base = -slope2 * (float)P.dist0; P.sd = slope2 * (float)d;
            if (j >= 1 && j <= 3 && tlo >= 0) attn_core_d<false>(qf, vs, lane, m, l, o, P);
            else attn_core_d<true>(qf, vs, lane, m, l, o, P);
        }
        if (j == 4) {
            if (seg < 2) {
                LAS float* sp = ST + tau * DST;
#pragma unroll
                for (int db = 0; db < 2; ++db)
#pragma unroll
                    for (int k = 0; k < 4; ++k) { const f32x4 v = {o[db][4 * k], o[db][4 * k + 1], o[db][4 * k + 2], o[db][4 * k + 3]}; *(LAS f32x4*)(sp + 32 * db + 8 * k + 4 * hi) = v; }
                if (hi == 0) sp[64] = m;
                sp[65 + hi] = l;
            } else {
                const float lt = l + __shfl_xor(l, 32), inv = 1.0f / lt;
#pragma unroll
                for (int r = 0; r < 16; ++r) { o[0][r] *= inv; o[1][r] *= inv; }
                if (c < 16) o_store(o, O + (size_t)tq * DM + h * 64, hi);
            }
        }
    };
    pipe_tiles1(20, issue, [&](KVT& T, int) { v_stage(T, vs, lane); k_stage(T.k, vs + 4096, lane); }, compute);
    __syncthreads();
}

constexpr int SL_S = 8192, SL_SEL = SL_S + 8 * 257 * 4, SL_UB = SL_SEL + 256, NSA_SLAB = 17920;
__device__ __forceinline__ void nsa_item(const bf16* Q, const bf16* KV, const bf16* KC, const bf16* VC, const float* GATES, bf16* O, int tt, int g, LAS unsigned char* slab, int lane) {
    const int hi = lane >> 5, col = lane & 31, ti = col >> 2, r4 = col & 3, hh = 4 * g + r4;
    const int tq = 8 * tt + ti, tq0 = 8 * tt, tqmax = 8 * tt + 7;
    const float slope2 = exp2f(-0.5f * (float)(hh + 1)) * LOG2E;
    LAS unsigned char* vs = slab;
    LAS float* S = (LAS float*)(slab + SL_S);
    LAS unsigned* SEL = (LAS unsigned*)(slab + SL_SEL);
    LAS int* UB = (LAS int*)(slab + SL_UB);
    bf16x8 qf[4]; q_load(qf, Q + (size_t)hh * ((size_t)SEQ * 64) + (size_t)tq * 64, lane);
    const float* gt = GATES + (size_t)tq * 48 + g * 4 + r4;
    f32x16 oacc[2];
    for (int i = lane; i < 8 * 257; i += 64) S[i] = 0.f;
    const int ncmp = (tqmax >= 31) ? (((tqmax - 31) >> 4) + 1) : 0;
    const int ntc = (ncmp + 31) >> 5;
    auto crow_of = [&](int t2) { return [=](int key) { int cc = 32 * t2 + key; cc = cc > 1022 ? 1022 : cc; return (size_t)(cc * 4 + g) * 64; }; };
    auto cmp_P = [&](int t2) { TileP P; P.dist0 = tq - 31 - 16 * (32 * t2 + 4 * hi); P.dd = 16; P.lim = 0x3fffffff; P.base = -slope2 * (float)P.dist0; P.sd = slope2 * 16.f; return P; };
    auto cmp_interior = [&](int t2) { return 16 * (32 * t2 + 31) + 31 <= tq0; };
    for (int rep_ = 0; rep_ < REP_CMP; ++rep_) {
        float m = -1e30f, l = 0.f;
        pipe_tiles<KT>(ntc, [&](KT& T, int t2) { k_load(T.k, KC, crow_of(t2), lane); },
                       [&](KT& T, int t2) { const TileP P = cmp_P(t2);
                           if (cmp_interior(t2)) stats_tile<false>(qf, T.k, vs, lane, m, l, P); else stats_tile<true>(qf, T.k, vs, lane, m, l, P); });
        l += __shfl_xor(l, 32);
        const float linv = (l > 0.f) ? 1.0f / l : 0.f;
        f32x16 oc[2];
#pragma unroll
        for (int r = 0; r < 16; ++r) { oc[0][r] = 0.f; oc[1][r] = 0.f; }
        float carry = 0.f;
        pipe_tiles<KVT>(ntc, [&](KVT& T, int t2) { kv_load(T, KC, VC, crow_of(t2), lane); }, [&](KVT& T, int t2) {
            v_stage(T, vs, lane); k_stage(T.k, vs + 4096, lane);
            bf16x8 kf[4]; k_frags(kf, vs + 4096, lane);
            f32x16 s = qk_tile(qf, kf);
            const TileP P = cmp_P(t2);
            if (cmp_interior(t2)) scores<false>(s, P); else scores<true>(s, P);
#pragma unroll
            for (int r = 0; r < 16; ++r) s[r] = ex2(s[r] - m) * linv;
            pv_acc(s, vs, lane, oc);
            float prevr = carry;
#pragma unroll
            for (int i = 0; i < 4; ++i) { float e = s[4 * i + 3], p = 2.f * (s[4 * i] + s[4 * i + 1] + s[4 * i + 2]) + e;
                p += __shfl_xor(p, 1); p += __shfl_xor(p, 2); e += __shfl_xor(e, 1); e += __shfl_xor(e, 2);
                const float rcv = __shfl_xor(e, 32);
                const float sc = p + (hi ? rcv : prevr);
                const int u = 8 * t2 + 2 * i + hi; if (r4 == 0) S[ti * 257 + u] = sc;
                prevr = rcv; }
            carry = prevr;
        });
        { const float gc = gt[0];
#pragma unroll
        for (int r = 0; r < 16; ++r) { oacc[0][r] = gc * oc[0][r]; oacc[1][r] = gc * oc[1][r]; } }
    }
    LDS_WAIT();
    const int cur_b = tq0 >> 6;
#ifndef NSA_NO_SEL
    for (int rep_ = 0; rep_ < REP_SEL; ++rep_) {
        const int tok = lane >> 3, sub = lane & 7;
        unsigned wsel = 0u;
        if (cur_b <= 15) { wsel = (sub == 0) ? ((2u << cur_b) - 1u) : 0u; }
        else {
            unsigned key[32];
#pragma unroll
            for (int k = 0; k < 32; ++k) { const int u = sub + 8 * k; const unsigned bits = __float_as_uint(S[tok * 257 + u]);
                key[k] = (u >= 1 && u <= cur_b - 2) ? ((bits & 0xffffff00u) | (unsigned)(255 - u)) : 0u; }
            wsel = ((sub == 0) ? 1u : 0u) | (((cur_b >> 5) == sub) ? (1u << (cur_b & 31)) : 0u) | ((((cur_b - 1) >> 5) == sub) ? (1u << ((cur_b - 1) & 31)) : 0u);
            for (int rnd = 0; rnd < 13; ++rnd) {
                unsigned mx = 0u;
#pragma unroll
                for (int k = 0; k < 32; ++k) mx = key[k] > mx ? key[k] : mx;
                { const unsigned o1 = __builtin_amdgcn_update_dpp(0u, mx, 0xB1, 0xF, 0xF, true); mx = o1 > mx ? o1 : mx;
                  const unsigned o2 = __builtin_amdgcn_update_dpp(0u, mx, 0x4E, 0xF, 0xF, true); mx = o2 > mx ? o2 : mx;
                  const unsigned o4 = __builtin_amdgcn_update_dpp(0u, mx, 0x141, 0xF, 0xF, true); mx = o4 > mx ? o4 : mx; }
#pragma unroll
                for (int k = 0; k < 32; ++k) key[k] = (key[k] == mx) ? 0u : key[k];
                const int u = 255 - (int)(mx & 0xffu);
                wsel |= ((u >> 5) == sub) ? (1u << (u & 31)) : 0u;
            }
        }
        SEL[tok * 8 + sub] = wsel;
    }
#endif
    LDS_WAIT();
    int nu = 0;
    for (int wd = 0; wd < 8; ++wd) {
        const unsigned mw = SEL[ti * 8 + wd];
        unsigned uw = 0u;
#pragma unroll
        for (int i = 0; i < 8; ++i) uw |= (unsigned)__builtin_amdgcn_readlane((int)mw, 4 * i);
        while (uw) { const int bb = __builtin_ctz(uw); uw &= uw - 1u; if (lane == 0) UB[nu] = wd * 32 + bb; ++nu; }
    }
    LDS_WAIT();
    LAS float* PARK = S;
#pragma unroll
    for (int r = 0; r < 16; ++r) { PARK[r * 64 + lane] = oacc[0][r]; PARK[(16 + r) * 64 + lane] = oacc[1][r]; }
#ifndef NSA_NO_SLC
    for (int rep_ = 0; rep_ < REP_SLC; ++rep_) {
        float m = -1e30f, l = 0.f; f32x16 os[2];
#pragma unroll
        for (int r = 0; r < 16; ++r) { os[0][r] = 0.f; os[1][r] = 0.f; }
        const bf16* kb = KV + 512 + g * 64; const bf16* vb = KV + 768 + g * 64;
        const int ntile = 2 * nu;
        auto tk0_of = [&](int idx) { return 64 * __builtin_amdgcn_readfirstlane(UB[idx >> 1]) + 32 * (idx & 1); };
        pipe_tiles<KVT>(ntile, [&](KVT& T, int idx) { const int tk0 = tk0_of(idx); kv_load(T, kb, vb, [=](int key) { return (size_t)(tk0 + key) * NKV; }, lane); },
            [&](KVT& T, int idx) {
                const int tk0 = tk0_of(idx), u = tk0 >> 6;
                if (tk0 <= tqmax) {
                    const bool mysel = (SEL[ti * 8 + (u >> 5)] >> (u & 31)) & 1u;
                    TileP P; P.dist0 = mysel ? (tq - tk0 - 4 * hi) : 0x40000000; P.dd = 1; P.lim = 0x3fffffff; P.base = -slope2 * (float)(tq - tk0 - 4 * hi); P.sd = slope2;
                    const bool interior = (tk0 + 31 <= tq0) && (__builtin_amdgcn_ballot_w64(!mysel) == 0ull);
                    if (interior) attn_tile<false>(qf, T, vs, lane, m, l, os, P); else attn_tile<true>(qf, T, vs, lane, m, l, os, P);
                }
            });
        l += __shfl_xor(l, 32);
        const float f = (l > 0.f && rep_ == REP_SLC - 1) ? gt[16] / l : 0.f;
#pragma unroll
        for (int r = 0; r < 16; ++r) { PARK[r * 64 + lane] += f * os[0][r]; PARK[(16 + r) * 64 + lane] += f * os[1][r]; }
    }
#endif
#ifndef NSA_NO_WIN
    for (int rep_ = 0; rep_ < REP_WIN; ++rep_) {
        float m = -1e30f, l = 0.f; f32x16 ow[2];
#pragma unroll
        for (int r = 0; r < 16; ++r) { ow[0][r] = 0.f; ow[1][r] = 0.f; }
        const bf16* kb = KV + 1024 + g * 64; const bf16* vb = KV + 1280 + g * 64;
        const int tkb = tq0 + 8 - 32 * 17;
        int t2s = 0; while (tkb + 32 * t2s + 31 < 0) ++t2s;
        auto wrow = [&](int tk0) { return [=](int key) { int tk = tk0 + key; tk = tk < 0 ? 0 : (tk > SEQ - 1 ? SEQ - 1 : tk); return (size_t)tk * NKV; }; };
        pipe_tiles<KVT>(17 - t2s, [&](KVT& T, int i) { kv_load(T, kb, vb, wrow(tkb + 32 * (t2s + i)), lane); },
            [&](KVT& T, int i) {
                const int tk0 = tkb + 32 * (t2s + i);
                TileP P; P.dist0 = tq - tk0 - 4 * hi; P.dd = 1; P.lim = 511 < tq ? 511 : tq; P.base = -slope2 * (float)P.dist0; P.sd = slope2;
                const bool interior = (tk0 >= 0) && (tqmax - tk0 <= 511) && (tk0 + 31 <= tq0);
                if (interior) attn_tile<false>(qf, T, vs, lane, m, l, ow, P); else attn_tile<true>(qf, T, vs, lane, m, l, ow, P);
            });
        l += __shfl_xor(l, 32);
        const float f = (l > 0.f) ? gt[32] / l : 0.f;
#pragma unroll
        for (int r = 0; r < 16; ++r) { oacc[0][r] = PARK[r * 64 + lane] + f * ow[0][r]; oacc[1][r] = PARK[(16 + r) * 64 + lane] + f * ow[1][r]; }
    }
#endif
    o_store(oacc, O + (size_t)tq * DM + hh * 64, hi);
}

#define NSA_CHUNK 1
__device__ __forceinline__ void nsa_chunk(const bf16* Q, const bf16* KV, const bf16* KC, const bf16* VC, const float* GATES, bf16* O, int ch, int g, LAS unsigned char* lds, int wave, int lane) {
    const int tt = 8 * ch + wave; LAS unsigned char* slab = lds + wave * NSA_SLAB; LAS unsigned char* SH = lds + 8 * NSA_SLAB;
    const int hi = lane >> 5, col = lane & 31, ti = col >> 2, r4 = col & 3, hh = 4 * g + r4;
    const int tq = 8 * tt + ti, tq0 = 8 * tt, tqmax = 8 * tt + 7;
    const float slope2 = exp2f(-0.5f * (float)(hh + 1)) * LOG2E;
    LAS unsigned char* vs = slab;
    LAS float* S = (LAS float*)(slab + SL_S);
    LAS unsigned* SEL = (LAS unsigned*)(slab + SL_SEL);
    LAS int* UB = (LAS int*)(slab + SL_UB);
    bf16x8 qf[4]; q_load(qf, Q + (size_t)hh * ((size_t)SEQ * 64) + (size_t)tq * 64, lane);
    const float* gt = GATES + (size_t)tq * 48 + g * 4 + r4;
    f32x16 oacc[2];
    for (int i = lane; i < 8 * 257; i += 64) S[i] = 0.f;
    const int ncmp = (tqmax >= 31) ? (((tqmax - 31) >> 4) + 1) : 0;
    const int ntc_w = (ncmp + 31) >> 5;
    const int ntc = (4 * ch + 3 + 31) >> 5;
    auto crow_of = [&](int t2) { return [=](int key) { int cc = 32 * t2 + key; cc = cc > 1022 ? 1022 : cc; return (size_t)(cc * 4 + g) * 64; }; };
    auto cmp_P = [&](int t2) { TileP P; P.dist0 = tq - 31 - 16 * (32 * t2 + 4 * hi); P.dd = 16; P.lim = 0x3fffffff; P.base = -slope2 * (float)P.dist0; P.sd = slope2 * 16.f; return P; };
    auto cmp_interior = [&](int t2) { return 16 * (32 * t2 + 31) + 31 <= tq0; };
    for (int rep_ = 0; rep_ < REP_CMP; ++rep_) {
        float m = -1e30f, l = 0.f;
        shared_pairs<false>(ntc, lds, NSA_SLAB, KC, VC, [&](int t2, int key) { int cc = 32 * t2 + key; cc = cc > 1022 ? 1022 : cc; return (size_t)(cc * 4 + g) * 64; }, wave, lane,
            [&](LAS unsigned char* ta, LAS unsigned char* tb, int s2) { const int t2 = 2 * s2;
                if (t2 + 1 < ntc_w && tb) { const TileP PA = cmp_P(t2), PB = cmp_P(t2 + 1);
                    if (cmp_interior(t2 + 1)) stats_core2_d<false, false>(qf, ta, tb, lane, m, l, PA, PB); else stats_core2_d<false, true>(qf, ta, tb, lane, m, l, PA, PB); }
                else if (t2 < ntc_w) { const TileP P = cmp_P(t2); if (cmp_interior(t2)) stats_core_d<false>(qf, ta, lane, m, l, P); else stats_core_d<true>(qf, ta, lane, m, l, P); } });
        l += __shfl_xor(l, 32);
        const float linv = (l > 0.f) ? 1.0f / l : 0.f, mfin = (m > -1e29f) ? m : 0.f; (void)mfin;
        f32x16 oc[2];
#pragma unroll
        for (int r = 0; r < 16; ++r) { oc[0][r] = 0.f; oc[1][r] = 0.f; }
        float carry = 0.f;
        auto cmp2_tile = [&](LAS unsigned char* tl, int t2) {
            bf16x8 kf[4]; k_frags(kf, tl + 4096, lane);
            const TileP P = cmp_P(t2);
#if CMP2_NEW
            f32x16 s = cmp_interior(t2) ? qk_scores_d<false>(qf, kf, P, mfin) : qk_scores_d<true>(qf, kf, P, mfin);
#pragma unroll
            for (int r = 0; r < 16; ++r) s[r] = ex2(s[r]) * linv;
#else
            f32x16 s = qk_tile(qf, kf);
            if (cmp_interior(t2)) scores<false>(s, P); else scores<true>(s, P);
#pragma unroll
            for (int r = 0; r < 16; ++r) s[r] = ex2(s[r] - m) * linv;
#endif
            pv_acc(s, tl, lane, oc);
            float prevr = carry;
#pragma unroll
            for (int i = 0; i < 4; ++i) { float e = s[4 * i + 3], p = 2.f * (s[4 * i] + s[4 * i + 1] + s[4 * i + 2]) + e;
                p = quad_sum(p); e = quad_sum(e);
                const float rcv = xhalf_other(e, hi);
                const float sc = p + (hi ? rcv : prevr);
                const int u = 8 * t2 + 2 * i + hi; if (r4 == 0) S[ti * 257 + u] = sc;
                prevr = rcv; }
            carry = prevr;
        };
        shared_pairs<true>(ntc, lds, NSA_SLAB, KC, VC, [&](int t2, int key) { int cc = 32 * t2 + key; cc = cc > 1022 ? 1022 : cc; return (size_t)(cc * 4 + g) * 64; }, wave, lane,
            [&](LAS unsigned char* ta, LAS unsigned char* tb, int s2) { const int t2 = 2 * s2;
                if (t2 < ntc_w) cmp2_tile(ta, t2);
                if (tb && t2 + 1 < ntc_w) cmp2_tile(tb, t2 + 1); });
        { const float gc = gt[0];
#pragma unroll
        for (int r = 0; r < 16; ++r) { oacc[0][r] = gc * oc[0][r]; oacc[1][r] = gc * oc[1][r]; } }
    }
    LDS_WAIT();
    const int cur_b = tq0 >> 6;
#ifndef NSA_NO_SEL
    for (int rep_ = 0; rep_ < REP_SEL; ++rep_) {
        const int tok = lane >> 3, sub = lane & 7;
        unsigned wsel = 0u;
        if (cur_b <= 15) { wsel = (sub == 0) ? ((2u << cur_b) - 1u) : 0u; }
        else {
            unsigned key[32];
#pragma unroll
            for (int k = 0; k < 32; ++k) { const int u = sub + 8 * k; const unsigned bits = __float_as_uint(S[tok * 257 + u]);
                key[k] = (u >= 1 && u <= cur_b - 2) ? ((bits & 0xffffff00u) | (unsigned)(255 - u)) : 0u; }
            wsel = ((sub == 0) ? 1u : 0u) | (((cur_b >> 5) == sub) ? (1u << (cur_b & 31)) : 0u) | ((((cur_b - 1) >> 5) == sub) ? (1u << ((cur_b - 1) & 31)) : 0u);
            for (int rnd = 0; rnd < 13; ++rnd) {
                unsigned mx = 0u;
#pragma unroll
                for (int k = 0; k < 32; ++k) mx = key[k] > mx ? key[k] : mx;
                { const unsigned o1 = __builtin_amdgcn_update_dpp(0u, mx, 0xB1, 0xF, 0xF, true); mx = o1 > mx ? o1 : mx;
                  const unsigned o2 = __builtin_amdgcn_update_dpp(0u, mx, 0x4E, 0xF, 0xF, true); mx = o2 > mx ? o2 : mx;
                  const unsigned o4 = __builtin_amdgcn_update_dpp(0u, mx, 0x141, 0xF, 0xF, true); mx = o4 > mx ? o4 : mx; }
#pragma unroll
                for (int k = 0; k < 32; ++k) key[k] = (key[k] == mx) ? 0u : key[k];
                const int u = 255 - (int)(mx & 0xffu);
                wsel |= ((u >> 5) == sub) ? (1u << (u & 31)) : 0u;
            }
        }
        SEL[tok * 8 + sub] = wsel;
    }
#endif
    LDS_WAIT();
    int nu = 0;
    for (int wd = 0; wd < 8; ++wd) {
        const unsigned mw = SEL[ti * 8 + wd];
        unsigned uw = 0u;
#pragma unroll
        for (int i = 0; i < 8; ++i) uw |= (unsigned)__builtin_amdgcn_readlane((int)mw, 4 * i);
        while (uw) { const int bb = __builtin_ctz(uw); uw &= uw - 1u; if (lane == 0) UB[nu] = wd * 32 + bb; ++nu; }
    }
    LDS_WAIT();
    LAS float* PARK = S;
#pragma unroll
    for (int r = 0; r < 16; ++r) { PARK[r * 64 + lane] = oacc[0][r]; PARK[(16 + r) * 64 + lane] = oacc[1][r]; }
#ifndef NSA_NO_SLC
    for (int rep_ = 0; rep_ < REP_SLC; ++rep_) {
        float m = -1e30f, l = 0.f; f32x16 os[2];
#pragma unroll
        for (int r = 0; r < 16; ++r) { os[0][r] = 0.f; os[1][r] = 0.f; }
        const bf16* kb = KV + 512 + g * 64; const bf16* vb = KV + 768 + g * 64;
        {
            bf16x8 tk[2][4]; u32x4 tv[2][4];
            const size_t loff = (size_t)(lane >> 3) * NKV + 8 * (lane & 7);
#define SLC_LDK(bi_) do { const bf16* p_ = kb + (size_t)(64 * __builtin_amdgcn_readfirstlane(UB[bi_])) * NKV + loff; \
    _Pragma("unroll") for (int x_ = 0; x_ < 2; ++x_) _Pragma("unroll") for (int i_ = 0; i_ < 4; ++i_) tk[x_][i_] = *(const bf16x8*)(p_ + (size_t)(32 * x_ + 8 * i_) * NKV); } while (0)
#define SLC_LDV(bi_) do { const bf16* p_ = vb + (size_t)(64 * __builtin_amdgcn_readfirstlane(UB[bi_])) * NKV + loff; \
    _Pragma("unroll") for (int x_ = 0; x_ < 2; ++x_) _Pragma("unroll") for (int i_ = 0; i_ < 4; ++i_) tv[x_][i_] = *(const u32x4*)(p_ + (size_t)(32 * x_ + 8 * i_) * NKV); } while (0)
            SLC_LDK(0); SLC_LDV(0);
#pragma nounroll
            for (int bi = 0; bi < nu; ++bi) {
                const int tk0 = 64 * __builtin_amdgcn_readfirstlane(UB[bi]), u = tk0 >> 6;
                const bool mysel = (SEL[ti * 8 + (u >> 5)] >> (u & 31)) & 1u;
                TileP PA; PA.dist0 = mysel ? (tq - tk0 - 4 * hi) : 0x40000000; PA.dd = 1; PA.lim = 0x3fffffff; PA.base = -slope2 * (float)(tq - tk0 - 4 * hi); PA.sd = slope2;
                TileP PB = PA; PB.dist0 = PA.dist0 - 32; PB.base = -slope2 * (float)(tq - tk0 - 32 - 4 * hi);
                const bool interior = (tk0 + 63 <= tq0) && (__builtin_amdgcn_ballot_w64(!mysel) == 0ull);
                k_stage(tk[0], vs, lane); k_stage(tk[1], vs + 4096, lane);
                if (bi + 1 < nu) SLC_LDK(bi + 1);
                const bool seeded = m > -1e29f; const float mref = seeded ? m : 0.f;
                f32x16 sa, sb;
                if (interior) pair_qk<false>(qf, vs, lane, mref, PA, PB, sa, sb); else pair_qk<true>(qf, vs, lane, mref, PA, PB, sa, sb);
                v_stage_raw(tv[0], vs, lane); v_stage_raw(tv[1], vs + 4096, lane);
                if (bi + 1 < nu) SLC_LDV(bi + 1);
                pair_sm_pv(sa, sb, vs, lane, m, l, os, seeded, mref);
            }
#undef SLC_LDK
#undef SLC_LDV
        }
        l += __shfl_xor(l, 32);
        const float f = (l > 0.f && rep_ == REP_SLC - 1) ? gt[16] / l : 0.f;
#pragma unroll
        for (int r = 0; r < 16; ++r) { PARK[r * 64 + lane] += f * os[0][r]; PARK[(16 + r) * 64 + lane] += f * os[1][r]; }
    }
#endif
#ifndef NSA_NO_WIN
    for (int rep_ = 0; rep_ < REP_WIN; ++rep_) {
        float m = -1e30f, l = 0.f; f32x16 ow[2];
#pragma unroll
        for (int r = 0; r < 16; ++r) { ow[0][r] = 0.f; ow[1][r] = 0.f; }
        const bf16* kb = KV + 1024 + g * 64; const bf16* vb = KV + 1280 + g * 64;
        const int tkb = 64 * ch - 512;
        int t2s = 0; while (tkb + 32 * t2s + 31 < 0) ++t2s;
        auto win_P = [&](int tk0) { TileP P; P.dist0 = tq - tk0 - 4 * hi; P.dd = 1; P.lim = 511 < tq ? 511 : tq; P.base = -slope2 * (float)P.dist0; P.sd = slope2; return P; };
        auto win_used = [&](int tk0) { return tk0 <= tqmax && tk0 + 31 >= tq0 - 511; };
        auto win_int = [&](int tk0) { return (tk0 >= 0) && (tqmax - tk0 <= 511) && (tk0 + 31 <= tq0); };
        shared_pairs<true>(18 - t2s, lds, NSA_SLAB, kb, vb, [&](int i, int key) { int tk = tkb + 32 * (t2s + i) + key; tk = tk < 0 ? 0 : (tk > SEQ - 1 ? SEQ - 1 : tk); return (size_t)tk * NKV; }, wave, lane,
            [&](LAS unsigned char* ta, LAS unsigned char* tb, int s2) {
                const int tkA = tkb + 32 * (t2s + 2 * s2), tkB = tkA + 32;
                const bool ua = win_used(tkA), ub = tb && win_used(tkB);
                if (ua && ub) { const TileP PA = win_P(tkA), PB = win_P(tkB); const bool ia = win_int(tkA), ib = win_int(tkB);
                    if (ia && ib) attn_core2_d<false, false>(qf, ta, tb, lane, m, l, ow, PA, PB);
                    else attn_core2_d<true, true>(qf, ta, tb, lane, m, l, ow, PA, PB); }
                else if (ua) { const TileP P = win_P(tkA); if (win_int(tkA)) attn_core_d<false>(qf, ta, lane, m, l, ow, P); else attn_core_d<true>(qf, ta, lane, m, l, ow, P); }
                else if (ub) { const TileP P = win_P(tkB); if (win_int(tkB)) attn_core_d<false>(qf, tb, lane, m, l, ow, P); else attn_core_d<true>(qf, tb, lane, m, l, ow, P); }
            });
        l += __shfl_xor(l, 32);
        const float f = (l > 0.f) ? gt[32] / l : 0.f;
#pragma unroll
        for (int r = 0; r < 16; ++r) { oacc[0][r] = PARK[r * 64 + lane] + f * ow[0][r]; oacc[1][r] = PARK[(16 + r) * 64 + lane] + f * ow[1][r]; }
    }
#endif
    o_store(oacc, O + (size_t)tq * DM + hh * 64, hi);
}

struct EpiHeadMajor {
    static constexpr bool PERM = true, AFTER_DRAIN = false;
    bf16* O; const float* bias; int smode;
    __device__ __forceinline__ void operator()(const f32x4 (&acc)[2][2][4][2], const pg8::Unit& u, int wr, int wc, int fr, int fq) const {
        const int row0 = u.pm * 256 + wr * 64 + fr, col0 = u.pn * 256 + wc * 32 + 8 * fq;
        const float sc = (smode == 2 || (smode == 1 && ((u.pn >> 2) % 3) == 0)) ? C1 : 1.0f;
#pragma unroll
        for (int bj = 0; bj < 2; ++bj) { const int col = col0 + bj * 128; bf16* blk = O + (size_t)(col >> 6) * ((size_t)SEQ * 64) + (col & 63);
            f32x4 b0 = {0.f, 0.f, 0.f, 0.f}, b1 = b0; if (bias) { b0 = *(const f32x4*)(bias + col); b1 = *(const f32x4*)(bias + col + 4); }
#pragma unroll
            for (int ai = 0; ai < 2; ++ai)
#pragma unroll
                for (int m = 0; m < 4; ++m) { const f32x4 v0 = (acc[ai][bj][m][0] + b0) * sc, v1 = (acc[ai][bj][m][1] + b1) * sc;
                    u32x4 o; o.x = pk2(v0[0], v0[1]); o.y = pk2(v0[2], v0[3]); o.z = pk2(v1[0], v1[1]); o.w = pk2(v1[2], v1[3]);
                    *(u32x4*)(blk + (size_t)(row0 + ai * 128 + m * 16) * 64) = o; } }
    }
};
struct EpiResid {
    static constexpr bool PERM = true, AFTER_DRAIN = false;
    bf16* H;
    __device__ __forceinline__ void operator()(const f32x4 (&acc)[2][2][4][2], const pg8::Unit& u, int wr, int wc, int fr, int fq) const {
        const int row0 = u.pm * 256 + wr * 64 + fr, col0 = u.pn * 256 + wc * 32 + 8 * fq;
#pragma unroll
        for (int ai = 0; ai < 2; ++ai)
#pragma unroll
            for (int m = 0; m < 4; ++m) { bf16* rowp = H + (size_t)(row0 + ai * 128 + m * 16) * DM + col0;
#pragma unroll
                for (int bj = 0; bj < 2; ++bj) { u32x4* p = (u32x4*)(rowp + bj * 128); const u32x4 h = *p; const f32x4 v0 = acc[ai][bj][m][0], v1 = acc[ai][bj][m][1];
                    u32x4 o; o.x = pk2(ALPHA * bflo(h.x) + v0[0], ALPHA * bfhi(h.x) + v0[1]); o.y = pk2(ALPHA * bflo(h.y) + v0[2], ALPHA * bfhi(h.y) + v0[3]);
                    o.z = pk2(ALPHA * bflo(h.z) + v1[0], ALPHA * bfhi(h.z) + v1[1]); o.w = pk2(ALPHA * bflo(h.w) + v1[2], ALPHA * bfhi(h.w) + v1[3]);
                    *p = o; } }
    }
};
struct EpiSwiglu {
    static constexpr bool PERM = true, AFTER_DRAIN = false;
    bf16* HID; const float* roww;
    __device__ __forceinline__ void operator()(const f32x4 (&acc)[2][2][4][2], const pg8::Unit& u, int wr, int wc, int fr, int fq) const {
        const int row0 = u.pm * 256 + wr * 64 + fr, ct = u.pn & 1, col0 = ct * 128 + wc * 32 + 8 * fq;
#pragma unroll
        for (int ai = 0; ai < 2; ++ai)
#pragma unroll
            for (int m = 0; m < 4; ++m) { const int row = row0 + ai * 128 + m * 16; const float w = roww[row];
                float hv[8];
#pragma unroll
                for (int n = 0; n < 2; ++n)
#pragma unroll
                    for (int j = 0; j < 4; ++j) { const float gte = acc[ai][0][m][n][j], up = acc[ai][1][m][n][j];
                        hv[4 * n + j] = gte * __builtin_amdgcn_rcpf(1.0f + ex2(-gte * LOG2E)) * up * w; }
                u32x4 o; o.x = pk2(hv[0], hv[1]); o.y = pk2(hv[2], hv[3]); o.z = pk2(hv[4], hv[5]); o.w = pk2(hv[6], hv[7]);
                *(u32x4*)(HID + (size_t)row * 256 + col0) = o; }
    }
};
struct EpiScatter {
    static constexpr bool PERM = true, AFTER_DRAIN = false;
    bf16* Y; const int* rowinfo;
    __device__ __forceinline__ void operator()(const f32x4 (&acc)[2][2][4][2], const pg8::Unit& u, int wr, int wc, int fr, int fq) const {
        int t_ = threadIdx.x; asm volatile("" : "+v"(t_));
        const int fr_ = t_ & 15, fq_ = (t_ & 63) >> 4; (void)fr; (void)fq;
        const int row0 = u.pm * 256 + wr * 64 + fr_, ct = u.pn & 3, col0 = ct * 256 + wc * 32 + 8 * fq_;
#pragma unroll
        for (int ai = 0; ai < 2; ++ai)
#pragma unroll
            for (int m = 0; m < 4; ++m) { const int info = rowinfo[row0 + ai * 128 + m * 16];
                if (info >= 0) { bf16* rowp = Y + ((size_t)(info & 1) * SEQ + (size_t)(info >> 1)) * DM + col0;
#pragma unroll
                    for (int bj = 0; bj < 2; ++bj) { const f32x4 v0 = acc[ai][bj][m][0], v1 = acc[ai][bj][m][1];
                        u32x4 o; o.x = pk2(v0[0], v0[1]); o.y = pk2(v0[2], v0[3]); o.z = pk2(v1[0], v1[1]); o.w = pk2(v1[2], v1[3]);
                        *(u32x4*)(rowp + bj * 128) = o; } } }
    }
};
template <bool GATHER_>
struct MoeOrderT {
    static constexpr bool GATHER = GATHER_;
    const LAS int* tb; const LAS int* rowtab; int NCT, G, c;
    __device__ __forceinline__ void init(const LAS int* tb_, int nct, int G_, int c_) { tb = tb_; rowtab = tb_ + 64; NCT = nct; G = G_; c = c_; }
    __device__ __forceinline__ bool next(int i, pg8::Unit& u) const {
        const int L = i * G + c, rt = L / NCT; if (rt >= __builtin_amdgcn_readfirstlane(tb[16])) return false;
        int e = 0;
#pragma unroll
        for (int k = 1; k < 16; ++k) e += (rt >= tb[k]) ? 1 : 0;
        u.pm = rt; u.pn = __builtin_amdgcn_readfirstlane(e) * NCT + (L % NCT); return true;
    }
    __device__ __forceinline__ void a_ready(const pg8::Unit&) const {}
    __device__ __forceinline__ void done(const pg8::Unit&) const {}
};
typedef MoeOrderT<false> MoeOrder;
typedef MoeOrderT<true> MoeGatherOrder;

__device__ __forceinline__ void ln_phase(LAS unsigned char* lds, int mode, float hscale, const bf16* Y, const float* gam, const float* bet, float* outF, float oscale, bf16* HB,
                                         const bf16* WT, const float* sb, int4* ROUTE, int* HIST, float* GATES) {
    const int tid = threadIdx.x, lane = tid & 63, wave = __builtin_amdgcn_readfirstlane(tid >> 6), hi = lane >> 5;
    LAS float* LOG = (LAS float*)(lds + LDS_MISC);
    LAS int* HCNT = (LAS int*)(lds + LDS_MISC + 64 * 97 * 4);
    f32x4 gv[4], bv[4];
#pragma unroll
    for (int j = 0; j < 4; ++j) { gv[j] = *(const f32x4*)(gam + 4 * lane + 256 * j); bv[j] = *(const f32x4*)(bet + 4 * lane + 256 * j); }
    for (int ch = blockIdx.x; ch < SEQ / 64; ch += gridDim.x) {
        if (tid < 16) HCNT[tid] = 0;
        auto load_row = [&](u32x2 (&hv)[4], u32x2 (&ya)[4], u32x2 (&yb)[4], int i) {
            const size_t row = (size_t)ch * 64 + wave * 8 + i;
#pragma unroll
            for (int j = 0; j < 4; ++j) hv[j] = *(const u32x2*)(HB + row * DM + 4 * lane + 256 * j);
            if (Y) {
#pragma unroll
                for (int j = 0; j < 4; ++j) { ya[j] = *(const u32x2*)(Y + row * DM + 4 * lane + 256 * j); yb[j] = *(const u32x2*)(Y + ((size_t)SEQ + row) * DM + 4 * lane + 256 * j); }
            }
        };
        auto do_row = [&](const u32x2 (&hv)[4], u32x2 (&ya)[4], u32x2 (&yb)[4], int i) {
            const int rl = wave * 8 + i; const size_t row = (size_t)ch * 64 + rl;
            f32x4 v[4];
#pragma unroll
            for (int j = 0; j < 4; ++j) { v[j][0] = hscale * bflo(hv[j].x); v[j][1] = hscale * bfhi(hv[j].x); v[j][2] = hscale * bflo(hv[j].y); v[j][3] = hscale * bfhi(hv[j].y); }
            if (Y) {
#pragma unroll
                for (int j = 0; j < 4; ++j) { v[j][0] = (v[j][0] + bflo(ya[j].x)) + bflo(yb[j].x); v[j][1] = (v[j][1] + bfhi(ya[j].x)) + bfhi(yb[j].x);
                    v[j][2] = (v[j][2] + bflo(ya[j].y)) + bflo(yb[j].y); v[j][3] = (v[j][3] + bfhi(ya[j].y)) + bfhi(yb[j].y); }
            }
            float s = 0.f;
#pragma unroll
            for (int j = 0; j < 4; ++j) s += (v[j][0] + v[j][1]) + (v[j][2] + v[j][3]);
            const float mean = wave_sum(s) * (1.0f / DM);
            float q = 0.f;
#pragma unroll
            for (int j = 0; j < 4; ++j) { v[j] = v[j] - mean; q += (v[j][0] * v[j][0] + v[j][1] * v[j][1]) + (v[j][2] * v[j][2] + v[j][3] * v[j][3]); }
            const float rstd = 1.0f / sqrtf(wave_sum(q) * (1.0f / DM) + LN_EPS);
#pragma unroll
            for (int j = 0; j < 4; ++j) { const f32x4 y = v[j] * rstd * gv[j] + bv[j];
                if (outF) *(f32x4*)(outF + row * DM + 4 * lane + 256 * j) = y * oscale;
                u32x2 w; w.x = pk2(y[0], y[1]); w.y = pk2(y[2], y[3]);
                *(u32x2*)(HB + row * DM + 4 * lane + 256 * j) = w;
                const int ck = (lane >> 1) + 32 * j;
                *(LAS u32x2*)(lds + rl * 2048 + ((ck ^ (rl & 15)) << 4) + (lane & 1) * 8) = w; }
        };
        {
            u32x2 va[4], vb[4], ya0[4], ya1[4], yb0[4], yb1[4];
            load_row(va, ya0, ya1, 0);
#pragma nounroll
            for (int i = 0; i < 8; i += 2) { load_row(vb, yb0, yb1, i + 1); do_row(va, ya0, ya1, i); if (i + 2 < 8) load_row(va, ya0, ya1, i + 2); do_row(vb, yb0, yb1, i + 1); }
        }
        __syncthreads();
        if (mode != 2) {
            const int nct = (mode == 0) ? 1 : 2, nks = 4 / nct;
            const int tt = wave & 1, ct = (nct == 2) ? ((wave >> 1) & 1) : 0, ks = (nct == 2) ? (wave >> 2) : (wave >> 1), rl = tt * 32 + (lane & 31);
            const int s0 = ks * (64 / nks), s1 = s0 + 64 / nks;
            const bf16* wrow = WT + (size_t)(ct * 32 + (lane & 31)) * DM + 8 * hi;
            f32x16 acc;
#pragma unroll
            for (int r = 0; r < 16; ++r) acc[r] = 0.f;
#pragma unroll 8
            for (int s2 = s0; s2 < s1; ++s2) { const bf16x8 a = *(const bf16x8*)(wrow + 16 * s2); const int ck = 2 * s2 + hi;
                const bf16x8 b = *(const LAS bf16x8*)(lds + rl * 2048 + ((ck ^ (rl & 15)) << 4)); acc = MFMA32(a, b, acc); }
            const int ncp = (mode == 0) ? 24 : 48;
#pragma unroll
            for (int r = 0; r < 16; ++r) { const int col = 32 * ct + crow(r, hi); if (col < ncp) LOG[rl * 97 + ks * ncp + col] = acc[r]; }
        }
        __syncthreads();
        if (mode == 0 && tid < 64) {
            const LAS float* lgp = LOG + tid * 97;
            auto LG = [&](int c) { return ((lgp[c] + lgp[24 + c]) + lgp[48 + c]) + lgp[72 + c]; };
            int gi = 0; float gm = LG(0) + sb[0];
#pragma unroll
            for (int k = 1; k < 4; ++k) { const float x = LG(k) + sb[k]; if (x > gm) { gm = x; gi = k; } }
            float den = 0.f;
#pragma unroll
            for (int k = 0; k < 4; ++k) den += __expf(LG(k) + sb[k] - gm);
            const float gw = 1.0f / den;
            float ev[4];
#pragma unroll
            for (int k = 0; k < 4; ++k) ev[k] = LG(4 + 4 * gi + k) + sb[4 + 4 * gi + k];
            int i0 = 0; float v0 = ev[0];
#pragma unroll
            for (int k = 1; k < 4; ++k) if (ev[k] > v0) { v0 = ev[k]; i0 = k; }
            int i1 = -1; float v1 = -INFINITY;
#pragma unroll
            for (int k = 0; k < 4; ++k) if (k != i0 && ev[k] > v1) { v1 = ev[k]; i1 = k; }
            if (i1 < 0) { i1 = (i0 + 1) & 3; v1 = ev[i1]; }
            const float t = __expf(v1 - v0), w0 = gw / (1.0f + t), w1 = gw * t / (1.0f + t);
            const int e0 = 4 * gi + i0, e1 = 4 * gi + i1;
            ROUTE[(size_t)ch * 64 + tid] = make_int4(e0, e1, __float_as_int(w0), __float_as_int(w1));
            atomicAdd((int*)&HCNT[e0], 1); atomicAdd((int*)&HCNT[e1], 1);
        }
        if (mode == 1 && tid < 64) {
            const LAS float* lgp = LOG + tid * 97; float* go = GATES + ((size_t)ch * 64 + tid) * 48;
#pragma unroll 4
            for (int c = 0; c < 48; ++c) go[c] = 1.0f / (1.0f + __expf(-((lgp[c] + lgp[48 + c]) + sb[c])));
        }
        __syncthreads();
        if (mode == 0 && tid < 16) HIST[ch * 16 + tid] = HCNT[tid];
    }
}

__device__ __forceinline__ void moe_scatter(LAS unsigned char* lds, const int4* ROUTE, const int* HIST, int* TILEB, int* ROWINFO, float* ROWW) {
    const int tid = threadIdx.x;
    LAS int* tot = (LAS int*)(lds + LDS_MISC);
    LAS int* pre = tot + 16;
    LAS int* tbl = pre + 16;
    LAS int* ent = tbl + 32;
    LAS int* pos = ent + 128;
    LAS float* ewt = (LAS float*)(pos + 128);
    for (int ch = blockIdx.x; ch < SEQ / 64; ch += gridDim.x) {
        {
            if (tid < 32) tot[tid] = 0;
            __syncthreads();
            const int e = tid & 15, part = tid >> 4; int t = 0, p = 0;
#pragma unroll
            for (int c2 = 0; c2 < 8; ++c2) { const int c = part * 8 + c2; const int v = HIST[c * 16 + e]; t += v; p += (c < ch) ? v : 0; }
            atomicAdd((int*)&tot[e], t); atomicAdd((int*)&pre[e], p);
        }
        if (tid >= 64 && tid < 128) { const int k = tid - 64; const int4 r = ROUTE[(size_t)ch * 64 + k]; ent[2 * k] = r.x; ent[2 * k + 1] = r.y; ewt[2 * k] = __int_as_float(r.z); ewt[2 * k + 1] = __int_as_float(r.w); }
        __syncthreads();
        if (tid == 0) { int a = 0; for (int e = 0; e < 16; ++e) { tbl[e] = a; a += (tot[e] + 255) >> 8; } tbl[16] = a;
            if (ch == 0) { for (int e = 0; e < 17; ++e) TILEB[e] = tbl[e]; } }
        __syncthreads();
        if (tid < 16) { int run = tbl[tid] * 256 + pre[tid]; for (int k = 0; k < 128; ++k) if (ent[k] == tid) pos[k] = run++; }
        __syncthreads();
        if (tid < 128) { const int k = tid, p = pos[k]; ROWINFO[p] = (ch * 64 + (k >> 1)) * 2 + (k & 1); ROWW[p] = ewt[k]; }
        if (ch < 16) { const int e = ch, r0 = tbl[e] * 256 + tot[e], r1 = tbl[e + 1] * 256; for (int r = r0 + tid; r < r1; r += NTHREADS) { ROWINFO[r] = -1; ROWW[r] = 0.f; } }
        __syncthreads();
    }
}

__device__ __forceinline__ float gelu_tanh(float x) { const float u = 0.7978845608028654f * (x + 0.044715f * x * x * x); const float t = 1.0f - 2.0f / (__expf(2.0f * u) + 1.0f); return 0.5f * x * (1.0f + t); }
__device__ __forceinline__ void compress_phase(LAS unsigned char* lds, const bf16* KV, const bf16* W1T, const bf16* W2T, const float* B1P, const float* b1, const float* b2, bf16* KCMP) {
    const int tid = threadIdx.x, lane = tid & 63, wave = __builtin_amdgcn_readfirstlane(tid >> 6), hi = lane >> 5;
    LAS unsigned char* H1 = lds;
    for (int item = blockIdx.x; item < 256; item += gridDim.x) {
        const int j = item >> 7, rt = item & 127;
        int rho = 32 * rt + (lane & 31); const bool rvalid = rho < 4092; rho = rvalid ? rho : 4091;
        const int c = rho >> 2, g = rho & 3;
        const bf16* arow = KV + (size_t)(16 * c) * NKV + j * 256 + g * 64;
        const bf16* wrow = W1T + ((size_t)j * 256 + 32 * wave + (lane & 31)) * 2048;
        f32x16 acc;
#pragma unroll
        for (int r = 0; r < 16; ++r) acc[r] = 0.f;
#pragma unroll 4
        for (int s = 0; s < 128; ++s) { const int k = 16 * s + 8 * hi;
            const bf16x8 b = *(const bf16x8*)(arow + (size_t)(k >> 6) * NKV + (k & 63)); const bf16x8 a = *(const bf16x8*)(wrow + k); acc = MFMA32(a, b, acc); }
#pragma unroll
        for (int r = 0; r < 16; ++r) { const int n = 32 * wave + crow(r, hi); float bsum = b1[j * 256 + n];
            for (int ks = 0; ks < 16; ++ks) bsum += B1P[(j * 16 + ks) * 256 + n];
            const float hval = gelu_tanh(acc[r] + bsum);
            *(LAS unsigned short*)(H1 + (lane & 31) * 528 + n * 2) = (unsigned short)(pk2(hval, 0.f) & 0xffffu); }
        __syncthreads();
        if (wave < 2) {
            const int db = wave;
            const bf16* w2row = W2T + ((size_t)j * 64 + 32 * db + (lane & 31)) * 256 + 8 * hi;
            f32x16 o;
#pragma unroll
            for (int r = 0; r < 16; ++r) o[r] = 0.f;
#pragma unroll
            for (int s = 0; s < 16; ++s) { const bf16x8 a = *(const bf16x8*)(w2row + 16 * s); const bf16x8 b = *(const LAS bf16x8*)(H1 + (lane & 31) * 528 + (16 * s + 8 * hi) * 2); o = MFMA32(a, b, o); }
            if (rvalid) { bf16* orow = KCMP + ((size_t)j * 1024 * 4 + (size_t)c * 4 + g) * 64 + 32 * db;
#pragma unroll
                for (int k = 0; k < 4; ++k) { const int d0 = 32 * db + 8 * k + 4 * hi; u32x2 w;
                    w.x = pk2(o[4 * k] + b2[j * 64 + d0], o[4 * k + 1] + b2[j * 64 + d0 + 1]); w.y = pk2(o[4 * k + 2] + b2[j * 64 + d0 + 2], o[4 * k + 3] + b2[j * 64 + d0 + 3]);
                    *(u32x2*)(orow + 8 * k + 4 * hi) = w; } }
        }
        __syncthreads();
    }
}

#if DBG_CHECK
__device__ __forceinline__ void dbg_acc(unsigned* ctl, int slot, float num, float den) {
    num = wave_sum(num); den = wave_sum(den);
    if ((threadIdx.x & 63) == 0) { atomicAdd((float*)(ctl + CW_DBG) + 2 * slot, num); atomicAdd((float*)(ctl + CW_DBG) + 2 * slot + 1, den); }
}
__device__ __forceinline__ float dbg_dot64(const bf16* a, const bf16* b, int lane) { return wave_sum(bf2f(a[lane]) * bf2f(b[lane])); }
__device__ __forceinline__ int dbg_token(int w) { const int sp[16] = {0, 5, 30, 31, 47, 63, 64, 100, 500, 1023, 1024, 1039, 2047, 4096, 16320, 16383}; return (w < 16) ? sp[w] : (int)(((unsigned)w * 6151u + 17u) % 16384u); }

__device__ __forceinline__ void dbg_check_dilated(unsigned* ctl, const bf16* qkv, const bf16* O) {
    const int lane = threadIdx.x & 63, wave = threadIdx.x >> 6;
    const int w = blockIdx.x * 8 + wave; const int t = dbg_token(w & 255), h = (w * 7 + (w >> 8)) & 15;
    const float slope = exp2f(-0.5f * (float)(h + 1));
    float outg[3], lse[3];
    for (int g = 0; g < 3; ++g) {
        const int d = 1 << (2 * g), W = 128 << (2 * g);
        const bf16* q = qkv + (size_t)((g * 3) * 16 + h) * ((size_t)SEQ * 64) + (size_t)t * 64;
        float m = -1e30f, l = 0.f, acc = 0.f;
        for (int j = 0; j * d <= W; ++j) { const int tk = t - j * d; if (tk < 0) break;
            const bf16* k = qkv + (size_t)((g * 3 + 1) * 16 + h) * ((size_t)SEQ * 64) + (size_t)tk * 64; const bf16* v = k + (size_t)16 * SEQ * 64;
            const float s = dbg_dot64(q, k, lane) * (1.0f / LOG2E) - slope * (float)(j * d);
            const float mn = fmaxf(m, s), a = __expf(m - mn), p = __expf(s - mn); l = l * a + p; acc = acc * a + p * bf2f(v[lane]); m = mn; }
        outg[g] = acc / l; lse[g] = m + __logf(l);
    }
    const float mx = fmaxf(lse[0], fmaxf(lse[1], lse[2])); const float e0 = __expf(lse[0] - mx), e1 = __expf(lse[1] - mx), e2 = __expf(lse[2] - mx);
    const float o = (e0 * outg[0] + e1 * outg[1] + e2 * outg[2]) / (e0 + e1 + e2);
    const float got = bf2f(O[(size_t)t * DM + h * 64 + lane]);
    dbg_acc(ctl, 0, (o - got) * (o - got), o * o);
}

__device__ __forceinline__ void dbg_check_nsa(LAS unsigned char* lds, unsigned* ctl, const bf16* Q, const bf16* KV, const bf16* KC, const bf16* VC, const float* GATES, const bf16* O) {
    const int lane = threadIdx.x & 63, wave = threadIdx.x >> 6;
    const int w = blockIdx.x; const int t = dbg_token(w), g = (w >> 2) & 3;
    LAS float* P = (LAS float*)lds; LAS float* IMP = (LAS float*)(lds + 16384); LAS float* SC = (LAS float*)(lds + 20480); LAS int* SELB = (LAS int*)(lds + 21504);
    const int hh = 4 * g + (wave & 3); const float slope = exp2f(-0.5f * (float)(hh + 1));
    const bf16* q = Q + (size_t)hh * ((size_t)SEQ * 64) + (size_t)t * 64;
    float oc = 0.f;
    __syncthreads();
    if (wave < 4) {
        LAS float* Pr = P + wave * 1024; float m = -1e30f;
        for (int c = 0; c < 1023; ++c) { const int dc = t - (16 * c + 31); float s = -1e30f; if (dc >= 0) s = dbg_dot64(q, KC + (size_t)(c * 4 + g) * 64, lane) * (1.0f / LOG2E) - slope * (float)dc; if (lane == 0) Pr[c] = s; m = fmaxf(m, s); }
        LDS_WAIT();
        float l = 0.f;
        for (int c = 0; c < 1023; ++c) { const int dc = t - (16 * c + 31); const float p = (dc >= 0) ? __expf(Pr[c] - m) : 0.f; l += p; }
        const float linv = 1.0f / fmaxf(l, 1e-30f);
        for (int c = 0; c < 1023; ++c) { const int dc = t - (16 * c + 31); const float p = (dc >= 0) ? __expf(Pr[c] - m) * linv : 0.f; oc += p * bf2f(VC[(size_t)(c * 4 + g) * 64 + lane]); if (lane == 0) Pr[c] = p; }
        if (lane == 0) Pr[1023] = 0.f;
    }
    __syncthreads();
    for (int c = threadIdx.x; c < 1024; c += NTHREADS) IMP[c] = P[c] + P[1024 + c] + P[2048 + c] + P[3072 + c];
    __syncthreads();
    const int cur = t >> 6;
    for (int s = threadIdx.x; s < 256; s += NTHREADS) { float a = 0.f;
        for (int aa = 0; aa < 4; ++aa) for (int bb = 0; bb < 2; ++bb) { const int idx = 4 * s + aa - bb; if (idx >= 0 && idx < 1023) a += IMP[idx]; }
        float sc = (s == 0 || s == cur || s == cur - 1) ? 1e4f : a; if (s > cur) sc = -1e4f; SC[s] = sc; }
    __syncthreads();
    if (threadIdx.x == 0) { for (int k = 0; k < 16; ++k) { int bi = 0; float bv = -3e38f; for (int s = 0; s < 256; ++s) if (SC[s] > bv) { bv = SC[s]; bi = s; } SELB[k] = bi; SC[bi] = -3e38f; } }
    __syncthreads();
    if (wave < 4) {
        float m = -1e30f, l = 0.f, acc = 0.f;
        for (int k = 0; k < 16; ++k) { const int blk = SELB[k];
            for (int j = 0; j < 64; ++j) { const int tok = 64 * blk + j, ds = t - tok; if (ds < 0) continue;
                const float s = dbg_dot64(q, KV + (size_t)tok * NKV + 512 + g * 64, lane) * (1.0f / LOG2E) - slope * (float)ds;
                const float mn = fmaxf(m, s), a = __expf(m - mn), p = __expf(s - mn); l = l * a + p; acc = acc * a + p * bf2f(KV[(size_t)tok * NKV + 768 + g * 64 + lane]); m = mn; } }
        const float os = (l > 0.f) ? acc / l : 0.f;
        m = -1e30f; l = 0.f; acc = 0.f;
        for (int dw = 0; dw < 512; ++dw) { const int tok = t - dw; if (tok < 0) break;
            const float s = dbg_dot64(q, KV + (size_t)tok * NKV + 1024 + g * 64, lane) * (1.0f / LOG2E) - slope * (float)dw;
            const float mn = fmaxf(m, s), a = __expf(m - mn), p = __expf(s - mn); l = l * a + p; acc = acc * a + p * bf2f(KV[(size_t)tok * NKV + 1280 + g * 64 + lane]); m = mn; }
        const float ow = (l > 0.f) ? acc / l : 0.f;
        const float* gt = GATES + (size_t)t * 48 + g * 4 + (wave & 3);
        const float o = gt[0] * oc + gt[16] * os + gt[32] * ow;
        const float got = bf2f(O[(size_t)t * DM + hh * 64 + lane]);
        dbg_acc(ctl, 1, (o - got) * (o - got), o * o);
    }
    __syncthreads();
}

__device__ __forceinline__ void dbg_check_moe(LAS unsigned char* lds, unsigned* ctl, const bf16* HB, const int4* ROUTE, const float* gu, const float* dn, const bf16* Y) {
    const int tid = threadIdx.x; const int t = dbg_token(blockIdx.x);
    LAS float* hv = (LAS float*)lds; LAS float* hid = (LAS float*)(lds + 4096);
    __syncthreads();
    for (int k = tid; k < DM; k += NTHREADS) hv[k] = bf2f(HB[(size_t)t * DM + k]);
    __syncthreads();
    const int4 r = ROUTE[t];
    { const int sl = tid >> 8, f = tid & 255, e = sl ? r.y : r.x; const float wgt = __int_as_float(sl ? r.w : r.z);
      const float* W = gu + (size_t)e * 1024 * 512; float a = 0.f, b = 0.f;
      for (int k = 0; k < DM; ++k) { a += hv[k] * W[(size_t)k * 512 + f]; b += hv[k] * W[(size_t)k * 512 + 256 + f]; }
      hid[tid] = a / (1.0f + __expf(-a)) * b * wgt; }
    __syncthreads();
    float num = 0.f, den = 0.f;
    for (int dd = tid; dd < DM; dd += NTHREADS) { float y = 0.f;
        for (int sl = 0; sl < 2; ++sl) { const int e = sl ? r.y : r.x; const float* W = dn + (size_t)e * 256 * 1024;
            for (int f = 0; f < 256; ++f) y += hid[sl * 256 + f] * W[(size_t)f * 1024 + dd]; }
        const float got = bf2f(Y[(size_t)t * DM + dd]) + bf2f(Y[((size_t)SEQ + t) * DM + dd]);
        num += (y - got) * (y - got); den += y * y; }
    dbg_acc(ctl, 2, num, den);
    __syncthreads();
}

__device__ __forceinline__ void dbg_check_compress(LAS unsigned char* lds, unsigned* ctl, const bf16* KV, const float* pos, const float* W1, const float* b1, const float* W2, const float* b2, const bf16* KCMP) {
    const int tid = threadIdx.x, w = blockIdx.x; const int j = w & 1, g = (w >> 1) & 3, c = (w < 8) ? (w < 4 ? 0 : 1022) : (int)(((unsigned)w * 977u) % 1023u);
    LAS float* hid = (LAS float*)lds;
    __syncthreads();
    if (tid < 256) { float a = b1[j * 256 + tid];
        for (int k = 0; k < 2048; ++k) { const int lt = k >> 6, d = k & 63; a += (bf2f(KV[(size_t)(16 * c + lt) * NKV + j * 256 + g * 64 + d]) + pos[j * 2048 + k]) * W1[((size_t)j * 2048 + k) * 256 + tid]; }
        hid[tid] = gelu_tanh(a); }
    __syncthreads();
    float num = 0.f, den = 0.f;
    if (tid < 64) { float o = b2[j * 64 + tid]; for (int n = 0; n < 256; ++n) o += hid[n] * W2[((size_t)j * 256 + n) * 64 + tid];
        const float got = bf2f(KCMP[((size_t)j * 4096 + (size_t)c * 4 + g) * 64 + tid]); num = (o - got) * (o - got); den = o * o; }
    if (tid < 64) dbg_acc(ctl, 3, num, den);
    __syncthreads();
}

__device__ __forceinline__ void dbg_check_gemm(unsigned* ctl, int slot, const bf16* A, int K, const float* W, int ldw, int ncols, const float* bias, const bf16* out, int ldo, int qmode) {
    const int lane = threadIdx.x & 63, w = blockIdx.x * 8 + (threadIdx.x >> 6);
    const int row = (int)(((unsigned)w * 2654435761u) >> 18) & (SEQ - 1), col = (int)(((unsigned)w * 40503u + 11u) % (unsigned)ncols);
    float a = 0.f; for (int k = lane; k < K; k += 64) a += bf2f(A[(size_t)row * K + k]) * W[(size_t)k * ldw + col];
    a = wave_sum(a) + (bias ? bias[col] : 0.f);
    if (qmode == 2 || (qmode == 1 && ((col >> 10) % 3) == 0)) a *= C1;
    const float got = bf2f(ldo ? out[(size_t)row * ldo + col] : out[(size_t)(col >> 6) * ((size_t)SEQ * 64) + (size_t)row * 64 + (col & 63)]);
    if (lane == 0) { atomicAdd((float*)(ctl + CW_DBG) + 2 * slot, (a - got) * (a - got)); atomicAdd((float*)(ctl + CW_DBG) + 2 * slot + 1, a * a); }
}
__device__ __forceinline__ void dbg_check_outproj(unsigned* ctl, const bf16* Ob, const float* W, const float* HF, const bf16* HB) {
    const int lane = threadIdx.x & 63, w = blockIdx.x * 8 + (threadIdx.x >> 6);
    const int row = (int)(((unsigned)w * 2654435761u) >> 18) & (SEQ - 1), col = (int)(((unsigned)w * 40503u + 11u) % 1024u);
    float a = 0.f; for (int k = lane; k < DM; k += 64) a += bf2f(Ob[(size_t)row * DM + k]) * W[(size_t)k * DM + col];
    a = wave_sum(a);
    const float got = HF[(size_t)row * DM + col] - ALPHA * bf2f(HB[(size_t)row * DM + col]);
    if (lane == 0) { atomicAdd((float*)(ctl + CW_DBG) + 14, (a - got) * (a - got)); atomicAdd((float*)(ctl + CW_DBG) + 15, a * a); }
}
__device__ __forceinline__ void dbg_check_route(unsigned* ctl, const bf16* HB, const float* Wr, const float* br, const int4* ROUTE) {
    const int lane = threadIdx.x & 63, w = blockIdx.x * 8 + (threadIdx.x >> 6); const int t = (int)(((unsigned)w * 7919u + 3u) % 16384u);
    float lg[20];
#pragma unroll
    for (int c = 0; c < 20; ++c) { float a = 0.f; for (int k = lane; k < DM; k += 64) a += bf2f(HB[(size_t)t * DM + k]) * Wr[(size_t)k * 20 + c]; lg[c] = wave_sum(a) + br[c]; }
    float num = 0.f, den = 0.f;
    if (lane == 0) {
        int gi = 0; float gm = lg[0];
#pragma unroll
        for (int k = 1; k < 4; ++k) if (lg[k] > gm) { gm = lg[k]; gi = k; }
        float dsum = 0.f;
#pragma unroll
        for (int k = 0; k < 4; ++k) dsum += __expf(lg[k] - gm);
        const float gw = 1.0f / dsum; float ev[4];
#pragma unroll
        for (int k = 0; k < 4; ++k) { float v = 0.f;
#pragma unroll
            for (int c = 0; c < 16; ++c) v = (c == 4 * gi + k) ? lg[4 + c] : v; ev[k] = v; }
        int i0 = 0; float v0 = ev[0];
#pragma unroll
        for (int k = 1; k < 4; ++k) if (ev[k] > v0) { v0 = ev[k]; i0 = k; }
        int i1 = -1; float v1 = -3e38f;
#pragma unroll
        for (int k = 0; k < 4; ++k) if (k != i0 && ev[k] > v1) { v1 = ev[k]; i1 = k; }
        const float tt = __expf(v1 - v0), w0 = gw / (1.0f + tt), w1 = gw * tt / (1.0f + tt);
        const int4 r = ROUTE[t];
#pragma unroll
        for (int e = 0; e < 16; ++e) { const float cr = (e == 4 * gi + i0 ? w0 : 0.f) + (e == 4 * gi + i1 ? w1 : 0.f);
            const float cm = (e == r.x ? __int_as_float(r.z) : 0.f) + (e == r.y ? __int_as_float(r.w) : 0.f); num += (cr - cm) * (cr - cm); den += cr * cr; }
        atomicAdd((float*)(ctl + CW_DBG) + 10, num); atomicAdd((float*)(ctl + CW_DBG) + 11, den);
    }
}
__device__ __forceinline__ void dbg_check_gates(unsigned* ctl, const bf16* HB, const float* Wq, const float* bq, const float* GATES) {
    const int lane = threadIdx.x & 63, w = blockIdx.x * 8 + (threadIdx.x >> 6); const int t = (int)(((unsigned)w * 7919u + 3u) % 16384u), c = w % 48;
    float a = 0.f; for (int k = lane; k < DM; k += 64) a += bf2f(HB[(size_t)t * DM + k]) * Wq[(size_t)k * 1072 + 1024 + c];
    a = wave_sum(a) + bq[1024 + c]; const float ref = 1.0f / (1.0f + __expf(-a)), got = GATES[(size_t)t * 48 + c];
    if (lane == 0) { atomicAdd((float*)(ctl + CW_DBG) + 12, (ref - got) * (ref - got)); atomicAdd((float*)(ctl + CW_DBG) + 13, ref * ref); }
}
#ifndef DBG_MASK
#define DBG_MASK 0xff
#endif
__device__ __forceinline__ float dbg_scale(unsigned* ctl) {
    float e = 0.f;
    for (int i = 0; i < 8; ++i) { if (!((DBG_MASK >> i) & 1)) continue; const float num = __hip_atomic_load((float*)(ctl + CW_DBG) + 2 * i, __ATOMIC_RELAXED, __HIP_MEMORY_SCOPE_AGENT), den = __hip_atomic_load((float*)(ctl + CW_DBG) + 2 * i + 1, __ATOMIC_RELAXED, __HIP_MEMORY_SCOPE_AGENT);
        const float r = (den > 0.f) ? sqrtf(num / den) : 7.77f; e = fmaxf(e, r); }
    return 1.0f + 10.0f * e;
}
#endif
struct Args { const float* in[20]; float* out; unsigned char* ws; int ph_lo, ph_hi; };
enum { I_X = 0, I_AWIN, I_AWOUT, I_BWKV, I_CPOS, I_CW1, I_CB1, I_CW2, I_CB2, I_BWQ, I_BBQ, I_BWOUT, I_MWR, I_MBR, I_MWGU, I_MWDN, I_LMG, I_LMB, I_LFG, I_LFB };
typedef const __attribute__((address_space(4))) Args* KArgs;
__device__ __forceinline__ KArgs kargs() { KArgs p = (KArgs)__builtin_amdgcn_kernarg_segment_ptr(); asm volatile("" : "+s"(p)); return p; }

struct Ids { int lane, wave, gw, NGW, G, bx; };
__device__ __forceinline__ Ids ids() {
    Ids d; const int tid = threadIdx.x; d.lane = tid & 63; d.wave = __builtin_amdgcn_readfirstlane(tid >> 6); d.G = gridDim.x; d.bx = blockIdx.x;
    const int vcu = (d.G % 8 == 0) ? (d.bx % 8) * (d.G / 8) + d.bx / 8 : d.bx;
    d.gw = vcu * NWAVES + d.wave; d.NGW = d.G * NWAVES; return d;
}

#ifdef TIMEPROBE
constexpr int CW_TP = 20000;
#define TP_START(k) do { if (blockIdx.x == 0 && threadIdx.x == 0) { unsigned* c_ = (unsigned*)(kargs()->ws + WS_CTL) + CW_TP; const unsigned now_ = (unsigned)__builtin_amdgcn_s_memrealtime(); \
    if ((k) == TP_A0 && (k) >= lo) c_[0] = now_; if ((k) == TP_B0 && (k) >= lo) c_[2] = now_; } } while (0)
#define TP_STOP(k) do { if (blockIdx.x == 0 && threadIdx.x == 0) { unsigned* c_ = (unsigned*)(kargs()->ws + WS_CTL) + CW_TP; const unsigned now_ = (unsigned)__builtin_amdgcn_s_memrealtime(); \
    if ((k) == TP_A1) c_[1] = now_ - c_[0]; if ((k) == TP_B1) c_[3] = now_ - c_[2]; } } while (0)
#else
#define TP_START(k) do { } while (0)
#define TP_STOP(k) do { } while (0)
#endif
#define PHASE_IF(k) TP_START(k); if ((k) >= lo && (k) < hi)
#define PHASE_BAR(k) do { if ((k) >= lo && (k) + 1 < hi) xcd_barrier(bar); TP_STOP(k); } while (0)

__device__ __forceinline__ void phase_prologue(LAS unsigned char* lds) {
    KArgs ka = kargs(); unsigned char* ws = ka->ws; const Ids d = ids(); const int lane = d.lane, gw = d.gw, NGW = d.NGW;
    LAS float* scr = (LAS float*)(lds + d.wave * 16384);
    for (int l = 0; l < 2; ++l) tc_matrix(ka->in[I_AWIN] + (size_t)l * DM * NQKV, NQKV, DM, 0, NQKV, (bf16*)(ws + WS_WIN) + (size_t)l * NQKV * DM, NQKV, scr, lane, gw, NGW);
    for (int l = 0; l < 2; ++l) tc_matrix(ka->in[I_AWOUT] + (size_t)l * DM * DM, DM, DM, 0, DM, (bf16*)(ws + WS_WOUTA) + (size_t)l * DM * DM, DM, scr, lane, gw, NGW);
    tc_matrix(ka->in[I_BWKV], NKV, DM, 0, NKV, (bf16*)(ws + WS_WKV), NKV, scr, lane, gw, NGW);
    for (int i = 0; i < 2; ++i) {
        tc_matrix(ka->in[I_BWQ] + (size_t)i * DM * 1072, 1072, DM, 0, 1024, (bf16*)(ws + WS_WQ) + (size_t)i * DM * DM, DM, scr, lane, gw, NGW);
        tc_matrix(ka->in[I_BWQ] + (size_t)i * DM * 1072, 1072, DM, 1024, 48, (bf16*)(ws + WS_WG) + (size_t)i * 64 * DM, 64, scr, lane, gw, NGW);
        tc_matrix(ka->in[I_BWOUT] + (size_t)i * DM * DM, DM, DM, 0, DM, (bf16*)(ws + WS_WOUTB) + (size_t)i * DM * DM, DM, scr, lane, gw, NGW);
    }
    for (int l = 0; l < 4; ++l) tc_matrix(ka->in[I_MWR] + (size_t)l * DM * 20, 20, DM, 0, 20, (bf16*)(ws + WS_WR) + (size_t)l * 32 * DM, 32, scr, lane, gw, NGW);
    for (int j = 0; j < 2; ++j) {
        tc_matrix(ka->in[I_CW1] + (size_t)j * 2048 * 256, 256, 2048, 0, 256, (bf16*)(ws + WS_W1T) + (size_t)j * 256 * 2048, 256, scr, lane, gw, NGW);
        tc_matrix(ka->in[I_CW2] + (size_t)j * 256 * 64, 64, 256, 0, 64, (bf16*)(ws + WS_W2T) + (size_t)j * 64 * 256, 64, scr, lane, gw, NGW);
    }
    convert_moe_weights(ka->in[I_MWGU], ka->in[I_MWDN], (bf16*)(ws + WS_WGU), (bf16*)(ws + WS_WDN), scr, lane, gw, NGW);
    float* B1P = (float*)(ws + WS_B1P);
    for (int it = gw; it < 128; it += NGW) { const int j = it >> 6, nb = (it >> 4) & 3, ks = it & 15, n = nb * 64 + lane;
        const float* W1 = ka->in[I_CW1] + (size_t)j * 2048 * 256; const float* pos = ka->in[I_CPOS] + (size_t)j * 2048; float a = 0.f;
        for (int k = ks * 128; k < ks * 128 + 128; ++k) a += pos[k] * W1[(size_t)k * 256 + n];
        B1P[(j * 16 + ks) * 256 + n] = a; }
    const float* x = ka->in[I_X]; bf16* HB = (bf16*)(ws + WS_HB);
    for (int row = gw; row < SEQ; row += NGW) {
#pragma unroll
        for (int j = 0; j < 4; ++j) { const f32x4 v = *(const f32x4*)(x + (size_t)row * DM + 4 * lane + 256 * j);
            u32x2 w; w.x = pk2(v[0], v[1]); w.y = pk2(v[2], v[3]); *(u32x2*)(HB + (size_t)row * DM + 4 * lane + 256 * j) = w; }
    }
}

template <int L, int KIND, bool CONVERT>
__device__ __forceinline__ void phase_proj(LAS unsigned char* lds) {
    KArgs ka = kargs(); unsigned char* ws = ka->ws; const Ids d = ids();
    if (CONVERT) {
        convert_moe_weights(ka->in[I_MWGU] + (size_t)L * 16 * 1024 * 512, ka->in[I_MWDN] + (size_t)L * 16 * 256 * 1024, (bf16*)(ws + WS_WGU), (bf16*)(ws + WS_WDN),
                            (LAS float*)(lds + d.wave * 16384), d.lane, d.gw, d.NGW);
        __syncthreads();
    }
    const bf16* HB = (const bf16*)(ws + WS_HB);
#ifndef NO_G1
    if (KIND == 0) { pg8::Gemm gm{HB, (const bf16*)(ws + WS_WIN) + (size_t)L * NQKV * DM, SEQ, NQKV, DM}; EpiHeadMajor E{(bf16*)(ws + WS_BIG), nullptr, 1};
        pg8::StaticOrder S; S.init(SEQ, NQKV, d.G, d.bx); pg8::gemm_phase<EpiHeadMajor, pg8::StaticOrder, false>(lds, gm, S, E, nullptr); }
    else if (KIND == 1) { pg8::Gemm gm{HB, (const bf16*)(ws + WS_WKV), SEQ, NKV, DM}; pg8::EpiBf16<0> E{(bf16*)(ws + BIG_KV), NKV, nullptr, 0, 0};
        pg8::StaticOrder S; S.init(SEQ, NKV, d.G, d.bx); pg8::gemm_phase<pg8::EpiBf16<0>, pg8::StaticOrder, false>(lds, gm, S, E, nullptr); }
    else { pg8::Gemm gm{HB, (const bf16*)(ws + WS_WQ) + (size_t)(L - 2) * DM * DM, SEQ, DM, DM}; EpiHeadMajor E{(bf16*)(ws + BIG_Q), ka->in[I_BBQ] + (size_t)(L - 2) * 1072, 2};
        pg8::StaticOrder S; S.init(SEQ, DM, d.G, d.bx); pg8::gemm_phase<EpiHeadMajor, pg8::StaticOrder, false>(lds, gm, S, E, nullptr); }
#endif
}
__device__ __forceinline__ void phase_compress(LAS unsigned char* lds) {
    KArgs ka = kargs(); unsigned char* ws = ka->ws;
    compress_phase(lds, (const bf16*)(ws + BIG_KV), (const bf16*)(ws + WS_W1T), (const bf16*)(ws + WS_W2T), (const float*)(ws + WS_B1P), ka->in[I_CB1], ka->in[I_CB2], (bf16*)(ws + BIG_KCMP));
}
__device__ __forceinline__ void phase_attn_dilated(LAS unsigned char* lds) {
    KArgs ka = kargs(); unsigned char* ws = ka->ws; const Ids d = ids();
    const bf16* QKV = (const bf16*)(ws + WS_BIG); bf16* OB = (bf16*)(ws + WS_O); LAS unsigned char* slab = lds + d.wave * 16384;
#ifndef NO_DIL
#ifdef ATT_V2
    for (int it = d.bx; it < 1024; it += d.G) dil_block(QKV, OB, it >> 4, it & 15, lds, d.wave, d.lane);
#else
    for (int it = d.gw; it < 8192; it += d.NGW) { const int rr = it & 15, h = (it >> 4) & 15, B = it >> 8; dil_item(QKV, OB, B, rr, h, slab, d.lane); }
#endif
#endif
}
__device__ __forceinline__ void phase_attn_nsa(LAS unsigned char* lds) {
    KArgs ka = kargs(); unsigned char* ws = ka->ws; const Ids d = ids();
    const bf16* KCMP = (const bf16*)(ws + BIG_KCMP); LAS unsigned char* slab = lds + d.wave * NSA_SLAB;
#ifndef NO_NSA
#ifdef NSA_CHUNK
    for (int idx = d.bx; idx < 1024; idx += d.G) { const int k = idx >> 8, b = idx & 255, b0 = (k & 2) ? ((b + 128) & 255) : b, ch = (k & 1) ? 255 - b0 : b0;
        nsa_chunk((const bf16*)(ws + BIG_Q), (const bf16*)(ws + BIG_KV), KCMP, KCMP + 1024 * 256, (const float*)(ws + WS_GATES), (bf16*)(ws + WS_O), ch, k, lds, d.wave, d.lane); }
    (void)slab;
#else
    for (int k = 0; k < 4; ++k) { const int idx = ((k & 1) ? (d.NGW - 1 - d.gw) : d.gw) + d.NGW * k;
        if (idx < 8192) nsa_item((const bf16*)(ws + BIG_Q), (const bf16*)(ws + BIG_KV), KCMP, KCMP + 1024 * 256, (const float*)(ws + WS_GATES), (bf16*)(ws + WS_O), idx >> 2, idx & 3, slab, d.lane); }
#endif
#endif
}
template <int L>
__device__ __forceinline__ void phase_outproj(LAS unsigned char* lds) {
    KArgs ka = kargs(); unsigned char* ws = ka->ws; const Ids d = ids();
    const bf16* Wt = (L < 2) ? (const bf16*)(ws + WS_WOUTA) + (size_t)L * DM * DM : (const bf16*)(ws + WS_WOUTB) + (size_t)(L - 2) * DM * DM;
    pg8::Gemm gm{(const bf16*)(ws + WS_O), Wt, SEQ, DM, DM}; EpiResid E{(bf16*)(ws + WS_HB)};
    pg8::StaticOrder S; S.init(SEQ, DM, d.G, d.bx);
#ifndef NO_G2
    pg8::gemm_phase<EpiResid, pg8::StaticOrder, false>(lds, gm, S, E, nullptr);
#endif
}
template <int L>
__device__ __forceinline__ void phase_ln_mix(LAS unsigned char* lds) {
    KArgs ka = kargs(); unsigned char* ws = ka->ws;
    ln_phase(lds, 0, 1.0f, nullptr, ka->in[I_LMG] + (size_t)L * DM, ka->in[I_LMB] + (size_t)L * DM, nullptr, 1.0f, (bf16*)(ws + WS_HB),
             (const bf16*)(ws + WS_WR) + (size_t)L * 32 * DM, ka->in[I_MBR] + (size_t)L * 20, (int4*)(ws + WS_ROUTE), (int*)(ws + WS_HIST), nullptr);
}
__device__ __forceinline__ void phase_scatter(LAS unsigned char* lds) {
    KArgs ka = kargs(); unsigned char* ws = ka->ws;
    moe_scatter(lds, (const int4*)(ws + WS_ROUTE), (const int*)(ws + WS_HIST), (int*)(ws + WS_TILEB), (int*)(ws + WS_ROWINFO), (float*)(ws + WS_ROWW));
}
__device__ __forceinline__ void load_tileb(LAS unsigned char* lds, const int* TILEB) {
    LAS int* tb = (LAS int*)(lds + LDS_MISC);
    if (threadIdx.x < 17) tb[threadIdx.x] = TILEB[threadIdx.x];
    __syncthreads();
}
__device__ __forceinline__ void phase_moe_up(LAS unsigned char* lds) {
    KArgs ka = kargs(); unsigned char* ws = ka->ws; const Ids d = ids();
    load_tileb(lds, (const int*)(ws + WS_TILEB));
    pg8::Gemm gm{(const bf16*)(ws + WS_HB), (const bf16*)(ws + WS_WGU), MAXROWS, 512, DM}; EpiSwiglu E{(bf16*)(ws + BIG_HID), (const float*)(ws + WS_ROWW)};
    MoeGatherOrder S; S.init((const LAS int*)(lds + LDS_MISC), 2, d.G, d.bx);
    {
        LAS int* rowtab = (LAS int*)(lds + LDS_MISC) + 64; const int* ROWINFO = (const int*)(ws + WS_ROWINFO);
        for (int i = 0; i < 4; ++i) { pg8::Unit u; if (!S.next(i, u)) break;
            if (threadIdx.x < 256) { const int info = ROWINFO[u.pm * 256 + threadIdx.x]; rowtab[i * 256 + threadIdx.x] = (info < 0 ? 0 : (info >> 1)) * (DM * 2); } }
        __syncthreads();
    }
#ifndef NO_M2
    pg8::gemm_phase<EpiSwiglu, MoeGatherOrder, false>(lds, gm, S, E, nullptr);
#endif
}
__device__ __forceinline__ void phase_moe_down(LAS unsigned char* lds) {
    KArgs ka = kargs(); unsigned char* ws = ka->ws; const Ids d = ids();
    load_tileb(lds, (const int*)(ws + WS_TILEB));
    pg8::Gemm gm{(const bf16*)(ws + BIG_HID), (const bf16*)(ws + WS_WDN), MAXROWS, 1024, 256}; EpiScatter E{(bf16*)(ws + BIG_Y), (const int*)(ws + WS_ROWINFO)};
    MoeOrder S; S.init((const LAS int*)(lds + LDS_MISC), 4, d.G, d.bx);
#ifndef NO_M3
    pg8::gemm_phase<EpiScatter, MoeOrder, false>(lds, gm, S, E, nullptr);
#endif
}
#if defined(TIMEPROBE)
#define DBG_OUT_SCALE (1.0f + (float)(((unsigned*)(ws + WS_CTL))[CW_TP + 1]) * (0.01f / 5000.0f))
#elif DBG_CHECK
#define DBG_OUT_SCALE dbg_scale((unsigned*)(ws + WS_CTL))
#else
#define DBG_OUT_SCALE 1.0f
#endif
template <int L>
__device__ __forceinline__ void phase_ln_ffn(LAS unsigned char* lds) {
    KArgs ka = kargs(); unsigned char* ws = ka->ws;
    constexpr bool last = (L == 3), gates = (L == 1 || L == 2);
    ln_phase(lds, gates ? 1 : 2, ALPHA, (const bf16*)(ws + BIG_Y), ka->in[I_LFG] + (size_t)L * DM, ka->in[I_LFB] + (size_t)L * DM, last ? ka->out : nullptr,
             last ? DBG_OUT_SCALE : 1.0f, (bf16*)(ws + WS_HB), (const bf16*)(ws + WS_WG) + (size_t)(gates ? L - 1 : 0) * 64 * DM, ka->in[I_BBQ] + (size_t)(gates ? L - 1 : 0) * 1072 + 1024,
             nullptr, nullptr, (float*)(ws + WS_GATES));
#ifdef TIMEPROBE
    if (last && blockIdx.x == 0 && threadIdx.x == 0) { asm volatile("s_waitcnt vmcnt(0)" ::: "memory"); ka->out[0] = (float)(((unsigned*)(ws + WS_CTL))[CW_TP + 3]) * (0.01f / 10.0f); }
#endif
}


#if DBG_CHECK
template <int L, int WHERE>
__device__ __forceinline__ void dbg_hook(LAS unsigned char* lds, const XcdBarrier& bar) {
    KArgs ka = kargs(); unsigned char* ws = ka->ws; unsigned* ctl = (unsigned*)(ws + WS_CTL);
    const bf16* HB = (const bf16*)(ws + WS_HB); const bf16* KCMP = (const bf16*)(ws + BIG_KCMP);
    if (WHERE == 0) {
        if (L == 2) dbg_check_compress(lds, ctl, (const bf16*)(ws + BIG_KV), ka->in[I_CPOS], ka->in[I_CW1], ka->in[I_CB1], ka->in[I_CW2], ka->in[I_CB2], KCMP);
        if (L == 2) dbg_check_gemm(ctl, 4, HB, DM, ka->in[I_BWKV], NKV, NKV, nullptr, (const bf16*)(ws + BIG_KV), NKV, 0);
        if (L == 3) dbg_check_gates(ctl, HB, ka->in[I_BWQ] + (size_t)(L - 2) * DM * 1072, ka->in[I_BBQ] + (size_t)(L - 2) * 1072, (const float*)(ws + WS_GATES));
    }
    if (WHERE == 5) { if (L == 2) dbg_check_gates(ctl, HB, ka->in[I_BWQ], ka->in[I_BBQ], (const float*)(ws + WS_GATES)); }
    if (WHERE == 1) {
        if (L < 2) dbg_check_gemm(ctl, 4, HB, DM, ka->in[I_AWIN] + (size_t)L * DM * NQKV, NQKV, NQKV, nullptr, (const bf16*)(ws + WS_BIG), 0, 1);
        else dbg_check_gemm(ctl, 4, HB, DM, ka->in[I_BWQ] + (size_t)(L - 2) * DM * 1072, 1072, 1024, ka->in[I_BBQ] + (size_t)(L - 2) * 1072, (const bf16*)(ws + BIG_Q), 0, 2);
    }
    if (WHERE == 2) {
        if (L < 2) dbg_check_dilated(ctl, (const bf16*)(ws + WS_BIG), (const bf16*)(ws + WS_O));
        else dbg_check_nsa(lds, ctl, (const bf16*)(ws + BIG_Q), (const bf16*)(ws + BIG_KV), KCMP, KCMP + 1024 * 256, (const float*)(ws + WS_GATES), (const bf16*)(ws + WS_O));
    }
    if (WHERE == 3) dbg_check_outproj(ctl, (const bf16*)(ws + WS_O), (L < 2) ? ka->in[I_AWOUT] + (size_t)L * DM * DM : ka->in[I_BWOUT] + (size_t)(L - 2) * DM * DM, (const float*)(ws + WS_HF), HB);
    if (WHERE == 4) dbg_check_route(ctl, HB, ka->in[I_MWR] + (size_t)L * DM * 20, ka->in[I_MBR] + (size_t)L * 20, (const int4*)(ws + WS_ROUTE));
    if (WHERE == 6) dbg_check_moe(lds, ctl, HB, (const int4*)(ws + WS_ROUTE), ka->in[I_MWGU] + (size_t)L * 16 * 1024 * 512, ka->in[I_MWDN] + (size_t)L * 16 * 256 * 1024, (const bf16*)(ws + BIG_Y));
    xcd_barrier(bar);
}
#define DBG_HOOK(L, W) dbg_hook<L, W>(lds, bar)
#else
#define DBG_HOOK(L, W) do { } while (0)
#endif
template <int L>
__device__ __forceinline__ void layer_phases(LAS unsigned char* lds, const XcdBarrier& bar, const int lo, const int hi) {
    constexpr int PB = (L == 0) ? 1 : ((L == 1) ? 9 : ((L == 2) ? 17 : 27));
    constexpr int P1 = (L == 2) ? PB + 2 : PB;
    if (L == 2) {
        PHASE_IF(PB) { DBG_HOOK(L, 5); phase_proj<L, 1, true>(lds); }
        PHASE_BAR(PB);
        PHASE_IF(PB + 1) phase_compress(lds);
        PHASE_BAR(PB + 1);
        PHASE_IF(P1) { DBG_HOOK(L, 0); phase_proj<L, 2, false>(lds); }
        PHASE_BAR(P1);
    } else if (L == 3) {
        PHASE_IF(P1) { DBG_HOOK(L, 0); phase_proj<L, 2, true>(lds); }
        PHASE_BAR(P1);
    } else {
        PHASE_IF(P1) phase_proj<L, 0, (L > 0)>(lds);
        PHASE_BAR(P1);
    }
    PHASE_IF(P1 + 1) { DBG_HOOK(L, 1); if (L < 2) phase_attn_dilated(lds); else phase_attn_nsa(lds);
#ifdef DUP_MASK
        if (L < 2 && (DUP_MASK & 4)) { __syncthreads(); phase_attn_dilated(lds); }
        if (L >= 2 && (DUP_MASK & 8)) { __syncthreads(); phase_attn_nsa(lds); }
#endif
    }
    PHASE_BAR(P1 + 1);
    PHASE_IF(P1 + 2) { DBG_HOOK(L, 2); phase_outproj<L>(lds); }
    PHASE_BAR(P1 + 2);
    PHASE_IF(P1 + 3) { DBG_HOOK(L, 3); phase_ln_mix<L>(lds); }
    PHASE_BAR(P1 + 3);
    PHASE_IF(P1 + 4) { DBG_HOOK(L, 4); phase_scatter(lds);
#ifdef DUP_MASK
        if (DUP_MASK & 16) { __syncthreads(); phase_scatter(lds); }
#endif
    }
    PHASE_BAR(P1 + 4);
    PHASE_IF(P1 + 5) { phase_moe_up(lds);
#ifdef DUP_MASK
        if (DUP_MASK & 32) { __syncthreads(); phase_moe_up(lds); }
#endif
    }
    PHASE_BAR(P1 + 5);
    PHASE_IF(P1 + 6) { phase_moe_down(lds);
#ifdef DUP_MASK
        if (DUP_MASK & 64) { __syncthreads(); phase_moe_down(lds); }
#endif
    }
    PHASE_BAR(P1 + 6);
    PHASE_IF(P1 + 7) { DBG_HOOK(L, 6); phase_ln_ffn<L>(lds); }
    PHASE_BAR(P1 + 7);
}
constexpr int NPHASES = 35;

__global__ void __launch_bounds__(NTHREADS, 2) yoco_fwd(Args args) {
    extern __shared__ __attribute__((aligned(16))) unsigned char lds_raw[];
    LAS unsigned char* lds = (LAS unsigned char*)lds_raw;
    const int lo = args.ph_lo, hi = args.ph_hi;
    if (threadIdx.x < 4) ((LAS unsigned*)(lds + LDS_BAR))[threadIdx.x] = 0u;
    __syncthreads();
    unsigned* barw = (unsigned*)(args.ws + WS_CTL) + CW_BAR;
    XcdBarrier bar; bar.bar = barw; bar.x = 0; bar.st = (volatile LAS unsigned*)(lds + LDS_BAR);
    if (hi - lo > 1) bar = xcd_barrier_post(barw, (volatile LAS unsigned*)(lds + LDS_BAR));
    PHASE_IF(0) { phase_prologue(lds);
#ifdef DUP_MASK
        if (DUP_MASK & 1) { __syncthreads(); phase_prologue(lds); }
#endif
    }
    PHASE_BAR(0);
    layer_phases<0>(lds, bar, lo, hi);
    layer_phases<1>(lds, bar, lo, hi);
    layer_phases<2>(lds, bar, lo, hi);
    layer_phases<3>(lds, bar, lo, hi);
}

extern "C" void kernel_launch(void* const* d_in, const int* in_sizes, int n_in, void* d_out, int out_size, void* d_ws, size_t ws_size, hipStream_t stream) {
    static int grid = 0;
    if (grid == 0) {
        if (n_in != 20 || out_size != SEQ * DM || ws_size < WS_END) { fprintf(stderr, "kernel_launch: unexpected problem shape (n_in %d, out %d, ws %zu)\n", n_in, out_size, ws_size); grid = -1; return; }
        int dev = 0, cus = 0;
        if (hipGetDevice(&dev) != hipSuccess || hipDeviceGetAttribute(&cus, hipDeviceAttributeMultiprocessorCount, dev) != hipSuccess) { grid = -1; return; }
        if (hipFuncSetAttribute((const void*)yoco_fwd, hipFuncAttributeMaxDynamicSharedMemorySize, LDS_BYTES) != hipSuccess) { fprintf(stderr, "kernel_launch: hipFuncSetAttribute failed\n"); grid = -1; return; }
        int per_cu = 0;
        if (hipOccupancyMaxActiveBlocksPerMultiprocessor(&per_cu, (const void*)yoco_fwd, NTHREADS, LDS_BYTES) != hipSuccess || per_cu < 1) fprintf(stderr, "kernel_launch: occupancy query says %d\n", per_cu);
        (void)hipGetLastError();
        grid = cus;
    }
    if (grid < 0) return;
    (void)hipMemsetAsync((char*)d_ws + WS_CTL, 0, CTL_BYTES, stream);
    Args a{};
    for (int i = 0; i < 20; ++i) a.in[i] = (const float*)d_in[i];
    a.out = (float*)d_out; a.ws = (unsigned char*)d_ws;
#if MK_ONE_LAUNCH
    a.ph_lo = 0; a.ph_hi = NPHASES;
    hipLaunchKernelGGL(yoco_fwd, dim3(grid), dim3(NTHREADS), LDS_BYTES, stream, a);
#else
    for (int ph = 0; ph < NPHASES; ++ph) { a.ph_lo = ph; a.ph_hi = ph + 1; hipLaunchKernelGGL(yoco_fwd, dim3(grid), dim3(NTHREADS), LDS_BYTES, stream, a); }
#endif
}
```
